# Optimizing an MI355X kernel written in HIP

```python
import jax
import jax.numpy as jnp
from jax import lax
import numpy as np


D_MODEL = 1024
BATCH = 4
SEQ = 4096
DEPTH = 1

ML_HEADS = 4
ML_HEAD_DIM = 128
ML_WIDTH = ML_HEADS * ML_HEAD_DIM
ML_CONV = 4
ML_CHUNK = 64
NSA_HEADS = 8
NSA_KV_GROUPS = 2
NSA_HEAD_DIM = 64
NSA_WIDTH = NSA_HEADS * NSA_HEAD_DIM
NSA_KV_WIDTH = NSA_KV_GROUPS * NSA_HEAD_DIM
NSA_N_BRANCH = 3
CMP_BLOCK = 32
CMP_STRIDE = 16
CMP_HIDDEN = 128
SEL_BLOCK = 64
SEL_COUNT = 16
SEL_FORCE = 1e4
WINDOW = 512
NSA_QBLOCK = 64
N_MIXERS = 2
MEM_TOKENS = 256
XA_HEADS = 4
XA_HEAD_DIM = D_MODEL // XA_HEADS
XA_WIDTH = XA_HEADS * XA_HEAD_DIM
MOE_GROUPS = 4
MOE_EXPERTS_PER_GROUP = 4
MOE_EXPERTS = MOE_GROUPS * MOE_EXPERTS_PER_GROUP
MOE_TOPK = 2
MOE_HIDDEN = 512

RMS_EPS = 1e-6
NEG_INF = -1e30
IN_SPLITS = (ML_WIDTH,) * 4 + (ML_HEADS,) * 2 + (NSA_WIDTH,) + (NSA_KV_WIDTH,) * 6 + (NSA_N_BRANCH * NSA_HEADS, N_MIXERS * D_MODEL)
D_IN = 4 * ML_WIDTH + 2 * ML_HEADS + NSA_WIDTH + 6 * NSA_KV_WIDTH + NSA_N_BRANCH * NSA_HEADS + N_MIXERS * D_MODEL

kernel_name = 'hybrid_mlstm_nsa_hmoe_block'


def rms_norm(x, g):
    xf = x.astype(jnp.float32)
    y = xf * lax.rsqrt(jnp.mean(xf * xf, axis=-1, keepdims=True) + RMS_EPS)
    return (y * g.astype(jnp.float32)).astype(x.dtype)


def alibi_slopes(n_heads):
    return jnp.exp2(-8.0 * jnp.arange(1, n_heads + 1, dtype=jnp.float32) / n_heads)


def causal_depthwise_conv(x, w):
    width, channels = w.shape
    return lax.conv_general_dilated(x, w[:, None, :].astype(x.dtype), window_strides=(1,), padding=[(width - 1, 0)], dimension_numbers=('NWC', 'WIO', 'NWC'), feature_group_count=channels)


def mlstm_chunkwise(q, k, v, i_pre, log_f):
    B, H, S, d = q.shape
    L = ML_CHUNK
    nc = S // L

    def to_chunks(a):
        return jnp.moveaxis(a.reshape(B, H, nc, L, *a.shape[3:]), 2, 0)

    tri = jnp.tril(jnp.ones((L, L), dtype=bool))

    def step(carry, xs):
        C, n, m = carry
        qc, kc, vc, ic, fc = xs
        b = jnp.cumsum(fc, axis=-1)
        dlog = jnp.where(tri, b[..., :, None] - b[..., None, :] + ic[..., None, :], -jnp.inf)
        inter = b + m[..., None]
        mt = jnp.maximum(jnp.max(dlog, axis=-1), inter)
        w_intra = jnp.exp(dlog - mt[..., None])
        w_inter = jnp.exp(inter - mt)
        s = jnp.einsum('bhtd,bhsd->bhts', qc, kc) * w_intra
        num = jnp.einsum('bhts,bhsd->bhtd', s, vc) + w_inter[..., None] * jnp.einsum('bhvk,bhtk->bhtv', C, qc)
        den = jnp.sum(s, axis=-1) + w_inter * jnp.einsum('bhk,bhtk->bht', n, qc)
        h = num / jnp.maximum(jnp.abs(den), jnp.exp(-mt))[..., None]
        bl = b[..., -1]
        logw = bl[..., None] - b + ic
        m_new = jnp.maximum(bl + m, jnp.max(logw, axis=-1))
        decay = jnp.exp(bl + m - m_new)
        ws = jnp.exp(logw - m_new[..., None])
        C_new = decay[..., None, None] * C + jnp.einsum('bhsv,bhsk->bhvk', vc * ws[..., None], kc)
        n_new = decay[..., None] * n + jnp.einsum('bhs,bhsk->bhk', ws, kc)
        return (C_new, n_new, m_new), h

    init = (jnp.zeros((B, H, d, d), jnp.float32), jnp.zeros((B, H, d), jnp.float32), jnp.zeros((B, H), jnp.float32))
    _, h = lax.scan(step, init, (to_chunks(q), to_chunks(k), to_chunks(v), to_chunks(i_pre), to_chunks(log_f)))
    return jnp.moveaxis(h, 0, 2).reshape(B, H, S, d)


def nsa_attention(q, k_cmp, v_cmp, k_slc, v_slc, k_win, v_win, gates, cmp_pos_k, cmp_pos_v, cmp_k_w1, cmp_k_w2, cmp_v_w1, cmp_v_w2):
    B, S, _ = q.shape
    H, G, dh = NSA_HEADS, NSA_KV_GROUPS, NSA_HEAD_DIM
    HG = H // G
    QB = NSA_QBLOCK
    nqb = S // QB
    n_cmp = S // CMP_STRIDE - 1
    n_slc = S // SEL_BLOCK
    n_sel = min(SEL_COUNT, n_slc)
    f32 = jnp.float32
    slopes = alibi_slopes(H).reshape(G, HG)

    qh = (q.reshape(B, S, H, dh) * dh ** -0.5).transpose(0, 2, 1, 3)
    q_blocks = jnp.moveaxis(qh.reshape(B, H, nqb, QB, dh), 2, 0)
    g_blocks = jnp.moveaxis(jax.nn.sigmoid(gates.astype(f32)).reshape(B, nqb, QB, H, NSA_N_BRANCH), 1, 0)

    def kv(a):
        return a.reshape(B, S, G, dh)

    def compress(a, pos, w1, w2):
        ch = kv(a).reshape(B, S // CMP_STRIDE, CMP_STRIDE, G, dh)
        blk = jnp.concatenate([ch[:, :-1], ch[:, 1:]], axis=2) + pos[None, None, :, None, :]
        blk = blk.transpose(0, 3, 1, 2, 4).reshape(B, G, n_cmp, CMP_BLOCK * dh)
        return jax.nn.gelu(blk @ w1) @ w2

    Kc = compress(k_cmp, cmp_pos_k, cmp_k_w1, cmp_k_w2)
    Vc = compress(v_cmp, cmp_pos_v, cmp_v_w1, cmp_v_w2)
    cmp_start = jnp.arange(n_cmp) * CMP_STRIDE
    cmp_end = cmp_start + CMP_BLOCK - 1
    cmp_center = cmp_start.astype(f32) + (CMP_BLOCK - 1) / 2
    cs = cmp_start[:, None]
    ss = jnp.arange(n_slc)[None, :] * SEL_BLOCK
    overlap = jnp.clip(jnp.minimum(cs + CMP_BLOCK, ss + SEL_BLOCK) - jnp.maximum(cs, ss), 0, None).astype(f32) / CMP_BLOCK

    Ks = kv(k_slc).reshape(B, n_slc, SEL_BLOCK, G, dh).transpose(0, 3, 1, 2, 4)
    Vs = kv(v_slc).reshape(B, n_slc, SEL_BLOCK, G, dh).transpose(0, 3, 1, 2, 4)
    Kw = jnp.pad(kv(k_win).transpose(0, 2, 1, 3), ((0, 0), (0, 0), (WINDOW, 0), (0, 0)))
    Vw = jnp.pad(kv(v_win).transpose(0, 2, 1, 3), ((0, 0), (0, 0), (WINDOW, 0), (0, 0)))
    bi = jnp.arange(B)[:, None, None, None]
    gi = jnp.arange(G)[None, :, None, None]
    sel_off = jnp.arange(SEL_BLOCK)
    s_idx = jnp.arange(n_slc)

    def query_block(args):
        i, qb, gb = args
        t = i * QB + jnp.arange(QB)
        tf = t.astype(f32)
        qg = qb.reshape(B, G, HG, QB, dh)
        sc = jnp.einsum('bgxqd,bgjd->bgxqj', qg, Kc).astype(f32)
        valid_c = cmp_end[None, :] <= t[:, None]
        sc = jnp.where(valid_c, sc - slopes[None, :, :, None, None] * (tf[:, None] - cmp_center[None, :]), NEG_INF)
        p_cmp = jax.nn.softmax(sc, axis=-1) * valid_c
        o_cmp = jnp.einsum('bgxqj,bgjd->bgxqd', p_cmp.astype(Vc.dtype), Vc)
        p_slc = jnp.einsum('bgxqj,js->bgqs', p_cmp, overlap)
        cur = t // SEL_BLOCK
        forced = (s_idx[None, :] == 0) | (s_idx[None, :] == cur[:, None]) | (s_idx[None, :] == cur[:, None] - 1)
        future = s_idx[None, :] > cur[:, None]
        score = jnp.where(forced, SEL_FORCE, jnp.where(future, -SEL_FORCE, p_slc))
        _, idx = lax.top_k(score, n_sel)
        Kg = Ks[bi, gi, idx]
        Vg = Vs[bi, gi, idx]
        dist = t[None, None, :, None, None] - (idx[..., None] * SEL_BLOCK + sel_off)
        ssc = jnp.einsum('bgxqd,bgqnsd->bgxqns', qg, Kg).astype(f32)
        ssc = jnp.where((dist >= 0)[:, :, None], ssc - slopes[None, :, :, None, None, None] * dist[:, :, None].astype(f32), NEG_INF)
        p_s = jax.nn.softmax(ssc.reshape(B, G, HG, QB, n_sel * SEL_BLOCK), axis=-1).reshape(ssc.shape)
        o_slc = jnp.einsum('bgxqns,bgqnsd->bgxqd', p_s.astype(Vg.dtype), Vg)
        Kwb = lax.dynamic_slice_in_dim(Kw, i * QB, QB + WINDOW, axis=2)
        Vwb = lax.dynamic_slice_in_dim(Vw, i * QB, QB + WINDOW, axis=2)
        kp = i * QB - WINDOW + jnp.arange(QB + WINDOW)
        dw = t[:, None] - kp[None, :]
        valid_w = (dw >= 0) & (dw < WINDOW) & (kp[None, :] >= 0)
        sw = jnp.einsum('bgxqd,bgkd->bgxqk', qg, Kwb).astype(f32)
        sw = jnp.where(valid_w, sw - slopes[None, :, :, None, None] * dw.astype(f32), NEG_INF)
        o_win = jnp.einsum('bgxqk,bgkd->bgxqd', jax.nn.softmax(sw, axis=-1).astype(Vwb.dtype), Vwb)
        gb = gb.transpose(0, 2, 1, 3).reshape(B, G, HG, QB, NSA_N_BRANCH)
        o = gb[..., 0:1] * o_cmp + gb[..., 1:2] * o_slc + gb[..., 2:3] * o_win
        return o.reshape(B, H, QB, dh).astype(qb.dtype)

    out = lax.map(query_block, (jnp.arange(nqb), q_blocks, g_blocks))
    return out.transpose(1, 0, 3, 2, 4).reshape(B, S, H * dh)


def hybrid_mixer(h, w_in, conv_qk, b_igate, b_fgate, mlstm_norm, cmp_pos_k, cmp_pos_v, cmp_k_w1, cmp_k_w2, cmp_v_w1, cmp_v_w2, w_br_mlstm, w_br_nsa, w_mix_out):
    B, S, _ = h.shape
    f32 = jnp.float32
    offs = [int(o) for o in np.cumsum(IN_SPLITS)[:-1]]
    (ml_q, ml_k, ml_v, ml_o, ml_i, ml_f, ns_q, k_cmp, v_cmp, k_slc, v_slc, k_win, v_win, ns_gates, merge_pre) = jnp.split(h @ w_in, offs, axis=-1)
    qk = jax.nn.silu(causal_depthwise_conv(jnp.concatenate([ml_q, ml_k], axis=-1), conv_qk))
    ml_q, ml_k = jnp.split(qk, 2, axis=-1)

    def heads(a):
        return a.reshape(B, S, ML_HEADS, ML_HEAD_DIM).transpose(0, 2, 1, 3).astype(f32)

    i_pre = (ml_i.astype(f32) + b_igate.astype(f32)).transpose(0, 2, 1)
    log_f = jax.nn.log_sigmoid(ml_f.astype(f32) + b_fgate.astype(f32)).transpose(0, 2, 1)
    h_cell = mlstm_chunkwise(heads(ml_q), heads(ml_k) * ML_HEAD_DIM ** -0.5, heads(ml_v), i_pre, log_f)
    h_cell = rms_norm(h_cell.transpose(0, 2, 1, 3), mlstm_norm.reshape(ML_HEADS, ML_HEAD_DIM)).reshape(B, S, ML_WIDTH)
    y_ml = (jax.nn.sigmoid(ml_o.astype(f32)) * h_cell).astype(h.dtype) @ w_br_mlstm
    y_ns = nsa_attention(ns_q, k_cmp, v_cmp, k_slc, v_slc, k_win, v_win, ns_gates, cmp_pos_k, cmp_pos_v, cmp_k_w1, cmp_k_w2, cmp_v_w1, cmp_v_w2) @ w_br_nsa
    g_ml, g_ns = jnp.split(jax.nn.sigmoid(merge_pre), 2, axis=-1)
    return (g_ml * y_ml + g_ns * y_ns) @ w_mix_out


def memory_cross_attention(h, m, wq, wkv, wo):
    B, S, _ = h.shape
    q = (h @ wq).reshape(B, S, XA_HEADS, XA_HEAD_DIM)
    k, v = jnp.split(m @ wkv, 2, axis=-1)
    k = k.reshape(B, -1, XA_HEADS, XA_HEAD_DIM)
    v = v.reshape(B, -1, XA_HEADS, XA_HEAD_DIM)
    s = jnp.einsum('bshd,bmhd->bhsm', q, k).astype(jnp.float32) * XA_HEAD_DIM ** -0.5
    p = jax.nn.softmax(s, axis=-1).astype(v.dtype)
    o = jnp.einsum('bhsm,bmhd->bshd', p, v).reshape(B, S, XA_WIDTH)
    return o @ wo


def hierarchical_moe(h, wg, bg, we, be, w1, w3, w2):
    B, S, D = h.shape
    f32 = jnp.float32
    hf = h.reshape(B * S, D)
    n_tok = B * S
    p_group = jax.nn.softmax((hf @ wg).astype(f32) + bg.astype(f32), axis=-1)
    g_val, g_idx = lax.top_k(p_group, 1)
    e_logits = ((hf @ we).astype(f32) + be.astype(f32)).reshape(n_tok, MOE_GROUPS, MOE_EXPERTS_PER_GROUP)
    e_in_group = e_logits[jnp.arange(n_tok), g_idx[:, 0]]
    e_val, e_idx = lax.top_k(e_in_group, MOE_TOPK)
    combine = g_val * jax.nn.softmax(e_val, axis=-1)
    expert_id = g_idx * MOE_EXPERTS_PER_GROUP + e_idx
    weights = jnp.sum(jax.nn.one_hot(expert_id, MOE_EXPERTS, dtype=f32) * combine[..., None], axis=1)
    y = jnp.zeros((n_tok, D), f32)
    for e in range(MOE_EXPERTS):
        a = jax.nn.silu(hf @ w1[e]) * (hf @ w3[e])
        y = y + weights[:, e:e + 1] * (a @ w2[e])
    return y.astype(h.dtype).reshape(B, S, D)


def setup_inputs(seed: int = 0) -> dict:
    key = jax.random.key(seed)
    ks = jax.random.split(key, 32)
    f32 = jnp.float32
    L = DEPTH
    dh = NSA_HEAD_DIM

    def nrm(k, shape, scale):
        return scale * jax.random.normal(k, shape, f32)

    def gain(k, shape):
        return 1.0 + 0.02 * jax.random.normal(k, shape, f32)

    return {
        'x': nrm(ks[0], (BATCH, SEQ, D_MODEL), 1.0),
        'mem': nrm(ks[1], (BATCH, MEM_TOKENS, D_MODEL), 1.0),
        'norm_mix': gain(ks[2], (L, D_MODEL)),
        'w_in': nrm(ks[3], (L, D_MODEL, D_IN), D_MODEL ** -0.5),
        'conv_qk': nrm(ks[4], (L, ML_CONV, 2 * ML_WIDTH), ML_CONV ** -0.5),
        'b_igate': nrm(ks[5], (L, ML_HEADS), 0.1),
        'b_fgate': jnp.linspace(3.0, 6.0, ML_HEADS, dtype=f32)[None, :] + nrm(ks[6], (L, ML_HEADS), 0.1),
        'mlstm_norm': gain(ks[7], (L, ML_WIDTH)),
        'cmp_pos_k': nrm(ks[8], (L, CMP_BLOCK, dh), 0.1),
        'cmp_pos_v': nrm(ks[9], (L, CMP_BLOCK, dh), 0.1),
        'cmp_k_w1': nrm(ks[10], (L, CMP_BLOCK * dh, CMP_HIDDEN), (CMP_BLOCK * dh) ** -0.5),
        'cmp_k_w2': nrm(ks[11], (L, CMP_HIDDEN, dh), CMP_HIDDEN ** -0.5),
        'cmp_v_w1': nrm(ks[12], (L, CMP_BLOCK * dh, CMP_HIDDEN), (CMP_BLOCK * dh) ** -0.5),
        'cmp_v_w2': nrm(ks[13], (L, CMP_HIDDEN, dh), CMP_HIDDEN ** -0.5),
        'w_br_mlstm': nrm(ks[14], (L, ML_WIDTH, D_MODEL), ML_WIDTH ** -0.5),
        'w_br_nsa': nrm(ks[15], (L, NSA_WIDTH, D_MODEL), NSA_WIDTH ** -0.5),
        'w_mix_out': nrm(ks[16], (L, D_MODEL, D_MODEL), D_MODEL ** -0.5),
        'norm_xattn': gain(ks[17], (L, D_MODEL)),
        'norm_mem': gain(ks[18], (L, D_MODEL)),
        'xa_wq': nrm(ks[19], (L, D_MODEL, XA_WIDTH), D_MODEL ** -0.5),
        'xa_wkv': nrm(ks[20], (L, D_MODEL, 2 * XA_WIDTH), D_MODEL ** -0.5),
        'xa_wo': nrm(ks[21], (L, XA_WIDTH, D_MODEL), XA_WIDTH ** -0.5),
        'norm_ffn': gain(ks[22], (L, D_MODEL)),
        'router_group_w': nrm(ks[23], (L, D_MODEL, MOE_GROUPS), D_MODEL ** -0.5),
        'router_group_b': nrm(ks[24], (L, MOE_GROUPS), 0.01),
        'router_expert_w': nrm(ks[25], (L, D_MODEL, MOE_EXPERTS), D_MODEL ** -0.5),
        'router_expert_b': nrm(ks[26], (L, MOE_EXPERTS), 0.01),
        'moe_w1': nrm(ks[27], (L, MOE_EXPERTS, D_MODEL, MOE_HIDDEN), D_MODEL ** -0.5),
        'moe_w3': nrm(ks[28], (L, MOE_EXPERTS, D_MODEL, MOE_HIDDEN), D_MODEL ** -0.5),
        'moe_w2': nrm(ks[29], (L, MOE_EXPERTS, MOE_HIDDEN, D_MODEL), MOE_HIDDEN ** -0.5),
        'norm_final': gain(ks[30], (D_MODEL,)),
    }


def reference(x, mem, norm_mix, w_in, conv_qk, b_igate, b_fgate, mlstm_norm, cmp_pos_k, cmp_pos_v, cmp_k_w1, cmp_k_w2, cmp_v_w1, cmp_v_w2, w_br_mlstm, w_br_nsa, w_mix_out, norm_xattn, norm_mem, xa_wq, xa_wkv, xa_wo, norm_ffn, router_group_w, router_group_b, router_expert_w, router_expert_b, moe_w1, moe_w3, moe_w2, norm_final):
    for layer in range(DEPTH):
        x = x + hybrid_mixer(rms_norm(x, norm_mix[layer]), w_in[layer], conv_qk[layer], b_igate[layer], b_fgate[layer], mlstm_norm[layer], cmp_pos_k[layer], cmp_pos_v[layer], cmp_k_w1[layer], cmp_k_w2[layer], cmp_v_w1[layer], cmp_v_w2[layer], w_br_mlstm[layer], w_br_nsa[layer], w_mix_out[layer])
        x = x + memory_cross_attention(rms_norm(x, norm_xattn[layer]), rms_norm(mem, norm_mem[layer]), xa_wq[layer], xa_wkv[layer], xa_wo[layer])
        x = x + hierarchical_moe(rms_norm(x, norm_ffn[layer]), router_group_w[layer], router_group_b[layer], router_expert_w[layer], router_expert_b[layer], moe_w1[layer], moe_w3[layer], moe_w2[layer])
    return rms_norm(x, norm_final)
```

```cpp
#include <hip/hip_runtime.h>
#include <stdint.h>

typedef unsigned short bf16_t;
__device__ __forceinline__ float bf2f(bf16_t v) { return __uint_as_float(((unsigned)v) << 16); }
__device__ __forceinline__ bf16_t f2bf(float f) { unsigned u = __float_as_uint(f); return (bf16_t)((u + 0x7fffu + ((u >> 16) & 1u)) >> 16); }

constexpr int NB = 4, SEQ = 4096, NTOK = NB * SEQ, DM = 1024;
constexpr int DIN = 5408, DIN_A = 3360;
constexpr int MEMT = 256;
constexpr float EPS = 1e-6f;
constexpr size_t MiB = 1u << 20;

constexpr size_t WS_CNT = 0;
constexpr size_t WS_LIST = 1 * MiB;
constexpr size_t WS_RTW = 2 * MiB;
constexpr size_t WS_SM = 3 * MiB;
constexpr size_t WS_BCUM = 5 * MiB;
constexpr size_t WS_IP = 5 * MiB + 256 * 1024;
constexpr size_t WS_BL = 5 * MiB + 512 * 1024;
constexpr size_t WS_MX = WS_BL + 4096;
constexpr size_t WS_MST = WS_MX + 4096;
constexpr size_t WS_NST = 6 * MiB;
constexpr size_t WS_KC = 7 * MiB;
constexpr size_t WS_VC = 7 * MiB + 512 * 1024;
constexpr size_t WS_QK = 8 * MiB;
constexpr size_t WS_V = 40 * MiB;
constexpr size_t WS_O = 56 * MiB;
constexpr size_t WS_NQ = 72 * MiB;
constexpr size_t WS_KV = 88 * MiB;
constexpr size_t WS_CST = 112 * MiB;
constexpr size_t WS_AML = 144 * MiB;
constexpr size_t WS_ANS = 160 * MiB;
constexpr size_t WS_MRG = 176 * MiB;
constexpr size_t WS_KVM = 233 * MiB;
constexpr size_t WS_MEMN = 237 * MiB;
constexpr size_t WS_H2 = 8 * MiB;
constexpr size_t WS_XQ = 40 * MiB;
constexpr size_t WS_XO = 72 * MiB;
constexpr size_t WS_Y = 72 * MiB;

__device__ __forceinline__ float wave_sum(float v) {
#pragma unroll
  for (int o = 32; o > 0; o >>= 1) v += __shfl_xor(v, o);
  return v;
}
__device__ __forceinline__ float wave_max(float v) {
#pragma unroll
  for (int o = 32; o > 0; o >>= 1) v = fmaxf(v, __shfl_xor(v, o));
  return v;
}
__device__ __forceinline__ float sigmoidf_(float x) { return 1.f / (1.f + __expf(-x)); }
__device__ __forceinline__ float siluf_(float x) { return x / (1.f + __expf(-x)); }
__device__ __forceinline__ float logsigmoidf_(float x) { return fminf(x, 0.f) - log1pf(__expf(-fabsf(x))); }
__device__ __forceinline__ float gelu_tanh(float x) { float u = 0.7978845608028654f * (x + 0.044715f * x * x * x); return 0.5f * x * (1.f + tanhf(u)); }

#include <hip/hip_cooperative_groups.h>
namespace cg = cooperative_groups;
#define LAS __attribute__((address_space(3)))
typedef short bf16x8 __attribute__((ext_vector_type(8)));
typedef float f32x4 __attribute__((ext_vector_type(4)));
typedef unsigned u32x2 __attribute__((ext_vector_type(2)));
typedef unsigned u32x4 __attribute__((ext_vector_type(4)));

constexpr size_t WS_RS1 = 5 * MiB + 768 * 1024;
constexpr size_t WS_RSM = WS_RS1 + 65536;
constexpr size_t WS_PS2 = 4 * MiB;
constexpr size_t WS_WIN_T = 208 * MiB;
constexpr size_t WS_WG_T = 215 * MiB;
constexpr size_t WS_WML_T = 219 * MiB;
constexpr size_t WS_WNS_T = 220 * MiB;
constexpr size_t WS_WOUT_T = 221 * MiB;
constexpr size_t WS_WQ_T = 223 * MiB;
constexpr size_t WS_WKV_T = 225 * MiB;
constexpr size_t WS_WO_T = 229 * MiB;
constexpr size_t WS_MEMB = 238 * MiB;
constexpr size_t WS_KVC = WS_KV;
constexpr size_t WS_KS = WS_KV + 8 * MiB;
constexpr size_t WS_KW = WS_KV + 12 * MiB;
constexpr size_t WS_VST = WS_KV + 16 * MiB;
constexpr size_t WS_VWT = WS_KV + 20 * MiB;
constexpr size_t WS_CK1T = 231 * MiB;
constexpr size_t WS_CV1T = 231 * MiB + 512 * 1024;
constexpr size_t WS_POSW = WS_RSM + 8192 + 65536;
constexpr int NIN = 3456;

__device__ __forceinline__ unsigned pk2bf(float lo, float hi) { return (unsigned)f2bf(lo) | ((unsigned)f2bf(hi) << 16); }
__device__ __forceinline__ void st_bf4(bf16_t* p, f32x4 v) { u32x2 o; o.x = pk2bf(v[0], v[1]); o.y = pk2bf(v[2], v[3]); *(u32x2*)p = o; }

struct TDesc { const float* src; bf16_t* dst; const float* gain; int ldw, K, c0, ncols, drow0, nitems, mode, rofs, per, sstride, dstride, pad; };
__device__ __forceinline__ void transpose_item(const TDesc& d, int item, float* t  , int tid) {
  const int bat = item / d.per; item -= bat * d.per;
  const float* src = d.src + (size_t)bat * d.sstride; bf16_t* dst = d.dst + (size_t)bat * d.dstride;
  const int ncb = (d.ncols + 63) >> 6; const int kb = item / ncb, cb = item % ncb; const int k0 = kb * 64, n0 = cb * 64;
  {
    const int c4 = (tid & 15) * 4, kq = tid >> 4;
    f32x4 v[4];
#pragma unroll
    for (int p = 0; p < 4; ++p) {
      const int kk = p * 16 + kq;
      v[p] = (n0 + c4 < d.ncols) ? *(const f32x4*)(src + (size_t)(k0 + kk) * d.ldw + d.c0 + n0 + c4) : (f32x4){0.f, 0.f, 0.f, 0.f};
    }
#pragma unroll
    for (int p = 0; p < 4; ++p) {
      const int kk = p * 16 + kq; const float g = d.gain ? d.gain[k0 + kk] : 1.f;
      float* tp = t + kk * 65 + c4; tp[0] = v[p][0] * g; tp[1] = v[p][1] * g; tp[2] = v[p][2] * g; tp[3] = v[p][3] * g;
    }
  }
  __syncthreads();
#pragma unroll
  for (int j = 0; j < 2; ++j) {
    int c = tid + j * 256; int n = c >> 3, kc = c & 7;
    if (n0 + n < d.ncols) {
      const float* p = t + (kc * 8) * 65 + n;
      u32x4 o; o.x = pk2bf(p[0], p[65]); o.y = pk2bf(p[130], p[195]); o.z = pk2bf(p[260], p[325]); o.w = pk2bf(p[390], p[455]);
      const int drow = d.mode ? (d.drow0 + cb * 128 + (n >> 5) * 64 + (n & 31) + d.rofs) : (d.drow0 + n0 + n);
      *(u32x4*)(dst + (size_t)drow * d.K + k0 + kc * 8) = o;
    }
  }
  __syncthreads();
}

__device__ __forceinline__ void rows_to_bf16(const float* __restrict__ src, bf16_t* __restrict__ dst, float* __restrict__ rs, int nrows, int gw, int ngw, int lane) {
  for (int row = gw; row < nrows; row += ngw) {
    const f32x4* xr = (const f32x4*)(src + (size_t)row * DM) + lane;
    f32x4 v[4]; float s = 0.f;
#pragma unroll
    for (int j = 0; j < 4; ++j) { v[j] = xr[64 * j]; s += v[j][0] * v[j][0] + v[j][1] * v[j][1] + v[j][2] * v[j][2] + v[j][3] * v[j][3]; }
    s = wave_sum(s);
    if (lane == 0) rs[row] = rsqrtf(s * (1.f / DM) + EPS);
#pragma unroll
    for (int j = 0; j < 4; ++j) st_bf4(dst + (size_t)row * DM + (lane + 64 * j) * 4, v[j]);
  }
}

__device__ __forceinline__ void glds16(const void* g, char* l) {
  __builtin_amdgcn_global_load_lds((const unsigned*)g, (LAS unsigned*)l, 16, 0, 0);
}
__device__ __forceinline__ int st_row(int tid, int i) { return (tid >> 3) + 32 * i; }
__device__ __forceinline__ int st_lc(int tid, int i) { return (tid & 7) ^ ((st_row(tid, i) >> 1) & 7); }
__device__ __forceinline__ void gemm_core(f32x4 (&acc)[4][4], const bf16_t* __restrict__ A, const unsigned (&ao)[4], unsigned ksa,
                                          const bf16_t* __restrict__ Bt, const unsigned (&bo)[4], unsigned ksb, int nt, char* lds, int tid) {
  const int lane = tid & 63, wid = tid >> 6, wr = wid >> 1, wc = wid & 1, fr = lane & 15, fq = lane >> 4;
  char* ldst = lds + tid * 16;
#pragma unroll
  for (int i = 0; i < 4; ++i) { glds16(A + ao[i], ldst + i * 4096); glds16(Bt + bo[i], ldst + 16384 + i * 4096); }
  const int sw = fr >> 1;
  const int aoff = (wr * 64 + fr) * 128, boff = (wc * 64 + fr) * 128;
  for (int t = 0; t < nt; ++t) {
    asm volatile("s_waitcnt vmcnt(0)" ::: "memory");
    __syncthreads();
    const int cur = t & 1;
    if (t + 1 < nt) {
      char* nb = ldst + (cur ^ 1) * 32768; const unsigned ka = (t + 1) * ksa, kb = (t + 1) * ksb;
#pragma unroll
      for (int i = 0; i < 4; ++i) { glds16(A + (ao[i] + ka), nb + i * 4096); glds16(Bt + (bo[i] + kb), nb + 16384 + i * 4096); }
    }
    const char* sA = lds + cur * 32768 + aoff; const char* sB = lds + cur * 32768 + 16384 + boff;
#pragma unroll
    for (int ks = 0; ks < 2; ++ks) {
      bf16x8 a[4], b[4];
      const int co = ((ks * 4 + fq) ^ sw) << 4;
#pragma unroll
      for (int i = 0; i < 4; ++i) { a[i] = *(const bf16x8*)(sA + i * 2048 + co); b[i] = *(const bf16x8*)(sB + i * 2048 + co); }
#pragma unroll
      for (int i = 0; i < 4; ++i)
#pragma unroll
        for (int j = 0; j < 4; ++j) acc[i][j] = __builtin_amdgcn_mfma_f32_16x16x32_bf16(b[j], a[i], acc[i][j], 0, 0, 0);
    }
  }
  __syncthreads();
}
__device__ __forceinline__ void gemm_acc(f32x4 (&acc)[4][4], const bf16_t* __restrict__ A, size_t lda, const int* __restrict__ arow, int ashift, int mvalid,
                                         const bf16_t* __restrict__ Bt, size_t ldb, int K, char* lds, int m0, int n0, int tid) {
  asm volatile("" : "+v"(tid));
  unsigned ao[4], bo[4];
#pragma unroll
  for (int i = 0; i < 4; ++i) {
    const int row = st_row(tid, i), lc = st_lc(tid, i);
    int gr;
    if (arow) { int mm = m0 + row; if (mm >= mvalid) mm = mvalid - 1; gr = arow[mm] >> ashift; } else gr = m0 + row;
    ao[i] = (unsigned)gr * (unsigned)lda + lc * 8;
    bo[i] = (unsigned)(n0 + row) * (unsigned)ldb + lc * 8;
  }
  gemm_core(acc, A, ao, 64u, Bt, bo, 64u, K >> 6, lds, tid);
}
__device__ __forceinline__ void zero_acc(f32x4 (&acc)[4][4]) {
#pragma unroll
  for (int i = 0; i < 4; ++i)
#pragma unroll
    for (int j = 0; j < 4; ++j) acc[i][j] = (f32x4){0.f, 0.f, 0.f, 0.f};
}

struct MlArgs { const float *conv, *b_i, *b_f, *gain; float *BCUM, *IP, *BL, *MX, *MST, *NST; bf16_t* CST; };
struct MegaArgs {
  const float* x; const float* mem; float* out;
  bf16_t *XB, *MEMB; float *RS1, *RSM, *PS2;
  bf16_t *QK, *V, *O, *NQ, *KVC, *KS, *KW, *VST, *VWT, *KC, *VCT, *CK1T, *CV1T; float *SM, *POSW;
  const float *posk, *posv, *ckw1, *cvw1, *ckw2, *cvw2;
  bf16_t *AML, *ANS, *MRG, *X1B, *XQ, *XO, *KVM;
  bf16_t *WinT, *WgT, *WmlT, *WnsT, *WoutT, *WqT, *WkvT, *WoT;
  bf16_t *H3, *ACT, *Y, *W13T, *W2T; float *RS3, *RTW; int *CNT, *LIST;
  const float *g_ffn, *wg, *bg, *we, *be, *g_final;
  unsigned* BAR;
  MlArgs ml;
  float* CPART; int* WQ;
  TDesc td[20]; int ntdA, ntdB; int ph_lo, ph_hi, li, pad; int rep[16]; int cv_lo[16], cv_hi[16];
};


constexpr int NSA_LDS = 66112;
constexpr int MEGA_LDS = 73728;
typedef unsigned long long u64;

template <bool WITH_V>
__device__ __forceinline__ void nsa_load_tile(const bf16_t* __restrict__ Ksrc, unsigned kstride, const bf16_t* __restrict__ Vsrc, unsigned vstride, char* lds, int tid) {
#pragma unroll
  for (int i = 0; i < 2; ++i) {
    const int idx = tid + 256 * i, row = idx >> 3, lc = (idx & 7) ^ ((row >> 1) & 7);
    glds16(Ksrc + (size_t)row * kstride + lc * 8, lds + idx * 16);
    if (WITH_V) glds16(Vsrc + (size_t)row * vstride + lc * 8, lds + 8192 + idx * 16);
  }
}

__device__ __forceinline__ void nsa_qk(f32x4 (&sacc)[4][2], const bf16x8 (&qf)[4][2], const char* lds, int hf, int fr, int fq) {
#pragma unroll
  for (int mi = 0; mi < 4; ++mi)
#pragma unroll
    for (int ni = 0; ni < 2; ++ni) sacc[mi][ni] = (f32x4){0.f, 0.f, 0.f, 0.f};
#pragma unroll
  for (int ks = 0; ks < 2; ++ks) {
    bf16x8 kf[2];
    const int co = ((ks * 4 + fq) ^ (fr >> 1)) << 4;
#pragma unroll
    for (int ni = 0; ni < 2; ++ni) kf[ni] = *(const bf16x8*)(lds + ((hf * 2 + ni) * 16 + fr) * 128 + co);
#pragma unroll
    for (int mi = 0; mi < 4; ++mi)
#pragma unroll
      for (int ni = 0; ni < 2; ++ni) sacc[mi][ni] = __builtin_amdgcn_mfma_f32_16x16x32_bf16(kf[ni], qf[mi][ks], sacc[mi][ni], 0, 0, 0);
  }
}
__device__ __forceinline__ void nsa_pv(f32x4 (&oacc)[4][4], const f32x4 (&p)[4][2], char* lds, char* pw, int hf, int fr, int fq) {
#pragma unroll
  for (int mi = 0; mi < 4; ++mi)
#pragma unroll
    for (int ni = 0; ni < 2; ++ni) {
      u32x2 o; o.x = pk2bf(p[mi][ni][0], p[mi][ni][1]); o.y = pk2bf(p[mi][ni][2], p[mi][ni][3]);
      *(u32x2*)(pw + (mi * 16 + fr) * 128 + ((((hf * 2 + ni) * 2 + (fq >> 1)) ^ (fr >> 1)) << 4) + (fq & 1) * 8) = o;
    }
  bf16x8 pf[4], vf[4];
  const int co = ((hf * 4 + fq) ^ (fr >> 1)) << 4;
#pragma unroll
  for (int i = 0; i < 4; ++i) { pf[i] = *(const bf16x8*)(pw + (i * 16 + fr) * 128 + co); vf[i] = *(const bf16x8*)(lds + 8192 + (i * 16 + fr) * 128 + co); }
#pragma unroll
  for (int mi = 0; mi < 4; ++mi)
#pragma unroll
    for (int ni = 0; ni < 4; ++ni) oacc[mi][ni] = __builtin_amdgcn_mfma_f32_16x16x32_bf16(vf[ni], pf[mi], oacc[mi][ni], 0, 0, 0);
}
__device__ __forceinline__ float red4(float v) { v += __shfl_xor(v, 16); v += __shfl_xor(v, 32); return v; }
__device__ __forceinline__ float max4(float v) { v = fmaxf(v, __shfl_xor(v, 16)); v = fmaxf(v, __shfl_xor(v, 32)); return v; }

__device__ __forceinline__ void nsa_online(f32x4 (&sv)[4][2], float (&m_run)[4], float (&l_run)[4], f32x4 (&oacc)[4][4]) {
#pragma unroll
  for (int mi = 0; mi < 4; ++mi) {
    float mx = fmaxf(fmaxf(fmaxf(sv[mi][0][0], sv[mi][0][1]), fmaxf(sv[mi][0][2], sv[mi][0][3])), fmaxf(fmaxf(sv[mi][1][0], sv[mi][1][1]), fmaxf(sv[mi][1][2], sv[mi][1][3])));
    mx = max4(mx);
    if (__any(mx > m_run[mi] + 8.f)) {
      const float mn = fmaxf(fmaxf(m_run[mi], mx), -1e20f);
      const float alpha = __builtin_amdgcn_exp2f(m_run[mi] - mn);
      m_run[mi] = mn; l_run[mi] *= alpha;
#pragma unroll
      for (int ni = 0; ni < 4; ++ni) oacc[mi][ni] *= alpha;
    }
    float ls = 0.f;
#pragma unroll
    for (int ni = 0; ni < 2; ++ni)
#pragma unroll
      for (int j = 0; j < 4; ++j) { const float pv = __builtin_amdgcn_exp2f(sv[mi][ni][j] - m_run[mi]); sv[mi][ni][j] = pv; ls += pv; }
    l_run[mi] += ls;
  }
}

__device__ __forceinline__ void nsa_main_item(const MegaArgs& a, int item, char* lds, int tid) {
  asm volatile("" : "+v"(tid));
  const int lane = tid & 63, wid = tid >> 6, fr = lane & 15, fq = lane >> 4;
  const int i = item & 63, g = (item >> 6) & 1, b = item >> 7;
  const int h = g * 4 + wid, nb = b * SEQ, t0 = i * 64, bg = b * 2 + g;
  const float slope = exp2f(-(float)(h + 1)) * 1.4426950408889634f;
  char* pw = lds + 16384 + wid * 8192;
  float* PSLC = (float*)(lds + 49152);
  u64* SELM = (u64*)(lds + 65536);
  u64* UNI = (u64*)(lds + 66048);
  bf16x8 qf[4][2];
#pragma unroll
  for (int mi = 0; mi < 4; ++mi)
#pragma unroll
    for (int ks = 0; ks < 2; ++ks) qf[mi][ks] = *(const bf16x8*)(a.NQ + (size_t)(nb + t0 + wid * 16 + fr) * 512 + (g * 4 + mi) * 64 + ks * 32 + fq * 8);
  for (int e = tid; e < 4096; e += 256) PSLC[e] = 0.f;
  f32x4 sacc[4][2], oacc[4][4];
  float m_run[4], l_run[4];
  const int nct = ((4 * i + 2) >> 6) + 1;
  const bf16_t* kcb = a.KC + (size_t)bg * 256 * 64;
  const bf16_t* vcb = a.VCT + (size_t)bg * 64 * 256;
  const int tc = t0 + wid * 16 + fr;
  const float slope0 = exp2f(-(float)(g * 4 + 1)) * 1.4426950408889634f;
#pragma unroll
  for (int mi = 0; mi < 4; ++mi) { m_run[mi] = -1e30f; l_run[mi] = 0.f; }
  __syncthreads();
  nsa_load_tile<false>(kcb, 64u, nullptr, 0u, lds, tid);
  for (int jt = 0; jt < nct; ++jt) {
    asm volatile("s_waitcnt vmcnt(0)" ::: "memory");
    __syncthreads();
    char* tb = (jt & 1) ? (lds + 16384) : lds;
    if (jt + 1 < nct) nsa_load_tile<false>(kcb + (size_t)(jt + 1) * 64 * 64, 64u, nullptr, 0u, (jt & 1) ? lds : (lds + 16384), tid);
#pragma unroll 1
    for (int hf = 0; hf < 2; ++hf) {
      nsa_qk(sacc, qf, tb, hf, fr, fq);
#pragma unroll
      for (int mi = 0; mi < 4; ++mi) {
        const float slope = slope0 * (1.f / (float)(1 << mi)); float mx = -1e30f;
#pragma unroll
        for (int ni = 0; ni < 2; ++ni)
#pragma unroll
          for (int j = 0; j < 4; ++j) {
            const int jj = jt * 64 + hf * 32 + ni * 16 + 4 * fq + j; const bool ok = (16 * jj + 31 <= tc);
            const float v = sacc[mi][ni][j] - slope * ((float)tc - (16.f * jj + 15.5f));
            sacc[mi][ni][j] = ok ? v : -1e30f; mx = fmaxf(mx, sacc[mi][ni][j]);
          }
        mx = max4(mx);
        const float mn = fmaxf(m_run[mi], mx); float ls = 0.f;
#pragma unroll
        for (int ni = 0; ni < 2; ++ni)
#pragma unroll
          for (int j = 0; j < 4; ++j) ls += (sacc[mi][ni][j] > -1e29f) ? __builtin_amdgcn_exp2f(sacc[mi][ni][j] - mn) : 0.f;
        l_run[mi] = l_run[mi] * __builtin_amdgcn_exp2f(m_run[mi] - mn) + ls; m_run[mi] = mn;
      }
    }
  }
  float invl[4];
#pragma unroll
  for (int mi = 0; mi < 4; ++mi) { const float l = red4(l_run[mi]); invl[mi] = l > 0.f ? 1.f / l : 0.f; }
#pragma unroll
  for (int mi = 0; mi < 4; ++mi)
#pragma unroll
    for (int ni = 0; ni < 4; ++ni) oacc[mi][ni] = (f32x4){0.f, 0.f, 0.f, 0.f};
  for (int jt = 0; jt < nct; ++jt) {
    __syncthreads();
    nsa_load_tile<true>(kcb + (size_t)jt * 64 * 64, 64u, vcb + jt * 64, 256u, lds, tid);
    asm volatile("s_waitcnt vmcnt(0)" ::: "memory");
    __syncthreads();
#pragma unroll 1
    for (int hf = 0; hf < 2; ++hf) {
      nsa_qk(sacc, qf, lds, hf, fr, fq);
      float imp[2] = {0.f, 0.f}, car[2] = {0.f, 0.f};
#pragma unroll
      for (int mi = 0; mi < 4; ++mi) {
        const float slope = slope0 * (1.f / (float)(1 << mi));
#pragma unroll
        for (int ni = 0; ni < 2; ++ni) {
#pragma unroll
          for (int j = 0; j < 4; ++j) {
            const int jj = jt * 64 + hf * 32 + ni * 16 + 4 * fq + j; const bool ok = (16 * jj + 31 <= tc);
            const float v = sacc[mi][ni][j] - slope * ((float)tc - (16.f * jj + 15.5f));
            sacc[mi][ni][j] = ok ? __builtin_amdgcn_exp2f(v - m_run[mi]) * invl[mi] : 0.f;
          }
          imp[ni] += (sacc[mi][ni][0] + sacc[mi][ni][1]) + sacc[mi][ni][2] + 0.5f * sacc[mi][ni][3]; car[ni] += 0.5f * sacc[mi][ni][3];
        }
      }
      nsa_pv(oacc, sacc, lds, pw, hf, fr, fq);
#pragma unroll
      for (int ni = 0; ni < 2; ++ni) {
        const int sb = jt * 16 + hf * 8 + ni * 4 + fq; float* pp = PSLC + (wid * 16 + fr) * 64 + sb;
        atomicAdd(pp, imp[ni]);
        if (sb < 63) atomicAdd(pp + 1, car[ni]);
      }
    }
  }
  int frc = fr; asm volatile("" : "+v"(frc));
  {
    const size_t n = nb + t0 + wid * 16 + frc;
#pragma unroll
    for (int mi = 0; mi < 4; ++mi) {
      const int hh = g * 4 + mi; const float gt = sigmoidf_(a.SM[n * 32 + 8 + hh * 3]);
#pragma unroll
      for (int ni = 0; ni < 4; ++ni) {
        bf16_t* dp = a.ANS + n * 512 + hh * 64 + ni * 16 + 4 * fq; const u32x2 pr = *(const u32x2*)dp;
        f32x4 r = oacc[mi][ni] * gt;
        r[0] += __uint_as_float(pr.x << 16); r[1] += __uint_as_float(pr.x & 0xffff0000u); r[2] += __uint_as_float(pr.y << 16); r[3] += __uint_as_float(pr.y & 0xffff0000u);
        st_bf4(dp, r);
      }
    }
  }
  __syncthreads();
  {
    int tsel = tid, isel = i; asm volatile("" : "+v"(tsel), "+v"(isel));
    const int q = tsel >> 2, sub = tsel & 3;
    float mine[16]; int cnt[16];
#pragma unroll
    for (int k = 0; k < 16; ++k) {
      const int sb = sub * 16 + k; const float ps = PSLC[q * 64 + sb];
      mine[k] = (sb == 0 || sb == isel || sb == isel - 1) ? 1e4f : (sb > isel ? -1e4f : ps); cnt[k] = 0;
    }
#pragma unroll
    for (int k = 0; k < 16; ++k) PSLC[q * 64 + sub * 16 + k] = mine[k];
    __syncthreads();
    for (int s2 = 0; s2 <= isel; ++s2) {
      const float o = PSLC[q * 64 + s2];
#pragma unroll
      for (int k = 0; k < 16; ++k) cnt[k] += (o > mine[k] || (o == mine[k] && s2 < sub * 16 + k)) ? 1 : 0;
    }
    unsigned m16 = 0;
#pragma unroll
    for (int k = 0; k < 16; ++k) m16 |= (cnt[k] < 16 ? 1u : 0u) << k;
    unsigned mlo = (sub < 2) ? (m16 << (16 * sub)) : 0u, mhi = (sub >= 2) ? (m16 << (16 * (sub - 2))) : 0u;
    mlo |= __shfl_xor(mlo, 1); mlo |= __shfl_xor(mlo, 2); mhi |= __shfl_xor(mhi, 1); mhi |= __shfl_xor(mhi, 2);
    u64 m64 = ((u64)mhi << 32) | (u64)mlo;
    m64 &= (isel == 63) ? ~0ull : ((2ull << isel) - 1ull);
    if (sub == 0) SELM[q] = m64;
    u64 un = m64;
#pragma unroll
    for (int o = 4; o < 64; o <<= 1) un |= __shfl_xor(un, o);
    if (lane == 0) UNI[wid] = un;
  }
  __syncthreads();
  const u64 uni = UNI[0] | UNI[1] | UNI[2] | UNI[3];
#pragma unroll
  for (int mi = 0; mi < 4; ++mi)
#pragma unroll
    for (int ks = 0; ks < 2; ++ks) qf[mi][ks] = *(const bf16x8*)(a.NQ + (size_t)(nb + t0 + mi * 16 + fr) * 512 + h * 64 + ks * 32 + fq * 8);
#pragma unroll 1
  for (int br = 1; br <= 1; ++br) {
#pragma unroll
    for (int mi = 0; mi < 4; ++mi) { m_run[mi] = -1e30f; l_run[mi] = 0.f;
#pragma unroll
      for (int ni = 0; ni < 4; ++ni) oacc[mi][ni] = (f32x4){0.f, 0.f, 0.f, 0.f}; }
    const bf16_t* Kb = (br == 1 ? a.KS : a.KW) + (size_t)nb * 128 + g * 64;
    const bf16_t* Vb = (br == 1 ? a.VST : a.VWT) + ((size_t)(b * 128 + g * 64) << 12);
    u64 todo;
    if (br == 1) todo = uni;
    else { const int lo = i >= 8 ? i - 8 : 0; todo = ((i == 63) ? ~0ull : ((2ull << i) - 1ull)) & ~((1ull << lo) - 1ull); }
    int cur = __builtin_ctzll(todo), bsel = 0;
    __syncthreads();
    nsa_load_tile<true>(Kb + (size_t)cur * 64 * 128, 128u, Vb + cur * 64, 4096u, lds, tid);
    while (cur >= 0) {
      todo &= todo - 1ull;
      const int nxt = todo ? __builtin_ctzll(todo) : -1;
      asm volatile("s_waitcnt vmcnt(0)" ::: "memory");
      __syncthreads();
      char* tb = bsel ? (lds + 49152) : lds;
      if (nxt >= 0) nsa_load_tile<true>(Kb + (size_t)nxt * 64 * 128, 128u, Vb + nxt * 64, 4096u, bsel ? lds : (lds + 49152), tid);
      const int sb = cur;
#pragma unroll 1
      for (int hf = 0; hf < 2; ++hf) {
        nsa_qk(sacc, qf, tb, hf, fr, fq);
        const bool edge = (sb == i) || (br == 2 && sb == i - 8);
#pragma unroll
        for (int mi = 0; mi < 4; ++mi) {
          const int tq = mi * 16 + fr;
          const bool rsel = (br == 2) || ((SELM[tq] >> sb) & 1ull);
          const float rc = rsel ? -slope * (float)(64 * (i - sb) + tq - hf * 32 - 4 * fq) : -1e30f;
          if (!edge) {
#pragma unroll
            for (int ni = 0; ni < 2; ++ni)
#pragma unroll
              for (int j = 0; j < 4; ++j) sacc[mi][ni][j] += fmaf(slope, (float)(ni * 16 + j), rc);
          } else {
            const int tqh = tq - hf * 32;
#pragma unroll
            for (int ni = 0; ni < 2; ++ni)
#pragma unroll
              for (int j = 0; j < 4; ++j) {
                const int c = ni * 16 + 4 * fq + j;
                const bool okv = (sb == i) ? (c <= tqh) : (c > tqh);
                sacc[mi][ni][j] = okv ? sacc[mi][ni][j] + fmaf(slope, (float)(ni * 16 + j), rc) : -1e30f;
              }
          }
        }
        nsa_online(sacc, m_run, l_run, oacc);
        nsa_pv(oacc, sacc, tb, pw, hf, fr, fq);
      }
      cur = nxt; bsel ^= 1;
    }
    int fre = fr; asm volatile("" : "+v"(fre));
#pragma unroll
    for (int mi = 0; mi < 4; ++mi) {
      const size_t n = nb + t0 + mi * 16 + fre;
      const float l = red4(l_run[mi]); const float sc = sigmoidf_(a.SM[n * 32 + 8 + h * 3 + br]) / l;
#pragma unroll
      for (int ni = 0; ni < 4; ++ni) {
        bf16_t* dp = a.ANS + n * 512 + h * 64 + ni * 16 + 4 * fq; const u32x2 pr = *(const u32x2*)dp;
        f32x4 r = oacc[mi][ni] * sc;
        r[0] += __uint_as_float(pr.x << 16); r[1] += __uint_as_float(pr.x & 0xffff0000u); r[2] += __uint_as_float(pr.y << 16); r[3] += __uint_as_float(pr.y & 0xffff0000u);
        st_bf4(dp, r);
      }
    }
  }
  __syncthreads();
}


__device__ __forceinline__ void nsa_win_item(const MegaArgs& a, int item, char* lds, int tid) {
  asm volatile("" : "+v"(tid));
  const int lane = tid & 63, wid = tid >> 6, fr = lane & 15, fq = lane >> 4;
  const int i = item & 63, g = (item >> 6) & 1, b = item >> 7;
  const int h = g * 4 + wid, nb = b * SEQ, t0 = i * 64, bg = b * 2 + g;
  const float slope = exp2f(-(float)(h + 1)) * 1.4426950408889634f;
  char* pw = lds + 16384 + wid * 8192;
  float* PSLC = (float*)(lds + 49152);
  u64* SELM = (u64*)(lds + 65536);
  u64* UNI = (u64*)(lds + 66048);
  bf16x8 qf[4][2];
#pragma unroll
  for (int mi = 0; mi < 4; ++mi)
#pragma unroll
    for (int ks = 0; ks < 2; ++ks) qf[mi][ks] = *(const bf16x8*)(a.NQ + (size_t)(nb + t0 + mi * 16 + fr) * 512 + h * 64 + ks * 32 + fq * 8);
  f32x4 sacc[4][2], oacc[4][4];
  float m_run[4], l_run[4];
  (void)PSLC; (void)UNI; (void)bg;
  const u64 uni = 0ull;
#pragma unroll 1
  for (int br = 2; br <= 2; ++br) {
#pragma unroll
    for (int mi = 0; mi < 4; ++mi) { m_run[mi] = -1e30f; l_run[mi] = 0.f;
#pragma unroll
      for (int ni = 0; ni < 4; ++ni) oacc[mi][ni] = (f32x4){0.f, 0.f, 0.f, 0.f}; }
    const bf16_t* Kb = (br == 1 ? a.KS : a.KW) + (size_t)nb * 128 + g * 64;
    const bf16_t* Vb = (br == 1 ? a.VST : a.VWT) + ((size_t)(b * 128 + g * 64) << 12);
    u64 todo;
    if (br == 1) todo = uni;
    else { const int lo = i >= 8 ? i - 8 : 0; todo = ((i == 63) ? ~0ull : ((2ull << i) - 1ull)) & ~((1ull << lo) - 1ull); }
    int cur = 63 - __builtin_clzll(todo), bsel = 0;
    __syncthreads();
    nsa_load_tile<true>(Kb + (size_t)cur * 64 * 128, 128u, Vb + cur * 64, 4096u, lds, tid);
    while (cur >= 0) {
      todo &= ~(1ull << cur);
      const int nxt = todo ? 63 - __builtin_clzll(todo) : -1;
      asm volatile("s_waitcnt vmcnt(0)" ::: "memory");
      __syncthreads();
      char* tb = bsel ? (lds + 49152) : lds;
      if (nxt >= 0) nsa_load_tile<true>(Kb + (size_t)nxt * 64 * 128, 128u, Vb + nxt * 64, 4096u, bsel ? lds : (lds + 49152), tid);
      const int sb = cur;
#pragma unroll 1
      for (int hf = 0; hf < 2; ++hf) {
        nsa_qk(sacc, qf, tb, hf, fr, fq);
        const bool edge = (sb == i) || (br == 2 && sb == i - 8);
#pragma unroll
        for (int mi = 0; mi < 4; ++mi) {
          const int tq = mi * 16 + fr;
          const bool rsel = (br == 2) || ((SELM[tq] >> sb) & 1ull);
          const float rc = rsel ? -slope * (float)(64 * (i - sb) + tq - hf * 32 - 4 * fq) : -1e30f;
          if (!edge) {
#pragma unroll
            for (int ni = 0; ni < 2; ++ni)
#pragma unroll
              for (int j = 0; j < 4; ++j) sacc[mi][ni][j] += fmaf(slope, (float)(ni * 16 + j), rc);
          } else {
            const int tqh = tq - hf * 32;
#pragma unroll
            for (int ni = 0; ni < 2; ++ni)
#pragma unroll
              for (int j = 0; j < 4; ++j) {
                const int c = ni * 16 + 4 * fq + j;
                const bool okv = (sb == i) ? (c <= tqh) : (c > tqh);
                sacc[mi][ni][j] = okv ? sacc[mi][ni][j] + fmaf(slope, (float)(ni * 16 + j), rc) : -1e30f;
              }
          }
        }
        nsa_online(sacc, m_run, l_run, oacc);
        nsa_pv(oacc, sacc, tb, pw, hf, fr, fq);
      }
      cur = nxt; bsel ^= 1;
    }
#pragma unroll
    for (int mi = 0; mi < 4; ++mi) {
      const size_t n = nb + t0 + mi * 16 + fr;
      const float l = red4(l_run[mi]); const float sc = sigmoidf_(a.SM[n * 32 + 8 + h * 3 + br]) / l;
#pragma unroll
      for (int ni = 0; ni < 4; ++ni) {
        st_bf4(a.ANS + n * 512 + h * 64 + ni * 16 + 4 * fq, oacc[mi][ni] * sc);
      }
    }
  }
  __syncthreads();
}


__device__ __forceinline__ int img_off(int row, int k) { return row * 128 + ((((k >> 3) ^ ((row >> 1) & 7))) << 4) + (k & 7) * 2; }
__device__ __forceinline__ bf16x8 img_frag(const char* img, int r0, int ks, int fr, int fq) { return *(const bf16x8*)(img + (r0 + fr) * 128 + (((ks * 4 + fq) ^ (fr >> 1)) << 4)); }


__device__ __forceinline__ void stage_raw(const bf16_t* __restrict__ QK, int nb, int t0, int chbase, char* raw, int tid) {
  u32x4 v[5];
#pragma unroll
  for (int i = 0; i < 5; ++i) {
    const int c = tid + 256 * i, row = c >> 4, cc = c & 15, t = t0 - 3 + row;
    v[i] = (c < 1072 && t >= 0) ? *(const u32x4*)(QK + (size_t)(nb + t) * 1024 + chbase + cc * 8) : (u32x4){0u, 0u, 0u, 0u};
  }
#pragma unroll
  for (int i = 0; i < 5; ++i) { const int c = tid + 256 * i; if (c < 1072) *(u32x4*)(raw + c * 16) = v[i]; }
}
template <class Put>
__device__ __forceinline__ void conv_col(const char* raw, const float* __restrict__ conv, int j0, int nj, int ch, int d, float scale, Put put) {
  const float w0 = conv[ch], w1 = conv[1024 + ch], w2 = conv[2048 + ch], w3 = conv[3072 + ch];
  const bf16_t* r = (const bf16_t*)raw + d;
  float x0 = bf2f(r[(j0 + 0) * 128]), x1 = bf2f(r[(j0 + 1) * 128]), x2 = bf2f(r[(j0 + 2) * 128]);
  for (int j = j0; j < j0 + nj; ++j) {
    const float x3 = bf2f(r[(j + 3) * 128]);
    put(j, siluf_(w0 * x0 + w1 * x1 + w2 * x2 + w3 * x3) * scale);
    x0 = x1; x1 = x2; x2 = x3;
  }
}

__device__ __forceinline__ void ml_dc_item(const MegaArgs& a, const MlArgs& ml, int item, char* lds, int tid) {
  asm volatile("" : "+v"(tid));
  const int lane = tid & 63, wid = tid >> 6, wr = wid >> 1, wc = wid & 1, fr = lane & 15, fq = lane >> 4;
  const int bh = item >> 6, c = item & 63, b = bh >> 2, h = bh & 3, nb = b * SEQ, t0 = c * 64;
  char* KT = lds; char* VT = lds + 16384; float* sc = (float*)(lds + 32768); float* dnp = (float*)(lds + 33792);
  if (tid < 64) {
    const size_t n = nb + t0 + tid;
    sc[tid] = a.SM[n * 32 + h] + ml.b_i[h];
    sc[64 + tid] = logsigmoidf_(a.SM[n * 32 + 4 + h] + ml.b_f[h]);
  }
  __syncthreads();
  if (tid < 64) {
    float cs = sc[64 + tid];
#pragma unroll
    for (int o = 1; o < 64; o <<= 1) { const float up = __shfl_up(cs, o); if (tid >= o) cs += up; }
    const float bl = __shfl(cs, 63);
    const float lw = bl - cs + sc[tid];
    const float mx = wave_max(lw);
    sc[128 + tid] = cs; sc[192 + tid] = __expf(lw - mx);
    if (tid == 0) { ml.BL[bh * 64 + c] = bl; ml.MX[bh * 64 + c] = mx; }
  }
  __syncthreads();
  if (tid < 64) { ml.BCUM[bh * SEQ + t0 + tid] = sc[128 + tid]; ml.IP[bh * SEQ + t0 + tid] = sc[tid]; }
  char* RAW = lds + 36864;
  stage_raw(a.QK, nb, t0, 512 + h * 128, RAW, tid);
  __syncthreads();
  {
    const int d = tid & 127, jh = tid >> 7;
    float dn = 0.f;
    conv_col(RAW, ml.conv, jh * 32, 32, 512 + h * 128 + d, d, 0.08838834764831845f,
             [&](int j, float v) { *(bf16_t*)(KT + img_off(d, j)) = f2bf(v); dn += sc[192 + j] * v; });
    dnp[jh * 128 + d] = dn;
    {
      bf16_t tv[32];
#pragma unroll
      for (int u = 0; u < 32; ++u) tv[u] = a.V[(size_t)(nb + t0 + jh * 32 + u) * 512 + h * 128 + d];
#pragma unroll
      for (int u = 0; u < 32; ++u) *(bf16_t*)(VT + img_off(d, jh * 32 + u)) = f2bf(sc[192 + jh * 32 + u] * bf2f(tv[u]));
    }
  }
  __syncthreads();
  if (tid < 128) ml.NST[(size_t)(bh * 64 + c) * 128 + tid] = dnp[tid] + dnp[128 + tid];
  f32x4 acc[4][4]; zero_acc(acc);
#pragma unroll
  for (int ks = 0; ks < 2; ++ks) {
    bf16x8 av[4], bk[4];
#pragma unroll
    for (int i = 0; i < 4; ++i) { av[i] = img_frag(VT, wr * 64 + i * 16, ks, fr, fq); bk[i] = img_frag(KT, wc * 64 + i * 16, ks, fr, fq); }
#pragma unroll
    for (int i = 0; i < 4; ++i)
#pragma unroll
      for (int j = 0; j < 4; ++j) acc[i][j] = __builtin_amdgcn_mfma_f32_16x16x32_bf16(bk[j], av[i], acc[i][j], 0, 0, 0);
  }
  bf16_t* cst = ml.CST + (size_t)(bh * 64 + c) * 16384;
#pragma unroll
  for (int mi = 0; mi < 4; ++mi)
#pragma unroll
    for (int ni = 0; ni < 4; ++ni) st_bf4(cst + (wr * 64 + mi * 16 + fr) * 128 + wc * 64 + ni * 16 + 4 * fq, acc[mi][ni]);
  __syncthreads();
}

__device__ __forceinline__ void ml_scan_item(const MlArgs& ml, int item, int tid) {
  const int bh = item / 17, part = item % 17;
  float m = 0.f;
  if (part < 16) {
    float run[4] = {0.f, 0.f, 0.f, 0.f};
#pragma unroll 1
    for (int c0 = 0; c0 < 64; c0 += 8) {
      u32x2 vb[8]; float bl[8], mxv[8];
#pragma unroll
      for (int u = 0; u < 8; ++u) {
        vb[u] = *(const u32x2*)(ml.CST + (size_t)(bh * 64 + c0 + u) * 16384 + part * 1024 + tid * 4);
        bl[u] = ml.BL[bh * 64 + c0 + u]; mxv[u] = ml.MX[bh * 64 + c0 + u];
      }
#pragma unroll
      for (int u = 0; u < 8; ++u) {
        const float mn = fmaxf(bl[u] + m, mxv[u]), decay = __expf(bl[u] + m - mn), scl = __expf(mxv[u] - mn);
        u32x2 o; o.x = pk2bf(run[0], run[1]); o.y = pk2bf(run[2], run[3]);
        *(u32x2*)(ml.CST + (size_t)(bh * 64 + c0 + u) * 16384 + part * 1024 + tid * 4) = o;
        run[0] = decay * run[0] + scl * __uint_as_float(vb[u].x << 16); run[1] = decay * run[1] + scl * __uint_as_float(vb[u].x & 0xffff0000u);
        run[2] = decay * run[2] + scl * __uint_as_float(vb[u].y << 16); run[3] = decay * run[3] + scl * __uint_as_float(vb[u].y & 0xffff0000u);
        if (part == 0 && tid == 0) ml.MST[bh * 64 + c0 + u] = m;
        m = mn;
      }
    }
  } else if (tid < 128) {
    float run = 0.f;
    for (int c = 0; c < 64; ++c) {
      const float bl = ml.BL[bh * 64 + c], mx = ml.MX[bh * 64 + c];
      const float mn = fmaxf(bl + m, mx), decay = __expf(bl + m - mn), scl = __expf(mx - mn);
      float* p = ml.NST + (size_t)(bh * 64 + c) * 128 + tid;
      const float v = *p; *p = run; run = decay * run + scl * v;
      m = mn;
    }
  }
}

__device__ __forceinline__ void ml_out_item(const MegaArgs& a, const MlArgs& ml, int item, char* lds, int tid) {
  asm volatile("" : "+v"(tid));
  const int lane = tid & 63, wid = tid >> 6, wr = wid >> 1, wc = wid & 1, fr = lane & 15, fq = lane >> 4;
  const int bh = item >> 6, c = item & 63, b = bh >> 2, h = bh & 3, nb = b * SEQ, t0 = c * 64;
  char* Qi = lds; char* Ki = lds + 16384; char* VT = lds + 32768; char* SP = lds + 49152;
  float* sc = (float*)(lds + 57344);
  float* H = (float*)lds;
  {
    char* RAW = lds + 49152;
    const int d = tid & 127, jh = tid >> 7;
    stage_raw(a.QK, nb, t0, h * 128, RAW, tid);
    {
      bf16_t tv[32];
#pragma unroll
      for (int u = 0; u < 32; ++u) tv[u] = a.V[(size_t)(nb + t0 + jh * 32 + u) * 512 + h * 128 + d];
#pragma unroll
      for (int u = 0; u < 32; ++u) *(bf16_t*)(VT + img_off(d, jh * 32 + u)) = tv[u];
    }
    __syncthreads();
    conv_col(RAW, ml.conv, jh * 32, 32, h * 128 + d, d, 1.f, [&](int j, float v) { *(bf16_t*)(Qi + (d >> 6) * 8192 + img_off(j, d & 63)) = f2bf(v); });
    __syncthreads();
    stage_raw(a.QK, nb, t0, 512 + h * 128, RAW, tid);
    __syncthreads();
    conv_col(RAW, ml.conv, jh * 32, 32, 512 + h * 128 + d, d, 0.08838834764831845f, [&](int j, float v) { *(bf16_t*)(Ki + (d >> 6) * 8192 + img_off(j, d & 63)) = f2bf(v); });
    __syncthreads();
  }
  if (tid < 64) { sc[tid] = ml.BCUM[bh * SEQ + t0 + tid]; sc[64 + tid] = ml.IP[bh * SEQ + t0 + tid]; }
  if (tid < 128) sc[448 + tid] = ml.NST[(size_t)(bh * 64 + c) * 128 + tid];
  __syncthreads();
  const float m = ml.MST[bh * 64 + c];
  if (tid < 64) {
    const float bj = sc[tid]; float mxi = -INFINITY;
    for (int s2 = 0; s2 <= tid; ++s2) mxi = fmaxf(mxi, bj - sc[s2] + sc[64 + s2]);
    const float inter = bj + m, mt = fmaxf(mxi, inter);
    sc[128 + tid] = mt; sc[192 + tid] = __expf(inter - mt);
  } else if (tid < 128) {
    const int t = tid - 64; float nq = 0.f;
    for (int k = 0; k < 128; ++k) nq += sc[448 + k] * bf2f(*(const bf16_t*)(Qi + (k >> 6) * 8192 + img_off(t, k & 63)));
    sc[384 + t] = nq;
  }
  f32x4 sacc[2][2];
#pragma unroll
  for (int i = 0; i < 2; ++i)
#pragma unroll
    for (int j = 0; j < 2; ++j) sacc[i][j] = (f32x4){0.f, 0.f, 0.f, 0.f};
#pragma unroll
  for (int kt = 0; kt < 2; ++kt)
#pragma unroll
    for (int ks = 0; ks < 2; ++ks) {
      bf16x8 aq[2], bk[2];
#pragma unroll
      for (int i = 0; i < 2; ++i) { aq[i] = img_frag(Qi + kt * 8192, wr * 32 + i * 16, ks, fr, fq); bk[i] = img_frag(Ki + kt * 8192, wc * 32 + i * 16, ks, fr, fq); }
#pragma unroll
      for (int i = 0; i < 2; ++i)
#pragma unroll
        for (int j = 0; j < 2; ++j) sacc[i][j] = __builtin_amdgcn_mfma_f32_16x16x32_bf16(bk[j], aq[i], sacc[i][j], 0, 0, 0);
    }
  __syncthreads();
  const bf16_t* cst = ml.CST + (size_t)(bh * 64 + c) * 16384;
#pragma unroll
  for (int i = 0; i < 4; ++i) { const int idx = tid + 256 * i, row = idx >> 3, lc = (idx & 7) ^ ((row >> 1) & 7); glds16(cst + row * 128 + lc * 8, Ki + idx * 16); }
#pragma unroll
  for (int mi = 0; mi < 2; ++mi) {
    const int t = wr * 32 + mi * 16 + fr; const float bt = sc[t], mt = sc[128 + t]; float rsum = 0.f;
#pragma unroll
    for (int ni = 0; ni < 2; ++ni) {
      const int s0 = wc * 32 + ni * 16 + 4 * fq; f32x4 p;
#pragma unroll
      for (int j = 0; j < 4; ++j) { const int s2 = s0 + j; p[j] = (s2 <= t) ? sacc[mi][ni][j] * __expf(bt - sc[s2] + sc[64 + s2] - mt) : 0.f; rsum += p[j]; }
      u32x2 o; o.x = pk2bf(p[0], p[1]); o.y = pk2bf(p[2], p[3]);
      *(u32x2*)(SP + img_off(t, s0)) = o;
    }
    rsum += __shfl_xor(rsum, 16); rsum += __shfl_xor(rsum, 32);
    if (fq == 0) sc[256 + t * 2 + wc] = rsum;
  }
  asm volatile("s_waitcnt vmcnt(0)" ::: "memory");
  __syncthreads();
  f32x4 acc1[2][4], acc2[2][4];
#pragma unroll
  for (int i = 0; i < 2; ++i)
#pragma unroll
    for (int j = 0; j < 4; ++j) { acc1[i][j] = (f32x4){0.f, 0.f, 0.f, 0.f}; acc2[i][j] = (f32x4){0.f, 0.f, 0.f, 0.f}; }
#pragma unroll
  for (int ks = 0; ks < 2; ++ks) {
    bf16x8 as[2], bv[4];
#pragma unroll
    for (int i = 0; i < 2; ++i) as[i] = img_frag(SP, wr * 32 + i * 16, ks, fr, fq);
#pragma unroll
    for (int j = 0; j < 4; ++j) bv[j] = img_frag(VT, wc * 64 + j * 16, ks, fr, fq);
#pragma unroll
    for (int i = 0; i < 2; ++i)
#pragma unroll
      for (int j = 0; j < 4; ++j) acc1[i][j] = __builtin_amdgcn_mfma_f32_16x16x32_bf16(bv[j], as[i], acc1[i][j], 0, 0, 0);
  }
#pragma unroll 1
  for (int kt = 0; kt < 2; ++kt) {
    if (kt == 1) {
      __syncthreads();
#pragma unroll
      for (int i = 0; i < 4; ++i) { const int idx = tid + 256 * i, row = idx >> 3, lc = (idx & 7) ^ ((row >> 1) & 7); glds16(cst + row * 128 + 64 + lc * 8, Ki + idx * 16); }
      asm volatile("s_waitcnt vmcnt(0)" ::: "memory");
      __syncthreads();
    }
#pragma unroll
    for (int ks = 0; ks < 2; ++ks) {
      bf16x8 aq[2], bc[4];
#pragma unroll
      for (int i = 0; i < 2; ++i) aq[i] = img_frag(Qi + kt * 8192, wr * 32 + i * 16, ks, fr, fq);
#pragma unroll
      for (int j = 0; j < 4; ++j) bc[j] = img_frag(Ki, wc * 64 + j * 16, ks, fr, fq);
#pragma unroll
      for (int i = 0; i < 2; ++i)
#pragma unroll
        for (int j = 0; j < 4; ++j) acc2[i][j] = __builtin_amdgcn_mfma_f32_16x16x32_bf16(bc[j], aq[i], acc2[i][j], 0, 0, 0);
    }
  }
  __syncthreads();
#pragma unroll
  for (int mi = 0; mi < 2; ++mi) {
    const int t = wr * 32 + mi * 16 + fr; const float wi = sc[192 + t];
    const float den = sc[256 + t * 2] + sc[256 + t * 2 + 1] + wi * sc[384 + t];
    const float inv = 1.f / fmaxf(fabsf(den), __expf(-sc[128 + t]));
#pragma unroll
    for (int ni = 0; ni < 4; ++ni) *(f32x4*)(H + t * 132 + wc * 64 + ni * 16 + 4 * fq) = (acc1[mi][ni] + acc2[mi][ni] * wi) * inv;
  }
  __syncthreads();
  {
    bf16_t og0[16], og1[16];
#pragma unroll
    for (int r = 0; r < 16; ++r) { const size_t n = nb + t0 + wid * 16 + r; og0[r] = a.O[n * 512 + h * 128 + lane]; og1[r] = a.O[n * 512 + h * 128 + 64 + lane]; }
    const float g0 = ml.gain[h * 128 + lane], g1 = ml.gain[h * 128 + 64 + lane];
#pragma unroll
    for (int r = 0; r < 16; ++r) {
      const int j = wid * 16 + r;
      const float a0 = H[j * 132 + lane], a1 = H[j * 132 + 64 + lane];
      const float ss = wave_sum(a0 * a0 + a1 * a1);
      const float rs = rsqrtf(ss * (1.f / 128.f) + EPS);
      const size_t n = nb + t0 + j; const int c0 = h * 128 + lane, c1 = c0 + 64;
      a.AML[n * 512 + c0] = f2bf(sigmoidf_(bf2f(og0[r])) * a0 * rs * g0);
      a.AML[n * 512 + c1] = f2bf(sigmoidf_(bf2f(og1[r])) * a1 * rs * g1);
    }
  }
  __syncthreads();
}


#define XB_TMO      128
#define XB_XCNT(j)  (256  + 64 * (j))
#define XB_XSUB(j)  (1280 + 64 * (j))
#define XB_XGEN(j)  (2304 + 64 * (j))
#define XB_TOP      3328
#define XB_TOPGEN   3392
#define XCD_BAR_WORDS 3456
#define XB_SPIN_CAP (1u << 24)
__device__ __forceinline__ unsigned xb_ld(unsigned* p)              { return __hip_atomic_load(p, __ATOMIC_RELAXED, __HIP_MEMORY_SCOPE_AGENT); }
__device__ __forceinline__ unsigned xb_add(unsigned* p, unsigned v) { return __hip_atomic_fetch_add(p, v, __ATOMIC_RELAXED, __HIP_MEMORY_SCOPE_AGENT); }
__device__ __forceinline__ unsigned xb_xcc_id() { return (unsigned)__builtin_amdgcn_s_getreg((3 << 11) | 20) & 0xFu; }
#define XB_SPIN(cond, bar) do { unsigned _sp = 0; while (cond) { __builtin_amdgcn_s_sleep(1); \
    if ((++_sp & 255u) == 0u) { if (xb_ld(&(bar)[XB_TMO])) break; if (_sp > XB_SPIN_CAP) { atomicAdd(&(bar)[XB_TMO], 1u); break; } } } } while (0)
__device__ __forceinline__ void xcd_barrier_complete(unsigned* bar, unsigned x, unsigned G, unsigned& nloc, unsigned& nx) {
  unsigned sum, cnt, mine, sp = 0u;
  for (;;) {
    sum = 0u; cnt = 0u; mine = 0u;
#pragma unroll
    for (unsigned j = 0; j < 16; ++j) { const unsigned c = xb_ld(&bar[XB_XCNT(j)]); sum += c; cnt += (c > 0u) ? 1u : 0u; mine = (j == x) ? c : mine; }
    if (sum == G) break;
    __builtin_amdgcn_s_sleep(1);
    if ((++sp & 255u) == 0u) { if (xb_ld(&bar[XB_TMO])) break; if (sp > XB_SPIN_CAP) { atomicAdd(&bar[XB_TMO], 1u); break; } }
  }
  nloc = mine > 0u ? mine : 1u; nx = cnt > 0u ? cnt : 1u;
}
__device__ __forceinline__ void xcd_barrier(unsigned* bar, unsigned x, volatile unsigned* st, unsigned G, bool leader_thread) {
  asm volatile("s_waitcnt vmcnt(0)" ::: "memory");
  __syncthreads();
  if (leader_thread) {
    __builtin_amdgcn_s_waitcnt(0);
    unsigned nloc = st[0], nx = st[1];
    if (nloc == 0u) { xcd_barrier_complete(bar, x, G, nloc, nx); st[0] = nloc; st[1] = nx; }
    const unsigned old = xb_add(&bar[XB_XSUB(x)], 1u);
    const unsigned gen = old / nloc;
    if (old + 1u == (gen + 1u) * nloc) {
      __builtin_amdgcn_fence(__ATOMIC_RELEASE, "agent");
      asm volatile("s_waitcnt vmcnt(0)" ::: "memory");
      const unsigned og = xb_add(&bar[XB_TOP], 1u);
      const unsigned tg = og / nx;
      if (og + 1u == (tg + 1u) * nx) xb_add(&bar[XB_TOPGEN], 1u);
      else XB_SPIN(xb_ld(&bar[XB_TOPGEN]) == tg, bar);
      __builtin_amdgcn_fence(__ATOMIC_ACQUIRE, "agent");
      xb_add(&bar[XB_XGEN(x)], 1u);
      asm volatile("s_waitcnt vmcnt(0)" ::: "memory");
    } else {
      XB_SPIN(xb_ld(&bar[XB_XGEN(x)]) == gen, bar);
      __builtin_amdgcn_fence(__ATOMIC_ACQUIRE, "agent");
      asm volatile("s_waitcnt vmcnt(0)" ::: "memory");
    }
  }
  __syncthreads();
}

__device__ __forceinline__ void convert_range(const MegaArgs& a, int lo, int hi, int bid, int nblk, char* lds, int tid) {
  for (int it = lo + bid; it < hi; it += nblk) {
    int r = it, di = 0;
    while (r >= a.td[di].nitems) { r -= a.td[di].nitems; ++di; }
    transpose_item(a.td[di], r, (float*)lds, tid);
  }
}
#define TILE_IDS unsigned tid_z = 0u; asm volatile("" : "+v"(tid_z)); int tid = wave_s * 64 + (int)__builtin_amdgcn_mbcnt_hi(~0u, __builtin_amdgcn_mbcnt_lo(~0u, tid_z)); asm volatile("" : "+v"(tid)); const int lane = tid & 63, wid = tid >> 6, wr = wid >> 1, wc = wid & 1, fr = lane & 15, fq = lane >> 4; (void)lane; (void)wid; (void)wr; (void)wc; (void)fr; (void)fq

__global__ void __launch_bounds__(256, 2) k_mega(MegaArgs a) {
  extern __shared__ __attribute__((aligned(16))) char lds_raw[];
  char* lds = lds_raw;
  cg::grid_group grid = cg::this_grid();
  const int nblk = gridDim.x, bid = blockIdx.x;
  const int wave_s = __builtin_amdgcn_readfirstlane((int)(threadIdx.x >> 6));
  unsigned* const xbar = a.BAR + a.li * XCD_BAR_WORDS;
  volatile unsigned* const xst = (volatile unsigned*)(lds + MEGA_LDS - 16);
  unsigned xcc;
  {
    TILE_IDS;
    if (tid == 0) { xst[0] = 0u; xst[1] = 0u; }
    xcc = xb_xcc_id();
    if (tid == 0) (void)xb_add(&xbar[XB_XCNT(xcc)], 1u);
    grid.sync();
  }
#define PH(k) (a.ph_lo <= (k) && (k) < a.ph_hi)
  const int xcd = bid & 7, li = bid >> 3, nloc = nblk >> 3;
#define GRID_BAR() do { const int ld_ = (wave_s == 0) && ((int)__builtin_amdgcn_mbcnt_hi(~0u, __builtin_amdgcn_mbcnt_lo(~0u, 0u)) == 0); xcd_barrier(xbar, xcc, xst, (unsigned)nblk, ld_); } while (0)
#define SYNC_AFTER(k) do { if (PH(k) && PH((k) + 1)) GRID_BAR(); } while (0)
#pragma unroll 1
  for (int rp_ = PH(0) ? a.rep[0] : 0; rp_ > 0; --rp_) {
    TILE_IDS;
    convert_range(a, a.cv_lo[0], a.cv_hi[0], bid, nblk, lds, tid);
    for (int i = bid * 256 + tid; i < (NIN - DIN_A) * 1024 / 8; i += nblk * 256) ((u32x4*)(a.WinT + (size_t)DIN_A * 1024))[i] = (u32x4){0u, 0u, 0u, 0u};
    rows_to_bf16(a.x, a.XB, a.RS1, NTOK, bid * 4 + wid, nblk * 4, lane);
    rows_to_bf16(a.mem, a.MEMB, a.RSM, NB * MEMT, bid * 4 + wid, nblk * 4, lane);
    for (int o = bid * 4 + wid; o < 256; o += nblk * 4) {
      const int which = o >> 7, u = o & 127; const float* pos = which ? a.posv : a.posk; const float* w1 = which ? a.cvw1 : a.ckw1;
      float sacc = 0.f;
      for (int f = lane; f < 2048; f += 64) sacc += pos[f] * w1[(size_t)f * 128 + u];
      sacc = wave_sum(sacc);
      if (lane == 0) a.POSW[o] = sacc;
    }
  }
  SYNC_AFTER(0);
#pragma unroll 1
  for (int rp_ = PH(1) ? a.rep[1] : 0; rp_ > 0; --rp_) {
    TILE_IDS;
    constexpr int NTN = NIN / 128, NTM = NTOK / 128, T1 = NTN * NTM, T2n = 16, T2 = 8 * T2n;
    (void)NTM; (void)T1; (void)T2;
    for (int q = li; q < 432; q += nloc) {
      f32x4 acc[4][4]; zero_acc(acc);
      if (q < 432) {
        const int mg = q / 216, r_ = q - mg * 216;
        const int m0 = (xcd * 16 + mg * 8 + (r_ & 7)) * 128, n0 = (r_ >> 3) * 128;
        const int seg = (n0 - 2560) >> 7;
        if (n0 >= 2560 && n0 < 3328 && (seg == 3 || seg == 5)) {
          gemm_acc(acc, a.WinT, DM, (const int*)nullptr, 0, 0, a.XB, DM, DM, lds, n0, m0, tid);
          bf16_t* dst = (seg == 3) ? a.VST : a.VWT;
#pragma unroll
          for (int ni = 0; ni < 4; ++ni) {
            const int tok = m0 + wc * 64 + ni * 16 + 4 * fq; const f32x4 rs = *(const f32x4*)(a.RS1 + tok);
            const int b = tok >> 12, t = tok & 4095;
#pragma unroll
            for (int mi = 0; mi < 4; ++mi) {
              const int col = wr * 64 + mi * 16 + fr;
              st_bf4(dst + ((size_t)(b * 128 + col) << 12) + t, acc[mi][ni] * rs);
            }
          }
        } else {
          gemm_acc(acc, a.XB, DM, (const int*)nullptr, 0, 0, a.WinT, DM, DM, lds, m0, n0, tid);
          bf16_t* dst; int ld, cofs; float scale = 1.f;
          if (n0 < 1024) { dst = a.QK; ld = 1024; cofs = n0; }
          else if (n0 < 1536) { dst = a.V; ld = 512; cofs = n0 - 1024; }
          else if (n0 < 2048) { dst = a.O; ld = 512; cofs = n0 - 1536; }
          else if (n0 < 2560) { dst = a.NQ; ld = 512; cofs = n0 - 2048; scale = 0.125f * 1.4426950408889634f; }
          else if (n0 < 2816) { dst = a.KVC; ld = 256; cofs = n0 - 2560; }
          else if (n0 < 2944) { dst = a.KS; ld = 128; cofs = 0; }
          else if (n0 < 3328) { dst = a.KW; ld = 128; cofs = 0; }
          else { dst = nullptr; ld = 0; cofs = 0; }
#pragma unroll
          for (int mi = 0; mi < 4; ++mi) {
            const int m = m0 + wr * 64 + mi * 16 + fr; const float rs = a.RS1[m] * scale;
            if (dst) {
#pragma unroll
              for (int ni = 0; ni < 4; ++ni) st_bf4(dst + (size_t)m * ld + cofs + wc * 64 + ni * 16 + 4 * fq, acc[mi][ni] * rs);
            } else if (wc == 0) {
#pragma unroll
              for (int ni = 0; ni < 2; ++ni) *(f32x4*)(a.SM + (size_t)m * 32 + ni * 16 + 4 * fq) = acc[mi][ni] * rs;
            }
          }
        }
      }
    }
    convert_range(a, a.cv_lo[1], a.cv_hi[1], bid, nblk, lds, tid);
  }
  SYNC_AFTER(1);
#pragma unroll 1
  for (int rp_ = PH(2) ? a.rep[2] : 0; rp_ > 0; --rp_) {
    TILE_IDS;
    for (int it = bid; it < 128; it += nblk) {
      const int which = it >> 6, m0 = ((it >> 2) & 15) * 128, slab = it & 3;
      f32x4 acc[4][4]; zero_acc(acc);
      {
        int tid2 = tid; asm volatile("" : "+v"(tid2));
        unsigned ao[4], bo[4];
#pragma unroll
        for (int i = 0; i < 4; ++i) {
          const int row = st_row(tid2, i), lc = st_lc(tid2, i);
          const int m = m0 + row, bg = m >> 8, j = m & 255;
          ao[i] = (unsigned)((bg >> 1) * SEQ + 16 * j + slab * 8) * 256u + which * 128 + (bg & 1) * 64 + lc * 8;
          bo[i] = (unsigned)row * 2048u + slab * 512 + lc * 8;
        }
        gemm_core(acc, a.KVC, ao, 256u, which ? a.CV1T : a.CK1T, bo, 64u, 8, lds, tid2);
      }
      float* cp = a.CPART + (size_t)((which * 4 + slab) * 2048 + m0) * 128;
#pragma unroll
      for (int mi = 0; mi < 4; ++mi)
#pragma unroll
        for (int ni = 0; ni < 4; ++ni) *(f32x4*)(cp + (wr * 64 + mi * 16 + fr) * 128 + wc * 64 + ni * 16 + 4 * fq) = acc[mi][ni];
    }
    for (int q = nloc - 1 - li; q < 16; q += nloc) {
      f32x4 acc[4][4]; zero_acc(acc);
      const int tile = xcd * 16 + q; constexpr int T1 = 0, T2n = 16;
        const int t2 = tile - T1; const int m0 = (t2 / T2n) * 128, n0 = (t2 % T2n) * 128;
        if (n0 < 1024) {
          gemm_acc(acc, a.MEMB, DM, (const int*)nullptr, 0, 0, a.WkvT, DM, DM, lds, m0, n0, tid);
#pragma unroll
          for (int mi = 0; mi < 4; ++mi) {
            const int m = m0 + wr * 64 + mi * 16 + fr; const float rs = a.RSM[m];
#pragma unroll
            for (int ni = 0; ni < 4; ++ni) st_bf4(a.KVM + (size_t)m * 1024 + n0 + wc * 64 + ni * 16 + 4 * fq, acc[mi][ni] * rs);
          }
        } else {
          gemm_acc(acc, a.WkvT, DM, (const int*)nullptr, 0, 0, a.MEMB, DM, DM, lds, n0, m0, tid);
          bf16_t* vmt = a.KVM + (size_t)1024 * 1024;
#pragma unroll
          for (int ni = 0; ni < 4; ++ni) {
            const int tok = m0 + wc * 64 + ni * 16 + 4 * fq; const f32x4 rs = *(const f32x4*)(a.RSM + tok);
            const int b = tok >> 8, key = tok & 255;
#pragma unroll
            for (int mi = 0; mi < 4; ++mi) {
              const int col = n0 - 1024 + wr * 64 + mi * 16 + fr;
              st_bf4(vmt + ((size_t)(b * 1024 + col) << 8) + key, acc[mi][ni] * rs);
            }
          }
        }
    }
    for (int q = li; q < 64; q += nloc) nsa_win_item(a, (xcd << 6) | (63 - q), lds, tid);
    {
      volatile int* wqw = (volatile int*)(lds + MEGA_LDS - 32);
      if (tid == 0) *wqw = atomicAdd(a.WQ + 1, 1);
      __syncthreads();
      int it = *wqw;
      __syncthreads();
      while (it < 1024) {
        int nx_ = 0;
        if (tid == 0) nx_ = atomicAdd(a.WQ + 1, 1);
        ml_dc_item(a, a.ml, it, lds, tid);
        if (tid == 0) *wqw = nx_;
        __syncthreads();
        it = *wqw;
        __syncthreads();
      }
    }
  }
  SYNC_AFTER(2);
#pragma unroll 1
  for (int rp_ = PH(3) ? a.rep[3] : 0; rp_ > 0; --rp_) {
    TILE_IDS;
    if (rp_ == 1) for (int it = bid; it < 272; it += nblk) ml_scan_item(a.ml, it, tid);
    for (int it = nblk - 1 - bid; it < 128; it += nblk) {
      const int which = it >> 6, m0 = (it & 63) * 32;
      float* hid = (float*)lds;
      float* w2s = (float*)(lds + 16640);
      {
        const float* w2 = which ? a.cvw2 : a.ckw2;
#pragma unroll
        for (int c = 0; c < 8; ++c) *(f32x4*)(w2s + (tid + 256 * c) * 4) = *(const f32x4*)(w2 + (tid + 256 * c) * 4);
        const int row = tid >> 3, u0 = (tid & 7) * 16;
        const float* cp = a.CPART + (size_t)(which * 4 * 2048 + m0 + row) * 128 + u0;
#pragma unroll
        for (int c4 = 0; c4 < 4; ++c4) {
          f32x4 hv = *(const f32x4*)(cp + c4 * 4) + *(const f32x4*)(cp + 2048 * 128 + c4 * 4) + *(const f32x4*)(cp + 2 * 2048 * 128 + c4 * 4) + *(const f32x4*)(cp + 3 * 2048 * 128 + c4 * 4)
                   + *(const f32x4*)(a.POSW + which * 128 + u0 + c4 * 4);
#pragma unroll
          for (int j = 0; j < 4; ++j) hid[row * 129 + u0 + c4 * 4 + j] = gelu_tanh(hv[j]);
        }
      }
      __syncthreads();
      {
        const int row = tid >> 3, d0 = (tid & 7) * 8;
        float o[8];
#pragma unroll
        for (int d = 0; d < 8; ++d) o[d] = 0.f;
        for (int u = 0; u < 128; ++u) {
          const float hv = hid[row * 129 + u]; const f32x4 w0 = *(const f32x4*)(w2s + u * 64 + d0), w1 = *(const f32x4*)(w2s + u * 64 + d0 + 4);
          o[0] += hv * w0[0]; o[1] += hv * w0[1]; o[2] += hv * w0[2]; o[3] += hv * w0[3]; o[4] += hv * w1[0]; o[5] += hv * w1[1]; o[6] += hv * w1[2]; o[7] += hv * w1[3];
        }
        const int m = m0 + row, bg = m >> 8, j = m & 255;
        if (which == 0) {
#pragma unroll
          for (int d = 0; d < 8; ++d) a.KC[(size_t)m * 64 + d0 + d] = (j == 255) ? (bf16_t)0 : f2bf(o[d]);
        } else {
#pragma unroll
          for (int d = 0; d < 8; ++d) a.VCT[((size_t)(bg * 64 + d0 + d) << 8) + j] = (j == 255) ? (bf16_t)0 : f2bf(o[d]);
        }
      }
      __syncthreads();
    }
  }
  SYNC_AFTER(3);
#pragma unroll 1
  for (int rp_ = PH(4) ? a.rep[4] : 0; rp_ > 0; --rp_) {
    for (int q = li; q < 64; q += nloc) { TILE_IDS; nsa_main_item(a, (xcd << 6) | (63 - q), lds, tid); }
    { TILE_IDS;
      volatile int* wqw = (volatile int*)(lds + MEGA_LDS - 32);
      if (tid == 0) *wqw = atomicAdd(a.WQ, 1);
      __syncthreads();
      int it = *wqw;
      __syncthreads();
      while (it < 1024) {
        int nx_ = 0;
        if (tid == 0) nx_ = atomicAdd(a.WQ, 1);
        ml_out_item(a, a.ml, it, lds, tid);
        if (tid == 0) *wqw = nx_;
        __syncthreads();
        it = *wqw;
        __syncthreads();
      } }
  }
  SYNC_AFTER(4);
#pragma unroll 1
  for (int rp_ = PH(5) ? a.rep[5] : 0; rp_ > 0; --rp_) {
    TILE_IDS;
    for (int q = li; q < 128; q += nloc) {
      const int m0 = (xcd * 16 + (q >> 6) * 8 + (q & 7)) * 128, n0 = ((q >> 3) & 7) * 128;
      f32x4 acc[4][4]; u32x2 gp[4][4], rp[4][4];
#pragma unroll
      for (int mi = 0; mi < 4; ++mi)
#pragma unroll
        for (int ni = 0; ni < 4; ++ni) rp[mi][ni] = (u32x2){0u, 0u};
#pragma unroll 1
      for (int br = 0; br < 2; ++br) {
        zero_acc(acc);
        gemm_acc(acc, a.XB, DM, (const int*)nullptr, 0, 0, a.WgT + (size_t)br * 1024 * DM, DM, DM, lds, m0, n0, tid);
#pragma unroll
        for (int mi = 0; mi < 4; ++mi) {
          const float rs = a.RS1[m0 + wr * 64 + mi * 16 + fr];
#pragma unroll
          for (int ni = 0; ni < 4; ++ni) {
            f32x4 g = acc[mi][ni] * rs;
            gp[mi][ni].x = pk2bf(sigmoidf_(g[0]), sigmoidf_(g[1])); gp[mi][ni].y = pk2bf(sigmoidf_(g[2]), sigmoidf_(g[3]));
          }
        }
        zero_acc(acc);
        gemm_acc(acc, br ? a.ANS : a.AML, 512, (const int*)nullptr, 0, 0, br ? a.WnsT : a.WmlT, 512, 512, lds, m0, n0, tid);
#pragma unroll
        for (int mi = 0; mi < 4; ++mi)
#pragma unroll
          for (int ni = 0; ni < 4; ++ni) {
            f32x4 g; g[0] = __uint_as_float(gp[mi][ni].x << 16); g[1] = __uint_as_float(gp[mi][ni].x & 0xffff0000u);
            g[2] = __uint_as_float(gp[mi][ni].y << 16); g[3] = __uint_as_float(gp[mi][ni].y & 0xffff0000u);
            f32x4 r = g * acc[mi][ni];
            r[0] += __uint_as_float(rp[mi][ni].x << 16); r[1] += __uint_as_float(rp[mi][ni].x & 0xffff0000u);
            r[2] += __uint_as_float(rp[mi][ni].y << 16); r[3] += __uint_as_float(rp[mi][ni].y & 0xffff0000u);
            rp[mi][ni].x = pk2bf(r[0], r[1]); rp[mi][ni].y = pk2bf(r[2], r[3]);
          }
      }
#pragma unroll
      for (int mi = 0; mi < 4; ++mi) {
        const int m = m0 + wr * 64 + mi * 16 + fr;
#pragma unroll
        for (int ni = 0; ni < 4; ++ni) *(u32x2*)(a.MRG + (size_t)m * 1024 + n0 + wc * 64 + ni * 16 + 4 * fq) = rp[mi][ni];
      }
    }
    convert_range(a, a.cv_lo[5], a.cv_hi[5], bid, nblk, lds, tid);
  }
  SYNC_AFTER(5);
#pragma unroll 1
  for (int rp_ = PH(6) ? a.rep[6] : 0; rp_ > 0; --rp_) {
    TILE_IDS;
    for (int q = li; q < 128; q += nloc) {
      const int m0 = (xcd * 16 + (q >> 6) * 8 + (q & 7)) * 128, n0 = ((q >> 3) & 7) * 128;
      f32x4 acc[4][4]; zero_acc(acc);
      gemm_acc(acc, a.MRG, DM, (const int*)nullptr, 0, 0, a.WoutT, DM, DM, lds, m0, n0, tid);
#pragma unroll
      for (int mi = 0; mi < 4; ++mi) {
        const int m = m0 + wr * 64 + mi * 16 + fr; float ss = 0.f;
#pragma unroll
        for (int ni = 0; ni < 4; ++ni) {
          const size_t off = (size_t)m * 1024 + n0 + wc * 64 + ni * 16 + 4 * fq;
          f32x4 v = *(const f32x4*)(a.x + off) + acc[mi][ni];
          st_bf4(a.X1B + off, v);
          ss += v[0] * v[0] + v[1] * v[1] + v[2] * v[2] + v[3] * v[3];
        }
        ss += __shfl_xor(ss, 16); ss += __shfl_xor(ss, 32);
        if (fq == 0) a.PS2[(size_t)m * 16 + (n0 >> 7) * 2 + wc] = ss;
      }
    }
    convert_range(a, a.cv_lo[6], a.cv_hi[6], bid, nblk, lds, tid);
  }
  SYNC_AFTER(6);
#pragma unroll 1
  for (int rp_ = PH(7) ? a.rep[7] : 0; rp_ > 0; --rp_) {
    TILE_IDS;
    for (int q = li; q < 128; q += nloc) {
      const int m0 = (xcd * 16 + (q >> 6) * 8 + (q & 7)) * 128, n0 = ((q >> 3) & 7) * 128;
      f32x4 acc[4][4]; zero_acc(acc);
      gemm_acc(acc, a.X1B, DM, (const int*)nullptr, 0, 0, a.WqT, DM, DM, lds, m0, n0, tid);
#pragma unroll
      for (int mi = 0; mi < 4; ++mi) {
        const int m = m0 + wr * 64 + mi * 16 + fr;
        const f32x4* pp = (const f32x4*)(a.PS2 + (size_t)m * 16);
        f32x4 p0 = pp[0], p1 = pp[1], p2 = pp[2], p3 = pp[3];
        float ss = ((p0[0] + p0[1]) + (p0[2] + p0[3])) + ((p1[0] + p1[1]) + (p1[2] + p1[3])) + ((p2[0] + p2[1]) + (p2[2] + p2[3])) + ((p3[0] + p3[1]) + (p3[2] + p3[3]));
        const float rs = rsqrtf(ss * (1.f / DM) + EPS);
#pragma unroll
        for (int ni = 0; ni < 4; ++ni) st_bf4(a.XQ + (size_t)m * 1024 + n0 + wc * 64 + ni * 16 + 4 * fq, acc[mi][ni] * rs);
      }
    }
    convert_range(a, a.cv_lo[7], a.cv_hi[7], bid, nblk, lds, tid);
  }
  SYNC_AFTER(7);
#pragma unroll 1
  for (int rp_ = PH(8) ? a.rep[8] : 0; rp_ > 0; --rp_) {
    TILE_IDS;
    float* RMX = (float*)lds; float* RSUM = (float*)(lds + 1024);
    for (int q = li; q < 64; q += nloc) {
      const int m0 = (xcd * 16 + (q >> 2)) * 128, hh = q & 3, b = m0 >> 12;
      bf16_t* Qh = a.XQ + hh * 256;
      const bf16_t* Kh = a.KVM + (size_t)(b * 256) * 1024 + hh * 256;
      const bf16_t* Vh = a.KVM + (size_t)1024 * 1024 + ((size_t)(b * 1024 + hh * 256) << 8);
      f32x4 acc0[4][4], acc1[4][4]; zero_acc(acc0); zero_acc(acc1);
      gemm_acc(acc0, Qh, 1024, (const int*)nullptr, 0, 0, Kh, 1024, 256, lds, m0, 0, tid);
      gemm_acc(acc1, Qh, 1024, (const int*)nullptr, 0, 0, Kh, 1024, 256, lds, m0, 128, tid);
      float mloc[4];
#pragma unroll
      for (int mi = 0; mi < 4; ++mi) {
        float mx = -INFINITY;
#pragma unroll
        for (int ni = 0; ni < 4; ++ni)
#pragma unroll
          for (int j = 0; j < 4; ++j) mx = fmaxf(mx, fmaxf(acc0[mi][ni][j], acc1[mi][ni][j]));
        mx = max4(mx); mloc[mi] = mx;
        if (fq == 0) RMX[(wr * 64 + mi * 16 + fr) * 2 + wc] = mx;
      }
      __syncthreads();
#pragma unroll
      for (int mi = 0; mi < 4; ++mi) {
        const int r = wr * 64 + mi * 16 + fr;
        const float m = fmaxf(RMX[r * 2], RMX[r * 2 + 1]); float ls = 0.f;
#pragma unroll
        for (int ni = 0; ni < 4; ++ni)
#pragma unroll
          for (int j = 0; j < 4; ++j) {
            acc0[mi][ni][j] = __expf((acc0[mi][ni][j] - m) * 0.0625f); acc1[mi][ni][j] = __expf((acc1[mi][ni][j] - m) * 0.0625f);
            ls += acc0[mi][ni][j] + acc1[mi][ni][j];
          }
        ls = red4(ls);
        if (fq == 0) RSUM[r * 2 + wc] = ls;
      }
      __syncthreads();
#pragma unroll
      for (int mi = 0; mi < 4; ++mi) {
        const int r = wr * 64 + mi * 16 + fr;
        const float inv = 1.f / (RSUM[r * 2] + RSUM[r * 2 + 1]);
        bf16_t* pr = Qh + (size_t)(m0 + r) * 1024 + wc * 64 + 4 * fq;
#pragma unroll
        for (int ni = 0; ni < 4; ++ni) { st_bf4(pr + ni * 16, acc0[mi][ni] * inv); st_bf4(pr + 128 + ni * 16, acc1[mi][ni] * inv); }
      }
      asm volatile("s_waitcnt vmcnt(0)" ::: "memory");
      __threadfence_block();
      __syncthreads();
#pragma unroll 1
      for (int dh = 0; dh < 2; ++dh) {
        zero_acc(acc0);
        gemm_acc(acc0, Qh, 1024, (const int*)nullptr, 0, 0, Vh, 256, 256, lds, m0, dh * 128, tid);
#pragma unroll
        for (int mi = 0; mi < 4; ++mi) {
          const int r = wr * 64 + mi * 16 + fr;
#pragma unroll
          for (int ni = 0; ni < 4; ++ni) st_bf4(a.XO + (size_t)(m0 + r) * 1024 + hh * 256 + dh * 128 + wc * 64 + ni * 16 + 4 * fq, acc0[mi][ni]);
        }
      }
    }
    convert_range(a, a.cv_lo[8], a.cv_hi[8], bid, nblk, lds, tid);
  }
  SYNC_AFTER(8);
#pragma unroll 1
  for (int rp_ = PH(9) ? a.rep[9] : 0; rp_ > 0; --rp_) {
    TILE_IDS;
    for (int q = li; q < 128; q += nloc) {
      const int m0 = (xcd * 16 + (q >> 6) * 8 + (q & 7)) * 128, n0 = ((q >> 3) & 7) * 128;
      f32x4 acc[4][4]; zero_acc(acc);
      gemm_acc(acc, a.XO, DM, (const int*)nullptr, 0, 0, a.WoT, DM, DM, lds, m0, n0, tid);
#pragma unroll
      for (int mi = 0; mi < 4; ++mi) {
        const int m = m0 + wr * 64 + mi * 16 + fr;
#pragma unroll
        for (int ni = 0; ni < 4; ++ni) {
          const size_t off = (size_t)m * 1024 + n0 + wc * 64 + ni * 16 + 4 * fq;
          const u32x2 pr = *(const u32x2*)(a.X1B + off); f32x4 r = acc[mi][ni];
          r[0] += __uint_as_float(pr.x << 16); r[1] += __uint_as_float(pr.x & 0xffff0000u); r[2] += __uint_as_float(pr.y << 16); r[3] += __uint_as_float(pr.y & 0xffff0000u);
          st_bf4(a.X1B + off, r);
        }
      }
    }
    convert_range(a, a.cv_lo[9], a.cv_hi[9], bid, nblk, lds, tid);
  }
  SYNC_AFTER(9);
#pragma unroll 1
  for (int rp_ = PH(10) ? a.rep[10] : 0; rp_ > 0; --rp_) {
    TILE_IDS;
    const int tpb = NTOK / nblk;
    int* ex_l = (int*)(lds + 65536);
    float* we_l = (float*)lds;
    for (int c = tid; c < 4096; c += 256) { const int k = c >> 2, q = c & 3; *(f32x4*)(we_l + (q * 1024 + k) * 4) = *(const f32x4*)(a.we + k * 16 + q * 4); }
    __syncthreads();
    for (int k = 0; k < tpb / 4; ++k) {
      const int tl = wid * (tpb / 4) + k, n = bid * tpb + tl;
      int lane = tid & 63; asm volatile("" : "+v"(lane));
      const bf16_t* xr = a.H3 + (size_t)n * DM;
      float v[16]; float s = 0.f;
#pragma unroll
      for (int i = 0; i < 16; ++i) { v[i] = bf2f(xr[lane + 64 * i]); s += v[i] * v[i]; }
      s = wave_sum(s);
      const float rs = rsqrtf(s * (1.f / DM) + EPS);
      float lg[20];
#pragma unroll
      for (int e = 0; e < 20; ++e) lg[e] = 0.f;
#pragma unroll
      for (int i = 0; i < 16; ++i) {
        const int k2 = lane + 64 * i; const float hk = v[i] * rs * a.g_ffn[k2];
        const f32x4 wgv = *(const f32x4*)(a.wg + k2 * 4);
#pragma unroll
        for (int e = 0; e < 4; ++e) lg[e] += hk * wgv[e];
#pragma unroll
        for (int q = 0; q < 4; ++q) { const f32x4 wv = *(const f32x4*)(we_l + (q * 1024 + k2) * 4);
#pragma unroll
          for (int e = 0; e < 4; ++e) lg[4 + q * 4 + e] += hk * wv[e]; }
      }
#pragma unroll
      for (int e = 0; e < 20; ++e) lg[e] = wave_sum(lg[e]);
      if (lane == 0) {
        float gl[4]; float gm = -INFINITY; int gi = 0;
#pragma unroll
        for (int e = 0; e < 4; ++e) { gl[e] = lg[e] + a.bg[e]; if (gl[e] > gm) { gm = gl[e]; gi = e; } }
        float gs = 0.f;
#pragma unroll
        for (int e = 0; e < 4; ++e) gs += __expf(gl[e] - gm);
        const float gval = 1.f / gs;
        float el[4] = {0.f, 0.f, 0.f, 0.f};
#pragma unroll
        for (int gg = 0; gg < 4; ++gg) if (gi == gg) {
#pragma unroll
          for (int e = 0; e < 4; ++e) el[e] = lg[4 + gg * 4 + e] + a.be[gg * 4 + e];
        }
        int i0 = 0; float v0 = el[0];
#pragma unroll
        for (int e = 1; e < 4; ++e) if (el[e] > v0) { v0 = el[e]; i0 = e; }
        int i1 = -1; float v1 = -INFINITY;
#pragma unroll
        for (int e = 0; e < 4; ++e) if (e != i0 && el[e] > v1) { v1 = el[e]; i1 = e; }
        const float e1 = __expf(v1 - v0);
        ex_l[tl * 2] = gi * 4 + i0; ex_l[tl * 2 + 1] = gi * 4 + i1;
        a.RTW[n * 2] = gval / (1.f + e1); a.RTW[n * 2 + 1] = gval * e1 / (1.f + e1);
        a.RS3[n] = rs;
      }
    }
    __syncthreads();
    if (tid < 16) {
      int cnt = 0;
      for (int j = 0; j < 2 * tpb; ++j) cnt += (ex_l[j] == tid) ? 1 : 0;
      if (cnt > 0) {
        int pos = atomicAdd(&a.CNT[tid], cnt);
        for (int j = 0; j < 2 * tpb; ++j) if (ex_l[j] == tid) a.LIST[tid * NTOK + pos++] = (bid * tpb) * 2 + j;
      }
    }
    __syncthreads();
  }
  SYNC_AFTER(10);
#pragma unroll 1
  for (int ph = 11; ph <= 12; ++ph) {
#pragma unroll 1
    for (int rp_ = PH(ph) ? a.rep[ph] : 0; rp_ > 0; --rp_) {
      TILE_IDS;
      int rtot = 0;
      for (int e = 0; e < 16; ++e) rtot += (a.CNT[e] + 127) >> 7;
      const int nmine = ((rtot - xcd + 7) >> 3) * 8;
      for (int q = li; q < nmine; q += nloc) {
        int r = (q >> 3) * 8 + xcd, e = 0, ce = a.CNT[0];
        while (r >= ((ce + 127) >> 7)) { r -= (ce + 127) >> 7; ++e; ce = a.CNT[e]; }
        const int m0 = r * 128, n0 = (q & 7) * 128;
        const int* lst = a.LIST + e * NTOK;
        f32x4 acc[4][4]; zero_acc(acc);
        if (ph == 11) {
          gemm_acc(acc, a.H3, DM, lst, 1, ce, a.W13T + (size_t)e * 1024 * 1024, DM, DM, lds, m0, n0, tid);
#pragma unroll
          for (int mi = 0; mi < 4; ++mi) {
            const int ml = m0 + wr * 64 + mi * 16 + fr;
            if (ml < ce) {
              const int entry = lst[ml]; const float rs = a.RS3[entry >> 1];
#pragma unroll
              for (int ni = 0; ni < 2; ++ni) {
                f32x4 a1 = acc[mi][ni] * rs, a3 = acc[mi][ni + 2] * rs, r4;
#pragma unroll
                for (int j = 0; j < 4; ++j) r4[j] = siluf_(a1[j]) * a3[j];
                st_bf4(a.ACT + (size_t)entry * 512 + (n0 >> 1) + wc * 32 + ni * 16 + 4 * fq, r4);
              }
            }
          }
        } else {
          gemm_acc(acc, a.ACT, 512, lst, 0, ce, a.W2T + (size_t)e * 1024 * 512, 512, 512, lds, m0, n0, tid);
#pragma unroll
          for (int mi = 0; mi < 4; ++mi) {
            const int ml = m0 + wr * 64 + mi * 16 + fr;
            if (ml < ce) {
              const int entry = lst[ml]; const float w = a.RTW[entry];
#pragma unroll
              for (int ni = 0; ni < 4; ++ni) st_bf4(a.Y + (size_t)entry * 1024 + n0 + wc * 64 + ni * 16 + 4 * fq, acc[mi][ni] * w);
            }
          }
        }
      }
    }
    if (PH(ph) && PH(ph + 1)) GRID_BAR();
  }
#pragma unroll 1
  for (int rp_ = PH(13) ? a.rep[13] : 0; rp_ > 0; --rp_) {
    TILE_IDS;
    for (int row = bid * 4 + wid; row < NTOK; row += nblk * 4) {
      f32x4* xr = (f32x4*)(a.out + (size_t)row * DM) + lane;
      const u32x2* x2r = (const u32x2*)(a.H3 + (size_t)row * DM) + lane;
      const u32x2* y0 = (const u32x2*)(a.Y + (size_t)(row * 2) * DM) + lane; const u32x2* y1 = y0 + DM / 4;
      f32x4 v[4]; float s = 0.f;
#pragma unroll
      for (int j = 0; j < 4; ++j) {
        { const u32x2 xx = x2r[64 * j]; v[j][0] = __uint_as_float(xx.x << 16); v[j][1] = __uint_as_float(xx.x & 0xffff0000u); v[j][2] = __uint_as_float(xx.y << 16); v[j][3] = __uint_as_float(xx.y & 0xffff0000u); }
        const u32x2 p = y0[64 * j], q = y1[64 * j];
        v[j][0] += __uint_as_float(p.x << 16) + __uint_as_float(q.x << 16); v[j][1] += __uint_as_float(p.x & 0xffff0000u) + __uint_as_float(q.x & 0xffff0000u);
        v[j][2] += __uint_as_float(p.y << 16) + __uint_as_float(q.y << 16); v[j][3] += __uint_as_float(p.y & 0xffff0000u) + __uint_as_float(q.y & 0xffff0000u);
        s += v[j][0] * v[j][0] + v[j][1] * v[j][1] + v[j][2] * v[j][2] + v[j][3] * v[j][3];
      }
      s = wave_sum(s);
      const float rs = rsqrtf(s * (1.f / DM) + EPS);
#pragma unroll
      for (int j = 0; j < 4; ++j) xr[64 * j] = v[j] * rs * ((const f32x4*)a.g_final)[lane + 64 * j];
    }
  }
}

extern "C" void kernel_launch(void* const* d_in, const int* in_sizes, int n_in, void* d_out, int out_size, void* d_ws, size_t ws_size, hipStream_t stream) {
  const float* x = (const float*)d_in[0];
  const float* mem = (const float*)d_in[1];
  const float* norm_mix = (const float*)d_in[2];
  const float* w_in = (const float*)d_in[3];
  const float* conv_qk = (const float*)d_in[4];
  const float* b_igate = (const float*)d_in[5];
  const float* b_fgate = (const float*)d_in[6];
  const float* mlstm_norm = (const float*)d_in[7];
  const float* cmp_pos_k = (const float*)d_in[8];
  const float* cmp_pos_v = (const float*)d_in[9];
  const float* cmp_k_w1 = (const float*)d_in[10];
  const float* cmp_k_w2 = (const float*)d_in[11];
  const float* cmp_v_w1 = (const float*)d_in[12];
  const float* cmp_v_w2 = (const float*)d_in[13];
  const float* w_br_mlstm = (const float*)d_in[14];
  const float* w_br_nsa = (const float*)d_in[15];
  const float* w_mix_out = (const float*)d_in[16];
  const float* norm_xattn = (const float*)d_in[17];
  const float* norm_mem = (const float*)d_in[18];
  const float* xa_wq = (const float*)d_in[19];
  const float* xa_wkv = (const float*)d_in[20];
  const float* xa_wo = (const float*)d_in[21];
  const float* norm_ffn = (const float*)d_in[22];
  const float* router_group_w = (const float*)d_in[23];
  const float* router_group_b = (const float*)d_in[24];
  const float* router_expert_w = (const float*)d_in[25];
  const float* router_expert_b = (const float*)d_in[26];
  const float* moe_w1 = (const float*)d_in[27];
  const float* moe_w3 = (const float*)d_in[28];
  const float* moe_w2 = (const float*)d_in[29];
  const float* norm_final = (const float*)d_in[30];
  float* out = (float*)d_out;
  char* ws = (char*)d_ws;

  int* CNT = (int*)(ws + WS_CNT); int* LIST = (int*)(ws + WS_LIST); float* RTW = (float*)(ws + WS_RTW);
  float* SM = (float*)(ws + WS_SM); float* BCUM = (float*)(ws + WS_BCUM); float* IP = (float*)(ws + WS_IP);
  float* BL = (float*)(ws + WS_BL); float* MX = (float*)(ws + WS_MX); float* MST = (float*)(ws + WS_MST); float* NST = (float*)(ws + WS_NST);
  bf16_t* KC = (bf16_t*)(ws + WS_KC); bf16_t* VC = (bf16_t*)(ws + WS_VC);
  bf16_t* QK = (bf16_t*)(ws + WS_QK); bf16_t* V = (bf16_t*)(ws + WS_V); bf16_t* O = (bf16_t*)(ws + WS_O);
  bf16_t* NQ = (bf16_t*)(ws + WS_NQ); bf16_t* KV = (bf16_t*)(ws + WS_KV); bf16_t* CST = (bf16_t*)(ws + WS_CST);
  bf16_t* AML = (bf16_t*)(ws + WS_AML); bf16_t* ANS = (bf16_t*)(ws + WS_ANS); bf16_t* MRG = (bf16_t*)(ws + WS_MRG);
  bf16_t* KVM = (bf16_t*)(ws + WS_KVM); bf16_t* MEMN = (bf16_t*)(ws + WS_MEMN);
  bf16_t* H2 = (bf16_t*)(ws + WS_H2); bf16_t* XQ = (bf16_t*)(ws + WS_XQ); bf16_t* XO = (bf16_t*)(ws + WS_XO);
  bf16_t* H3 = H2; bf16_t* ACT = XQ; bf16_t* Y = (bf16_t*)(ws + 136 * MiB);
  bf16_t* H = (bf16_t*)d_out;
  bf16_t* T2 = (bf16_t*)((char*)d_out + 32 * MiB);

  (void)hipMemsetAsync(ws, 0, 131072, stream);
  static int grid_blocks = 0;
  if (!grid_blocks) {
    int dev = 0, cus = 0, per_cu = 0;
    (void)hipGetDevice(&dev);
    (void)hipDeviceGetAttribute(&cus, hipDeviceAttributeMultiprocessorCount, dev);
    (void)hipFuncSetAttribute((const void*)k_mega, hipFuncAttributeMaxDynamicSharedMemorySize, MEGA_LDS);
    (void)hipOccupancyMaxActiveBlocksPerMultiprocessor(&per_cu, (const void*)k_mega, 256, MEGA_LDS);
    if (per_cu > 2) per_cu = 2;
    if (per_cu < 1) per_cu = 1;
    grid_blocks = cus * per_cu;
  }
  MegaArgs fa{};
  fa.x = x; fa.mem = mem; fa.out = out; fa.BAR = (unsigned*)(ws + 65536);
  fa.ml.conv = conv_qk; fa.ml.b_i = b_igate; fa.ml.b_f = b_fgate; fa.ml.gain = mlstm_norm;
  fa.ml.BCUM = BCUM; fa.ml.IP = IP; fa.ml.BL = BL; fa.ml.MX = MX; fa.ml.MST = MST; fa.ml.NST = NST; fa.ml.CST = CST;
  fa.XB = (bf16_t*)d_out; fa.MEMB = (bf16_t*)(ws + WS_MEMB); fa.RS1 = (float*)(ws + WS_RS1); fa.RSM = (float*)(ws + WS_RSM); fa.PS2 = (float*)(ws + WS_PS2);
  fa.QK = QK; fa.V = V; fa.O = O; fa.NQ = NQ; fa.SM = SM;
  fa.KVC = (bf16_t*)(ws + WS_KVC); fa.KS = (bf16_t*)(ws + WS_KS); fa.KW = (bf16_t*)(ws + WS_KW); fa.VST = (bf16_t*)(ws + WS_VST); fa.VWT = (bf16_t*)(ws + WS_VWT);
  fa.KC = KC; fa.VCT = VC; fa.CK1T = (bf16_t*)(ws + WS_CK1T); fa.CV1T = (bf16_t*)(ws + WS_CV1T); fa.POSW = (float*)(ws + WS_POSW);
  fa.posk = cmp_pos_k; fa.posv = cmp_pos_v; fa.ckw1 = cmp_k_w1; fa.cvw1 = cmp_v_w1; fa.ckw2 = cmp_k_w2; fa.cvw2 = cmp_v_w2;
  fa.AML = AML; fa.ANS = ANS; fa.MRG = MRG; fa.X1B = H2; fa.XQ = XQ; fa.XO = XO; fa.KVM = KVM;
  fa.WinT = (bf16_t*)(ws + WS_WIN_T); fa.WgT = (bf16_t*)(ws + WS_WG_T); fa.WmlT = (bf16_t*)(ws + WS_WML_T); fa.WnsT = (bf16_t*)(ws + WS_WNS_T);
  fa.H3 = H3; fa.ACT = ACT; fa.Y = Y; fa.W13T = (bf16_t*)(ws + 104 * MiB); fa.W2T = (bf16_t*)(ws + 240 * MiB);
  fa.CPART = (float*)(ws + 176 * MiB); fa.WQ = (int*)(ws + 256);
  fa.RS3 = (float*)(ws + WS_RSM + 8192); fa.RTW = RTW; fa.CNT = CNT; fa.LIST = LIST;
  fa.g_ffn = norm_ffn; fa.wg = router_group_w; fa.bg = router_group_b; fa.we = router_expert_w; fa.be = router_expert_b; fa.g_final = norm_final;
  fa.WoutT = (bf16_t*)(ws + WS_WOUT_T); fa.WqT = (bf16_t*)(ws + WS_WQ_T); fa.WkvT = (bf16_t*)(ws + WS_WKV_T); fa.WoT = (bf16_t*)(ws + WS_WO_T);
  {
    auto mk = [&](const float* src, bf16_t* dst, const float* gain, int ldw, int K, int c0, int ncols, int drow0) {
      TDesc d{}; d.src = src; d.dst = dst; d.gain = gain; d.ldw = ldw; d.K = K; d.c0 = c0; d.ncols = ncols; d.drow0 = drow0; d.per = (K / 64) * ((ncols + 63) / 64); d.nitems = d.per; d.mode = 0; d.rofs = 0; d.sstride = 0; d.dstride = 0; d.pad = 0; return d; };
    int n = 0;
    fa.td[n++] = mk(w_in, fa.WinT, norm_mix, DIN, DM, 0, 2048, 0);
    fa.td[n++] = mk(w_in, fa.WinT, norm_mix, DIN, DM, 2056, 512, 2048);
    fa.td[n++] = mk(w_in, fa.WinT, norm_mix, DIN, DM, 2568, 768, 2560);
    fa.td[n++] = mk(w_in, fa.WinT, norm_mix, DIN, DM, 2048, 8, 3328);
    fa.td[n++] = mk(w_in, fa.WinT, norm_mix, DIN, DM, 3336, 24, 3336);
    fa.td[n++] = mk(w_in, fa.WgT, norm_mix, DIN, DM, 3360, 2048, 0);
    fa.td[n++] = mk(w_br_mlstm, fa.WmlT, nullptr, 1024, 512, 0, 1024, 0);
    fa.td[n++] = mk(w_br_nsa, fa.WnsT, nullptr, 1024, 512, 0, 1024, 0);
    fa.td[n++] = mk(w_mix_out, fa.WoutT, nullptr, 1024, 1024, 0, 1024, 0);
    fa.td[n++] = mk(xa_wq, fa.WqT, norm_xattn, 1024, 1024, 0, 1024, 0);
    fa.td[n++] = mk(xa_wkv, fa.WkvT, norm_mem, 2048, 1024, 0, 2048, 0);
    fa.td[n++] = mk(xa_wo, fa.WoT, nullptr, 1024, 1024, 0, 1024, 0);
    fa.td[n++] = mk(cmp_k_w1, fa.CK1T, nullptr, 128, 2048, 0, 128, 0);
    fa.td[n++] = mk(cmp_v_w1, fa.CV1T, nullptr, 128, 2048, 0, 128, 0);
    fa.ntdA = n;
    { TDesc d = mk(moe_w1, fa.W13T, norm_ffn, 512, 1024, 0, 512, 0); d.mode = 1; d.rofs = 0; d.nitems = 16 * d.per; d.sstride = 1024 * 512; d.dstride = 1024 * 1024; fa.td[n++] = d; }
    { TDesc d = mk(moe_w3, fa.W13T, norm_ffn, 512, 1024, 0, 512, 0); d.mode = 1; d.rofs = 32; d.nitems = 16 * d.per; d.sstride = 1024 * 512; d.dstride = 1024 * 1024; fa.td[n++] = d; }
    { TDesc d = mk(moe_w2, fa.W2T, nullptr, 1024, 512, 0, 1024, 0); d.nitems = 16 * d.per; d.sstride = 512 * 1024; d.dstride = 1024 * 512; fa.td[n++] = d; }
    fa.ntdB = n;
    int cum[21]; cum[0] = 0; for (int i = 0; i < n; ++i) cum[i + 1] = cum[i] + fa.td[i].nitems;
    for (int k = 0; k < 16; ++k) { fa.cv_lo[k] = 0; fa.cv_hi[k] = 0; }
    fa.cv_lo[0] = 0; fa.cv_hi[0] = cum[5];
    fa.cv_lo[1] = cum[5]; fa.cv_hi[1] = cum[fa.ntdA];
    { const int lo = cum[fa.ntdA], tot = cum[n] - lo; const int phs[5] = {5, 6, 7, 8, 9};
      for (int i = 0; i < 5; ++i) { fa.cv_lo[phs[i]] = lo + (int)((long long)tot * i / 5); fa.cv_hi[phs[i]] = lo + (int)((long long)tot * (i + 1) / 5); } }
  }
  int launch_i = 0;
  auto mega = [&](int lo, int hi) {
    fa.ph_lo = lo; fa.ph_hi = hi; fa.li = launch_i++; fa.pad = 0;
    for (int k = 0; k < 16; ++k) fa.rep[k] = 1;

    void* args[] = {&fa};
    (void)hipLaunchCooperativeKernel((const void*)k_mega, dim3(grid_blocks), dim3(256), args, MEGA_LDS, stream);
  };
  mega(0, 14);
}
```

```cpp
#include <hip/hip_runtime.h>
#include <stdint.h>

typedef unsigned short bf16_t;
__device__ __forceinline__ float bf2f(bf16_t v) { return __uint_as_float(((unsigned)v) << 16); }
__device__ __forceinline__ bf16_t f2bf(float f) { unsigned u = __float_as_uint(f); return (bf16_t)((u + 0x7fffu + ((u >> 16) & 1u)) >> 16); }

constexpr int NB = 4, SEQ = 4096, NTOK = NB * SEQ, DM = 1024;
constexpr int DIN = 5408, DIN_A = 3360;
constexpr int MEMT = 256;
constexpr float EPS = 1e-6f;
constexpr size_t MiB = 1u << 20;

constexpr size_t WS_CNT = 0;
constexpr size_t WS_LIST = 1 * MiB;
constexpr size_t WS_RTW = 2 * MiB;
constexpr size_t WS_SM = 3 * MiB;
constexpr size_t WS_BCUM = 5 * MiB;
constexpr size_t WS_IP = 5 * MiB + 256 * 1024;
constexpr size_t WS_BL = 5 * MiB + 512 * 1024;
constexpr size_t WS_MX = WS_BL + 4096;
constexpr size_t WS_MST = WS_MX + 4096;
constexpr size_t WS_NST = 6 * MiB;
constexpr size_t WS_KC = 7 * MiB;
constexpr size_t WS_VC = 7 * MiB + 512 * 1024;
constexpr size_t WS_QK = 8 * MiB;
constexpr size_t WS_V = 40 * MiB;
constexpr size_t WS_O = 56 * MiB;
constexpr size_t WS_NQ = 72 * MiB;
constexpr size_t WS_KV = 88 * MiB;
constexpr size_t WS_CST = 112 * MiB;
constexpr size_t WS_AML = 144 * MiB;
constexpr size_t WS_ANS = 160 * MiB;
constexpr size_t WS_MRG = 176 * MiB;
constexpr size_t WS_KVM = 233 * MiB;
constexpr size_t WS_MEMN = 237 * MiB;
constexpr size_t WS_H2 = 8 * MiB;
constexpr size_t WS_XQ = 40 * MiB;
constexpr size_t WS_XO = 72 * MiB;
constexpr size_t WS_Y = 72 * MiB;

__device__ __forceinline__ float wave_sum(float v) {
#pragma unroll
  for (int o = 32; o > 0; o >>= 1) v += __shfl_xor(v, o);
  return v;
}
__device__ __forceinline__ float wave_max(float v) {
#pragma unroll
  for (int o = 32; o > 0; o >>= 1) v = fmaxf(v, __shfl_xor(v, o));
  return v;
}
__device__ __forceinline__ float sigmoidf_(float x) { return 1.f / (1.f + __expf(-x)); }
__device__ __forceinline__ float siluf_(float x) { return x / (1.f + __expf(-x)); }
__device__ __forceinline__ float logsigmoidf_(float x) { return fminf(x, 0.f) - log1pf(__expf(-fabsf(x))); }
__device__ __forceinline__ float gelu_tanh(float x) { float u = 0.7978845608028654f * (x + 0.044715f * x * x * x); return 0.5f * x * (1.f + tanhf(u)); }

#include <hip/hip_cooperative_groups.h>
namespace cg = cooperative_groups;
#define LAS __attribute__((address_space(3)))
typedef short bf16x8 __attribute__((ext_vector_type(8)));
typedef float f32x4 __attribute__((ext_vector_type(4)));
typedef unsigned u32x2 __attribute__((ext_vector_type(2)));
typedef unsigned u32x4 __attribute__((ext_vector_type(4)));

constexpr size_t WS_RS1 = 5 * MiB + 768 * 1024;
constexpr size_t WS_RSM = WS_RS1 + 65536;
constexpr size_t WS_PS2 = 4 * MiB;
constexpr size_t WS_WIN_T = 208 * MiB;
constexpr size_t WS_WG_T = 216 * MiB;
constexpr size_t WS_WML_T = 220 * MiB;
constexpr size_t WS_WNS_T = 221 * MiB;
constexpr size_t WS_WOUT_T = 222 * MiB;
constexpr size_t WS_WQ_T = 224 * MiB;
constexpr size_t WS_WKV_T = 226 * MiB;
constexpr size_t WS_WO_T = 230 * MiB;
constexpr size_t WS_MEMB = 238 * MiB;
constexpr size_t WS_KVC = WS_KV;
constexpr size_t WS_KS = WS_KV + 8 * MiB;
constexpr size_t WS_KW = WS_KV + 12 * MiB;
constexpr size_t WS_VST = WS_KV + 16 * MiB;
constexpr size_t WS_VWT = WS_KV + 20 * MiB;
constexpr size_t WS_CK1T = 232 * MiB;
constexpr size_t WS_CV1T = 232 * MiB + 512 * 1024;
constexpr size_t WS_POSW = WS_RSM + 8192 + 65536;
constexpr int NIN = 3584;

__device__ __forceinline__ unsigned pk2bf(float lo, float hi) { return (unsigned)f2bf(lo) | ((unsigned)f2bf(hi) << 16); }
__device__ __forceinline__ void st_bf4(bf16_t* p, f32x4 v) { u32x2 o; o.x = pk2bf(v[0], v[1]); o.y = pk2bf(v[2], v[3]); *(u32x2*)p = o; }

struct TDesc { const float* src; bf16_t* dst; const float* gain; int ldw, K, c0, ncols, drow0, nitems, mode, rofs, per, sstride, dstride, pad; };
__device__ __forceinline__ void transpose_item(const TDesc& d, int item, float* t  , int tid) {
  const int bat = item / d.per; item -= bat * d.per;
  const float* src = d.src + (size_t)bat * d.sstride; bf16_t* dst = d.dst + (size_t)bat * d.dstride;
  const int ncb = (d.ncols + 63) >> 6; const int kb = item / ncb, cb = item % ncb; const int k0 = kb * 64, n0 = cb * 64;
  {
    const int c4 = (tid & 15) * 4, kq = tid >> 4;
    f32x4 v[4];
#pragma unroll
    for (int p = 0; p < 4; ++p) {
      const int kk = p * 16 + kq;
      v[p] = (n0 + c4 < d.ncols) ? *(const f32x4*)(src + (size_t)(k0 + kk) * d.ldw + d.c0 + n0 + c4) : (f32x4){0.f, 0.f, 0.f, 0.f};
    }
#pragma unroll
    for (int p = 0; p < 4; ++p) {
      const int kk = p * 16 + kq; const float g = d.gain ? d.gain[k0 + kk] : 1.f;
      float* tp = t + kk * 65 + c4; tp[0] = v[p][0] * g; tp[1] = v[p][1] * g; tp[2] = v[p][2] * g; tp[3] = v[p][3] * g;
    }
  }
  __syncthreads();
#pragma unroll
  for (int j = 0; j < 2; ++j) {
    int c = tid + j * 256; int n = c >> 3, kc = c & 7;
    if (n0 + n < d.ncols) {
      const float* p = t + (kc * 8) * 65 + n;
      u32x4 o; o.x = pk2bf(p[0], p[65]); o.y = pk2bf(p[130], p[195]); o.z = pk2bf(p[260], p[325]); o.w = pk2bf(p[390], p[455]);
      const int drow = d.mode == 2 ? (d.drow0 + (cb * 4 + (n >> 4)) * 32 + (n & 15) + d.rofs) : d.mode ? (d.drow0 + cb * 128 + (n >> 5) * 64 + (n & 31) + d.rofs) : (d.drow0 + n0 + n);
      *(u32x4*)(dst + (size_t)drow * d.K + k0 + kc * 8) = o;
    }
  }
  __syncthreads();
}

__device__ __forceinline__ void rows_to_bf16(const float* __restrict__ src, bf16_t* __restrict__ dst, float* __restrict__ rs, int nrows, int gw, int ngw, int lane) {
  for (int row = gw; row < nrows; row += ngw) {
    const f32x4* xr = (const f32x4*)(src + (size_t)row * DM) + lane;
    f32x4 v[4]; float s = 0.f;
#pragma unroll
    for (int j = 0; j < 4; ++j) { v[j] = xr[64 * j]; s += v[j][0] * v[j][0] + v[j][1] * v[j][1] + v[j][2] * v[j][2] + v[j][3] * v[j][3]; }
    s = wave_sum(s);
    if (lane == 0) rs[row] = rsqrtf(s * (1.f / DM) + EPS);
#pragma unroll
    for (int j = 0; j < 4; ++j) st_bf4(dst + (size_t)row * DM + (lane + 64 * j) * 4, v[j]);
  }
}

__device__ __forceinline__ void glds16(const void* g, char* l) {
  __builtin_amdgcn_global_load_lds((const unsigned*)g, (LAS unsigned*)l, 16, 0, 0);
}
__device__ __forceinline__ int st_row(int tid, int i) { return (tid >> 3) + 32 * i; }
__device__ __forceinline__ int st_lc(int tid, int i) { return (tid & 7) ^ ((st_row(tid, i) >> 1) & 7); }
__device__ __forceinline__ void gemm_core(f32x4 (&acc)[4][4], const bf16_t* __restrict__ A, const unsigned (&ao)[4], unsigned ksa,
                                          const bf16_t* __restrict__ Bt, const unsigned (&bo)[4], unsigned ksb, int nt, char* lds, int tid) {
  const int lane = tid & 63, wid = tid >> 6, wr = wid >> 1, wc = wid & 1, fr = lane & 15, fq = lane >> 4;
  char* ldst = lds + tid * 16;
#pragma unroll
  for (int i = 0; i < 4; ++i) { glds16(A + ao[i], ldst + i * 4096); glds16(Bt + bo[i], ldst + 16384 + i * 4096); }
  const int sw = fr >> 1;
  const int aoff = (wr * 64 + fr) * 128, boff = (wc * 64 + fr) * 128;
  for (int t = 0; t < nt; ++t) {
    asm volatile("s_waitcnt vmcnt(0)" ::: "memory");
    __syncthreads();
    const int cur = t & 1;
    if (t + 1 < nt) {
      char* nb = ldst + (cur ^ 1) * 32768; const unsigned ka = (t + 1) * ksa, kb = (t + 1) * ksb;
#pragma unroll
      for (int i = 0; i < 4; ++i) { glds16(A + (ao[i] + ka), nb + i * 4096); glds16(Bt + (bo[i] + kb), nb + 16384 + i * 4096); }
    }
    const char* sA = lds + cur * 32768 + aoff; const char* sB = lds + cur * 32768 + 16384 + boff;
#pragma unroll
    for (int ks = 0; ks < 2; ++ks) {
      bf16x8 a[4], b[4];
      const int co = ((ks * 4 + fq) ^ sw) << 4;
#pragma unroll
      for (int i = 0; i < 4; ++i) { a[i] = *(const bf16x8*)(sA + i * 2048 + co); b[i] = *(const bf16x8*)(sB + i * 2048 + co); }
#pragma unroll
      for (int i = 0; i < 4; ++i)
#pragma unroll
        for (int j = 0; j < 4; ++j) acc[i][j] = __builtin_amdgcn_mfma_f32_16x16x32_bf16(b[j], a[i], acc[i][j], 0, 0, 0);
    }
  }
  __syncthreads();
}
__device__ __forceinline__ void gemm_acc(f32x4 (&acc)[4][4], const bf16_t* __restrict__ A, size_t lda, const int* __restrict__ arow, int ashift, int mvalid,
                                         const bf16_t* __restrict__ Bt, size_t ldb, int K, char* lds, int m0, int n0, int tid) {
  asm volatile("" : "+v"(tid));
  unsigned ao[4], bo[4];
#pragma unroll
  for (int i = 0; i < 4; ++i) {
    const int row = st_row(tid, i), lc = st_lc(tid, i);
    int gr;
    if (arow) { int mm = m0 + row; if (mm >= mvalid) mm = mvalid - 1; gr = arow[mm] >> ashift; } else gr = m0 + row;
    ao[i] = (unsigned)gr * (unsigned)lda + lc * 8;
    bo[i] = (unsigned)(n0 + row) * (unsigned)ldb + lc * 8;
  }
  gemm_core(acc, A, ao, 64u, Bt, bo, 64u, K >> 6, lds, tid);
}
__device__ __forceinline__ void zero_acc(f32x4 (&acc)[4][4]) {
#pragma unroll
  for (int i = 0; i < 4; ++i)
#pragma unroll
    for (int j = 0; j < 4; ++j) acc[i][j] = (f32x4){0.f, 0.f, 0.f, 0.f};
}


namespace pg8 {
#define PG8_LAS __attribute__((address_space(3)))
typedef unsigned short bf16_t;
typedef short bf16x8 __attribute__((ext_vector_type(8)));
typedef float f32x4 __attribute__((ext_vector_type(4)));
typedef unsigned u32x4 __attribute__((ext_vector_type(4)));
constexpr int BM = 256, BK = 64, HALF = 128, HTB = HALF * BK * 2  , STAGE_BYTES = 8 * HTB, NXCD = 8, WGM = 8;

__host__ __device__ __forceinline__ int lds_byte(int r, int c) { const int st = (r >> 4) * 2 + (c >> 5), rr = r & 15, cc = c & 31, ob = rr * 64 + cc * 2; return st * 1024 + (ob ^ (((ob >> 9) & 1) << 5)); }
__host__ __device__ __forceinline__ void stage_rc(int b, int& R, int& C) { const int st = b / 1024, sb = b % 1024, swz = sb ^ (((sb >> 9) & 1) << 5); R = (st >> 1) * 16 + swz / 64; C = (st & 1) * 32 + (swz % 64) / 2; }
__host__ __device__ __forceinline__ int perm32(int rho) { const int n = rho >> 4, i = rho & 15; return 8 * (i >> 2) + 4 * n + (i & 3); }

struct Unit { int pm, pn; const char* aptr; const char* bptr; int e, ce, p0, rt; };
struct Gemm { int K; };
template <class Epi, class Sched, bool ALIGN_EPI = false, bool SP2 = false>
__device__ __forceinline__ void gemm_phase(PG8_LAS unsigned char* lds, const Gemm g, const Sched& S, const Epi& E, int tid  , int wid  ) {
    asm volatile("" : "+v"(tid));
    const int lane = tid & 63, wr = wid >> 2, wc = wid & 3, fr = lane & 15, fq = lane >> 4;
    const int K = g.K, nt = K / BK;
    unsigned voffA[2], voffB[2];
#pragma unroll
    for (int i = 0; i < 2; ++i) { int R, C; stage_rc(tid * 16 + i * 8192, R, C); const int Rb = Epi::PERM ? ((R & ~31) + perm32(R & 31)) : R;
        voffA[i] = (unsigned)(R * K + C) * 2u; voffB[i] = (unsigned)(Rb * K + C) * 2u; }
    unsigned cva0[2], cva1[2], nva0[2], nva1[2];
    const size_t kstep = (size_t)(BK * 2);
    const size_t hstep = (size_t)HALF * K * 2;
    const unsigned ldsw = (unsigned)wid * 1024u;
    const int aoff = lds_byte(wr * 64 + fr, fq * 8), boff = lds_byte(wc * 32 + fr, fq * 8);
#define PG8_SA(b, h) (((b) * 2 + (h)) * HTB)
#define PG8_SB(b, h) ((4 + (b) * 2 + (h)) * HTB)
#define PG8_STAGE(bufoff, gbase, voff) do { _Pragma("unroll") for (int _i = 0; _i < 2; ++_i) \
        __builtin_amdgcn_global_load_lds((const unsigned*)((const char*)(gbase) + (voff)[_i]), (PG8_LAS unsigned*)(lds + (bufoff) + ldsw + _i * 8192), 16, 0, 0); } while (0)
#define PG8_LDA(dst, b, h) do { _Pragma("unroll") for (int m = 0; m < 4; ++m) _Pragma("unroll") for (int k = 0; k < 2; ++k) dst[m][k] = *(const PG8_LAS bf16x8*)(lds + PG8_SA(b, h) + aoff + m * 2048 + k * 1024); } while (0)
#define PG8_LDB(dst, b, h) do { _Pragma("unroll") for (int n = 0; n < 2; ++n) _Pragma("unroll") for (int k = 0; k < 2; ++k) dst[n][k] = *(const PG8_LAS bf16x8*)(lds + PG8_SB(b, h) + boff + n * 2048 + k * 1024); } while (0)
#define PG8_MMA(ai, bj, At, Bt) do { __builtin_amdgcn_s_setprio(1); _Pragma("unroll") for (int m = 0; m < 4; ++m) _Pragma("unroll") for (int n = 0; n < 2; ++n) _Pragma("unroll") for (int k = 0; k < 2; ++k) \
        acc[ai][bj][m][n] = __builtin_amdgcn_mfma_f32_16x16x32_bf16(Bt[n][k], At[m][k], acc[ai][bj][m][n], 0, 0, 0); __builtin_amdgcn_s_setprio(0); } while (0)
#define PG8_WAIT_V(n) asm volatile("s_waitcnt vmcnt(" #n ")" ::: "memory")
#define PG8_WAIT_L(n) asm volatile("s_waitcnt lgkmcnt(" #n ")" ::: "memory")
#define PG8_BAR __builtin_amdgcn_s_barrier()
#define PG8_SCHED __builtin_amdgcn_sched_barrier(0)
    Unit cur, nxt; int ui = 0;
    if (!S.next(0, cur)) return;
    S.avoff(cur, tid, K, voffA, cva0, cva1);
    f32x4 acc[2][2][4][2];
#pragma unroll
    for (int a = 0; a < 2; ++a)
#pragma unroll
        for (int b = 0; b < 2; ++b)
#pragma unroll
            for (int m = 0; m < 4; ++m)
#pragma unroll
                for (int n = 0; n < 2; ++n) acc[a][b][m][n] = (f32x4){0.f, 0.f, 0.f, 0.f};
    bf16x8 At[4][2], B0[2][2], B1[2][2];
    const char* cA = cur.aptr; const char* cB = cur.bptr;
    S.a_ready(cur);
    if constexpr (SP2) {
        PG8_STAGE(PG8_SB(0, 0), cB, voffB); PG8_STAGE(PG8_SB(0, 1), cB + hstep, voffB); PG8_STAGE(PG8_SA(0, 0), cA, cva0); PG8_STAGE(PG8_SA(0, 1), cA, cva1);
        if (wr == 1) PG8_BAR;
        PG8_WAIT_V(2); PG8_BAR;
        PG8_STAGE(PG8_SB(1, 0), cB + kstep, voffB); PG8_STAGE(PG8_SA(1, 0), cA + kstep, cva0); PG8_STAGE(PG8_SB(1, 1), cB + hstep + kstep, voffB);
        PG8_WAIT_V(6); PG8_BAR;
    } else {
        PG8_STAGE(PG8_SB(0, 0), cB, voffB); PG8_STAGE(PG8_SA(0, 0), cA, cva0); PG8_STAGE(PG8_SB(0, 1), cB + hstep, voffB); PG8_STAGE(PG8_SA(0, 1), cA, cva1);
        if (wr == 1) PG8_BAR;
        PG8_WAIT_V(4); PG8_BAR;
        PG8_STAGE(PG8_SB(1, 0), cB + kstep, voffB); PG8_STAGE(PG8_SA(1, 0), cA + kstep, cva0); PG8_STAGE(PG8_SB(1, 1), cB + hstep + kstep, voffB);
        PG8_WAIT_V(6); PG8_BAR;
    }
    for (;;) {
        const bool has_next = S.next(ui + 1, nxt);
        if (has_next) S.avoff(nxt, tid, K, voffA, nva0, nva1); else { nva0[0] = cva0[0]; nva0[1] = cva0[1]; nva1[0] = cva1[0]; nva1[1] = cva1[1]; }
        const char* nA = has_next ? nxt.aptr : cA; const char* nB = has_next ? nxt.bptr : cB;
        for (int t = 0; t < nt; t += 2) {
            const bool last = (t == nt - 2);
            const char* a1 = cA + (size_t)(t + 1) * kstep;
            const char* a2 = last ? nA : cA + (size_t)(t + 2) * kstep; const char* b2 = last ? nB : cB + (size_t)(t + 2) * kstep;
            const char* a3 = a2 + kstep; const char* b3 = b2 + kstep;
            const unsigned xva0[2] = {last ? nva0[0] : cva0[0], last ? nva0[1] : cva0[1]}, xva1[2] = {last ? nva1[0] : cva1[0], last ? nva1[1] : cva1[1]};
            if (last && has_next) S.a_ready(nxt);
            if constexpr (SP2) {
            PG8_LDB(B0, 0, 0); PG8_LDB(B1, 0, 1); PG8_SCHED; PG8_LDA(At, 0, 0); PG8_STAGE(PG8_SA(1, 1), a1, cva1);
            PG8_WAIT_V(8); PG8_WAIT_L(0); PG8_BAR; PG8_MMA(0, 0, At, B0); PG8_MMA(0, 1, At, B1); PG8_BAR; PG8_SCHED;
            PG8_LDA(At, 0, 1); PG8_STAGE(PG8_SB(0, 0), b2, voffB); PG8_STAGE(PG8_SB(0, 1), b2 + hstep, voffB); PG8_STAGE(PG8_SA(0, 0), a2, xva0);
            PG8_WAIT_V(8); PG8_WAIT_L(0); PG8_BAR; PG8_MMA(1, 0, At, B0); PG8_MMA(1, 1, At, B1); PG8_BAR; PG8_SCHED;
            PG8_LDB(B0, 1, 0); PG8_LDB(B1, 1, 1); PG8_SCHED; PG8_LDA(At, 1, 0); PG8_STAGE(PG8_SA(0, 1), a2, xva1);
            PG8_WAIT_V(8); PG8_WAIT_L(0); PG8_BAR; PG8_MMA(0, 0, At, B0); PG8_MMA(0, 1, At, B1); PG8_BAR; PG8_SCHED;
            PG8_LDA(At, 1, 1); PG8_STAGE(PG8_SB(1, 0), b3, voffB); PG8_STAGE(PG8_SB(1, 1), b3 + hstep, voffB); PG8_STAGE(PG8_SA(1, 0), a3, xva0);
            PG8_WAIT_V(8); PG8_WAIT_L(0); PG8_BAR; PG8_MMA(1, 0, At, B0); PG8_MMA(1, 1, At, B1); PG8_BAR; PG8_SCHED;
            } else {
            PG8_LDB(B0, 0, 0); PG8_SCHED; PG8_LDA(At, 0, 0); PG8_STAGE(PG8_SA(1, 1), a1, cva1);
            PG8_WAIT_L(8); PG8_BAR; PG8_WAIT_L(0); PG8_MMA(0, 0, At, B0); PG8_BAR; PG8_SCHED;
            PG8_LDB(B1, 0, 1); PG8_STAGE(PG8_SB(0, 0), b2, voffB);
            PG8_BAR; PG8_WAIT_L(0); PG8_MMA(0, 1, At, B1); PG8_BAR;
            PG8_LDA(At, 0, 1); PG8_STAGE(PG8_SA(0, 0), a2, xva0);
            PG8_BAR; PG8_WAIT_L(0); PG8_MMA(1, 0, At, B0); PG8_BAR; PG8_SCHED;
            PG8_STAGE(PG8_SB(0, 1), b2 + hstep, voffB);
            PG8_WAIT_V(6); PG8_BAR; PG8_MMA(1, 1, At, B1); PG8_BAR;
            PG8_LDB(B0, 1, 0); PG8_SCHED; PG8_LDA(At, 1, 0); PG8_STAGE(PG8_SA(0, 1), a2, xva1);
            PG8_WAIT_L(8); PG8_BAR; PG8_WAIT_L(0); PG8_MMA(0, 0, At, B0); PG8_BAR; PG8_SCHED;
            PG8_LDB(B1, 1, 1); PG8_STAGE(PG8_SB(1, 0), b3, voffB);
            PG8_BAR; PG8_WAIT_L(0); PG8_MMA(0, 1, At, B1); PG8_BAR;
            PG8_LDA(At, 1, 1); PG8_STAGE(PG8_SA(1, 0), a3, xva0);
            PG8_BAR; PG8_WAIT_L(0); PG8_MMA(1, 0, At, B0); PG8_BAR; PG8_SCHED;
            PG8_STAGE(PG8_SB(1, 1), b3 + hstep, voffB);
            PG8_WAIT_V(6); PG8_BAR; PG8_MMA(1, 1, At, B1); PG8_BAR;
            }
        }
        if constexpr (ALIGN_EPI) { if (wr == 0) PG8_BAR; }
        if constexpr (!Epi::AFTER_DRAIN) { E(acc, cur, wr, wc, fr, fq); S.done(cur); }
        if (!has_next) break;
#pragma unroll
        for (int a = 0; a < 2; ++a)
#pragma unroll
            for (int b = 0; b < 2; ++b)
#pragma unroll
                for (int m = 0; m < 4; ++m)
#pragma unroll
                    for (int n = 0; n < 2; ++n) acc[a][b][m][n] = (f32x4){0.f, 0.f, 0.f, 0.f};
        cur = nxt; cA = nA; cB = nB; ++ui; cva0[0] = nva0[0]; cva0[1] = nva0[1]; cva1[0] = nva1[0]; cva1[1] = nva1[1];
        if constexpr (ALIGN_EPI) { if (wr == 1) PG8_BAR; }
    }
    PG8_WAIT_V(0);
    if constexpr (!ALIGN_EPI) { if (wr == 0) PG8_BAR; }
    PG8_BAR;
    if constexpr (Epi::AFTER_DRAIN) { E.fused(acc, cur, wr, wc, fr, fq, lds, wid, lane); S.done(cur); }
#undef PG8_SA
#undef PG8_SB
#undef PG8_STAGE
#undef PG8_LDA
#undef PG8_LDB
#undef PG8_MMA
#undef PG8_WAIT_V
#undef PG8_WAIT_L
#undef PG8_BAR
#undef PG8_SCHED
}
}

#define TILE8_IDS unsigned t8_z = 0u; asm volatile("" : "+v"(t8_z)); int t512 = wave_s * 64 + (int)__builtin_amdgcn_mbcnt_hi(~0u, __builtin_amdgcn_mbcnt_lo(~0u, t8_z)); asm volatile("" : "+v"(t512))
template <class Map> struct ListSched {
  int first, stride, count; Map map;
  __device__ __forceinline__ bool next(int i, pg8::Unit& u) const { const int idx = first + i * stride; if (idx >= count) return false; map(idx, u); return true; }
  __device__ __forceinline__ void avoff(const pg8::Unit& u, int tid, int K, const unsigned (&voffA)[2], unsigned (&v0)[2], unsigned (&v1)[2]) const { map.avoff(u, tid, K, voffA, v0, v1); }
  __device__ __forceinline__ void a_ready(const pg8::Unit&) const {}
  __device__ __forceinline__ void done(const pg8::Unit&) const {}
};
struct MlArgs { const float *conv, *b_i, *b_f, *gain; float *BCUM, *IP, *BL, *MX, *MST, *NST; bf16_t* CST; };
struct MegaArgs {
  const float* x; const float* mem; float* out;
  bf16_t *XB, *MEMB; float *RS1, *RSM, *PS2;
  bf16_t *QK, *V, *O, *NQ, *KVC, *KS, *KW, *VST, *VWT, *KC, *VCT, *CK1T, *CV1T; float *SM, *POSW;
  const float *posk, *posv, *ckw1, *cvw1, *ckw2, *cvw2;
  bf16_t *AML, *ANS, *MRG, *X1B, *XQ, *XO, *KVM;
  bf16_t *WinT, *WgT, *WmlT, *WnsT, *WoutT, *WqT, *WkvT, *WoT;
  bf16_t *H3, *ACT, *Y, *W13T, *W2T; float *RS3, *RTW; int *CNT, *LIST;
  const float *g_ffn, *wg, *bg, *we, *be, *g_final;
  unsigned* BAR;
  MlArgs ml;
  float* CPART; int* WQ;
  TDesc td[24]; int ntdA, ntdB; int ph_lo, ph_hi, li, pad; int rep[16]; int cv_lo[16], cv_hi[16];
};


constexpr int NSA_LDS = 66112;
constexpr int MEGA_LDS = 73728;
constexpr int HALF_LDS = 73728, CTRL_OFF = 2 * HALF_LDS, TOTAL_LDS = CTRL_OFF + 64;
typedef unsigned long long u64;

template <bool WITH_V>
__device__ __forceinline__ void nsa_load_tile(const bf16_t* __restrict__ Ksrc, unsigned kstride, const bf16_t* __restrict__ Vsrc, unsigned vstride, char* lds, int tid) {
#pragma unroll
  for (int i = 0; i < 2; ++i) {
    const int idx = tid + 256 * i, row = idx >> 3, lc = (idx & 7) ^ ((row >> 1) & 7);
    glds16(Ksrc + (size_t)row * kstride + lc * 8, lds + idx * 16);
    if (WITH_V) glds16(Vsrc + (size_t)row * vstride + lc * 8, lds + 8192 + idx * 16);
  }
}

__device__ __forceinline__ void nsa_qk(f32x4 (&sacc)[4][2], const bf16x8 (&qf)[4][2], const char* lds, int hf, int fr, int fq) {
#pragma unroll
  for (int mi = 0; mi < 4; ++mi)
#pragma unroll
    for (int ni = 0; ni < 2; ++ni) sacc[mi][ni] = (f32x4){0.f, 0.f, 0.f, 0.f};
#pragma unroll
  for (int ks = 0; ks < 2; ++ks) {
    bf16x8 kf[2];
    const int co = ((ks * 4 + fq) ^ (fr >> 1)) << 4;
#pragma unroll
    for (int ni = 0; ni < 2; ++ni) kf[ni] = *(const bf16x8*)(lds + ((hf * 2 + ni) * 16 + fr) * 128 + co);
#pragma unroll
    for (int mi = 0; mi < 4; ++mi)
#pragma unroll
      for (int ni = 0; ni < 2; ++ni) sacc[mi][ni] = __builtin_amdgcn_mfma_f32_16x16x32_bf16(kf[ni], qf[mi][ks], sacc[mi][ni], 0, 0, 0);
  }
}
__device__ __forceinline__ void nsa_pv(f32x4 (&oacc)[4][4], const f32x4 (&p)[4][2], char* lds, char* pw, int hf, int fr, int fq) {
#pragma unroll
  for (int mi = 0; mi < 4; ++mi)
#pragma unroll
    for (int ni = 0; ni < 2; ++ni) {
      u32x2 o; o.x = pk2bf(p[mi][ni][0], p[mi][ni][1]); o.y = pk2bf(p[mi][ni][2], p[mi][ni][3]);
      *(u32x2*)(pw + (mi * 16 + fr) * 128 + ((((hf * 2 + ni) * 2 + (fq >> 1)) ^ (fr >> 1)) << 4) + (fq & 1) * 8) = o;
    }
  bf16x8 pf[4], vf[4];
  const int co = ((hf * 4 + fq) ^ (fr >> 1)) << 4;
#pragma unroll
  for (int i = 0; i < 4; ++i) { pf[i] = *(const bf16x8*)(pw + (i * 16 + fr) * 128 + co); vf[i] = *(const bf16x8*)(lds + 8192 + (i * 16 + fr) * 128 + co); }
#pragma unroll
  for (int mi = 0; mi < 4; ++mi)
#pragma unroll
    for (int ni = 0; ni < 4; ++ni) oacc[mi][ni] = __builtin_amdgcn_mfma_f32_16x16x32_bf16(vf[ni], pf[mi], oacc[mi][ni], 0, 0, 0);
}
__device__ __forceinline__ float red4(float v) { v += __shfl_xor(v, 16); v += __shfl_xor(v, 32); return v; }
__device__ __forceinline__ float max4(float v) { v = fmaxf(v, __shfl_xor(v, 16)); v = fmaxf(v, __shfl_xor(v, 32)); return v; }

__device__ __forceinline__ void nsa_online(f32x4 (&sv)[4][2], float (&m_run)[4], float (&l_run)[4], f32x4 (&oacc)[4][4]) {
#pragma unroll
  for (int mi = 0; mi < 4; ++mi) {
    float mx = fmaxf(fmaxf(fmaxf(sv[mi][0][0], sv[mi][0][1]), fmaxf(sv[mi][0][2], sv[mi][0][3])), fmaxf(fmaxf(sv[mi][1][0], sv[mi][1][1]), fmaxf(sv[mi][1][2], sv[mi][1][3])));
    mx = max4(mx);
    if (__any(mx > m_run[mi] + 8.f)) {
      const float mn = fmaxf(fmaxf(m_run[mi], mx), -1e20f);
      const float alpha = __builtin_amdgcn_exp2f(m_run[mi] - mn);
      m_run[mi] = mn; l_run[mi] *= alpha;
#pragma unroll
      for (int ni = 0; ni < 4; ++ni) oacc[mi][ni] *= alpha;
    }
    float ls = 0.f;
#pragma unroll
    for (int ni = 0; ni < 2; ++ni)
#pragma unroll
      for (int j = 0; j < 4; ++j) { const float pv = __builtin_amdgcn_exp2f(sv[mi][ni][j] - m_run[mi]); sv[mi][ni][j] = pv; ls += pv; }
    l_run[mi] += ls;
  }
}

__device__ __forceinline__ void nsa_main_item(const MegaArgs& a, int item, char* lds, int tid, volatile int* xch, int half) {
  asm volatile("" : "+v"(tid));
  const int lane = tid & 63, wid = tid >> 6, fr = lane & 15, fq = lane >> 4;
  const int i = item & 63, g = (item >> 6) & 1, b = item >> 7;
  const int h = g * 4 + wid, nb = b * SEQ, t0 = i * 64, bg = b * 2 + g;
  const float slope = exp2f(-(float)(h + 1)) * 1.4426950408889634f;
  char* pw = lds + 16384 + wid * 8192;
  float* PSLC = (float*)(lds + 49152);
  u64* SELM = (u64*)(lds + 65536);
  u64* UNI = (u64*)(lds + 66048);
  bf16x8 qf[4][2];
#pragma unroll
  for (int mi = 0; mi < 4; ++mi)
#pragma unroll
    for (int ks = 0; ks < 2; ++ks) qf[mi][ks] = *(const bf16x8*)(a.NQ + (size_t)(nb + t0 + wid * 16 + fr) * 512 + (g * 4 + mi) * 64 + ks * 32 + fq * 8);
  for (int e = tid; e < 4096; e += 256) PSLC[e] = 0.f;
  f32x4 sacc[4][2], oacc[4][4];
  float m_run[4], l_run[4];
  const int nct = ((4 * i + 2) >> 6) + 1;
  const bf16_t* kcb = a.KC + (size_t)bg * 256 * 64;
  const bf16_t* vcb = a.VCT + (size_t)bg * 64 * 256;
  const int tc = t0 + wid * 16 + fr;
  const float slope0 = exp2f(-(float)(g * 4 + 1)) * 1.4426950408889634f;
#pragma unroll
  for (int mi = 0; mi < 4; ++mi) { m_run[mi] = -1e30f; l_run[mi] = 0.f; }
  __syncthreads();
  nsa_load_tile<false>(kcb, 64u, nullptr, 0u, lds, tid);
  for (int jt = 0; jt < nct; ++jt) {
    asm volatile("s_waitcnt vmcnt(0)" ::: "memory");
    __syncthreads();
    char* tb = (jt & 1) ? (lds + 16384) : lds;
    if (jt + 1 < nct) nsa_load_tile<false>(kcb + (size_t)(jt + 1) * 64 * 64, 64u, nullptr, 0u, (jt & 1) ? lds : (lds + 16384), tid);
#pragma unroll 1
    for (int hf = 0; hf < 2; ++hf) {
      nsa_qk(sacc, qf, tb, hf, fr, fq);
#pragma unroll
      for (int mi = 0; mi < 4; ++mi) {
        const float slope = slope0 * (1.f / (float)(1 << mi)); float mx = -1e30f;
#pragma unroll
        for (int ni = 0; ni < 2; ++ni)
#pragma unroll
          for (int j = 0; j < 4; ++j) {
            const int jj = jt * 64 + hf * 32 + ni * 16 + 4 * fq + j; const bool ok = (16 * jj + 31 <= tc);
            const float v = sacc[mi][ni][j] - slope * ((float)tc - (16.f * jj + 15.5f));
            sacc[mi][ni][j] = ok ? v : -1e30f; mx = fmaxf(mx, sacc[mi][ni][j]);
          }
        mx = max4(mx);
        const float mn = fmaxf(m_run[mi], mx); float ls = 0.f;
#pragma unroll
        for (int ni = 0; ni < 2; ++ni)
#pragma unroll
          for (int j = 0; j < 4; ++j) ls += (sacc[mi][ni][j] > -1e29f) ? __builtin_amdgcn_exp2f(sacc[mi][ni][j] - mn) : 0.f;
        l_run[mi] = l_run[mi] * __builtin_amdgcn_exp2f(m_run[mi] - mn) + ls; m_run[mi] = mn;
      }
    }
  }
  float invl[4];
#pragma unroll
  for (int mi = 0; mi < 4; ++mi) { const float l = red4(l_run[mi]); invl[mi] = l > 0.f ? 1.f / l : 0.f; }
#pragma unroll
  for (int mi = 0; mi < 4; ++mi)
#pragma unroll
    for (int ni = 0; ni < 4; ++ni) oacc[mi][ni] = (f32x4){0.f, 0.f, 0.f, 0.f};
  for (int jt = 0; jt < nct; ++jt) {
    __syncthreads();
    nsa_load_tile<true>(kcb + (size_t)jt * 64 * 64, 64u, vcb + jt * 64, 256u, lds, tid);
    asm volatile("s_waitcnt vmcnt(0)" ::: "memory");
    __syncthreads();
#pragma unroll 1
    for (int hf = 0; hf < 2; ++hf) {
      nsa_qk(sacc, qf, lds, hf, fr, fq);
      float imp[2] = {0.f, 0.f}, car[2] = {0.f, 0.f};
#pragma unroll
      for (int mi = 0; mi < 4; ++mi) {
        const float slope = slope0 * (1.f / (float)(1 << mi));
#pragma unroll
        for (int ni = 0; ni < 2; ++ni) {
#pragma unroll
          for (int j = 0; j < 4; ++j) {
            const int jj = jt * 64 + hf * 32 + ni * 16 + 4 * fq + j; const bool ok = (16 * jj + 31 <= tc);
            const float v = sacc[mi][ni][j] - slope * ((float)tc - (16.f * jj + 15.5f));
            sacc[mi][ni][j] = ok ? __builtin_amdgcn_exp2f(v - m_run[mi]) * invl[mi] : 0.f;
          }
          imp[ni] += (sacc[mi][ni][0] + sacc[mi][ni][1]) + sacc[mi][ni][2] + 0.5f * sacc[mi][ni][3]; car[ni] += 0.5f * sacc[mi][ni][3];
        }
      }
      nsa_pv(oacc, sacc, lds, pw, hf, fr, fq);
#pragma unroll
      for (int ni = 0; ni < 2; ++ni) {
        const int sb = jt * 16 + hf * 8 + ni * 4 + fq; float* pp = PSLC + (wid * 16 + fr) * 64 + sb;
        atomicAdd(pp, imp[ni]);
        if (sb < 63) atomicAdd(pp + 1, car[ni]);
      }
    }
  }
  int frc = fr; asm volatile("" : "+v"(frc));
  {
    const size_t n = nb + t0 + wid * 16 + frc;
#pragma unroll
    for (int mi = 0; mi < 4; ++mi) {
      const int hh = g * 4 + mi; const float gt = sigmoidf_(a.SM[n * 32 + 8 + hh * 3]);
#pragma unroll
      for (int ni = 0; ni < 4; ++ni) {
        bf16_t* dp = a.ANS + n * 512 + hh * 64 + ni * 16 + 4 * fq; const u32x2 pr = *(const u32x2*)dp;
        f32x4 r = oacc[mi][ni] * gt;
        r[0] += __uint_as_float(pr.x << 16); r[1] += __uint_as_float(pr.x & 0xffff0000u); r[2] += __uint_as_float(pr.y << 16); r[3] += __uint_as_float(pr.y & 0xffff0000u);
        st_bf4(dp, r);
      }
    }
  }
  __syncthreads();
  {
    int tsel = tid, isel = i; asm volatile("" : "+v"(tsel), "+v"(isel));
    const int q = tsel >> 2, sub = tsel & 3;
    float mine[16]; int cnt[16];
#pragma unroll
    for (int k = 0; k < 16; ++k) {
      const int sb = sub * 16 + k; const float ps = PSLC[q * 64 + sb];
      mine[k] = (sb == 0 || sb == isel || sb == isel - 1) ? 1e4f : (sb > isel ? -1e4f : ps); cnt[k] = 0;
    }
#pragma unroll
    for (int k = 0; k < 16; ++k) PSLC[q * 64 + sub * 16 + k] = mine[k];
    __syncthreads();
    for (int s2 = 0; s2 <= isel; ++s2) {
      const float o = PSLC[q * 64 + s2];
#pragma unroll
      for (int k = 0; k < 16; ++k) cnt[k] += (o > mine[k] || (o == mine[k] && s2 < sub * 16 + k)) ? 1 : 0;
    }
    unsigned m16 = 0;
#pragma unroll
    for (int k = 0; k < 16; ++k) m16 |= (cnt[k] < 16 ? 1u : 0u) << k;
    unsigned mlo = (sub < 2) ? (m16 << (16 * sub)) : 0u, mhi = (sub >= 2) ? (m16 << (16 * (sub - 2))) : 0u;
    mlo |= __shfl_xor(mlo, 1); mlo |= __shfl_xor(mlo, 2); mhi |= __shfl_xor(mhi, 1); mhi |= __shfl_xor(mhi, 2);
    u64 m64 = ((u64)mhi << 32) | (u64)mlo;
    m64 &= (isel == 63) ? ~0ull : ((2ull << isel) - 1ull);
    if (sub == 0) SELM[q] = m64;
    u64 un = m64;
#pragma unroll
    for (int o = 4; o < 64; o <<= 1) un |= __shfl_xor(un, o);
    if (lane == 0) UNI[wid] = un;
  }
  __syncthreads();
  const u64 uni = UNI[0] | UNI[1] | UNI[2] | UNI[3];
#pragma unroll
  for (int mi = 0; mi < 4; ++mi)
#pragma unroll
    for (int ks = 0; ks < 2; ++ks) qf[mi][ks] = *(const bf16x8*)(a.NQ + (size_t)(nb + t0 + mi * 16 + fr) * 512 + h * 64 + ks * 32 + fq * 8);
#pragma unroll 1
  for (int br = 1; br <= 1; ++br) {
#pragma unroll
    for (int mi = 0; mi < 4; ++mi) { m_run[mi] = -1e30f; l_run[mi] = 0.f;
#pragma unroll
      for (int ni = 0; ni < 4; ++ni) oacc[mi][ni] = (f32x4){0.f, 0.f, 0.f, 0.f}; }
    const bf16_t* Kb = (br == 1 ? a.KS : a.KW) + (size_t)nb * 128 + g * 64;
    const bf16_t* Vb = (br == 1 ? a.VST : a.VWT) + ((size_t)(b * 128 + g * 64) << 12);
    u64 todo;
    if (br == 1) todo = uni;
    else { const int lo = i >= 8 ? i - 8 : 0; todo = ((i == 63) ? ~0ull : ((2ull << i) - 1ull)) & ~((1ull << lo) - 1ull); }
    int cur = __builtin_ctzll(todo), bsel = 0;
    if (tid == 0) xch[half] = __builtin_popcountll(todo);
    __syncthreads();
    const int ntile = max(xch[0], xch[1]);
    nsa_load_tile<true>(Kb + (size_t)cur * 64 * 128, 128u, Vb + cur * 64, 4096u, lds, tid);
    for (int kt = 0; kt < ntile; ++kt) {
      int nxt = -1;
      if (cur >= 0) { todo &= todo - 1ull; nxt = todo ? __builtin_ctzll(todo) : -1; }
      asm volatile("s_waitcnt vmcnt(0)" ::: "memory");
      __syncthreads();
      if (cur < 0) continue;
      char* tb = bsel ? (lds + 49152) : lds;
      if (nxt >= 0) nsa_load_tile<true>(Kb + (size_t)nxt * 64 * 128, 128u, Vb + nxt * 64, 4096u, bsel ? lds : (lds + 49152), tid);
      const int sb = cur;
#pragma unroll 1
      for (int hf = 0; hf < 2; ++hf) {
        nsa_qk(sacc, qf, tb, hf, fr, fq);
        const bool edge = (sb == i) || (br == 2 && sb == i - 8);
#pragma unroll
        for (int mi = 0; mi < 4; ++mi) {
          const int tq = mi * 16 + fr;
          const bool rsel = (br == 2) || ((SELM[tq] >> sb) & 1ull);
          const float rc = rsel ? -slope * (float)(64 * (i - sb) + tq - hf * 32 - 4 * fq) : -1e30f;
          if (!edge) {
#pragma unroll
            for (int ni = 0; ni < 2; ++ni)
#pragma unroll
              for (int j = 0; j < 4; ++j) sacc[mi][ni][j] += fmaf(slope, (float)(ni * 16 + j), rc);
          } else {
            const int tqh = tq - hf * 32;
#pragma unroll
            for (int ni = 0; ni < 2; ++ni)
#pragma unroll
              for (int j = 0; j < 4; ++j) {
                const int c = ni * 16 + 4 * fq + j;
                const bool okv = (sb == i) ? (c <= tqh) : (c > tqh);
                sacc[mi][ni][j] = okv ? sacc[mi][ni][j] + fmaf(slope, (float)(ni * 16 + j), rc) : -1e30f;
              }
          }
        }
        nsa_online(sacc, m_run, l_run, oacc);
        nsa_pv(oacc, sacc, tb, pw, hf, fr, fq);
      }
      cur = nxt; bsel ^= 1;
    }
    int fre = fr; asm volatile("" : "+v"(fre));
#pragma unroll
    for (int mi = 0; mi < 4; ++mi) {
      const size_t n = nb + t0 + mi * 16 + fre;
      const float l = red4(l_run[mi]); const float sc = sigmoidf_(a.SM[n * 32 + 8 + h * 3 + br]) / l;
#pragma unroll
      for (int ni = 0; ni < 4; ++ni) {
        bf16_t* dp = a.ANS + n * 512 + h * 64 + ni * 16 + 4 * fq; const u32x2 pr = *(const u32x2*)dp;
        f32x4 r = oacc[mi][ni] * sc;
        r[0] += __uint_as_float(pr.x << 16); r[1] += __uint_as_float(pr.x & 0xffff0000u); r[2] += __uint_as_float(pr.y << 16); r[3] += __uint_as_float(pr.y & 0xffff0000u);
        st_bf4(dp, r);
      }
    }
  }
  __syncthreads();
}


__device__ __forceinline__ void nsa_win_item(const MegaArgs& a, int item, char* lds, int tid) {
  asm volatile("" : "+v"(tid));
  const int lane = tid & 63, wid = tid >> 6, fr = lane & 15, fq = lane >> 4;
  const int i = item & 63, g = (item >> 6) & 1, b = item >> 7;
  const int h = g * 4 + wid, nb = b * SEQ, t0 = i * 64, bg = b * 2 + g;
  const float slope = exp2f(-(float)(h + 1)) * 1.4426950408889634f;
  char* pw = lds + 16384 + wid * 8192;
  float* PSLC = (float*)(lds + 49152);
  u64* SELM = (u64*)(lds + 65536);
  u64* UNI = (u64*)(lds + 66048);
  bf16x8 qf[4][2];
#pragma unroll
  for (int mi = 0; mi < 4; ++mi)
#pragma unroll
    for (int ks = 0; ks < 2; ++ks) qf[mi][ks] = *(const bf16x8*)(a.NQ + (size_t)(nb + t0 + mi * 16 + fr) * 512 + h * 64 + ks * 32 + fq * 8);
  f32x4 sacc[4][2], oacc[4][4];
  float m_run[4], l_run[4];
  (void)PSLC; (void)UNI; (void)bg;
  const u64 uni = 0ull;
#pragma unroll 1
  for (int br = 2; br <= 2; ++br) {
#pragma unroll
    for (int mi = 0; mi < 4; ++mi) { m_run[mi] = -1e30f; l_run[mi] = 0.f;
#pragma unroll
      for (int ni = 0; ni < 4; ++ni) oacc[mi][ni] = (f32x4){0.f, 0.f, 0.f, 0.f}; }
    const bf16_t* Kb = (br == 1 ? a.KS : a.KW) + (size_t)nb * 128 + g * 64;
    const bf16_t* Vb = (br == 1 ? a.VST : a.VWT) + ((size_t)(b * 128 + g * 64) << 12);
    u64 todo;
    if (br == 1) todo = uni;
    else { const int lo = i >= 8 ? i - 8 : 0; todo = ((i == 63) ? ~0ull : ((2ull << i) - 1ull)) & ~((1ull << lo) - 1ull); }
    int cur = 63 - __builtin_clzll(todo), bsel = 0;
    __syncthreads();
    nsa_load_tile<true>(Kb + (size_t)cur * 64 * 128, 128u, Vb + cur * 64, 4096u, lds, tid);
    while (cur >= 0) {
      todo &= ~(1ull << cur);
      const int nxt = todo ? 63 - __builtin_clzll(todo) : -1;
      asm volatile("s_waitcnt vmcnt(0)" ::: "memory");
      __syncthreads();
      char* tb = bsel ? (lds + 49152) : lds;
      if (nxt >= 0) nsa_load_tile<true>(Kb + (size_t)nxt * 64 * 128, 128u, Vb + nxt * 64, 4096u, bsel ? lds : (lds + 49152), tid);
      const int sb = cur;
#pragma unroll 1
      for (int hf = 0; hf < 2; ++hf) {
        nsa_qk(sacc, qf, tb, hf, fr, fq);
        const bool edge = (sb == i) || (br == 2 && sb == i - 8);
#pragma unroll
        for (int mi = 0; mi < 4; ++mi) {
          const int tq = mi * 16 + fr;
          const bool rsel = (br == 2) || ((SELM[tq] >> sb) & 1ull);
          const float rc = rsel ? -slope * (float)(64 * (i - sb) + tq - hf * 32 - 4 * fq) : -1e30f;
          if (!edge) {
#pragma unroll
            for (int ni = 0; ni < 2; ++ni)
#pragma unroll
              for (int j = 0; j < 4; ++j) sacc[mi][ni][j] += fmaf(slope, (float)(ni * 16 + j), rc);
          } else {
            const int tqh = tq - hf * 32;
#pragma unroll
            for (int ni = 0; ni < 2; ++ni)
#pragma unroll
              for (int j = 0; j < 4; ++j) {
                const int c = ni * 16 + 4 * fq + j;
                const bool okv = (sb == i) ? (c <= tqh) : (c > tqh);
                sacc[mi][ni][j] = okv ? sacc[mi][ni][j] + fmaf(slope, (float)(ni * 16 + j), rc) : -1e30f;
              }
          }
        }
        nsa_online(sacc, m_run, l_run, oacc);
        nsa_pv(oacc, sacc, tb, pw, hf, fr, fq);
      }
      cur = nxt; bsel ^= 1;
    }
#pragma unroll
    for (int mi = 0; mi < 4; ++mi) {
      const size_t n = nb + t0 + mi * 16 + fr;
      const float l = red4(l_run[mi]); const float sc = sigmoidf_(a.SM[n * 32 + 8 + h * 3 + br]) / l;
#pragma unroll
      for (int ni = 0; ni < 4; ++ni) {
        st_bf4(a.ANS + n * 512 + h * 64 + ni * 16 + 4 * fq, oacc[mi][ni] * sc);
      }
    }
  }
  __syncthreads();
}


__device__ __forceinline__ int img_off(int row, int k) { return row * 128 + ((((k >> 3) ^ ((row >> 1) & 7))) << 4) + (k & 7) * 2; }
__device__ __forceinline__ bf16x8 img_frag(const char* img, int r0, int ks, int fr, int fq) { return *(const bf16x8*)(img + (r0 + fr) * 128 + (((ks * 4 + fq) ^ (fr >> 1)) << 4)); }


__device__ __forceinline__ void stage_raw(const bf16_t* __restrict__ QK, int nb, int t0, int chbase, char* raw, int tid) {
  u32x4 v[5];
#pragma unroll
  for (int i = 0; i < 5; ++i) {
    const int c = tid + 256 * i, row = c >> 4, cc = c & 15, t = t0 - 3 + row;
    v[i] = (c < 1072 && t >= 0) ? *(const u32x4*)(QK + (size_t)(nb + t) * 1024 + chbase + cc * 8) : (u32x4){0u, 0u, 0u, 0u};
  }
#pragma unroll
  for (int i = 0; i < 5; ++i) { const int c = tid + 256 * i; if (c < 1072) *(u32x4*)(raw + c * 16) = v[i]; }
}
template <class Put>
__device__ __forceinline__ void conv_col(const char* raw, const float* __restrict__ conv, int j0, int nj, int ch, int d, float scale, Put put) {
  const float w0 = conv[ch], w1 = conv[1024 + ch], w2 = conv[2048 + ch], w3 = conv[3072 + ch];
  const bf16_t* r = (const bf16_t*)raw + d;
  float x0 = bf2f(r[(j0 + 0) * 128]), x1 = bf2f(r[(j0 + 1) * 128]), x2 = bf2f(r[(j0 + 2) * 128]);
  for (int j = j0; j < j0 + nj; ++j) {
    const float x3 = bf2f(r[(j + 3) * 128]);
    put(j, siluf_(w0 * x0 + w1 * x1 + w2 * x2 + w3 * x3) * scale);
    x0 = x1; x1 = x2; x2 = x3;
  }
}

__device__ __forceinline__ void ml_dc_item(const MegaArgs& a, const MlArgs& ml, int item, char* lds, int tid) {
  asm volatile("" : "+v"(tid));
  const int lane = tid & 63, wid = tid >> 6, wr = wid >> 1, wc = wid & 1, fr = lane & 15, fq = lane >> 4;
  const int bh = item >> 6, c = item & 63, b = bh >> 2, h = bh & 3, nb = b * SEQ, t0 = c * 64;
  char* KT = lds; char* VT = lds + 16384; float* sc = (float*)(lds + 32768); float* dnp = (float*)(lds + 33792);
  if (tid < 64) {
    const size_t n = nb + t0 + tid;
    sc[tid] = a.SM[n * 32 + h] + ml.b_i[h];
    sc[64 + tid] = logsigmoidf_(a.SM[n * 32 + 4 + h] + ml.b_f[h]);
  }
  __syncthreads();
  if (tid < 64) {
    float cs = sc[64 + tid];
#pragma unroll
    for (int o = 1; o < 64; o <<= 1) { const float up = __shfl_up(cs, o); if (tid >= o) cs += up; }
    const float bl = __shfl(cs, 63);
    const float lw = bl - cs + sc[tid];
    const float mx = wave_max(lw);
    sc[128 + tid] = cs; sc[192 + tid] = __expf(lw - mx);
    if (tid == 0) { ml.BL[bh * 64 + c] = bl; ml.MX[bh * 64 + c] = mx; }
  }
  __syncthreads();
  if (tid < 64) { ml.BCUM[bh * SEQ + t0 + tid] = sc[128 + tid]; ml.IP[bh * SEQ + t0 + tid] = sc[tid]; }
  char* RAW = lds + 36864;
  stage_raw(a.QK, nb, t0, 512 + h * 128, RAW, tid);
  __syncthreads();
  {
    const int d = tid & 127, jh = tid >> 7;
    float dn = 0.f;
    conv_col(RAW, ml.conv, jh * 32, 32, 512 + h * 128 + d, d, 0.08838834764831845f,
             [&](int j, float v) { *(bf16_t*)(KT + img_off(d, j)) = f2bf(v); dn += sc[192 + j] * v; });
    dnp[jh * 128 + d] = dn;
    {
      bf16_t tv[32];
#pragma unroll
      for (int u = 0; u < 32; ++u) tv[u] = a.V[(size_t)(nb + t0 + jh * 32 + u) * 512 + h * 128 + d];
#pragma unroll
      for (int u = 0; u < 32; ++u) *(bf16_t*)(VT + img_off(d, jh * 32 + u)) = f2bf(sc[192 + jh * 32 + u] * bf2f(tv[u]));
    }
  }
  __syncthreads();
  if (tid < 128) ml.NST[(size_t)(bh * 64 + c) * 128 + tid] = dnp[tid] + dnp[128 + tid];
  f32x4 acc[4][4]; zero_acc(acc);
#pragma unroll
  for (int ks = 0; ks < 2; ++ks) {
    bf16x8 av[4], bk[4];
#pragma unroll
    for (int i = 0; i < 4; ++i) { av[i] = img_frag(VT, wr * 64 + i * 16, ks, fr, fq); bk[i] = img_frag(KT, wc * 64 + i * 16, ks, fr, fq); }
#pragma unroll
    for (int i = 0; i < 4; ++i)
#pragma unroll
      for (int j = 0; j < 4; ++j) acc[i][j] = __builtin_amdgcn_mfma_f32_16x16x32_bf16(bk[j], av[i], acc[i][j], 0, 0, 0);
  }
  bf16_t* cst = ml.CST + (size_t)(bh * 64 + c) * 16384;
#pragma unroll
  for (int mi = 0; mi < 4; ++mi)
#pragma unroll
    for (int ni = 0; ni < 4; ++ni) st_bf4(cst + (wr * 64 + mi * 16 + fr) * 128 + wc * 64 + ni * 16 + 4 * fq, acc[mi][ni]);
  __syncthreads();
}

__device__ __forceinline__ void ml_scan_item(const MlArgs& ml, int item, int tid) {
  const int bh = item / 17, part = item % 17;
  float m = 0.f;
  if (part < 16) {
    float run[4] = {0.f, 0.f, 0.f, 0.f};
#pragma unroll 1
    for (int c0 = 0; c0 < 64; c0 += 8) {
      u32x2 vb[8]; float bl[8], mxv[8];
#pragma unroll
      for (int u = 0; u < 8; ++u) {
        vb[u] = *(const u32x2*)(ml.CST + (size_t)(bh * 64 + c0 + u) * 16384 + part * 1024 + tid * 4);
        bl[u] = ml.BL[bh * 64 + c0 + u]; mxv[u] = ml.MX[bh * 64 + c0 + u];
      }
#pragma unroll
      for (int u = 0; u < 8; ++u) {
        const float mn = fmaxf(bl[u] + m, mxv[u]), decay = __expf(bl[u] + m - mn), scl = __expf(mxv[u] - mn);
        u32x2 o; o.x = pk2bf(run[0], run[1]); o.y = pk2bf(run[2], run[3]);
        *(u32x2*)(ml.CST + (size_t)(bh * 64 + c0 + u) * 16384 + part * 1024 + tid * 4) = o;
        run[0] = decay * run[0] + scl * __uint_as_float(vb[u].x << 16); run[1] = decay * run[1] + scl * __uint_as_float(vb[u].x & 0xffff0000u);
        run[2] = decay * run[2] + scl * __uint_as_float(vb[u].y << 16); run[3] = decay * run[3] + scl * __uint_as_float(vb[u].y & 0xffff0000u);
        if (part == 0 && tid == 0) ml.MST[bh * 64 + c0 + u] = m;
        m = mn;
      }
    }
  } else if (tid < 128) {
    float run = 0.f;
    for (int c = 0; c < 64; ++c) {
      const float bl = ml.BL[bh * 64 + c], mx = ml.MX[bh * 64 + c];
      const float mn = fmaxf(bl + m, mx), decay = __expf(bl + m - mn), scl = __expf(mx - mn);
      float* p = ml.NST + (size_t)(bh * 64 + c) * 128 + tid;
      const float v = *p; *p = run; run = decay * run + scl * v;
      m = mn;
    }
  }
}

__device__ __forceinline__ void ml_out_item(const MegaArgs& a, const MlArgs& ml, int item, char* lds, int tid) {
  asm volatile("" : "+v"(tid));
  const int lane = tid & 63, wid = tid >> 6, wr = wid >> 1, wc = wid & 1, fr = lane & 15, fq = lane >> 4;
  const int bh = item >> 6, c = item & 63, b = bh >> 2, h = bh & 3, nb = b * SEQ, t0 = c * 64;
  char* Qi = lds; char* Ki = lds + 16384; char* VT = lds + 32768; char* SP = lds + 49152;
  float* sc = (float*)(lds + 57344);
  float* H = (float*)lds;
  {
    char* RAW = lds + 49152;
    const int d = tid & 127, jh = tid >> 7;
    stage_raw(a.QK, nb, t0, h * 128, RAW, tid);
    {
      bf16_t tv[32];
#pragma unroll
      for (int u = 0; u < 32; ++u) tv[u] = a.V[(size_t)(nb + t0 + jh * 32 + u) * 512 + h * 128 + d];
#pragma unroll
      for (int u = 0; u < 32; ++u) *(bf16_t*)(VT + img_off(d, jh * 32 + u)) = tv[u];
    }
    __syncthreads();
    conv_col(RAW, ml.conv, jh * 32, 32, h * 128 + d, d, 1.f, [&](int j, float v) { *(bf16_t*)(Qi + (d >> 6) * 8192 + img_off(j, d & 63)) = f2bf(v); });
    __syncthreads();
    stage_raw(a.QK, nb, t0, 512 + h * 128, RAW, tid);
    __syncthreads();
    conv_col(RAW, ml.conv, jh * 32, 32, 512 + h * 128 + d, d, 0.08838834764831845f, [&](int j, float v) { *(bf16_t*)(Ki + (d >> 6) * 8192 + img_off(j, d & 63)) = f2bf(v); });
    __syncthreads();
  }
  if (tid < 64) { sc[tid] = ml.BCUM[bh * SEQ + t0 + tid]; sc[64 + tid] = ml.IP[bh * SEQ + t0 + tid]; }
  if (tid < 128) sc[448 + tid] = ml.NST[(size_t)(bh * 64 + c) * 128 + tid];
  __syncthreads();
  const float m = ml.MST[bh * 64 + c];
  if (tid < 64) {
    const float bj = sc[tid]; float mxi = -INFINITY;
    for (int s2 = 0; s2 <= tid; ++s2) mxi = fmaxf(mxi, bj - sc[s2] + sc[64 + s2]);
    const float inter = bj + m, mt = fmaxf(mxi, inter);
    sc[128 + tid] = mt; sc[192 + tid] = __expf(inter - mt);
  } else if (tid < 128) {
    const int t = tid - 64; float nq = 0.f;
    for (int k = 0; k < 128; ++k) nq += sc[448 + k] * bf2f(*(const bf16_t*)(Qi + (k >> 6) * 8192 + img_off(t, k & 63)));
    sc[384 + t] = nq;
  }
  f32x4 sacc[2][2];
#pragma unroll
  for (int i = 0; i < 2; ++i)
#pragma unroll
    for (int j = 0; j < 2; ++j) sacc[i][j] = (f32x4){0.f, 0.f, 0.f, 0.f};
#pragma unroll
  for (int kt = 0; kt < 2; ++kt)
#pragma unroll
    for (int ks = 0; ks < 2; ++ks) {
      bf16x8 aq[2], bk[2];
#pragma unroll
      for (int i = 0; i < 2; ++i) { aq[i] = img_frag(Qi + kt * 8192, wr * 32 + i * 16, ks, fr, fq); bk[i] = img_frag(Ki + kt * 8192, wc * 32 + i * 16, ks, fr, fq); }
#pragma unroll
      for (int i = 0; i < 2; ++i)
#pragma unroll
        for (int j = 0; j < 2; ++j) sacc[i][j] = __builtin_amdgcn_mfma_f32_16x16x32_bf16(bk[j], aq[i], sacc[i][j], 0, 0, 0);
    }
  __syncthreads();
  const bf16_t* cst = ml.CST + (size_t)(bh * 64 + c) * 16384;
#pragma unroll
  for (int i = 0; i < 4; ++i) { const int idx = tid + 256 * i, row = idx >> 3, lc = (idx & 7) ^ ((row >> 1) & 7); glds16(cst + row * 128 + lc * 8, Ki + idx * 16); }
#pragma unroll
  for (int mi = 0; mi < 2; ++mi) {
    const int t = wr * 32 + mi * 16 + fr; const float bt = sc[t], mt = sc[128 + t]; float rsum = 0.f;
#pragma unroll
    for (int ni = 0; ni < 2; ++ni) {
      const int s0 = wc * 32 + ni * 16 + 4 * fq; f32x4 p;
#pragma unroll
      for (int j = 0; j < 4; ++j) { const int s2 = s0 + j; p[j] = (s2 <= t) ? sacc[mi][ni][j] * __expf(bt - sc[s2] + sc[64 + s2] - mt) : 0.f; rsum += p[j]; }
      u32x2 o; o.x = pk2bf(p[0], p[1]); o.y = pk2bf(p[2], p[3]);
      *(u32x2*)(SP + img_off(t, s0)) = o;
    }
    rsum += __shfl_xor(rsum, 16); rsum += __shfl_xor(rsum, 32);
    if (fq == 0) sc[256 + t * 2 + wc] = rsum;
  }
  asm volatile("s_waitcnt vmcnt(0)" ::: "memory");
  __syncthreads();
  f32x4 acc1[2][4], acc2[2][4];
#pragma unroll
  for (int i = 0; i < 2; ++i)
#pragma unroll
    for (int j = 0; j < 4; ++j) { acc1[i][j] = (f32x4){0.f, 0.f, 0.f, 0.f}; acc2[i][j] = (f32x4){0.f, 0.f, 0.f, 0.f}; }
#pragma unroll
  for (int ks = 0; ks < 2; ++ks) {
    bf16x8 as[2], bv[4];
#pragma unroll
    for (int i = 0; i < 2; ++i) as[i] = img_frag(SP, wr * 32 + i * 16, ks, fr, fq);
#pragma unroll
    for (int j = 0; j < 4; ++j) bv[j] = img_frag(VT, wc * 64 + j * 16, ks, fr, fq);
#pragma unroll
    for (int i = 0; i < 2; ++i)
#pragma unroll
      for (int j = 0; j < 4; ++j) acc1[i][j] = __builtin_amdgcn_mfma_f32_16x16x32_bf16(bv[j], as[i], acc1[i][j], 0, 0, 0);
  }
#pragma unroll 1
  for (int kt = 0; kt < 2; ++kt) {
    if (kt == 1) {
      __syncthreads();
#pragma unroll
      for (int i = 0; i < 4; ++i) { const int idx = tid + 256 * i, row = idx >> 3, lc = (idx & 7) ^ ((row >> 1) & 7); glds16(cst + row * 128 + 64 + lc * 8, Ki + idx * 16); }
      asm volatile("s_waitcnt vmcnt(0)" ::: "memory");
      __syncthreads();
    }
#pragma unroll
    for (int ks = 0; ks < 2; ++ks) {
      bf16x8 aq[2], bc[4];
#pragma unroll
      for (int i = 0; i < 2; ++i) aq[i] = img_frag(Qi + kt * 8192, wr * 32 + i * 16, ks, fr, fq);
#pragma unroll
      for (int j = 0; j < 4; ++j) bc[j] = img_frag(Ki, wc * 64 + j * 16, ks, fr, fq);
#pragma unroll
      for (int i = 0; i < 2; ++i)
#pragma unroll
        for (int j = 0; j < 4; ++j) acc2[i][j] = __builtin_amdgcn_mfma_f32_16x16x32_bf16(bc[j], aq[i], acc2[i][j], 0, 0, 0);
    }
  }
  __syncthreads();
#pragma unroll
  for (int mi = 0; mi < 2; ++mi) {
    const int t = wr * 32 + mi * 16 + fr; const float wi = sc[192 + t];
    const float den = sc[256 + t * 2] + sc[256 + t * 2 + 1] + wi * sc[384 + t];
    const float inv = 1.f / fmaxf(fabsf(den), __expf(-sc[128 + t]));
#pragma unroll
    for (int ni = 0; ni < 4; ++ni) *(f32x4*)(H + t * 132 + wc * 64 + ni * 16 + 4 * fq) = (acc1[mi][ni] + acc2[mi][ni] * wi) * inv;
  }
  __syncthreads();
  {
    bf16_t og0[16], og1[16];
#pragma unroll
    for (int r = 0; r < 16; ++r) { const size_t n = nb + t0 + wid * 16 + r; og0[r] = a.O[n * 512 + h * 128 + lane]; og1[r] = a.O[n * 512 + h * 128 + 64 + lane]; }
    const float g0 = ml.gain[h * 128 + lane], g1 = ml.gain[h * 128 + 64 + lane];
#pragma unroll
    for (int r = 0; r < 16; ++r) {
      const int j = wid * 16 + r;
      const float a0 = H[j * 132 + lane], a1 = H[j * 132 + 64 + lane];
      const float ss = wave_sum(a0 * a0 + a1 * a1);
      const float rs = rsqrtf(ss * (1.f / 128.f) + EPS);
      const size_t n = nb + t0 + j; const int c0 = h * 128 + lane, c1 = c0 + 64;
      a.AML[n * 512 + c0] = f2bf(sigmoidf_(bf2f(og0[r])) * a0 * rs * g0);
      a.AML[n * 512 + c1] = f2bf(sigmoidf_(bf2f(og1[r])) * a1 * rs * g1);
    }
  }
  __syncthreads();
}


struct EpiX1 {
  static constexpr bool PERM = false, AFTER_DRAIN = false;
  const float* x; bf16_t* X1B; float* PS2;
  __device__ __forceinline__ void operator()(const f32x4 (&acc)[2][2][4][2], const pg8::Unit& u, int wr, int wc, int fr, int fq) const {
#pragma unroll
    for (int ai = 0; ai < 2; ++ai)
#pragma unroll
      for (int m = 0; m < 4; ++m) {
        const int row = u.pm * 256 + ai * 128 + wr * 64 + m * 16 + fr;
#pragma unroll
        for (int bj = 0; bj < 2; ++bj) {
          float ss = 0.f;
#pragma unroll
          for (int n = 0; n < 2; ++n) {
            const size_t off = (size_t)row * 1024 + u.pn * 256 + bj * 128 + wc * 32 + n * 16 + 4 * fq;
            const f32x4 v = *(const f32x4*)(x + off) + acc[ai][bj][m][n];
            st_bf4(X1B + off, v);
            ss += v[0] * v[0] + v[1] * v[1] + v[2] * v[2] + v[3] * v[3];
          }
          ss += __shfl_xor(ss, 16); ss += __shfl_xor(ss, 32);
          if (fq == 0) PS2[(size_t)row * 32 + u.pn * 8 + bj * 4 + wc] = ss;
        }
      }
  }
};
struct EpiXQ {
  static constexpr bool PERM = false, AFTER_DRAIN = false;
  bf16_t* XQ; const float* PS2;
  __device__ __forceinline__ void operator()(const f32x4 (&acc)[2][2][4][2], const pg8::Unit& u, int wr, int wc, int fr, int fq) const {
#pragma unroll
    for (int ai = 0; ai < 2; ++ai)
#pragma unroll
      for (int m = 0; m < 4; ++m) {
        const int row = u.pm * 256 + ai * 128 + wr * 64 + m * 16 + fr;
        const f32x4* pp = (const f32x4*)(PS2 + (size_t)row * 32);
        float ss = 0.f;
#pragma unroll
        for (int c = 0; c < 8; ++c) { const f32x4 p = pp[c]; ss += (p[0] + p[1]) + (p[2] + p[3]); }
        const float rs = rsqrtf(ss * (1.f / DM) + EPS);
#pragma unroll
        for (int bj = 0; bj < 2; ++bj)
#pragma unroll
          for (int n = 0; n < 2; ++n) st_bf4(XQ + (size_t)row * 1024 + u.pn * 256 + bj * 128 + wc * 32 + n * 16 + 4 * fq, acc[ai][bj][m][n] * rs);
      }
  }
};
struct EpiX2 {
  static constexpr bool PERM = false, AFTER_DRAIN = false;
  bf16_t* X1B;
  __device__ __forceinline__ void operator()(const f32x4 (&acc)[2][2][4][2], const pg8::Unit& u, int wr, int wc, int fr, int fq) const {
#pragma unroll
    for (int ai = 0; ai < 2; ++ai)
#pragma unroll
      for (int m = 0; m < 4; ++m) {
        const int row = u.pm * 256 + ai * 128 + wr * 64 + m * 16 + fr;
#pragma unroll
        for (int bj = 0; bj < 2; ++bj)
#pragma unroll
          for (int n = 0; n < 2; ++n) {
            bf16_t* p = X1B + (size_t)row * 1024 + u.pn * 256 + bj * 128 + wc * 32 + n * 16 + 4 * fq;
            const u32x2 pr = *(const u32x2*)p; f32x4 r = acc[ai][bj][m][n];
            r[0] += __uint_as_float(pr.x << 16); r[1] += __uint_as_float(pr.x & 0xffff0000u); r[2] += __uint_as_float(pr.y << 16); r[3] += __uint_as_float(pr.y & 0xffff0000u);
            st_bf4(p, r);
          }
      }
  }
};
struct MapMN {
  const bf16_t* A; const bf16_t* Bt; int K, xcd;
  __device__ __forceinline__ void avoff(const pg8::Unit&, int, int K, const unsigned (&voffA)[2], unsigned (&v0)[2], unsigned (&v1)[2]) const { v0[0] = voffA[0]; v0[1] = voffA[1]; v1[0] = voffA[0] + 256u * K; v1[1] = voffA[1] + 256u * K; }
  __device__ __forceinline__ void operator()(int idx, pg8::Unit& u) const {
    u.pm = xcd * 8 + (idx & 7); u.pn = idx >> 3;
    u.aptr = (const char*)(A + (size_t)u.pm * 256 * K); u.bptr = (const char*)(Bt + (size_t)u.pn * 256 * K);
  }
};

struct MapInProj {
  const bf16_t* XB; const bf16_t* WinT; int xcd;
  __device__ __forceinline__ void avoff(const pg8::Unit&, int, int K, const unsigned (&voffA)[2], unsigned (&v0)[2], unsigned (&v1)[2]) const { v0[0] = voffA[0]; v0[1] = voffA[1]; v1[0] = voffA[0] + 256u * K; v1[1] = voffA[1] + 256u * K; }
  __device__ __forceinline__ void operator()(int idx, pg8::Unit& u) const {
    u.pm = xcd * 8 + (idx & 7); u.pn = idx >> 3;
    const char* tokp = (const char*)(XB + (size_t)u.pm * 256 * DM); const char* colp = (const char*)(WinT + (size_t)u.pn * 256 * DM);
    if (u.pn == 12) { u.aptr = colp; u.bptr = tokp; } else { u.aptr = tokp; u.bptr = colp; }
  }
};
struct EpiInProj8 {
  static constexpr bool PERM = false, AFTER_DRAIN = false;
  bf16_t *QK, *V, *O, *NQ, *KVC, *KS, *KW, *VST, *VWT; float* SM; const float* RS1;
  __device__ __forceinline__ void operator()(const f32x4 (&acc)[2][2][4][2], const pg8::Unit& u, int wr, int wc, int fr, int fq) const {
    if (u.pn == 12) {
#pragma unroll
      for (int bj = 0; bj < 2; ++bj)
#pragma unroll
        for (int n = 0; n < 2; ++n) {
          const int tok = u.pm * 256 + bj * 128 + wc * 32 + n * 16 + 4 * fq; const f32x4 rs = *(const f32x4*)(RS1 + tok);
          const int b = tok >> 12, t = tok & 4095;
#pragma unroll
          for (int ai = 0; ai < 2; ++ai)
#pragma unroll
            for (int m = 0; m < 4; ++m) st_bf4((ai ? VWT : VST) + ((size_t)(b * 128 + wr * 64 + m * 16 + fr) << 12) + t, acc[ai][bj][m][n] * rs);
        }
      return;
    }
#pragma unroll
    for (int bj = 0; bj < 2; ++bj) {
      const int nh = u.pn * 256 + bj * 128;
      bf16_t* dst; int ld, cofs; float scale = 1.f;
      if (nh < 1024) { dst = QK; ld = 1024; cofs = nh; }
      else if (nh < 1536) { dst = V; ld = 512; cofs = nh - 1024; }
      else if (nh < 2048) { dst = O; ld = 512; cofs = nh - 1536; }
      else if (nh < 2560) { dst = NQ; ld = 512; cofs = nh - 2048; scale = 0.125f * 1.4426950408889634f; }
      else if (nh < 2816) { dst = KVC; ld = 256; cofs = nh - 2560; }
      else if (nh < 2944) { dst = KS; ld = 128; cofs = 0; }
      else if (nh < 3072) { dst = KW; ld = 128; cofs = 0; }
      else { dst = nullptr; ld = 0; cofs = 0; }
      if (!dst && nh != 3328) continue;
#pragma unroll
      for (int ai = 0; ai < 2; ++ai)
#pragma unroll
        for (int m = 0; m < 4; ++m) {
          const int row = u.pm * 256 + ai * 128 + wr * 64 + m * 16 + fr; const float rs = RS1[row] * scale;
          if (dst) {
#pragma unroll
            for (int n = 0; n < 2; ++n) st_bf4(dst + (size_t)row * ld + cofs + wc * 32 + n * 16 + 4 * fq, acc[ai][bj][m][n] * rs);
          } else if (wc == 0) {
#pragma unroll
            for (int n = 0; n < 2; ++n) *(f32x4*)(SM + (size_t)row * 32 + n * 16 + 4 * fq) = acc[ai][bj][m][n] * rs;
          }
        }
    }
  }
};

struct MapMoe {
  const int* CNT; const int* LIST; const bf16_t* Abase; const bf16_t* W; size_t wstride; int K, xcd, gather;
  __device__ __forceinline__ void operator()(int idx, pg8::Unit& u) const {
    int g = (idx >> 2) * 8 + xcd, e = 0, ce = CNT[0], pre = 0;
    while (g >= ((ce + 255) >> 8)) { g -= (ce + 255) >> 8; pre += ce; ++e; ce = CNT[e]; }
    u.e = e; u.ce = ce; u.rt = g; u.p0 = pre + g * 256; u.pm = 0; u.pn = idx & 3;
    u.bptr = (const char*)(W + (size_t)e * wstride + (size_t)u.pn * 256 * K);
    u.aptr = gather ? (const char*)Abase : (const char*)(Abase + (size_t)u.p0 * K);
  }
  __device__ __forceinline__ void avoff(const pg8::Unit& u, int tid, int K_, const unsigned (&voffA)[2], unsigned (&v0)[2], unsigned (&v1)[2]) const {
    if (!gather) { v0[0] = voffA[0]; v0[1] = voffA[1]; v1[0] = voffA[0] + 256u * K_; v1[1] = voffA[1] + 256u * K_; return; }
#pragma unroll
    for (int i = 0; i < 2; ++i) {
      int R, C; pg8::stage_rc(tid * 16 + i * 8192, R, C);
      int m0_ = u.rt * 256 + R, m1_ = m0_ + 128; if (m0_ >= u.ce) m0_ = u.ce - 1; if (m1_ >= u.ce) m1_ = u.ce - 1;
      v0[i] = (unsigned)((LIST[u.e * NTOK + m0_] >> 1) * K_ + C) * 2u; v1[i] = (unsigned)((LIST[u.e * NTOK + m1_] >> 1) * K_ + C) * 2u;
    }
  }
};
struct EpiMoe1 {
  static constexpr bool PERM = false, AFTER_DRAIN = false;
  const int* LIST; const float* RS3; bf16_t* ACT;
  __device__ __forceinline__ void operator()(const f32x4 (&acc)[2][2][4][2], const pg8::Unit& u, int wr, int wc, int fr, int fq) const {
#pragma unroll
    for (int ai = 0; ai < 2; ++ai)
#pragma unroll
      for (int m = 0; m < 4; ++m) {
        const int r = ai * 128 + wr * 64 + m * 16 + fr, ml = u.rt * 256 + r;
        if (ml < u.ce) {
          const float rs = RS3[LIST[u.e * NTOK + ml] >> 1];
#pragma unroll
          for (int bj = 0; bj < 2; ++bj) {
            const f32x4 a1 = acc[ai][bj][m][0] * rs, a3 = acc[ai][bj][m][1] * rs; f32x4 r4;
#pragma unroll
            for (int j = 0; j < 4; ++j) r4[j] = siluf_(a1[j]) * a3[j];
            st_bf4(ACT + (size_t)(u.p0 + r) * 512 + (u.pn * 8 + bj * 4 + wc) * 16 + 4 * fq, r4);
          }
        }
      }
  }
};
struct EpiMoe2 {
  static constexpr bool PERM = false, AFTER_DRAIN = false;
  const int* LIST; const float* RTW; bf16_t* Y;
  __device__ __forceinline__ void operator()(const f32x4 (&acc)[2][2][4][2], const pg8::Unit& u, int wr, int wc, int fr, int fq) const {
#pragma unroll
    for (int ai = 0; ai < 2; ++ai)
#pragma unroll
      for (int m = 0; m < 4; ++m) {
        const int r = ai * 128 + wr * 64 + m * 16 + fr, ml = u.rt * 256 + r;
        if (ml < u.ce) {
          const int entry = LIST[u.e * NTOK + ml]; const float w = RTW[entry];
#pragma unroll
          for (int bj = 0; bj < 2; ++bj)
#pragma unroll
            for (int n = 0; n < 2; ++n) st_bf4(Y + (size_t)entry * 1024 + u.pn * 256 + bj * 128 + wc * 32 + n * 16 + 4 * fq, acc[ai][bj][m][n] * w);
        }
      }
  }
};

struct EpiGate {
  static constexpr bool PERM = false, AFTER_DRAIN = false;
  bf16_t* G; const float* RS1;
  __device__ __forceinline__ void operator()(const f32x4 (&acc)[2][2][4][2], const pg8::Unit& u, int wr, int wc, int fr, int fq) const {
#pragma unroll
    for (int ai = 0; ai < 2; ++ai)
#pragma unroll
      for (int m = 0; m < 4; ++m) {
        const int row = u.pm * 256 + ai * 128 + wr * 64 + m * 16 + fr; const float rs = RS1[row];
#pragma unroll
        for (int bj = 0; bj < 2; ++bj)
#pragma unroll
          for (int n = 0; n < 2; ++n) {
            const f32x4 g = acc[ai][bj][m][n] * rs; f32x4 sg;
#pragma unroll
            for (int j = 0; j < 4; ++j) sg[j] = sigmoidf_(g[j]);
            st_bf4(G + (size_t)row * 1024 + u.pn * 256 + bj * 128 + wc * 32 + n * 16 + 4 * fq, sg);
          }
      }
  }
};
template <bool ADDP> struct EpiMrg {
  static constexpr bool PERM = false, AFTER_DRAIN = false;
  const bf16_t* G; bf16_t* OUT;
  __device__ __forceinline__ void operator()(const f32x4 (&acc)[2][2][4][2], const pg8::Unit& u, int wr, int wc, int fr, int fq) const {
#pragma unroll
    for (int ai = 0; ai < 2; ++ai)
#pragma unroll
      for (int m = 0; m < 4; ++m) {
        const unsigned rowoff = (unsigned)(u.pm * 256 + ai * 128 + wr * 64 + m * 16 + fr) * 1024u + (unsigned)(u.pn * 256 + wc * 32 + 4 * fq);
#pragma unroll
        for (int bj = 0; bj < 2; ++bj)
#pragma unroll
          for (int n = 0; n < 2; ++n) {
            const unsigned off = rowoff + bj * 128 + n * 16;
            const u32x2 gv = *(const u32x2*)(G + off);
            f32x4 r = acc[ai][bj][m][n];
            r[0] *= __uint_as_float(gv.x << 16); r[1] *= __uint_as_float(gv.x & 0xffff0000u); r[2] *= __uint_as_float(gv.y << 16); r[3] *= __uint_as_float(gv.y & 0xffff0000u);
            if (ADDP) { const u32x2 pv = *(const u32x2*)(OUT + off);
              r[0] += __uint_as_float(pv.x << 16); r[1] += __uint_as_float(pv.x & 0xffff0000u); r[2] += __uint_as_float(pv.y << 16); r[3] += __uint_as_float(pv.y & 0xffff0000u); }
            st_bf4(OUT + off, r);
          }
      }
  }
};

#define XB_TMO      128
#define XB_XCNT(j)  (256  + 64 * (j))
#define XB_XSUB(j)  (1280 + 64 * (j))
#define XB_XGEN(j)  (2304 + 64 * (j))
#define XB_TOP      3328
#define XB_TOPGEN   3392
#define XCD_BAR_WORDS 3456
#define XB_SPIN_CAP (1u << 24)
__device__ __forceinline__ unsigned xb_ld(unsigned* p)              { return __hip_atomic_load(p, __ATOMIC_RELAXED, __HIP_MEMORY_SCOPE_AGENT); }
__device__ __forceinline__ unsigned xb_add(unsigned* p, unsigned v) { return __hip_atomic_fetch_add(p, v, __ATOMIC_RELAXED, __HIP_MEMORY_SCOPE_AGENT); }
__device__ __forceinline__ unsigned xb_xcc_id() { return (unsigned)__builtin_amdgcn_s_getreg((3 << 11) | 20) & 0xFu; }
#define XB_SPIN(cond, bar) do { unsigned _sp = 0; while (cond) { __builtin_amdgcn_s_sleep(1); \
    if ((++_sp & 255u) == 0u) { if (xb_ld(&(bar)[XB_TMO])) break; if (_sp > XB_SPIN_CAP) { atomicAdd(&(bar)[XB_TMO], 1u); break; } } } } while (0)
__device__ __forceinline__ void xcd_barrier_complete(unsigned* bar, unsigned x, unsigned G, unsigned& nloc, unsigned& nx) {
  unsigned sum, cnt, mine, sp = 0u;
  for (;;) {
    sum = 0u; cnt = 0u; mine = 0u;
#pragma unroll
    for (unsigned j = 0; j < 16; ++j) { const unsigned c = xb_ld(&bar[XB_XCNT(j)]); sum += c; cnt += (c > 0u) ? 1u : 0u; mine = (j == x) ? c : mine; }
    if (sum == G) break;
    __builtin_amdgcn_s_sleep(1);
    if ((++sp & 255u) == 0u) { if (xb_ld(&bar[XB_TMO])) break; if (sp > XB_SPIN_CAP) { atomicAdd(&bar[XB_TMO], 1u); break; } }
  }
  nloc = mine > 0u ? mine : 1u; nx = cnt > 0u ? cnt : 1u;
}
__device__ __forceinline__ void xcd_barrier(unsigned* bar, unsigned x, volatile unsigned* st, unsigned G, bool leader_thread) {
  asm volatile("s_waitcnt vmcnt(0)" ::: "memory");
  __syncthreads();
  if (leader_thread) {
    __builtin_amdgcn_s_waitcnt(0);
    unsigned nloc = st[0], nx = st[1];
    if (nloc == 0u) { xcd_barrier_complete(bar, x, G, nloc, nx); st[0] = nloc; st[1] = nx; }
    const unsigned old = xb_add(&bar[XB_XSUB(x)], 1u);
    const unsigned gen = old / nloc;
    if (old + 1u == (gen + 1u) * nloc) {
      __builtin_amdgcn_fence(__ATOMIC_RELEASE, "agent");
      asm volatile("s_waitcnt vmcnt(0)" ::: "memory");
      const unsigned og = xb_add(&bar[XB_TOP], 1u);
      const unsigned tg = og / nx;
      if (og + 1u == (tg + 1u) * nx) xb_add(&bar[XB_TOPGEN], 1u);
      else XB_SPIN(xb_ld(&bar[XB_TOPGEN]) == tg, bar);
      __builtin_amdgcn_fence(__ATOMIC_ACQUIRE, "agent");
      xb_add(&bar[XB_XGEN(x)], 1u);
      asm volatile("s_waitcnt vmcnt(0)" ::: "memory");
    } else {
      XB_SPIN(xb_ld(&bar[XB_XGEN(x)]) == gen, bar);
      __builtin_amdgcn_fence(__ATOMIC_ACQUIRE, "agent");
      asm volatile("s_waitcnt vmcnt(0)" ::: "memory");
    }
  }
  __syncthreads();
}

__device__ __forceinline__ void convert_range(const MegaArgs& a, int lo, int hi, int bid, int nblk, char* lds, int tid) {
  for (int it0 = lo; it0 < hi; it0 += nblk) {
    int it = it0 + bid; if (it >= hi) it = hi - 1;
    int r = it, di = 0;
    while (r >= a.td[di].nitems) { r -= a.td[di].nitems; ++di; }
    transpose_item(a.td[di], r, (float*)lds, tid);
  }
}
#define TILE_IDS unsigned tid_z = 0u; asm volatile("" : "+v"(tid_z)); int tid = (wave_s & 3) * 64 + (int)__builtin_amdgcn_mbcnt_hi(~0u, __builtin_amdgcn_mbcnt_lo(~0u, tid_z)); asm volatile("" : "+v"(tid)); const int half = wave_s >> 2; char* const lds = plds + half * HALF_LDS; const int bid = pbid * 2 + half, nblk = pnblk * 2, li = (pbid >> 3) * 2 + half, nloc = (pnblk >> 3) * 2; const int lane = tid & 63, wid = tid >> 6, wr = wid >> 1, wc = wid & 1, fr = lane & 15, fq = lane >> 4; (void)lane; (void)wid; (void)wr; (void)wc; (void)fr; (void)fq; (void)half; (void)lds; (void)bid; (void)nblk; (void)li; (void)nloc

__global__ void __launch_bounds__(512, 2) k_mega(MegaArgs a) {
  extern __shared__ __attribute__((aligned(16))) char lds_raw[];
  char* const plds = lds_raw;
  cg::grid_group grid = cg::this_grid();
  const int pnblk = gridDim.x, pbid = blockIdx.x;
  const int wave_s = __builtin_amdgcn_readfirstlane((int)(threadIdx.x >> 6));
  unsigned* const xbar = a.BAR + a.li * XCD_BAR_WORDS;
  volatile unsigned* const xst = (volatile unsigned*)(plds + CTRL_OFF);
  volatile int* const xch = (volatile int*)(plds + CTRL_OFF + 16);
  unsigned xcc;
  {
    const bool t0 = (wave_s == 0) && ((int)__builtin_amdgcn_mbcnt_hi(~0u, __builtin_amdgcn_mbcnt_lo(~0u, 0u)) == 0);
    if (t0) { xst[0] = 0u; xst[1] = 0u; }
    xcc = xb_xcc_id();
    if (t0) (void)xb_add(&xbar[XB_XCNT(xcc)], 1u);
    grid.sync();
  }
#define PH(k) (a.ph_lo <= (k) && (k) < a.ph_hi)
  const int xcd = pbid & 7;
#define GRID_BAR() do { const int ld_ = (wave_s == 0) && ((int)__builtin_amdgcn_mbcnt_hi(~0u, __builtin_amdgcn_mbcnt_lo(~0u, 0u)) == 0); xcd_barrier(xbar, xcc, xst, (unsigned)pnblk, ld_); } while (0)
#define SYNC_AFTER(k) do { if (PH(k) && PH((k) + 1)) GRID_BAR(); } while (0)
#pragma unroll 1
  for (int rp_ = PH(0) ? a.rep[0] : 0; rp_ > 0; --rp_) {
    TILE_IDS;
    convert_range(a, a.cv_lo[0], a.cv_hi[0], bid, nblk, lds, tid);
    for (int i = bid * 256 + tid; i < (NIN - DIN_A) * 1024 / 8; i += nblk * 256) ((u32x4*)(a.WinT + (size_t)DIN_A * 1024))[i] = (u32x4){0u, 0u, 0u, 0u};
    rows_to_bf16(a.x, a.XB, a.RS1, NTOK, bid * 4 + wid, nblk * 4, lane);
    rows_to_bf16(a.mem, a.MEMB, a.RSM, NB * MEMT, bid * 4 + wid, nblk * 4, lane);
    for (int o = bid * 4 + wid; o < 256; o += nblk * 4) {
      const int which = o >> 7, u = o & 127; const float* pos = which ? a.posv : a.posk; const float* w1 = which ? a.cvw1 : a.ckw1;
      float sacc = 0.f;
      for (int f = lane; f < 2048; f += 64) sacc += pos[f] * w1[(size_t)f * 128 + u];
      sacc = wave_sum(sacc);
      if (lane == 0) a.POSW[o] = sacc;
    }
  }
  SYNC_AFTER(0);
#pragma unroll 1
  for (int rp_ = PH(1) ? a.rep[1] : 0; rp_ > 0; --rp_) {
    TILE_IDS;
    {
      TILE8_IDS;
      ListSched<MapInProj> S8{pbid >> 3, pnblk >> 3, 112, MapInProj{a.XB, a.WinT, xcd}};
      EpiInProj8 E8{a.QK, a.V, a.O, a.NQ, a.KVC, a.KS, a.KW, a.VST, a.VWT, a.SM, a.RS1};
      pg8::gemm_phase<EpiInProj8, ListSched<MapInProj>, true, true>((PG8_LAS unsigned char*)plds, pg8::Gemm{DM}, S8, E8, t512, wave_s);
    }
    convert_range(a, a.cv_lo[1], a.cv_hi[1], bid, nblk, lds, tid);
  }
  SYNC_AFTER(1);
#pragma unroll 1
  for (int rp_ = PH(2) ? a.rep[2] : 0; rp_ > 0; --rp_) {
    TILE_IDS;
    for (int it = bid; it < 128; it += nblk) {
      const int which = it >> 6, m0 = ((it >> 2) & 15) * 128, slab = it & 3;
      f32x4 acc[4][4]; zero_acc(acc);
      {
        int tid2 = tid; asm volatile("" : "+v"(tid2));
        unsigned ao[4], bo[4];
#pragma unroll
        for (int i = 0; i < 4; ++i) {
          const int row = st_row(tid2, i), lc = st_lc(tid2, i);
          const int m = m0 + row, bg = m >> 8, j = m & 255;
          ao[i] = (unsigned)((bg >> 1) * SEQ + 16 * j + slab * 8) * 256u + which * 128 + (bg & 1) * 64 + lc * 8;
          bo[i] = (unsigned)row * 2048u + slab * 512 + lc * 8;
        }
        gemm_core(acc, a.KVC, ao, 256u, which ? a.CV1T : a.CK1T, bo, 64u, 8, lds, tid2);
      }
      float* cp = a.CPART + (size_t)((which * 4 + slab) * 2048 + m0) * 128;
#pragma unroll
      for (int mi = 0; mi < 4; ++mi)
#pragma unroll
        for (int ni = 0; ni < 4; ++ni) *(f32x4*)(cp + (wr * 64 + mi * 16 + fr) * 128 + wc * 64 + ni * 16 + 4 * fq) = acc[mi][ni];
    }
    for (int q = nloc - 1 - li; q < 16; q += nloc) {
      f32x4 acc[4][4]; zero_acc(acc);
      const int tile = xcd * 16 + q; constexpr int T1 = 0, T2n = 16;
        const int t2 = tile - T1; const int m0 = (t2 / T2n) * 128, n0 = (t2 % T2n) * 128;
        if (n0 < 1024) {
          gemm_acc(acc, a.MEMB, DM, (const int*)nullptr, 0, 0, a.WkvT, DM, DM, lds, m0, n0, tid);
#pragma unroll
          for (int mi = 0; mi < 4; ++mi) {
            const int m = m0 + wr * 64 + mi * 16 + fr; const float rs = a.RSM[m];
#pragma unroll
            for (int ni = 0; ni < 4; ++ni) st_bf4(a.KVM + (size_t)m * 1024 + n0 + wc * 64 + ni * 16 + 4 * fq, acc[mi][ni] * rs);
          }
        } else {
          gemm_acc(acc, a.WkvT, DM, (const int*)nullptr, 0, 0, a.MEMB, DM, DM, lds, n0, m0, tid);
          bf16_t* vmt = a.KVM + (size_t)1024 * 1024;
#pragma unroll
          for (int ni = 0; ni < 4; ++ni) {
            const int tok = m0 + wc * 64 + ni * 16 + 4 * fq; const f32x4 rs = *(const f32x4*)(a.RSM + tok);
            const int b = tok >> 8, key = tok & 255;
#pragma unroll
            for (int mi = 0; mi < 4; ++mi) {
              const int col = n0 - 1024 + wr * 64 + mi * 16 + fr;
              st_bf4(vmt + ((size_t)(b * 1024 + col) << 8) + key, acc[mi][ni] * rs);
            }
          }
        }
    }
    for (int lp = pbid >> 3; lp < 32; lp += pnblk >> 3) nsa_win_item(a, ((((((xcd >> 1) & 1) * 2 + half) * 2 + (xcd & 1)) << 6)) | (63 - (2 * lp + (xcd >> 2))), lds, tid);
    {
      volatile int* wqw = (volatile int*)(lds + MEGA_LDS - 32);
      (void)wqw;
      for (;;) {
        if (wave_s == 0 && lane == 0) xch[2] = atomicAdd(a.WQ + 1, 2);
        __syncthreads();
        const int it0 = xch[2];
        __syncthreads();
        if (it0 >= 1024) break;
        ml_dc_item(a, a.ml, it0 + half, lds, tid);
      }
    }
  }
  SYNC_AFTER(2);
#pragma unroll 1
  for (int rp_ = PH(3) ? a.rep[3] : 0; rp_ > 0; --rp_) {
    TILE_IDS;
    if (rp_ == 1) for (int it = bid; it < 272; it += nblk) ml_scan_item(a.ml, it, tid);
    for (int it = nblk - 1 - bid; it < 128; it += nblk) {
      const int which = it >> 6, m0 = (it & 63) * 32;
      float* hid = (float*)lds;
      float* w2s = (float*)(lds + 16640);
      {
        const float* w2 = which ? a.cvw2 : a.ckw2;
#pragma unroll
        for (int c = 0; c < 8; ++c) *(f32x4*)(w2s + (tid + 256 * c) * 4) = *(const f32x4*)(w2 + (tid + 256 * c) * 4);
        const int row = tid >> 3, u0 = (tid & 7) * 16;
        const float* cp = a.CPART + (size_t)(which * 4 * 2048 + m0 + row) * 128 + u0;
#pragma unroll
        for (int c4 = 0; c4 < 4; ++c4) {
          f32x4 hv = *(const f32x4*)(cp + c4 * 4) + *(const f32x4*)(cp + 2048 * 128 + c4 * 4) + *(const f32x4*)(cp + 2 * 2048 * 128 + c4 * 4) + *(const f32x4*)(cp + 3 * 2048 * 128 + c4 * 4)
                   + *(const f32x4*)(a.POSW + which * 128 + u0 + c4 * 4);
#pragma unroll
          for (int j = 0; j < 4; ++j) hid[row * 129 + u0 + c4 * 4 + j] = gelu_tanh(hv[j]);
        }
      }
      __syncthreads();
      {
        const int row = tid >> 3, d0 = (tid & 7) * 8;
        float o[8];
#pragma unroll
        for (int d = 0; d < 8; ++d) o[d] = 0.f;
        for (int u = 0; u < 128; ++u) {
          const float hv = hid[row * 129 + u]; const f32x4 w0 = *(const f32x4*)(w2s + u * 64 + d0), w1 = *(const f32x4*)(w2s + u * 64 + d0 + 4);
          o[0] += hv * w0[0]; o[1] += hv * w0[1]; o[2] += hv * w0[2]; o[3] += hv * w0[3]; o[4] += hv * w1[0]; o[5] += hv * w1[1]; o[6] += hv * w1[2]; o[7] += hv * w1[3];
        }
        const int m = m0 + row, bg = m >> 8, j = m & 255;
        if (which == 0) {
#pragma unroll
          for (int d = 0; d < 8; ++d) a.KC[(size_t)m * 64 + d0 + d] = (j == 255) ? (bf16_t)0 : f2bf(o[d]);
        } else {
#pragma unroll
          for (int d = 0; d < 8; ++d) a.VCT[((size_t)(bg * 64 + d0 + d) << 8) + j] = (j == 255) ? (bf16_t)0 : f2bf(o[d]);
        }
      }
      __syncthreads();
    }
  }
  SYNC_AFTER(3);
#pragma unroll 1
  for (int rp_ = PH(4) ? a.rep[4] : 0; rp_ > 0; --rp_) {
    for (int lp = pbid >> 3; lp < 32; lp += pnblk >> 3) { TILE_IDS; nsa_main_item(a, ((((((xcd >> 1) & 1) * 2 + half) * 2 + (xcd & 1)) << 6)) | (63 - (2 * lp + (xcd >> 2))), lds, tid, xch, half); }
    { TILE_IDS;
      volatile int* wqw = (volatile int*)(lds + MEGA_LDS - 32);
      (void)wqw;
      for (;;) {
        if (wave_s == 0 && lane == 0) xch[2] = atomicAdd(a.WQ, 2);
        __syncthreads();
        const int it0 = xch[2];
        __syncthreads();
        if (it0 >= 1024) break;
        ml_out_item(a, a.ml, it0 + half, lds, tid);
      } }
  }
  SYNC_AFTER(4);
#pragma unroll 1
  for (int rp_ = PH(5) ? a.rep[5] : 0; rp_ > 0; --rp_) {
    TILE_IDS;
    {
      TILE8_IDS;
      PG8_LAS unsigned char* l8 = (PG8_LAS unsigned char*)plds;
      bf16_t* G1 = (bf16_t*)((char*)a.out + 32 * MiB);
      { ListSched<MapMN> S8{pbid >> 3, pnblk >> 3, 32, MapMN{a.XB, a.WgT, DM, xcd}}; EpiGate E8{a.MRG, a.RS1};
        pg8::gemm_phase<EpiGate, ListSched<MapMN>, false, true>(l8, pg8::Gemm{DM}, S8, E8, t512, wave_s); }
      { ListSched<MapMN> S8{pbid >> 3, pnblk >> 3, 32, MapMN{a.XB, a.WgT + (size_t)1024 * DM, DM, xcd}}; EpiGate E8{G1, a.RS1};
        pg8::gemm_phase<EpiGate, ListSched<MapMN>, false, true>(l8, pg8::Gemm{DM}, S8, E8, t512, wave_s); }
      { ListSched<MapMN> S8{pbid >> 3, pnblk >> 3, 32, MapMN{a.AML, a.WmlT, 512, xcd}}; EpiMrg<false> E8{a.MRG, a.MRG};
        pg8::gemm_phase<EpiMrg<false>, ListSched<MapMN>, false, true>(l8, pg8::Gemm{512}, S8, E8, t512, wave_s); }
      { ListSched<MapMN> S8{pbid >> 3, pnblk >> 3, 32, MapMN{a.ANS, a.WnsT, 512, xcd}}; EpiMrg<true> E8{G1, a.MRG};
        pg8::gemm_phase<EpiMrg<true>, ListSched<MapMN>, false, true>(l8, pg8::Gemm{512}, S8, E8, t512, wave_s); }
    }
    convert_range(a, a.cv_lo[5], a.cv_hi[5], bid, nblk, lds, tid);
  }
  SYNC_AFTER(5);
#pragma unroll 1
  for (int rp_ = PH(6) ? a.rep[6] : 0; rp_ > 0; --rp_) {
    TILE_IDS;
    {
      TILE8_IDS;
      ListSched<MapMN> S8{pbid >> 3, pnblk >> 3, 32, MapMN{a.MRG, a.WoutT, DM, xcd}};
      EpiX1 E8{a.x, a.X1B, a.PS2};
      pg8::gemm_phase<decltype(E8), ListSched<MapMN>, false, true>((PG8_LAS unsigned char*)plds, pg8::Gemm{DM}, S8, E8, t512, wave_s);
    }
    convert_range(a, a.cv_lo[6], a.cv_hi[6], bid, nblk, lds, tid);
  }
  SYNC_AFTER(6);
#pragma unroll 1
  for (int rp_ = PH(7) ? a.rep[7] : 0; rp_ > 0; --rp_) {
    TILE_IDS;
    {
      TILE8_IDS;
      ListSched<MapMN> S8{pbid >> 3, pnblk >> 3, 32, MapMN{a.X1B, a.WqT, DM, xcd}};
      EpiXQ E8{a.XQ, a.PS2};
      pg8::gemm_phase<decltype(E8), ListSched<MapMN>, false, true>((PG8_LAS unsigned char*)plds, pg8::Gemm{DM}, S8, E8, t512, wave_s);
    }
    convert_range(a, a.cv_lo[7], a.cv_hi[7], bid, nblk, lds, tid);
  }
  SYNC_AFTER(7);
#pragma unroll 1
  for (int rp_ = PH(8) ? a.rep[8] : 0; rp_ > 0; --rp_) {
    TILE_IDS;
    float* RMX = (float*)lds; float* RSUM = (float*)(lds + 1024);
    for (int q = li; q < 64; q += nloc) {
      const int m0 = (xcd * 16 + (q >> 2)) * 128, hh = q & 3, b = m0 >> 12;
      bf16_t* Qh = a.XQ + hh * 256;
      const bf16_t* Kh = a.KVM + (size_t)(b * 256) * 1024 + hh * 256;
      const bf16_t* Vh = a.KVM + (size_t)1024 * 1024 + ((size_t)(b * 1024 + hh * 256) << 8);
      f32x4 acc0[4][4], acc1[4][4]; zero_acc(acc0); zero_acc(acc1);
      gemm_acc(acc0, Qh, 1024, (const int*)nullptr, 0, 0, Kh, 1024, 256, lds, m0, 0, tid);
      gemm_acc(acc1, Qh, 1024, (const int*)nullptr, 0, 0, Kh, 1024, 256, lds, m0, 128, tid);
      float mloc[4];
#pragma unroll
      for (int mi = 0; mi < 4; ++mi) {
        float mx = -INFINITY;
#pragma unroll
        for (int ni = 0; ni < 4; ++ni)
#pragma unroll
          for (int j = 0; j < 4; ++j) mx = fmaxf(mx, fmaxf(acc0[mi][ni][j], acc1[mi][ni][j]));
        mx = max4(mx); mloc[mi] = mx;
        if (fq == 0) RMX[(wr * 64 + mi * 16 + fr) * 2 + wc] = mx;
      }
      __syncthreads();
#pragma unroll
      for (int mi = 0; mi < 4; ++mi) {
        const int r = wr * 64 + mi * 16 + fr;
        const float m = fmaxf(RMX[r * 2], RMX[r * 2 + 1]); float ls = 0.f;
#pragma unroll
        for (int ni = 0; ni < 4; ++ni)
#pragma unroll
          for (int j = 0; j < 4; ++j) {
            acc0[mi][ni][j] = __expf((acc0[mi][ni][j] - m) * 0.0625f); acc1[mi][ni][j] = __expf((acc1[mi][ni][j] - m) * 0.0625f);
            ls += acc0[mi][ni][j] + acc1[mi][ni][j];
          }
        ls = red4(ls);
        if (fq == 0) RSUM[r * 2 + wc] = ls;
      }
      __syncthreads();
#pragma unroll
      for (int mi = 0; mi < 4; ++mi) {
        const int r = wr * 64 + mi * 16 + fr;
        const float inv = 1.f / (RSUM[r * 2] + RSUM[r * 2 + 1]);
        bf16_t* pr = Qh + (size_t)(m0 + r) * 1024 + wc * 64 + 4 * fq;
#pragma unroll
        for (int ni = 0; ni < 4; ++ni) { st_bf4(pr + ni * 16, acc0[mi][ni] * inv); st_bf4(pr + 128 + ni * 16, acc1[mi][ni] * inv); }
      }
      asm volatile("s_waitcnt vmcnt(0)" ::: "memory");
      __threadfence_block();
      __syncthreads();
#pragma unroll 1
      for (int dh = 0; dh < 2; ++dh) {
        zero_acc(acc0);
        gemm_acc(acc0, Qh, 1024, (const int*)nullptr, 0, 0, Vh, 256, 256, lds, m0, dh * 128, tid);
#pragma unroll
        for (int mi = 0; mi < 4; ++mi) {
          const int r = wr * 64 + mi * 16 + fr;
#pragma unroll
          for (int ni = 0; ni < 4; ++ni) st_bf4(a.XO + (size_t)(m0 + r) * 1024 + hh * 256 + dh * 128 + wc * 64 + ni * 16 + 4 * fq, acc0[mi][ni]);
        }
      }
    }
    convert_range(a, a.cv_lo[8], a.cv_hi[8], bid, nblk, lds, tid);
  }
  SYNC_AFTER(8);
#pragma unroll 1
  for (int rp_ = PH(9) ? a.rep[9] : 0; rp_ > 0; --rp_) {
    TILE_IDS;
    {
      TILE8_IDS;
      ListSched<MapMN> S8{pbid >> 3, pnblk >> 3, 32, MapMN{a.XO, a.WoT, DM, xcd}};
      EpiX2 E8{a.X1B};
      pg8::gemm_phase<decltype(E8), ListSched<MapMN>, false, true>((PG8_LAS unsigned char*)plds, pg8::Gemm{DM}, S8, E8, t512, wave_s);
    }
    convert_range(a, a.cv_lo[9], a.cv_hi[9], bid, nblk, lds, tid);
  }
  SYNC_AFTER(9);
#pragma unroll 1
  for (int rp_ = PH(10) ? a.rep[10] : 0; rp_ > 0; --rp_) {
    TILE_IDS;
    const int tpb = NTOK / nblk;
    int* ex_l = (int*)(lds + 65536);
    float* we_l = (float*)lds;
    for (int c = tid; c < 4096; c += 256) { const int k = c >> 2, q = c & 3; *(f32x4*)(we_l + (q * 1024 + k) * 4) = *(const f32x4*)(a.we + k * 16 + q * 4); }
    __syncthreads();
    for (int k = 0; k < tpb / 4; ++k) {
      const int tl = wid * (tpb / 4) + k, n = bid * tpb + tl;
      int lane = tid & 63; asm volatile("" : "+v"(lane));
      const bf16_t* xr = a.H3 + (size_t)n * DM;
      float v[16]; float s = 0.f;
#pragma unroll
      for (int i = 0; i < 16; ++i) { v[i] = bf2f(xr[lane + 64 * i]); s += v[i] * v[i]; }
      s = wave_sum(s);
      const float rs = rsqrtf(s * (1.f / DM) + EPS);
      float lg[20];
#pragma unroll
      for (int e = 0; e < 20; ++e) lg[e] = 0.f;
#pragma unroll
      for (int i = 0; i < 16; ++i) {
        const int k2 = lane + 64 * i; const float hk = v[i] * rs * a.g_ffn[k2];
        const f32x4 wgv = *(const f32x4*)(a.wg + k2 * 4);
#pragma unroll
        for (int e = 0; e < 4; ++e) lg[e] += hk * wgv[e];
#pragma unroll
        for (int q = 0; q < 4; ++q) { const f32x4 wv = *(const f32x4*)(we_l + (q * 1024 + k2) * 4);
#pragma unroll
          for (int e = 0; e < 4; ++e) lg[4 + q * 4 + e] += hk * wv[e]; }
      }
#pragma unroll
      for (int e = 0; e < 20; ++e) lg[e] = wave_sum(lg[e]);
      if (lane == 0) {
        float gl[4]; float gm = -INFINITY; int gi = 0;
#pragma unroll
        for (int e = 0; e < 4; ++e) { gl[e] = lg[e] + a.bg[e]; if (gl[e] > gm) { gm = gl[e]; gi = e; } }
        float gs = 0.f;
#pragma unroll
        for (int e = 0; e < 4; ++e) gs += __expf(gl[e] - gm);
        const float gval = 1.f / gs;
        float el[4] = {0.f, 0.f, 0.f, 0.f};
#pragma unroll
        for (int gg = 0; gg < 4; ++gg) if (gi == gg) {
#pragma unroll
          for (int e = 0; e < 4; ++e) el[e] = lg[4 + gg * 4 + e] + a.be[gg * 4 + e];
        }
        int i0 = 0; float v0 = el[0];
#pragma unroll
        for (int e = 1; e < 4; ++e) if (el[e] > v0) { v0 = el[e]; i0 = e; }
        int i1 = -1; float v1 = -INFINITY;
#pragma unroll
        for (int e = 0; e < 4; ++e) if (e != i0 && el[e] > v1) { v1 = el[e]; i1 = e; }
        const float e1 = __expf(v1 - v0);
        ex_l[tl * 2] = gi * 4 + i0; ex_l[tl * 2 + 1] = gi * 4 + i1;
        a.RTW[n * 2] = gval / (1.f + e1); a.RTW[n * 2 + 1] = gval * e1 / (1.f + e1);
        a.RS3[n] = rs;
      }
    }
    __syncthreads();
    if (tid < 16) {
      int cnt = 0;
      for (int j = 0; j < 2 * tpb; ++j) cnt += (ex_l[j] == tid) ? 1 : 0;
      if (cnt > 0) {
        int pos = atomicAdd(&a.CNT[tid], cnt);
        for (int j = 0; j < 2 * tpb; ++j) if (ex_l[j] == tid) a.LIST[tid * NTOK + pos++] = (bid * tpb) * 2 + j;
      }
    }
    __syncthreads();
  }
  SYNC_AFTER(10);
#pragma unroll 1
  for (int ph = 11; ph <= 12; ++ph) {
#pragma unroll 1
    for (int rp_ = PH(ph) ? a.rep[ph] : 0; rp_ > 0; --rp_) {
      TILE8_IDS;
      int rtot = 0;
      for (int e = 0; e < 16; ++e) rtot += (a.CNT[e] + 255) >> 8;
      const int nmine = ((rtot - xcd + 7) >> 3) * 4;
      if (ph == 11) {
        ListSched<MapMoe> S8{pbid >> 3, pnblk >> 3, nmine, MapMoe{a.CNT, a.LIST, a.H3, a.W13T, (size_t)1024 * 1024, DM, xcd, 1}};
        EpiMoe1 E8{a.LIST, a.RS3, a.ACT};
        pg8::gemm_phase<EpiMoe1, ListSched<MapMoe>, true, true>((PG8_LAS unsigned char*)plds, pg8::Gemm{DM}, S8, E8, t512, wave_s);
      } else {
        ListSched<MapMoe> S8{pbid >> 3, pnblk >> 3, nmine, MapMoe{a.CNT, a.LIST, a.ACT, a.W2T, (size_t)1024 * 512, 512, xcd, 0}};
        EpiMoe2 E8{a.LIST, a.RTW, a.Y};
        pg8::gemm_phase<EpiMoe2, ListSched<MapMoe>, true, true>((PG8_LAS unsigned char*)plds, pg8::Gemm{512}, S8, E8, t512, wave_s);
      }
    }
    if (PH(ph) && PH(ph + 1)) GRID_BAR();
  }
#pragma unroll 1
  for (int rp_ = PH(13) ? a.rep[13] : 0; rp_ > 0; --rp_) {
    TILE_IDS;
    for (int row = bid * 4 + wid; row < NTOK; row += nblk * 4) {
      f32x4* xr = (f32x4*)(a.out + (size_t)row * DM) + lane;
      const u32x2* x2r = (const u32x2*)(a.H3 + (size_t)row * DM) + lane;
      const u32x2* y0 = (const u32x2*)(a.Y + (size_t)(row * 2) * DM) + lane; const u32x2* y1 = y0 + DM / 4;
      f32x4 v[4]; float s = 0.f;
#pragma unroll
      for (int j = 0; j < 4; ++j) {
        { const u32x2 xx = x2r[64 * j]; v[j][0] = __uint_as_float(xx.x << 16); v[j][1] = __uint_as_float(xx.x & 0xffff0000u); v[j][2] = __uint_as_float(xx.y << 16); v[j][3] = __uint_as_float(xx.y & 0xffff0000u); }
        const u32x2 p = y0[64 * j], q = y1[64 * j];
        v[j][0] += __uint_as_float(p.x << 16) + __uint_as_float(q.x << 16); v[j][1] += __uint_as_float(p.x & 0xffff0000u) + __uint_as_float(q.x & 0xffff0000u);
        v[j][2] += __uint_as_float(p.y << 16) + __uint_as_float(q.y << 16); v[j][3] += __uint_as_float(p.y & 0xffff0000u) + __uint_as_float(q.y & 0xffff0000u);
        s += v[j][0] * v[j][0] + v[j][1] * v[j][1] + v[j][2] * v[j][2] + v[j][3] * v[j][3];
      }
      s = wave_sum(s);
      const float rs = rsqrtf(s * (1.f / DM) + EPS);
#pragma unroll
      for (int j = 0; j < 4; ++j) xr[64 * j] = v[j] * rs * ((const f32x4*)a.g_final)[lane + 64 * j];
    }
  }
}

extern "C" void kernel_launch(void* const* d_in, const int* in_sizes, int n_in, void* d_out, int out_size, void* d_ws, size_t ws_size, hipStream_t stream) {
  const float* x = (const float*)d_in[0];
  const float* mem = (const float*)d_in[1];
  const float* norm_mix = (const float*)d_in[2];
  const float* w_in = (const float*)d_in[3];
  const float* conv_qk = (const float*)d_in[4];
  const float* b_igate = (const float*)d_in[5];
  const float* b_fgate = (const float*)d_in[6];
  const float* mlstm_norm = (const float*)d_in[7];
  const float* cmp_pos_k = (const float*)d_in[8];
  const float* cmp_pos_v = (const float*)d_in[9];
  const float* cmp_k_w1 = (const float*)d_in[10];
  const float* cmp_k_w2 = (const float*)d_in[11];
  const float* cmp_v_w1 = (const float*)d_in[12];
  const float* cmp_v_w2 = (const float*)d_in[13];
  const float* w_br_mlstm = (const float*)d_in[14];
  const float* w_br_nsa = (const float*)d_in[15];
  const float* w_mix_out = (const float*)d_in[16];
  const float* norm_xattn = (const float*)d_in[17];
  const float* norm_mem = (const float*)d_in[18];
  const float* xa_wq = (const float*)d_in[19];
  const float* xa_wkv = (const float*)d_in[20];
  const float* xa_wo = (const float*)d_in[21];
  const float* norm_ffn = (const float*)d_in[22];
  const float* router_group_w = (const float*)d_in[23];
  const float* router_group_b = (const float*)d_in[24];
  const float* router_expert_w = (const float*)d_in[25];
  const float* router_expert_b = (const float*)d_in[26];
  const float* moe_w1 = (const float*)d_in[27];
  const float* moe_w3 = (const float*)d_in[28];
  const float* moe_w2 = (const float*)d_in[29];
  const float* norm_final = (const float*)d_in[30];
  float* out = (float*)d_out;
  char* ws = (char*)d_ws;

  int* CNT = (int*)(ws + WS_CNT); int* LIST = (int*)(ws + WS_LIST); float* RTW = (float*)(ws + WS_RTW);
  float* SM = (float*)(ws + WS_SM); float* BCUM = (float*)(ws + WS_BCUM); float* IP = (float*)(ws + WS_IP);
  float* BL = (float*)(ws + WS_BL); float* MX = (float*)(ws + WS_MX); float* MST = (float*)(ws + WS_MST); float* NST = (float*)(ws + WS_NST);
  bf16_t* KC = (bf16_t*)(ws + WS_KC); bf16_t* VC = (bf16_t*)(ws + WS_VC);
  bf16_t* QK = (bf16_t*)(ws + WS_QK); bf16_t* V = (bf16_t*)(ws + WS_V); bf16_t* O = (bf16_t*)(ws + WS_O);
  bf16_t* NQ = (bf16_t*)(ws + WS_NQ); bf16_t* KV = (bf16_t*)(ws + WS_KV); bf16_t* CST = (bf16_t*)(ws + WS_CST);
  bf16_t* AML = (bf16_t*)(ws + WS_AML); bf16_t* ANS = (bf16_t*)(ws + WS_ANS); bf16_t* MRG = (bf16_t*)(ws + WS_MRG);
  bf16_t* KVM = (bf16_t*)(ws + WS_KVM); bf16_t* MEMN = (bf16_t*)(ws + WS_MEMN);
  bf16_t* H2 = (bf16_t*)(ws + WS_H2); bf16_t* XQ = (bf16_t*)(ws + WS_XQ); bf16_t* XO = (bf16_t*)(ws + WS_XO);
  bf16_t* H3 = H2; bf16_t* ACT = XQ; bf16_t* Y = (bf16_t*)(ws + 136 * MiB);
  bf16_t* H = (bf16_t*)d_out;
  bf16_t* T2 = (bf16_t*)((char*)d_out + 32 * MiB);

  (void)hipMemsetAsync(ws, 0, 131072, stream);
  static int grid_blocks = 0;
  if (!grid_blocks) {
    int dev = 0, cus = 0, per_cu = 0;
    (void)hipGetDevice(&dev);
    (void)hipDeviceGetAttribute(&cus, hipDeviceAttributeMultiprocessorCount, dev);
    (void)hipFuncSetAttribute((const void*)k_mega, hipFuncAttributeMaxDynamicSharedMemorySize, TOTAL_LDS);
    (void)hipOccupancyMaxActiveBlocksPerMultiprocessor(&per_cu, (const void*)k_mega, 512, TOTAL_LDS);
    if (per_cu > 1) per_cu = 1;
    if (per_cu < 1) per_cu = 1;
    grid_blocks = cus * per_cu;
  }
  MegaArgs fa{};
  fa.x = x; fa.mem = mem; fa.out = out; fa.BAR = (unsigned*)(ws + 65536);
  fa.ml.conv = conv_qk; fa.ml.b_i = b_igate; fa.ml.b_f = b_fgate; fa.ml.gain = mlstm_norm;
  fa.ml.BCUM = BCUM; fa.ml.IP = IP; fa.ml.BL = BL; fa.ml.MX = MX; fa.ml.MST = MST; fa.ml.NST = NST; fa.ml.CST = CST;
  fa.XB = (bf16_t*)d_out; fa.MEMB = (bf16_t*)(ws + WS_MEMB); fa.RS1 = (float*)(ws + WS_RS1); fa.RSM = (float*)(ws + WS_RSM); fa.PS2 = (float*)(ws + WS_PS2);
  fa.QK = QK; fa.V = V; fa.O = O; fa.NQ = NQ; fa.SM = SM;
  fa.KVC = (bf16_t*)(ws + WS_KVC); fa.KS = (bf16_t*)(ws + WS_KS); fa.KW = (bf16_t*)(ws + WS_KW); fa.VST = (bf16_t*)(ws + WS_VST); fa.VWT = (bf16_t*)(ws + WS_VWT);
  fa.KC = KC; fa.VCT = VC; fa.CK1T = (bf16_t*)(ws + WS_CK1T); fa.CV1T = (bf16_t*)(ws + WS_CV1T); fa.POSW = (float*)(ws + WS_POSW);
  fa.posk = cmp_pos_k; fa.posv = cmp_pos_v; fa.ckw1 = cmp_k_w1; fa.cvw1 = cmp_v_w1; fa.ckw2 = cmp_k_w2; fa.cvw2 = cmp_v_w2;
  fa.AML = AML; fa.ANS = ANS; fa.MRG = MRG; fa.X1B = H2; fa.XQ = XQ; fa.XO = XO; fa.KVM = KVM;
  fa.WinT = (bf16_t*)(ws + WS_WIN_T); fa.WgT = (bf16_t*)(ws + WS_WG_T); fa.WmlT = (bf16_t*)(ws + WS_WML_T); fa.WnsT = (bf16_t*)(ws + WS_WNS_T);
  fa.H3 = H3; fa.ACT = ACT; fa.Y = Y; fa.W13T = (bf16_t*)(ws + 104 * MiB); fa.W2T = (bf16_t*)(ws + 240 * MiB);
  fa.CPART = (float*)(ws + 176 * MiB); fa.WQ = (int*)(ws + 256);
  fa.RS3 = (float*)(ws + WS_RSM + 8192); fa.RTW = RTW; fa.CNT = CNT; fa.LIST = LIST;
  fa.g_ffn = norm_ffn; fa.wg = router_group_w; fa.bg = router_group_b; fa.we = router_expert_w; fa.be = router_expert_b; fa.g_final = norm_final;
  fa.WoutT = (bf16_t*)(ws + WS_WOUT_T); fa.WqT = (bf16_t*)(ws + WS_WQ_T); fa.WkvT = (bf16_t*)(ws + WS_WKV_T); fa.WoT = (bf16_t*)(ws + WS_WO_T);
  {
    auto mk = [&](const float* src, bf16_t* dst, const float* gain, int ldw, int K, int c0, int ncols, int drow0) {
      TDesc d{}; d.src = src; d.dst = dst; d.gain = gain; d.ldw = ldw; d.K = K; d.c0 = c0; d.ncols = ncols; d.drow0 = drow0; d.per = (K / 64) * ((ncols + 63) / 64); d.nitems = d.per; d.mode = 0; d.rofs = 0; d.sstride = 0; d.dstride = 0; d.pad = 0; return d; };
    int n = 0;
    fa.td[n++] = mk(w_in, fa.WinT, norm_mix, DIN, DM, 0, 2048, 0);
    fa.td[n++] = mk(w_in, fa.WinT, norm_mix, DIN, DM, 2056, 512, 2048);
    fa.td[n++] = mk(w_in, fa.WinT, norm_mix, DIN, DM, 2568, 384, 2560);
    fa.td[n++] = mk(w_in, fa.WinT, norm_mix, DIN, DM, 3080, 128, 2944);
    fa.td[n++] = mk(w_in, fa.WinT, norm_mix, DIN, DM, 2952, 128, 3072);
    fa.td[n++] = mk(w_in, fa.WinT, norm_mix, DIN, DM, 3208, 128, 3200);
    fa.td[n++] = mk(w_in, fa.WinT, norm_mix, DIN, DM, 2048, 8, 3328);
    fa.td[n++] = mk(w_in, fa.WinT, norm_mix, DIN, DM, 3336, 24, 3336);
    fa.td[n++] = mk(w_in, fa.WgT, norm_mix, DIN, DM, 3360, 2048, 0);
    fa.td[n++] = mk(w_br_mlstm, fa.WmlT, nullptr, 1024, 512, 0, 1024, 0);
    fa.td[n++] = mk(w_br_nsa, fa.WnsT, nullptr, 1024, 512, 0, 1024, 0);
    fa.td[n++] = mk(w_mix_out, fa.WoutT, nullptr, 1024, 1024, 0, 1024, 0);
    fa.td[n++] = mk(xa_wq, fa.WqT, norm_xattn, 1024, 1024, 0, 1024, 0);
    fa.td[n++] = mk(xa_wkv, fa.WkvT, norm_mem, 2048, 1024, 0, 2048, 0);
    fa.td[n++] = mk(xa_wo, fa.WoT, nullptr, 1024, 1024, 0, 1024, 0);
    fa.td[n++] = mk(cmp_k_w1, fa.CK1T, nullptr, 128, 2048, 0, 128, 0);
    fa.td[n++] = mk(cmp_v_w1, fa.CV1T, nullptr, 128, 2048, 0, 128, 0);
    fa.ntdA = n;
    { TDesc d = mk(moe_w1, fa.W13T, norm_ffn, 512, 1024, 0, 512, 0); d.mode = 2; d.rofs = 0; d.nitems = 16 * d.per; d.sstride = 1024 * 512; d.dstride = 1024 * 1024; fa.td[n++] = d; }
    { TDesc d = mk(moe_w3, fa.W13T, norm_ffn, 512, 1024, 0, 512, 0); d.mode = 2; d.rofs = 16; d.nitems = 16 * d.per; d.sstride = 1024 * 512; d.dstride = 1024 * 1024; fa.td[n++] = d; }
    { TDesc d = mk(moe_w2, fa.W2T, nullptr, 1024, 512, 0, 1024, 0); d.nitems = 16 * d.per; d.sstride = 512 * 1024; d.dstride = 1024 * 512; fa.td[n++] = d; }
    fa.ntdB = n;
    int cum[25]; cum[0] = 0; for (int i = 0; i < n; ++i) cum[i + 1] = cum[i] + fa.td[i].nitems;
    for (int k = 0; k < 16; ++k) { fa.cv_lo[k] = 0; fa.cv_hi[k] = 0; }
    fa.cv_lo[0] = 0; fa.cv_hi[0] = cum[8];
    fa.cv_lo[1] = cum[8]; fa.cv_hi[1] = cum[fa.ntdA];
    { const int lo = cum[fa.ntdA], tot = cum[n] - lo; const int phs[5] = {5, 6, 7, 8, 9};
      for (int i = 0; i < 5; ++i) { fa.cv_lo[phs[i]] = lo + (int)((long long)tot * i / 5); fa.cv_hi[phs[i]] = lo + (int)((long long)tot * (i + 1) / 5); } }
  }
  int launch_i = 0;
  auto mega = [&](int lo, int hi) {
    fa.ph_lo = lo; fa.ph_hi = hi; fa.li = launch_i++; fa.pad = 0;
    for (int k = 0; k < 16; ++k) fa.rep[k] = 1;

    void* args[] = {&fa};
    (void)hipLaunchCooperativeKernel((const void*)k_mega, dim3(grid_blocks), dim3(512), args, TOTAL_LDS, stream);
  };
  mega(0, 14);
}
```

```cpp
#include <hip/hip_runtime.h>
#include <stdint.h>

typedef unsigned short bf16_t;
__device__ __forceinline__ float bf2f(bf16_t v) { return __uint_as_float(((unsigned)v) << 16); }
__device__ __forceinline__ bf16_t f2bf(float f) { unsigned u = __float_as_uint(f); return (bf16_t)((u + 0x7fffu + ((u >> 16) & 1u)) >> 16); }

constexpr int NB = 4, SEQ = 4096, NTOK = NB * SEQ, DM = 1024;
constexpr int DIN = 5408, DIN_A = 3360;
constexpr int MEMT = 256;
constexpr float EPS = 1e-6f;
constexpr size_t MiB = 1u << 20;

constexpr size_t WS_CNT = 0;
constexpr size_t WS_LIST = 1 * MiB;
constexpr size_t WS_RTW = 2 * MiB;
constexpr size_t WS_SM = 3 * MiB;
constexpr size_t WS_BCUM = 5 * MiB;
constexpr size_t WS_IP = 5 * MiB + 256 * 1024;
constexpr size_t WS_BL = 5 * MiB + 512 * 1024;
constexpr size_t WS_MX = WS_BL + 4096;
constexpr size_t WS_MST = WS_MX + 4096;
constexpr size_t WS_NST = 6 * MiB;
constexpr size_t WS_KC = 7 * MiB;
constexpr size_t WS_VC = 7 * MiB + 512 * 1024;
constexpr size_t WS_QK = 8 * MiB;
constexpr size_t WS_V = 40 * MiB;
constexpr size_t WS_O = 56 * MiB;
constexpr size_t WS_NQ = 72 * MiB;
constexpr size_t WS_KV = 88 * MiB;
constexpr size_t WS_CST = 112 * MiB;
constexpr size_t WS_AML = 144 * MiB;
constexpr size_t WS_ANS = 160 * MiB;
constexpr size_t WS_MRG = 176 * MiB;
constexpr size_t WS_KVM = 233 * MiB;
constexpr size_t WS_MEMN = 237 * MiB;
constexpr size_t WS_H2 = 8 * MiB;
constexpr size_t WS_XQ = 40 * MiB;
constexpr size_t WS_XO = 72 * MiB;
constexpr size_t WS_Y = 72 * MiB;

__device__ __forceinline__ float wave_sum(float v) {
#pragma unroll
  for (int o = 32; o > 0; o >>= 1) v += __shfl_xor(v, o);
  return v;
}
__device__ __forceinline__ float wave_max(float v) {
#pragma unroll
  for (int o = 32; o > 0; o >>= 1) v = fmaxf(v, __shfl_xor(v, o));
  return v;
}
__device__ __forceinline__ float sigmoidf_(float x) { return 1.f / (1.f + __expf(-x)); }
__device__ __forceinline__ float siluf_(float x) { return x / (1.f + __expf(-x)); }
__device__ __forceinline__ float logsigmoidf_(float x) { return fminf(x, 0.f) - log1pf(__expf(-fabsf(x))); }
__device__ __forceinline__ float gelu_tanh(float x) { float u = 0.7978845608028654f * (x + 0.044715f * x * x * x); return 0.5f * x * (1.f + tanhf(u)); }

#include <hip/hip_cooperative_groups.h>
namespace cg = cooperative_groups;
#define LAS __attribute__((address_space(3)))
typedef short bf16x8 __attribute__((ext_vector_type(8)));
typedef float f32x4 __attribute__((ext_vector_type(4)));
typedef unsigned u32x2 __attribute__((ext_vector_type(2)));
typedef unsigned u32x4 __attribute__((ext_vector_type(4)));

constexpr size_t WS_RS1 = 5 * MiB + 768 * 1024;
constexpr size_t WS_RSM = WS_RS1 + 65536;
constexpr size_t WS_PS2 = 4 * MiB;
constexpr size_t WS_WIN_T = 208 * MiB;
constexpr size_t WS_WG_T = 216 * MiB;
constexpr size_t WS_WML_T = 220 * MiB;
constexpr size_t WS_WNS_T = 221 * MiB;
constexpr size_t WS_WOUT_T = 222 * MiB;
constexpr size_t WS_WQ_T = 224 * MiB;
constexpr size_t WS_WKV_T = 226 * MiB;
constexpr size_t WS_WO_T = 230 * MiB;
constexpr size_t WS_MEMB = 238 * MiB;
constexpr size_t WS_KVC = WS_KV;
constexpr size_t WS_KS = WS_KV + 8 * MiB;
constexpr size_t WS_KW = WS_KV + 12 * MiB;
constexpr size_t WS_VST = WS_KV + 16 * MiB;
constexpr size_t WS_VWT = WS_KV + 20 * MiB;
constexpr size_t WS_CK1T = 232 * MiB;
constexpr size_t WS_CV1T = 232 * MiB + 512 * 1024;
constexpr size_t WS_POSW = WS_RSM + 8192 + 65536;
constexpr int NIN = 3584;

__device__ __forceinline__ unsigned pk2bf(float lo, float hi) { return (unsigned)f2bf(lo) | ((unsigned)f2bf(hi) << 16); }
__device__ __forceinline__ void st_bf4(bf16_t* p, f32x4 v) { u32x2 o; o.x = pk2bf(v[0], v[1]); o.y = pk2bf(v[2], v[3]); *(u32x2*)p = o; }

struct TDesc { const float* src; bf16_t* dst; const float* gain; int ldw, K, c0, ncols, drow0, nitems, mode, rofs, per, sstride, dstride, pad; };
__device__ __forceinline__ void transpose_item(const TDesc& d, int item, float* t  , int tid) {
  const int bat = item / d.per; item -= bat * d.per;
  const float* src = d.src + (size_t)bat * d.sstride; bf16_t* dst = d.dst + (size_t)bat * d.dstride;
  const int ncb = (d.ncols + 63) >> 6; const int kb = item / ncb, cb = item % ncb; const int k0 = kb * 64, n0 = cb * 64;
  {
    const int c4 = (tid & 15) * 4, kq = tid >> 4;
    f32x4 v[4];
#pragma unroll
    for (int p = 0; p < 4; ++p) {
      const int kk = p * 16 + kq;
      v[p] = (n0 + c4 < d.ncols) ? *(const f32x4*)(src + (size_t)(k0 + kk) * d.ldw + d.c0 + n0 + c4) : (f32x4){0.f, 0.f, 0.f, 0.f};
    }
#pragma unroll
    for (int p = 0; p < 4; ++p) {
      const int kk = p * 16 + kq; const float g = d.gain ? d.gain[k0 + kk] : 1.f;
      float* tp = t + kk * 65 + c4; tp[0] = v[p][0] * g; tp[1] = v[p][1] * g; tp[2] = v[p][2] * g; tp[3] = v[p][3] * g;
    }
  }
  __syncthreads();
#pragma unroll
  for (int j = 0; j < 2; ++j) {
    int c = tid + j * 256; int n = c >> 3, kc = c & 7;
    if (n0 + n < d.ncols) {
      const float* p = t + (kc * 8) * 65 + n;
      u32x4 o; o.x = pk2bf(p[0], p[65]); o.y = pk2bf(p[130], p[195]); o.z = pk2bf(p[260], p[325]); o.w = pk2bf(p[390], p[455]);
      const int drow = d.mode == 2 ? (d.drow0 + (cb * 4 + (n >> 4)) * 32 + (n & 15) + d.rofs) : d.mode ? (d.drow0 + cb * 128 + (n >> 5) * 64 + (n & 31) + d.rofs) : (d.drow0 + n0 + n);
      *(u32x4*)(dst + (size_t)drow * d.K + k0 + kc * 8) = o;
    }
  }
  __syncthreads();
}

__device__ __forceinline__ void rows_to_bf16(const float* __restrict__ src, bf16_t* __restrict__ dst, float* __restrict__ rs, int nrows, int gw, int ngw, int lane) {
  for (int row = gw; row < nrows; row += ngw) {
    const f32x4* xr = (const f32x4*)(src + (size_t)row * DM) + lane;
    f32x4 v[4]; float s = 0.f;
#pragma unroll
    for (int j = 0; j < 4; ++j) { v[j] = xr[64 * j]; s += v[j][0] * v[j][0] + v[j][1] * v[j][1] + v[j][2] * v[j][2] + v[j][3] * v[j][3]; }
    s = wave_sum(s);
    if (lane == 0) rs[row] = rsqrtf(s * (1.f / DM) + EPS);
#pragma unroll
    for (int j = 0; j < 4; ++j) st_bf4(dst + (size_t)row * DM + (lane + 64 * j) * 4, v[j]);
  }
}

__device__ __forceinline__ void glds16(const void* g, char* l) {
  __builtin_amdgcn_global_load_lds((const unsigned*)g, (LAS unsigned*)l, 16, 0, 0);
}
__device__ __forceinline__ int st_row(int tid, int i) { return (tid >> 3) + 32 * i; }
__device__ __forceinline__ int st_lc(int tid, int i) { return (tid & 7) ^ ((st_row(tid, i) >> 1) & 7); }
__device__ __forceinline__ void gemm_core(f32x4 (&acc)[4][4], const bf16_t* __restrict__ A, const unsigned (&ao)[4], unsigned ksa,
                                          const bf16_t* __restrict__ Bt, const unsigned (&bo)[4], unsigned ksb, int nt, char* lds, int tid) {
  const int lane = tid & 63, wid = tid >> 6, wr = wid >> 1, wc = wid & 1, fr = lane & 15, fq = lane >> 4;
  char* ldst = lds + tid * 16;
#pragma unroll
  for (int i = 0; i < 4; ++i) { glds16(A + ao[i], ldst + i * 4096); glds16(Bt + bo[i], ldst + 16384 + i * 4096); }
  const int sw = fr >> 1;
  const int aoff = (wr * 64 + fr) * 128, boff = (wc * 64 + fr) * 128;
  for (int t = 0; t < nt; ++t) {
    asm volatile("s_waitcnt vmcnt(0)" ::: "memory");
    __syncthreads();
    const int cur = t & 1;
    if (t + 1 < nt) {
      char* nb = ldst + (cur ^ 1) * 32768; const unsigned ka = (t + 1) * ksa, kb = (t + 1) * ksb;
#pragma unroll
      for (int i = 0; i < 4; ++i) { glds16(A + (ao[i] + ka), nb + i * 4096); glds16(Bt + (bo[i] + kb), nb + 16384 + i * 4096); }
    }
    const char* sA = lds + cur * 32768 + aoff; const char* sB = lds + cur * 32768 + 16384 + boff;
#pragma unroll
    for (int ks = 0; ks < 2; ++ks) {
      bf16x8 a[4], b[4];
      const int co = ((ks * 4 + fq) ^ sw) << 4;
#pragma unroll
      for (int i = 0; i < 4; ++i) { a[i] = *(const bf16x8*)(sA + i * 2048 + co); b[i] = *(const bf16x8*)(sB + i * 2048 + co); }
#pragma unroll
      for (int i = 0; i < 4; ++i)
#pragma unroll
        for (int j = 0; j < 4; ++j) acc[i][j] = __builtin_amdgcn_mfma_f32_16x16x32_bf16(b[j], a[i], acc[i][j], 0, 0, 0);
    }
  }
  __syncthreads();
}
__device__ __forceinline__ void gemm_acc(f32x4 (&acc)[4][4], const bf16_t* __restrict__ A, size_t lda, const int* __restrict__ arow, int ashift, int mvalid,
                                         const bf16_t* __restrict__ Bt, size_t ldb, int K, char* lds, int m0, int n0, int tid) {
  asm volatile("" : "+v"(tid));
  unsigned ao[4], bo[4];
#pragma unroll
  for (int i = 0; i < 4; ++i) {
    const int row = st_row(tid, i), lc = st_lc(tid, i);
    int gr;
    if (arow) { int mm = m0 + row; if (mm >= mvalid) mm = mvalid - 1; gr = arow[mm] >> ashift; } else gr = m0 + row;
    ao[i] = (unsigned)gr * (unsigned)lda + lc * 8;
    bo[i] = (unsigned)(n0 + row) * (unsigned)ldb + lc * 8;
  }
  gemm_core(acc, A, ao, 64u, Bt, bo, 64u, K >> 6, lds, tid);
}
__device__ __forceinline__ void zero_acc(f32x4 (&acc)[4][4]) {
#pragma unroll
  for (int i = 0; i < 4; ++i)
#pragma unroll
    for (int j = 0; j < 4; ++j) acc[i][j] = (f32x4){0.f, 0.f, 0.f, 0.f};
}


namespace pg8 {
#define PG8_LAS __attribute__((address_space(3)))
typedef unsigned short bf16_t;
typedef short bf16x8 __attribute__((ext_vector_type(8)));
typedef float f32x4 __attribute__((ext_vector_type(4)));
typedef unsigned u32x4 __attribute__((ext_vector_type(4)));
constexpr int BM = 256, BK = 64, HALF = 128, HTB = HALF * BK * 2  , STAGE_BYTES = 8 * HTB, NXCD = 8, WGM = 8;

__host__ __device__ __forceinline__ int lds_byte(int r, int c) { const int st = (r >> 4) * 2 + (c >> 5), rr = r & 15, cc = c & 31, ob = rr * 64 + cc * 2; return st * 1024 + (ob ^ (((ob >> 9) & 1) << 5)); }
__host__ __device__ __forceinline__ void stage_rc(int b, int& R, int& C) { const int st = b / 1024, sb = b % 1024, swz = sb ^ (((sb >> 9) & 1) << 5); R = (st >> 1) * 16 + swz / 64; C = (st & 1) * 32 + (swz % 64) / 2; }
__host__ __device__ __forceinline__ int perm32(int rho) { const int n = rho >> 4, i = rho & 15; return 8 * (i >> 2) + 4 * n + (i & 3); }

struct Unit { int pm, pn; const char* aptr; const char* bptr; int e, ce, p0, rt; };
struct Gemm { int K; };
template <class Epi, class Sched, bool ALIGN_EPI = false, bool SP2 = false>
__device__ __forceinline__ void gemm_phase(PG8_LAS unsigned char* lds, const Gemm g, const Sched& S, const Epi& E, int tid  , int wid  ) {
    asm volatile("" : "+v"(tid));
    const int lane = tid & 63, wr = wid >> 2, wc = wid & 3, fr = lane & 15, fq = lane >> 4;
    const int K = g.K, nt = K / BK;
    unsigned voffA[2], voffB[2];
#pragma unroll
    for (int i = 0; i < 2; ++i) { int R, C; stage_rc(tid * 16 + i * 8192, R, C); const int Rb = Epi::PERM ? ((R & ~31) + perm32(R & 31)) : R;
        voffA[i] = (unsigned)(R * K + C) * 2u; voffB[i] = (unsigned)(Rb * K + C) * 2u; }
    unsigned cva0[2], cva1[2], nva0[2], nva1[2];
    const size_t kstep = (size_t)(BK * 2);
    const size_t hstep = (size_t)HALF * K * 2;
    const unsigned ldsw = (unsigned)wid * 1024u;
    const int aoff = lds_byte(wr * 64 + fr, fq * 8), boff = lds_byte(wc * 32 + fr, fq * 8);
#define PG8_SA(b, h) (((b) * 2 + (h)) * HTB)
#define PG8_SB(b, h) ((4 + (b) * 2 + (h)) * HTB)
#define PG8_STAGE(bufoff, gbase, voff) do { _Pragma("unroll") for (int _i = 0; _i < 2; ++_i) \
        __builtin_amdgcn_global_load_lds((const unsigned*)((const char*)(gbase) + (voff)[_i]), (PG8_LAS unsigned*)(lds + (bufoff) + ldsw + _i * 8192), 16, 0, 0); } while (0)
#define PG8_LDA(dst, b, h) do { _Pragma("unroll") for (int m = 0; m < 4; ++m) _Pragma("unroll") for (int k = 0; k < 2; ++k) dst[m][k] = *(const PG8_LAS bf16x8*)(lds + PG8_SA(b, h) + aoff + m * 2048 + k * 1024); } while (0)
#define PG8_LDB(dst, b, h) do { _Pragma("unroll") for (int n = 0; n < 2; ++n) _Pragma("unroll") for (int k = 0; k < 2; ++k) dst[n][k] = *(const PG8_LAS bf16x8*)(lds + PG8_SB(b, h) + boff + n * 2048 + k * 1024); } while (0)
#define PG8_MMA(ai, bj, At, Bt) do { __builtin_amdgcn_s_setprio(1); _Pragma("unroll") for (int m = 0; m < 4; ++m) _Pragma("unroll") for (int n = 0; n < 2; ++n) _Pragma("unroll") for (int k = 0; k < 2; ++k) \
        acc[ai][bj][m][n] = __builtin_amdgcn_mfma_f32_16x16x32_bf16(Bt[n][k], At[m][k], acc[ai][bj][m][n], 0, 0, 0); __builtin_amdgcn_s_setprio(0); } while (0)
#define PG8_WAIT_V(n) asm volatile("s_waitcnt vmcnt(" #n ")" ::: "memory")
#define PG8_WAIT_L(n) asm volatile("s_waitcnt lgkmcnt(" #n ")" ::: "memory")
#define PG8_BAR __builtin_amdgcn_s_barrier()
#define PG8_SCHED __builtin_amdgcn_sched_barrier(0)
    Unit cur, nxt; int ui = 0;
    if (!S.next(0, cur)) return;
    S.avoff(cur, tid, K, voffA, cva0, cva1);
    f32x4 acc[2][2][4][2];
#pragma unroll
    for (int a = 0; a < 2; ++a)
#pragma unroll
        for (int b = 0; b < 2; ++b)
#pragma unroll
            for (int m = 0; m < 4; ++m)
#pragma unroll
                for (int n = 0; n < 2; ++n) acc[a][b][m][n] = (f32x4){0.f, 0.f, 0.f, 0.f};
    bf16x8 At[4][2], B0[2][2], B1[2][2];
    const char* cA = cur.aptr; const char* cB = cur.bptr;
    S.a_ready(cur);
    if constexpr (SP2) {
        PG8_STAGE(PG8_SB(0, 0), cB, voffB); PG8_STAGE(PG8_SB(0, 1), cB + hstep, voffB); PG8_STAGE(PG8_SA(0, 0), cA, cva0); PG8_STAGE(PG8_SA(0, 1), cA, cva1);
        if (wr == 1) PG8_BAR;
        PG8_WAIT_V(2); PG8_BAR;
        PG8_STAGE(PG8_SB(1, 0), cB + kstep, voffB); PG8_STAGE(PG8_SA(1, 0), cA + kstep, cva0); PG8_STAGE(PG8_SB(1, 1), cB + hstep + kstep, voffB);
        PG8_WAIT_V(6); PG8_BAR;
    } else {
        PG8_STAGE(PG8_SB(0, 0), cB, voffB); PG8_STAGE(PG8_SA(0, 0), cA, cva0); PG8_STAGE(PG8_SB(0, 1), cB + hstep, voffB); PG8_STAGE(PG8_SA(0, 1), cA, cva1);
        if (wr == 1) PG8_BAR;
        PG8_WAIT_V(4); PG8_BAR;
        PG8_STAGE(PG8_SB(1, 0), cB + kstep, voffB); PG8_STAGE(PG8_SA(1, 0), cA + kstep, cva0); PG8_STAGE(PG8_SB(1, 1), cB + hstep + kstep, voffB);
        PG8_WAIT_V(6); PG8_BAR;
    }
    for (;;) {
        const bool has_next = S.next(ui + 1, nxt);
        if (has_next) S.avoff(nxt, tid, K, voffA, nva0, nva1); else { nva0[0] = cva0[0]; nva0[1] = cva0[1]; nva1[0] = cva1[0]; nva1[1] = cva1[1]; }
        const char* nA = has_next ? nxt.aptr : cA; const char* nB = has_next ? nxt.bptr : cB;
        for (int t = 0; t < nt; t += 2) {
            const bool last = (t == nt - 2);
            const char* a1 = cA + (size_t)(t + 1) * kstep;
            const char* a2 = last ? nA : cA + (size_t)(t + 2) * kstep; const char* b2 = last ? nB : cB + (size_t)(t + 2) * kstep;
            const char* a3 = a2 + kstep; const char* b3 = b2 + kstep;
            const unsigned xva0[2] = {last ? nva0[0] : cva0[0], last ? nva0[1] : cva0[1]}, xva1[2] = {last ? nva1[0] : cva1[0], last ? nva1[1] : cva1[1]};
            if (last && has_next) S.a_ready(nxt);
            if constexpr (SP2) {
            PG8_LDB(B0, 0, 0); PG8_LDB(B1, 0, 1); PG8_SCHED; PG8_LDA(At, 0, 0); PG8_STAGE(PG8_SA(1, 1), a1, cva1);
            PG8_WAIT_V(8); PG8_WAIT_L(0); PG8_BAR; PG8_MMA(0, 0, At, B0); PG8_MMA(0, 1, At, B1); PG8_BAR; PG8_SCHED;
            PG8_LDA(At, 0, 1); PG8_STAGE(PG8_SB(0, 0), b2, voffB); PG8_STAGE(PG8_SB(0, 1), b2 + hstep, voffB); PG8_STAGE(PG8_SA(0, 0), a2, xva0);
            PG8_WAIT_V(8); PG8_WAIT_L(0); PG8_BAR; PG8_MMA(1, 0, At, B0); PG8_MMA(1, 1, At, B1); PG8_BAR; PG8_SCHED;
            PG8_LDB(B0, 1, 0); PG8_LDB(B1, 1, 1); PG8_SCHED; PG8_LDA(At, 1, 0); PG8_STAGE(PG8_SA(0, 1), a2, xva1);
            PG8_WAIT_V(8); PG8_WAIT_L(0); PG8_BAR; PG8_MMA(0, 0, At, B0); PG8_MMA(0, 1, At, B1); PG8_BAR; PG8_SCHED;
            PG8_LDA(At, 1, 1); PG8_STAGE(PG8_SB(1, 0), b3, voffB); PG8_STAGE(PG8_SB(1, 1), b3 + hstep, voffB); PG8_STAGE(PG8_SA(1, 0), a3, xva0);
            PG8_WAIT_V(8); PG8_WAIT_L(0); PG8_BAR; PG8_MMA(1, 0, At, B0); PG8_MMA(1, 1, At, B1); PG8_BAR; PG8_SCHED;
            } else {
            PG8_LDB(B0, 0, 0); PG8_SCHED; PG8_LDA(At, 0, 0); PG8_STAGE(PG8_SA(1, 1), a1, cva1);
            PG8_WAIT_L(8); PG8_BAR; PG8_WAIT_L(0); PG8_MMA(0, 0, At, B0); PG8_BAR; PG8_SCHED;
            PG8_LDB(B1, 0, 1); PG8_STAGE(PG8_SB(0, 0), b2, voffB);
            PG8_BAR; PG8_WAIT_L(0); PG8_MMA(0, 1, At, B1); PG8_BAR;
            PG8_LDA(At, 0, 1); PG8_STAGE(PG8_SA(0, 0), a2, xva0);
            PG8_BAR; PG8_WAIT_L(0); PG8_MMA(1, 0, At, B0); PG8_BAR; PG8_SCHED;
            PG8_STAGE(PG8_SB(0, 1), b2 + hstep, voffB);
            PG8_WAIT_V(6); PG8_BAR; PG8_MMA(1, 1, At, B1); PG8_BAR;
            PG8_LDB(B0, 1, 0); PG8_SCHED; PG8_LDA(At, 1, 0); PG8_STAGE(PG8_SA(0, 1), a2, xva1);
            PG8_WAIT_L(8); PG8_BAR; PG8_WAIT_L(0); PG8_MMA(0, 0, At, B0); PG8_BAR; PG8_SCHED;
            PG8_LDB(B1, 1, 1); PG8_STAGE(PG8_SB(1, 0), b3, voffB);
            PG8_BAR; PG8_WAIT_L(0); PG8_MMA(0, 1, At, B1); PG8_BAR;
            PG8_LDA(At, 1, 1); PG8_STAGE(PG8_SA(1, 0), a3, xva0);
            PG8_BAR; PG8_WAIT_L(0); PG8_MMA(1, 0, At, B0); PG8_BAR; PG8_SCHED;
            PG8_STAGE(PG8_SB(1, 1), b3 + hstep, voffB);
            PG8_WAIT_V(6); PG8_BAR; PG8_MMA(1, 1, At, B1); PG8_BAR;
            }
        }
        if constexpr (ALIGN_EPI) { if (wr == 0) PG8_BAR; }
        if constexpr (!Epi::AFTER_DRAIN) { E(acc, cur, wr, wc, fr, fq); S.done(cur); }
        if (!has_next) break;
#pragma unroll
        for (int a = 0; a < 2; ++a)
#pragma unroll
            for (int b = 0; b < 2; ++b)
#pragma unroll
                for (int m = 0; m < 4; ++m)
#pragma unroll
                    for (int n = 0; n < 2; ++n) acc[a][b][m][n] = (f32x4){0.f, 0.f, 0.f, 0.f};
        cur = nxt; cA = nA; cB = nB; ++ui; cva0[0] = nva0[0]; cva0[1] = nva0[1]; cva1[0] = nva1[0]; cva1[1] = nva1[1];
        if constexpr (ALIGN_EPI) { if (wr == 1) PG8_BAR; }
    }
    PG8_WAIT_V(0);
    if constexpr (!ALIGN_EPI) { if (wr == 0) PG8_BAR; }
    PG8_BAR;
    if constexpr (Epi::AFTER_DRAIN) { E.fused(acc, cur, wr, wc, fr, fq, lds, wid, lane); S.done(cur); }
#undef PG8_SA
#undef PG8_SB
#undef PG8_STAGE
#undef PG8_LDA
#undef PG8_LDB
#undef PG8_MMA
#undef PG8_WAIT_V
#undef PG8_WAIT_L
#undef PG8_BAR
#undef PG8_SCHED
}
}

#define TILE8_IDS unsigned t8_z = 0u; asm volatile("" : "+v"(t8_z)); int t512 = wave_s * 64 + (int)__builtin_amdgcn_mbcnt_hi(~0u, __builtin_amdgcn_mbcnt_lo(~0u, t8_z)); asm volatile("" : "+v"(t512))
template <class Map> struct ListSched {
  int first, stride, count; Map map;
  __device__ __forceinline__ bool next(int i, pg8::Unit& u) const { const int idx = first + i * stride; if (idx >= count) return false; map(idx, u); return true; }
  __device__ __forceinline__ void avoff(const pg8::Unit& u, int tid, int K, const unsigned (&voffA)[2], unsigned (&v0)[2], unsigned (&v1)[2]) const { map.avoff(u, tid, K, voffA, v0, v1); }
  __device__ __forceinline__ void a_ready(const pg8::Unit&) const {}
  __device__ __forceinline__ void done(const pg8::Unit&) const {}
};
struct MlArgs { const float *conv, *b_i, *b_f, *gain; float *BCUM, *IP, *BL, *MX, *MST, *NST; bf16_t* CST; };
struct MegaArgs {
  const float* x; const float* mem; float* out;
  bf16_t *XB, *MEMB; float *RS1, *RSM, *PS2;
  bf16_t *QK, *V, *O, *NQ, *KVC, *KS, *KW, *VST, *VWT, *KC, *VCT, *CK1T, *CV1T; float *SM, *POSW;
  const float *posk, *posv, *ckw1, *cvw1, *ckw2, *cvw2;
  bf16_t *AML, *ANS, *MRG, *X1B, *XQ, *XO, *KVM;
  bf16_t *WinT, *WgT, *WmlT, *WnsT, *WoutT, *WqT, *WkvT, *WoT;
  bf16_t *H3, *ACT, *Y, *W13T, *W2T; float *RS3, *RTW; int *CNT, *LIST;
  const float *g_ffn, *wg, *bg, *we, *be, *g_final;
  unsigned* BAR;
  MlArgs ml;
  float* CPART; int* WQ;
  TDesc td[24]; int ntdA, ntdB; int ph_lo, ph_hi, li, pad; int rep[16]; int cv_lo[16], cv_hi[16];
};


constexpr int NSA_LDS = 66112;
constexpr int MEGA_LDS = 73728;
constexpr int HALF_LDS = 73728, CTRL_OFF = 2 * HALF_LDS, TOTAL_LDS = CTRL_OFF + 64;
typedef unsigned long long u64;

template <bool WITH_V>
__device__ __forceinline__ void nsa_load_tile(const bf16_t* __restrict__ Ksrc, unsigned kstride, const bf16_t* __restrict__ Vsrc, unsigned vstride, char* lds, int tid) {
#pragma unroll
  for (int i = 0; i < 2; ++i) {
    const int idx = tid + 256 * i, row = idx >> 3, lc = (idx & 7) ^ ((row >> 1) & 7);
    glds16(Ksrc + (size_t)row * kstride + lc * 8, lds + idx * 16);
    if (WITH_V) glds16(Vsrc + (size_t)row * vstride + lc * 8, lds + 8192 + idx * 16);
  }
}

__device__ __forceinline__ void nsa_qk(f32x4 (&sacc)[4][2], const bf16x8 (&qf)[4][2], const char* lds, int hf, int fr, int fq) {
#pragma unroll
  for (int mi = 0; mi < 4; ++mi)
#pragma unroll
    for (int ni = 0; ni < 2; ++ni) sacc[mi][ni] = (f32x4){0.f, 0.f, 0.f, 0.f};
#pragma unroll
  for (int ks = 0; ks < 2; ++ks) {
    bf16x8 kf[2];
    const int co = ((ks * 4 + fq) ^ (fr >> 1)) << 4;
#pragma unroll
    for (int ni = 0; ni < 2; ++ni) kf[ni] = *(const bf16x8*)(lds + ((hf * 2 + ni) * 16 + fr) * 128 + co);
#pragma unroll
    for (int mi = 0; mi < 4; ++mi)
#pragma unroll
      for (int ni = 0; ni < 2; ++ni) sacc[mi][ni] = __builtin_amdgcn_mfma_f32_16x16x32_bf16(kf[ni], qf[mi][ks], sacc[mi][ni], 0, 0, 0);
  }
}
__device__ __forceinline__ void nsa_pv(f32x4 (&oacc)[4][4], const f32x4 (&p)[4][2], char* lds, char* pw, int hf, int fr, int fq) {
#pragma unroll
  for (int mi = 0; mi < 4; ++mi)
#pragma unroll
    for (int ni = 0; ni < 2; ++ni) {
      u32x2 o; o.x = pk2bf(p[mi][ni][0], p[mi][ni][1]); o.y = pk2bf(p[mi][ni][2], p[mi][ni][3]);
      *(u32x2*)(pw + (mi * 16 + fr) * 128 + ((((hf * 2 + ni) * 2 + (fq >> 1)) ^ (fr >> 1)) << 4) + (fq & 1) * 8) = o;
    }
  bf16x8 pf[4], vf[4];
  const int co = ((hf * 4 + fq) ^ (fr >> 1)) << 4;
#pragma unroll
  for (int i = 0; i < 4; ++i) { pf[i] = *(const bf16x8*)(pw + (i * 16 + fr) * 128 + co); vf[i] = *(const bf16x8*)(lds + 8192 + (i * 16 + fr) * 128 + co); }
#pragma unroll
  for (int mi = 0; mi < 4; ++mi)
#pragma unroll
    for (int ni = 0; ni < 4; ++ni) oacc[mi][ni] = __builtin_amdgcn_mfma_f32_16x16x32_bf16(vf[ni], pf[mi], oacc[mi][ni], 0, 0, 0);
}
__device__ __forceinline__ float red4(float v) { v += __shfl_xor(v, 16); v += __shfl_xor(v, 32); return v; }
__device__ __forceinline__ float max4(float v) { v = fmaxf(v, __shfl_xor(v, 16)); v = fmaxf(v, __shfl_xor(v, 32)); return v; }

__device__ __forceinline__ void nsa_online(f32x4 (&sv)[4][2], float (&m_run)[4], float (&l_run)[4], f32x4 (&oacc)[4][4]) {
#pragma unroll
  for (int mi = 0; mi < 4; ++mi) {
    float mx = fmaxf(fmaxf(fmaxf(sv[mi][0][0], sv[mi][0][1]), fmaxf(sv[mi][0][2], sv[mi][0][3])), fmaxf(fmaxf(sv[mi][1][0], sv[mi][1][1]), fmaxf(sv[mi][1][2], sv[mi][1][3])));
    mx = max4(mx);
    if (__any(mx > m_run[mi] + 8.f)) {
      const float mn = fmaxf(fmaxf(m_run[mi], mx), -1e20f);
      const float alpha = __builtin_amdgcn_exp2f(m_run[mi] - mn);
      m_run[mi] = mn; l_run[mi] *= alpha;
#pragma unroll
      for (int ni = 0; ni < 4; ++ni) oacc[mi][ni] *= alpha;
    }
    float ls = 0.f;
#pragma unroll
    for (int ni = 0; ni < 2; ++ni)
#pragma unroll
      for (int j = 0; j < 4; ++j) { const float pv = __builtin_amdgcn_exp2f(sv[mi][ni][j] - m_run[mi]); sv[mi][ni][j] = pv; ls += pv; }
    l_run[mi] += ls;
  }
}

__device__ __forceinline__ void nsa_main_item(const MegaArgs& a, int item, char* lds, int tid, volatile int* xch, int half) {
  asm volatile("" : "+v"(tid));
  const int lane = tid & 63, wid = tid >> 6, fr = lane & 15, fq = lane >> 4;
  const int i = item & 63, g = (item >> 6) & 1, b = item >> 7;
  const int h = g * 4 + wid, nb = b * SEQ, t0 = i * 64, bg = b * 2 + g;
  const float slope = exp2f(-(float)(h + 1)) * 1.4426950408889634f;
  char* pw = lds + 16384 + wid * 8192;
  float* PSLC = (float*)(lds + 49152);
  u64* SELM = (u64*)(lds + 65536);
  u64* UNI = (u64*)(lds + 66048);
  bf16x8 qf[4][2];
#pragma unroll
  for (int mi = 0; mi < 4; ++mi)
#pragma unroll
    for (int ks = 0; ks < 2; ++ks) qf[mi][ks] = *(const bf16x8*)(a.NQ + (size_t)(nb + t0 + wid * 16 + fr) * 512 + (g * 4 + mi) * 64 + ks * 32 + fq * 8);
  for (int e = tid; e < 4096; e += 256) PSLC[e] = 0.f;
  f32x4 sacc[4][2], oacc[4][4];
  float m_run[4], l_run[4];
  const int nct = ((4 * i + 2) >> 6) + 1;
  const bf16_t* kcb = a.KC + (size_t)bg * 256 * 64;
  const bf16_t* vcb = a.VCT + (size_t)bg * 64 * 256;
  const int tc = t0 + wid * 16 + fr;
  const float slope0 = exp2f(-(float)(g * 4 + 1)) * 1.4426950408889634f;
#pragma unroll
  for (int mi = 0; mi < 4; ++mi) { m_run[mi] = -1e30f; l_run[mi] = 0.f; }
  __syncthreads();
  nsa_load_tile<false>(kcb, 64u, nullptr, 0u, lds, tid);
  for (int jt = 0; jt < nct; ++jt) {
    asm volatile("s_waitcnt vmcnt(0)" ::: "memory");
    __syncthreads();
    char* tb = (jt & 1) ? (lds + 16384) : lds;
    if (jt + 1 < nct) nsa_load_tile<false>(kcb + (size_t)(jt + 1) * 64 * 64, 64u, nullptr, 0u, (jt & 1) ? lds : (lds + 16384), tid);
#pragma unroll 1
    for (int hf = 0; hf < 2; ++hf) {
      nsa_qk(sacc, qf, tb, hf, fr, fq);
#pragma unroll
      for (int mi = 0; mi < 4; ++mi) {
        const float slope = slope0 * (1.f / (float)(1 << mi)); float mx = -1e30f;
#pragma unroll
        for (int ni = 0; ni < 2; ++ni)
#pragma unroll
          for (int j = 0; j < 4; ++j) {
            const int jj = jt * 64 + hf * 32 + ni * 16 + 4 * fq + j; const bool ok = (16 * jj + 31 <= tc);
            const float v = sacc[mi][ni][j] - slope * ((float)tc - (16.f * jj + 15.5f));
            sacc[mi][ni][j] = ok ? v : -1e30f; mx = fmaxf(mx, sacc[mi][ni][j]);
          }
        mx = max4(mx);
        const float mn = fmaxf(m_run[mi], mx); float ls = 0.f;
#pragma unroll
        for (int ni = 0; ni < 2; ++ni)
#pragma unroll
          for (int j = 0; j < 4; ++j) ls += (sacc[mi][ni][j] > -1e29f) ? __builtin_amdgcn_exp2f(sacc[mi][ni][j] - mn) : 0.f;
        l_run[mi] = l_run[mi] * __builtin_amdgcn_exp2f(m_run[mi] - mn) + ls; m_run[mi] = mn;
      }
    }
  }
  float invl[4];
#pragma unroll
  for (int mi = 0; mi < 4; ++mi) { const float l = red4(l_run[mi]); invl[mi] = l > 0.f ? 1.f / l : 0.f; }
#pragma unroll
  for (int mi = 0; mi < 4; ++mi)
#pragma unroll
    for (int ni = 0; ni < 4; ++ni) oacc[mi][ni] = (f32x4){0.f, 0.f, 0.f, 0.f};
  for (int jt = 0; jt < nct; ++jt) {
    __syncthreads();
    nsa_load_tile<true>(kcb + (size_t)jt * 64 * 64, 64u, vcb + jt * 64, 256u, lds, tid);
    asm volatile("s_waitcnt vmcnt(0)" ::: "memory");
    __syncthreads();
#pragma unroll 1
    for (int hf = 0; hf < 2; ++hf) {
      nsa_qk(sacc, qf, lds, hf, fr, fq);
      float imp[2] = {0.f, 0.f}, car[2] = {0.f, 0.f};
#pragma unroll
      for (int mi = 0; mi < 4; ++mi) {
        const float slope = slope0 * (1.f / (float)(1 << mi));
#pragma unroll
        for (int ni = 0; ni < 2; ++ni) {
#pragma unroll
          for (int j = 0; j < 4; ++j) {
            const int jj = jt * 64 + hf * 32 + ni * 16 + 4 * fq + j; const bool ok = (16 * jj + 31 <= tc);
            const float v = sacc[mi][ni][j] - slope * ((float)tc - (16.f * jj + 15.5f));
            sacc[mi][ni][j] = ok ? __builtin_amdgcn_exp2f(v - m_run[mi]) * invl[mi] : 0.f;
          }
          imp[ni] += (sacc[mi][ni][0] + sacc[mi][ni][1]) + sacc[mi][ni][2] + 0.5f * sacc[mi][ni][3]; car[ni] += 0.5f * sacc[mi][ni][3];
        }
      }
      nsa_pv(oacc, sacc, lds, pw, hf, fr, fq);
#pragma unroll
      for (int ni = 0; ni < 2; ++ni) {
        const int sb = jt * 16 + hf * 8 + ni * 4 + fq; float* pp = PSLC + (wid * 16 + fr) * 64 + sb;
        atomicAdd(pp, imp[ni]);
        if (sb < 63) atomicAdd(pp + 1, car[ni]);
      }
    }
  }
  int frc = fr; asm volatile("" : "+v"(frc));
  {
    const size_t n = nb + t0 + wid * 16 + frc;
#pragma unroll
    for (int mi = 0; mi < 4; ++mi) {
      const int hh = g * 4 + mi; const float gt = sigmoidf_(a.SM[n * 32 + 8 + hh * 3]);
#pragma unroll
      for (int ni = 0; ni < 4; ++ni) {
        bf16_t* dp = a.ANS + n * 512 + hh * 64 + ni * 16 + 4 * fq; const u32x2 pr = *(const u32x2*)dp;
        f32x4 r = oacc[mi][ni] * gt;
        r[0] += __uint_as_float(pr.x << 16); r[1] += __uint_as_float(pr.x & 0xffff0000u); r[2] += __uint_as_float(pr.y << 16); r[3] += __uint_as_float(pr.y & 0xffff0000u);
        st_bf4(dp, r);
      }
    }
  }
  __syncthreads();
  {
    int tsel = tid, isel = i; asm volatile("" : "+v"(tsel), "+v"(isel));
    const int q = tsel >> 2, sub = tsel & 3;
    float mine[16]; int cnt[16];
#pragma unroll
    for (int k = 0; k < 16; ++k) {
      const int sb = sub * 16 + k; const float ps = PSLC[q * 64 + sb];
      mine[k] = (sb == 0 || sb == isel || sb == isel - 1) ? 1e4f : (sb > isel ? -1e4f : ps); cnt[k] = 0;
    }
#pragma unroll
    for (int k = 0; k < 16; ++k) PSLC[q * 64 + sub * 16 + k] = mine[k];
    __syncthreads();
    for (int s2 = 0; s2 <= isel; ++s2) {
      const float o = PSLC[q * 64 + s2];
#pragma unroll
      for (int k = 0; k < 16; ++k) cnt[k] += (o > mine[k] || (o == mine[k] && s2 < sub * 16 + k)) ? 1 : 0;
    }
    unsigned m16 = 0;
#pragma unroll
    for (int k = 0; k < 16; ++k) m16 |= (cnt[k] < 16 ? 1u : 0u) << k;
    unsigned mlo = (sub < 2) ? (m16 << (16 * sub)) : 0u, mhi = (sub >= 2) ? (m16 << (16 * (sub - 2))) : 0u;
    mlo |= __shfl_xor(mlo, 1); mlo |= __shfl_xor(mlo, 2); mhi |= __shfl_xor(mhi, 1); mhi |= __shfl_xor(mhi, 2);
    u64 m64 = ((u64)mhi << 32) | (u64)mlo;
    m64 &= (isel == 63) ? ~0ull : ((2ull << isel) - 1ull);
    if (sub == 0) SELM[q] = m64;
    u64 un = m64;
#pragma unroll
    for (int o = 4; o < 64; o <<= 1) un |= __shfl_xor(un, o);
    if (lane == 0) UNI[wid] = un;
  }
  __syncthreads();
  const u64 uni = UNI[0] | UNI[1] | UNI[2] | UNI[3];
#pragma unroll
  for (int mi = 0; mi < 4; ++mi)
#pragma unroll
    for (int ks = 0; ks < 2; ++ks) qf[mi][ks] = *(const bf16x8*)(a.NQ + (size_t)(nb + t0 + mi * 16 + fr) * 512 + h * 64 + ks * 32 + fq * 8);
#pragma unroll 1
  for (int br = 1; br <= 1; ++br) {
#pragma unroll
    for (int mi = 0; mi < 4; ++mi) { m_run[mi] = -1e30f; l_run[mi] = 0.f;
#pragma unroll
      for (int ni = 0; ni < 4; ++ni) oacc[mi][ni] = (f32x4){0.f, 0.f, 0.f, 0.f}; }
    const bf16_t* Kb = (br == 1 ? a.KS : a.KW) + (size_t)nb * 128 + g * 64;
    const bf16_t* Vb = (br == 1 ? a.VST : a.VWT) + ((size_t)(b * 128 + g * 64) << 12);
    u64 todo;
    if (br == 1) todo = uni;
    else { const int lo = i >= 8 ? i - 8 : 0; todo = ((i == 63) ? ~0ull : ((2ull << i) - 1ull)) & ~((1ull << lo) - 1ull); }
    int cur = __builtin_ctzll(todo), bsel = 0;
    if (tid == 0) xch[half] = __builtin_popcountll(todo);
    __syncthreads();
    const int ntile = max(xch[0], xch[1]);
    nsa_load_tile<true>(Kb + (size_t)cur * 64 * 128, 128u, Vb + cur * 64, 4096u, lds, tid);
    for (int kt = 0; kt < ntile; ++kt) {
      int nxt = -1;
      if (cur >= 0) { todo &= todo - 1ull; nxt = todo ? __builtin_ctzll(todo) : -1; }
      asm volatile("s_waitcnt vmcnt(0)" ::: "memory");
      __syncthreads();
      if (cur < 0) continue;
      char* tb = bsel ? (lds + 49152) : lds;
      if (nxt >= 0) nsa_load_tile<true>(Kb + (size_t)nxt * 64 * 128, 128u, Vb + nxt * 64, 4096u, bsel ? lds : (lds + 49152), tid);
      const int sb = cur;
#pragma unroll 1
      for (int hf = 0; hf < 2; ++hf) {
        nsa_qk(sacc, qf, tb, hf, fr, fq);
        const bool edge = (sb == i) || (br == 2 && sb == i - 8);
#pragma unroll
        for (int mi = 0; mi < 4; ++mi) {
          const int tq = mi * 16 + fr;
          const bool rsel = (br == 2) || ((SELM[tq] >> sb) & 1ull);
          const float rc = rsel ? -slope * (float)(64 * (i - sb) + tq - hf * 32 - 4 * fq) : -1e30f;
          if (!edge) {
#pragma unroll
            for (int ni = 0; ni < 2; ++ni)
#pragma unroll
              for (int j = 0; j < 4; ++j) sacc[mi][ni][j] += fmaf(slope, (float)(ni * 16 + j), rc);
          } else {
            const int tqh = tq - hf * 32;
#pragma unroll
            for (int ni = 0; ni < 2; ++ni)
#pragma unroll
              for (int j = 0; j < 4; ++j) {
                const int c = ni * 16 + 4 * fq + j;
                const bool okv = (sb == i) ? (c <= tqh) : (c > tqh);
                sacc[mi][ni][j] = okv ? sacc[mi][ni][j] + fmaf(slope, (float)(ni * 16 + j), rc) : -1e30f;
              }
          }
        }
        nsa_online(sacc, m_run, l_run, oacc);
        nsa_pv(oacc, sacc, tb, pw, hf, fr, fq);
      }
      cur = nxt; bsel ^= 1;
    }
    int fre = fr; asm volatile("" : "+v"(fre));
#pragma unroll
    for (int mi = 0; mi < 4; ++mi) {
      const size_t n = nb + t0 + mi * 16 + fre;
      const float l = red4(l_run[mi]); const float sc = sigmoidf_(a.SM[n * 32 + 8 + h * 3 + br]) / l;
#pragma unroll
      for (int ni = 0; ni < 4; ++ni) {
        bf16_t* dp = a.ANS + n * 512 + h * 64 + ni * 16 + 4 * fq; const u32x2 pr = *(const u32x2*)dp;
        f32x4 r = oacc[mi][ni] * sc;
        r[0] += __uint_as_float(pr.x << 16); r[1] += __uint_as_float(pr.x & 0xffff0000u); r[2] += __uint_as_float(pr.y << 16); r[3] += __uint_as_float(pr.y & 0xffff0000u);
        st_bf4(dp, r);
      }
    }
  }
  __syncthreads();
}


__device__ __forceinline__ void nsa_win_item(const MegaArgs& a, int item, char* lds, int tid) {
  asm volatile("" : "+v"(tid));
  const int lane = tid & 63, wid = tid >> 6, fr = lane & 15, fq = lane >> 4;
  const int i = item & 63, g = (item >> 6) & 1, b = item >> 7;
  const int h = g * 4 + wid, nb = b * SEQ, t0 = i * 64, bg = b * 2 + g;
  const float slope = exp2f(-(float)(h + 1)) * 1.4426950408889634f;
  char* pw = lds + 16384 + wid * 8192;
  float* PSLC = (float*)(lds + 49152);
  u64* SELM = (u64*)(lds + 65536);
  u64* UNI = (u64*)(lds + 66048);
  bf16x8 qf[4][2];
#pragma unroll
  for (int mi = 0; mi < 4; ++mi)
#pragma unroll
    for (int ks = 0; ks < 2; ++ks) qf[mi][ks] = *(const bf16x8*)(a.NQ + (size_t)(nb + t0 + mi * 16 + fr) * 512 + h * 64 + ks * 32 + fq * 8);
  f32x4 sacc[4][2], oacc[4][4];
  float m_run[4], l_run[4];
  (void)PSLC; (void)UNI; (void)bg;
  const u64 uni = 0ull;
#pragma unroll 1
  for (int br = 2; br <= 2; ++br) {
#pragma unroll
    for (int mi = 0; mi < 4; ++mi) { m_run[mi] = -1e30f; l_run[mi] = 0.f;
#pragma unroll
      for (int ni = 0; ni < 4; ++ni) oacc[mi][ni] = (f32x4){0.f, 0.f, 0.f, 0.f}; }
    const bf16_t* Kb = (br == 1 ? a.KS : a.KW) + (size_t)nb * 128 + g * 64;
    const bf16_t* Vb = (br == 1 ? a.VST : a.VWT) + ((size_t)(b * 128 + g * 64) << 12);
    u64 todo;
    if (br == 1) todo = uni;
    else { const int lo = i >= 8 ? i - 8 : 0; todo = ((i == 63) ? ~0ull : ((2ull << i) - 1ull)) & ~((1ull << lo) - 1ull); }
    int cur = 63 - __builtin_clzll(todo), bsel = 0;
    __syncthreads();
    nsa_load_tile<true>(Kb + (size_t)cur * 64 * 128, 128u, Vb + cur * 64, 4096u, lds, tid);
    while (cur >= 0) {
      todo &= ~(1ull << cur);
      const int nxt = todo ? 63 - __builtin_clzll(todo) : -1;
      asm volatile("s_waitcnt vmcnt(0)" ::: "memory");
      __syncthreads();
      char* tb = bsel ? (lds + 49152) : lds;
      if (nxt >= 0) nsa_load_tile<true>(Kb + (size_t)nxt * 64 * 128, 128u, Vb + nxt * 64, 4096u, bsel ? lds : (lds + 49152), tid);
      const int sb = cur;
#pragma unroll 1
      for (int hf = 0; hf < 2; ++hf) {
        nsa_qk(sacc, qf, tb, hf, fr, fq);
        const bool edge = (sb == i) || (br == 2 && sb == i - 8);
#pragma unroll
        for (int mi = 0; mi < 4; ++mi) {
          const int tq = mi * 16 + fr;
          const bool rsel = (br == 2) || ((SELM[tq] >> sb) & 1ull);
          const float rc = rsel ? -slope * (float)(64 * (i - sb) + tq - hf * 32 - 4 * fq) : -1e30f;
          if (!edge) {
#pragma unroll
            for (int ni = 0; ni < 2; ++ni)
#pragma unroll
              for (int j = 0; j < 4; ++j) sacc[mi][ni][j] += fmaf(slope, (float)(ni * 16 + j), rc);
          } else {
            const int tqh = tq - hf * 32;
#pragma unroll
            for (int ni = 0; ni < 2; ++ni)
#pragma unroll
              for (int j = 0; j < 4; ++j) {
                const int c = ni * 16 + 4 * fq + j;
                const bool okv = (sb == i) ? (c <= tqh) : (c > tqh);
                sacc[mi][ni][j] = okv ? sacc[mi][ni][j] + fmaf(slope, (float)(ni * 16 + j), rc) : -1e30f;
              }
          }
        }
        nsa_online(sacc, m_run, l_run, oacc);
        nsa_pv(oacc, sacc, tb, pw, hf, fr, fq);
      }
      cur = nxt; bsel ^= 1;
    }
#pragma unroll
    for (int mi = 0; mi < 4; ++mi) {
      const size_t n = nb + t0 + mi * 16 + fr;
      const float l = red4(l_run[mi]); const float sc = sigmoidf_(a.SM[n * 32 + 8 + h * 3 + br]) / l;
#pragma unroll
      for (int ni = 0; ni < 4; ++ni) {
        st_bf4(a.ANS + n * 512 + h * 64 + ni * 16 + 4 * fq, oacc[mi][ni] * sc);
      }
    }
  }
  __syncthreads();
}


__device__ __forceinline__ int img_off(int row, int k) { return row * 128 + ((((k >> 3) ^ ((row >> 1) & 7))) << 4) + (k & 7) * 2; }
__device__ __forceinline__ bf16x8 img_frag(const char* img, int r0, int ks, int fr, int fq) { return *(const bf16x8*)(img + (r0 + fr) * 128 + (((ks * 4 + fq) ^ (fr >> 1)) << 4)); }


__device__ __forceinline__ void stage_raw(const bf16_t* __restrict__ QK, int nb, int t0, int chbase, char* raw, int tid) {
  u32x4 v[5];
#pragma unroll
  for (int i = 0; i < 5; ++i) {
    const int c = tid + 256 * i, row = c >> 4, cc = c & 15, t = t0 - 3 + row;
    v[i] = (c < 1072 && t >= 0) ? *(const u32x4*)(QK + (size_t)(nb + t) * 1024 + chbase + cc * 8) : (u32x4){0u, 0u, 0u, 0u};
  }
#pragma unroll
  for (int i = 0; i < 5; ++i) { const int c = tid + 256 * i; if (c < 1072) *(u32x4*)(raw + c * 16) = v[i]; }
}
template <class Put>
__device__ __forceinline__ void conv_col(const char* raw, const float* __restrict__ conv, int j0, int nj, int ch, int d, float scale, Put put) {
  const float w0 = conv[ch], w1 = conv[1024 + ch], w2 = conv[2048 + ch], w3 = conv[3072 + ch];
  const bf16_t* r = (const bf16_t*)raw + d;
  float x0 = bf2f(r[(j0 + 0) * 128]), x1 = bf2f(r[(j0 + 1) * 128]), x2 = bf2f(r[(j0 + 2) * 128]);
  for (int j = j0; j < j0 + nj; ++j) {
    const float x3 = bf2f(r[(j + 3) * 128]);
    put(j, siluf_(w0 * x0 + w1 * x1 + w2 * x2 + w3 * x3) * scale);
    x0 = x1; x1 = x2; x2 = x3;
  }
}

__device__ __forceinline__ void ml_dc_item(const MegaArgs& a, const MlArgs& ml, int item, char* lds, int tid) {
  asm volatile("" : "+v"(tid));
  const int lane = tid & 63, wid = tid >> 6, wr = wid >> 1, wc = wid & 1, fr = lane & 15, fq = lane >> 4;
  const int bh = item >> 6, c = item & 63, b = bh >> 2, h = bh & 3, nb = b * SEQ, t0 = c * 64;
  char* KT = lds; char* VT = lds + 16384; float* sc = (float*)(lds + 32768); float* dnp = (float*)(lds + 33792);
  if (tid < 64) {
    const size_t n = nb + t0 + tid;
    sc[tid] = a.SM[n * 32 + h] + ml.b_i[h];
    sc[64 + tid] = logsigmoidf_(a.SM[n * 32 + 4 + h] + ml.b_f[h]);
  }
  __syncthreads();
  if (tid < 64) {
    float cs = sc[64 + tid];
#pragma unroll
    for (int o = 1; o < 64; o <<= 1) { const float up = __shfl_up(cs, o); if (tid >= o) cs += up; }
    const float bl = __shfl(cs, 63);
    const float lw = bl - cs + sc[tid];
    const float mx = wave_max(lw);
    sc[128 + tid] = cs; sc[192 + tid] = __expf(lw - mx);
    if (tid == 0) { ml.BL[bh * 64 + c] = bl; ml.MX[bh * 64 + c] = mx; }
  }
  __syncthreads();
  if (tid < 64) { ml.BCUM[bh * SEQ + t0 + tid] = sc[128 + tid]; ml.IP[bh * SEQ + t0 + tid] = sc[tid]; }
  char* RAW = lds + 36864;
  stage_raw(a.QK, nb, t0, 512 + h * 128, RAW, tid);
  __syncthreads();
  {
    const int d = tid & 127, jh = tid >> 7;
    float dn = 0.f;
    conv_col(RAW, ml.conv, jh * 32, 32, 512 + h * 128 + d, d, 0.08838834764831845f,
             [&](int j, float v) { *(bf16_t*)(KT + img_off(d, j)) = f2bf(v); dn += sc[192 + j] * v; });
    dnp[jh * 128 + d] = dn;
    {
      bf16_t tv[32];
#pragma unroll
      for (int u = 0; u < 32; ++u) tv[u] = a.V[(size_t)(nb + t0 + jh * 32 + u) * 512 + h * 128 + d];
#pragma unroll
      for (int u = 0; u < 32; ++u) *(bf16_t*)(VT + img_off(d, jh * 32 + u)) = f2bf(sc[192 + jh * 32 + u] * bf2f(tv[u]));
    }
  }
  __syncthreads();
  if (tid < 128) ml.NST[(size_t)(bh * 64 + c) * 128 + tid] = dnp[tid] + dnp[128 + tid];
  f32x4 acc[4][4]; zero_acc(acc);
#pragma unroll
  for (int ks = 0; ks < 2; ++ks) {
    bf16x8 av[4], bk[4];
#pragma unroll
    for (int i = 0; i < 4; ++i) { av[i] = img_frag(VT, wr * 64 + i * 16, ks, fr, fq); bk[i] = img_frag(KT, wc * 64 + i * 16, ks, fr, fq); }
#pragma unroll
    for (int i = 0; i < 4; ++i)
#pragma unroll
      for (int j = 0; j < 4; ++j) acc[i][j] = __builtin_amdgcn_mfma_f32_16x16x32_bf16(bk[j], av[i], acc[i][j], 0, 0, 0);
  }
  bf16_t* cst = ml.CST + (size_t)(bh * 64 + c) * 16384;
#pragma unroll
  for (int mi = 0; mi < 4; ++mi)
#pragma unroll
    for (int ni = 0; ni < 4; ++ni) st_bf4(cst + (wr * 64 + mi * 16 + fr) * 128 + wc * 64 + ni * 16 + 4 * fq, acc[mi][ni]);
  __syncthreads();
}

__device__ __forceinline__ void ml_scan_item(const MlArgs& ml, int item, int tid) {
  const int bh = item / 17, part = item % 17;
  float m = 0.f;
  if (part < 16) {
    float run[4] = {0.f, 0.f, 0.f, 0.f};
#pragma unroll 1
    for (int c0 = 0; c0 < 64; c0 += 8) {
      u32x2 vb[8]; float bl[8], mxv[8];
#pragma unroll
      for (int u = 0; u < 8; ++u) {
        vb[u] = *(const u32x2*)(ml.CST + (size_t)(bh * 64 + c0 + u) * 16384 + part * 1024 + tid * 4);
        bl[u] = ml.BL[bh * 64 + c0 + u]; mxv[u] = ml.MX[bh * 64 + c0 + u];
      }
#pragma unroll
      for (int u = 0; u < 8; ++u) {
        const float mn = fmaxf(bl[u] + m, mxv[u]), decay = __expf(bl[u] + m - mn), scl = __expf(mxv[u] - mn);
        u32x2 o; o.x = pk2bf(run[0], run[1]); o.y = pk2bf(run[2], run[3]);
        *(u32x2*)(ml.CST + (size_t)(bh * 64 + c0 + u) * 16384 + part * 1024 + tid * 4) = o;
        run[0] = decay * run[0] + scl * __uint_as_float(vb[u].x << 16); run[1] = decay * run[1] + scl * __uint_as_float(vb[u].x & 0xffff0000u);
        run[2] = decay * run[2] + scl * __uint_as_float(vb[u].y << 16); run[3] = decay * run[3] + scl * __uint_as_float(vb[u].y & 0xffff0000u);
        if (part == 0 && tid == 0) ml.MST[bh * 64 + c0 + u] = m;
        m = mn;
      }
    }
  } else if (tid < 128) {
    float run = 0.f;
    for (int c = 0; c < 64; ++c) {
      const float bl = ml.BL[bh * 64 + c], mx = ml.MX[bh * 64 + c];
      const float mn = fmaxf(bl + m, mx), decay = __expf(bl + m - mn), scl = __expf(mx - mn);
      float* p = ml.NST + (size_t)(bh * 64 + c) * 128 + tid;
      const float v = *p; *p = run; run = decay * run + scl * v;
      m = mn;
    }
  }
}

__device__ __forceinline__ void ml_out_item(const MegaArgs& a, const MlArgs& ml, int item, char* lds, int tid) {
  asm volatile("" : "+v"(tid));
  const int lane = tid & 63, wid = tid >> 6, wr = wid >> 1, wc = wid & 1, fr = lane & 15, fq = lane >> 4;
  const int bh = item >> 6, c = item & 63, b = bh >> 2, h = bh & 3, nb = b * SEQ, t0 = c * 64;
  char* Qi = lds; char* Ki = lds + 16384; char* VT = lds + 32768; char* SP = lds + 49152;
  float* sc = (float*)(lds + 57344);
  float* H = (float*)lds;
  {
    char* RAW = lds + 49152;
    const int d = tid & 127, jh = tid >> 7;
    stage_raw(a.QK, nb, t0, h * 128, RAW, tid);
    {
      bf16_t tv[32];
#pragma unroll
      for (int u = 0; u < 32; ++u) tv[u] = a.V[(size_t)(nb + t0 + jh * 32 + u) * 512 + h * 128 + d];
#pragma unroll
      for (int u = 0; u < 32; ++u) *(bf16_t*)(VT + img_off(d, jh * 32 + u)) = tv[u];
    }
    __syncthreads();
    conv_col(RAW, ml.conv, jh * 32, 32, h * 128 + d, d, 1.f, [&](int j, float v) { *(bf16_t*)(Qi + (d >> 6) * 8192 + img_off(j, d & 63)) = f2bf(v); });
    __syncthreads();
    stage_raw(a.QK, nb, t0, 512 + h * 128, RAW, tid);
    __syncthreads();
    conv_col(RAW, ml.conv, jh * 32, 32, 512 + h * 128 + d, d, 0.08838834764831845f, [&](int j, float v) { *(bf16_t*)(Ki + (d >> 6) * 8192 + img_off(j, d & 63)) = f2bf(v); });
    __syncthreads();
  }
  if (tid < 64) { sc[tid] = ml.BCUM[bh * SEQ + t0 + tid]; sc[64 + tid] = ml.IP[bh * SEQ + t0 + tid]; }
  if (tid < 128) sc[448 + tid] = ml.NST[(size_t)(bh * 64 + c) * 128 + tid];
  __syncthreads();
  const float m = ml.MST[bh * 64 + c];
  if (tid < 64) {
    const float bj = sc[tid]; float mxi = -INFINITY;
    for (int s2 = 0; s2 <= tid; ++s2) mxi = fmaxf(mxi, bj - sc[s2] + sc[64 + s2]);
    const float inter = bj + m, mt = fmaxf(mxi, inter);
    sc[128 + tid] = mt; sc[192 + tid] = __expf(inter - mt);
  } else if (tid < 128) {
    const int t = tid - 64; float nq = 0.f;
    for (int k = 0; k < 128; ++k) nq += sc[448 + k] * bf2f(*(const bf16_t*)(Qi + (k >> 6) * 8192 + img_off(t, k & 63)));
    sc[384 + t] = nq;
  }
  f32x4 sacc[2][2];
#pragma unroll
  for (int i = 0; i < 2; ++i)
#pragma unroll
    for (int j = 0; j < 2; ++j) sacc[i][j] = (f32x4){0.f, 0.f, 0.f, 0.f};
#pragma unroll
  for (int kt = 0; kt < 2; ++kt)
#pragma unroll
    for (int ks = 0; ks < 2; ++ks) {
      bf16x8 aq[2], bk[2];
#pragma unroll
      for (int i = 0; i < 2; ++i) { aq[i] = img_frag(Qi + kt * 8192, wr * 32 + i * 16, ks, fr, fq); bk[i] = img_frag(Ki + kt * 8192, wc * 32 + i * 16, ks, fr, fq); }
#pragma unroll
      for (int i = 0; i < 2; ++i)
#pragma unroll
        for (int j = 0; j < 2; ++j) sacc[i][j] = __builtin_amdgcn_mfma_f32_16x16x32_bf16(bk[j], aq[i], sacc[i][j], 0, 0, 0);
    }
  __syncthreads();
  const bf16_t* cst = ml.CST + (size_t)(bh * 64 + c) * 16384;
#pragma unroll
  for (int i = 0; i < 4; ++i) { const int idx = tid + 256 * i, row = idx >> 3, lc = (idx & 7) ^ ((row >> 1) & 7); glds16(cst + row * 128 + lc * 8, Ki + idx * 16); }
#pragma unroll
  for (int mi = 0; mi < 2; ++mi) {
    const int t = wr * 32 + mi * 16 + fr; const float bt = sc[t], mt = sc[128 + t]; float rsum = 0.f;
#pragma unroll
    for (int ni = 0; ni < 2; ++ni) {
      const int s0 = wc * 32 + ni * 16 + 4 * fq; f32x4 p;
#pragma unroll
      for (int j = 0; j < 4; ++j) { const int s2 = s0 + j; p[j] = (s2 <= t) ? sacc[mi][ni][j] * __expf(bt - sc[s2] + sc[64 + s2] - mt) : 0.f; rsum += p[j]; }
      u32x2 o; o.x = pk2bf(p[0], p[1]); o.y = pk2bf(p[2], p[3]);
      *(u32x2*)(SP + img_off(t, s0)) = o;
    }
    rsum += __shfl_xor(rsum, 16); rsum += __shfl_xor(rsum, 32);
    if (fq == 0) sc[256 + t * 2 + wc] = rsum;
  }
  asm volatile("s_waitcnt vmcnt(0)" ::: "memory");
  __syncthreads();
  f32x4 acc1[2][4], acc2[2][4];
#pragma unroll
  for (int i = 0; i < 2; ++i)
#pragma unroll
    for (int j = 0; j < 4; ++j) { acc1[i][j] = (f32x4){0.f, 0.f, 0.f, 0.f}; acc2[i][j] = (f32x4){0.f, 0.f, 0.f, 0.f}; }
#pragma unroll
  for (int ks = 0; ks < 2; ++ks) {
    bf16x8 as[2], bv[4];
#pragma unroll
    for (int i = 0; i < 2; ++i) as[i] = img_frag(SP, wr * 32 + i * 16, ks, fr, fq);
#pragma unroll
    for (int j = 0; j < 4; ++j) bv[j] = img_frag(VT, wc * 64 + j * 16, ks, fr, fq);
#pragma unroll
    for (int i = 0; i < 2; ++i)
#pragma unroll
      for (int j = 0; j < 4; ++j) acc1[i][j] = __builtin_amdgcn_mfma_f32_16x16x32_bf16(bv[j], as[i], acc1[i][j], 0, 0, 0);
  }
#pragma unroll 1
  for (int kt = 0; kt < 2; ++kt) {
    if (kt == 1) {
      __syncthreads();
#pragma unroll
      for (int i = 0; i < 4; ++i) { const int idx = tid + 256 * i, row = idx >> 3, lc = (idx & 7) ^ ((row >> 1) & 7); glds16(cst + row * 128 + 64 + lc * 8, Ki + idx * 16); }
      asm volatile("s_waitcnt vmcnt(0)" ::: "memory");
      __syncthreads();
    }
#pragma unroll
    for (int ks = 0; ks < 2; ++ks) {
      bf16x8 aq[2], bc[4];
#pragma unroll
      for (int i = 0; i < 2; ++i) aq[i] = img_frag(Qi + kt * 8192, wr * 32 + i * 16, ks, fr, fq);
#pragma unroll
      for (int j = 0; j < 4; ++j) bc[j] = img_frag(Ki, wc * 64 + j * 16, ks, fr, fq);
#pragma unroll
      for (int i = 0; i < 2; ++i)
#pragma unroll
        for (int j = 0; j < 4; ++j) acc2[i][j] = __builtin_amdgcn_mfma_f32_16x16x32_bf16(bc[j], aq[i], acc2[i][j], 0, 0, 0);
    }
  }
  __syncthreads();
#pragma unroll
  for (int mi = 0; mi < 2; ++mi) {
    const int t = wr * 32 + mi * 16 + fr; const float wi = sc[192 + t];
    const float den = sc[256 + t * 2] + sc[256 + t * 2 + 1] + wi * sc[384 + t];
    const float inv = 1.f / fmaxf(fabsf(den), __expf(-sc[128 + t]));
#pragma unroll
    for (int ni = 0; ni < 4; ++ni) *(f32x4*)(H + t * 132 + wc * 64 + ni * 16 + 4 * fq) = (acc1[mi][ni] + acc2[mi][ni] * wi) * inv;
  }
  __syncthreads();
  {
    bf16_t og0[16], og1[16];
#pragma unroll
    for (int r = 0; r < 16; ++r) { const size_t n = nb + t0 + wid * 16 + r; og0[r] = a.O[n * 512 + h * 128 + lane]; og1[r] = a.O[n * 512 + h * 128 + 64 + lane]; }
    const float g0 = ml.gain[h * 128 + lane], g1 = ml.gain[h * 128 + 64 + lane];
#pragma unroll
    for (int r = 0; r < 16; ++r) {
      const int j = wid * 16 + r;
      const float a0 = H[j * 132 + lane], a1 = H[j * 132 + 64 + lane];
      const float ss = wave_sum(a0 * a0 + a1 * a1);
      const float rs = rsqrtf(ss * (1.f / 128.f) + EPS);
      const size_t n = nb + t0 + j; const int c0 = h * 128 + lane, c1 = c0 + 64;
      a.AML[n * 512 + c0] = f2bf(sigmoidf_(bf2f(og0[r])) * a0 * rs * g0);
      a.AML[n * 512 + c1] = f2bf(sigmoidf_(bf2f(og1[r])) * a1 * rs * g1);
    }
  }
  __syncthreads();
}


struct EpiX1 {
  static constexpr bool PERM = false, AFTER_DRAIN = false;
  const float* x; bf16_t* X1B; float* PS2;
  __device__ __forceinline__ void operator()(const f32x4 (&acc)[2][2][4][2], const pg8::Unit& u, int wr, int wc, int fr, int fq) const {
#pragma unroll
    for (int ai = 0; ai < 2; ++ai)
#pragma unroll
      for (int m = 0; m < 4; ++m) {
        const int row = u.pm * 256 + ai * 128 + wr * 64 + m * 16 + fr;
#pragma unroll
        for (int bj = 0; bj < 2; ++bj) {
          float ss = 0.f;
#pragma unroll
          for (int n = 0; n < 2; ++n) {
            const size_t off = (size_t)row * 1024 + u.pn * 256 + bj * 128 + wc * 32 + n * 16 + 4 * fq;
            const f32x4 v = *(const f32x4*)(x + off) + acc[ai][bj][m][n];
            st_bf4(X1B + off, v);
            ss += v[0] * v[0] + v[1] * v[1] + v[2] * v[2] + v[3] * v[3];
          }
          ss += __shfl_xor(ss, 16); ss += __shfl_xor(ss, 32);
          if (fq == 0) PS2[(size_t)row * 32 + u.pn * 8 + bj * 4 + wc] = ss;
        }
      }
  }
};
struct EpiXQ {
  static constexpr bool PERM = false, AFTER_DRAIN = false;
  bf16_t* XQ; const float* PS2;
  __device__ __forceinline__ void operator()(const f32x4 (&acc)[2][2][4][2], const pg8::Unit& u, int wr, int wc, int fr, int fq) const {
#pragma unroll
    for (int ai = 0; ai < 2; ++ai)
#pragma unroll
      for (int m = 0; m < 4; ++m) {
        const int row = u.pm * 256 + ai * 128 + wr * 64 + m * 16 + fr;
        const f32x4* pp = (const f32x4*)(PS2 + (size_t)row * 32);
        float ss = 0.f;
#pragma unroll
        for (int c = 0; c < 8; ++c) { const f32x4 p = pp[c]; ss += (p[0] + p[1]) + (p[2] + p[3]); }
        const float rs = rsqrtf(ss * (1.f / DM) + EPS);
#pragma unroll
        for (int bj = 0; bj < 2; ++bj)
#pragma unroll
          for (int n = 0; n < 2; ++n) st_bf4(XQ + (size_t)row * 1024 + u.pn * 256 + bj * 128 + wc * 32 + n * 16 + 4 * fq, acc[ai][bj][m][n] * rs);
      }
  }
};
struct EpiX2 {
  static constexpr bool PERM = false, AFTER_DRAIN = false;
  bf16_t* X1B;
  __device__ __forceinline__ void operator()(const f32x4 (&acc)[2][2][4][2], const pg8::Unit& u, int wr, int wc, int fr, int fq) const {
#pragma unroll
    for (int ai = 0; ai < 2; ++ai)
#pragma unroll
      for (int m = 0; m < 4; ++m) {
        const int row = u.pm * 256 + ai * 128 + wr * 64 + m * 16 + fr;
#pragma unroll
        for (int bj = 0; bj < 2; ++bj)
#pragma unroll
          for (int n = 0; n < 2; ++n) {
            bf16_t* p = X1B + (size_t)row * 1024 + u.pn * 256 + bj * 128 + wc * 32 + n * 16 + 4 * fq;
            const u32x2 pr = *(const u32x2*)p; f32x4 r = acc[ai][bj][m][n];
            r[0] += __uint_as_float(pr.x << 16); r[1] += __uint_as_float(pr.x & 0xffff0000u); r[2] += __uint_as_float(pr.y << 16); r[3] += __uint_as_float(pr.y & 0xffff0000u);
            st_bf4(p, r);
          }
      }
  }
};
struct MapMN {
  const bf16_t* A; const bf16_t* Bt; int K, xcd;
  __device__ __forceinline__ void avoff(const pg8::Unit&, int, int K, const unsigned (&voffA)[2], unsigned (&v0)[2], unsigned (&v1)[2]) const { v0[0] = voffA[0]; v0[1] = voffA[1]; v1[0] = voffA[0] + 256u * K; v1[1] = voffA[1] + 256u * K; }
  __device__ __forceinline__ void operator()(int idx, pg8::Unit& u) const {
    u.pm = xcd * 8 + (idx & 7); u.pn = idx >> 3;
    u.aptr = (const char*)(A + (size_t)u.pm * 256 * K); u.bptr = (const char*)(Bt + (size_t)u.pn * 256 * K);
  }
};

struct MapInProj {
  const bf16_t* XB; const bf16_t* WinT; int xcd;
  __device__ __forceinline__ void avoff(const pg8::Unit&, int, int K, const unsigned (&voffA)[2], unsigned (&v0)[2], unsigned (&v1)[2]) const { v0[0] = voffA[0]; v0[1] = voffA[1]; v1[0] = voffA[0] + 256u * K; v1[1] = voffA[1] + 256u * K; }
  __device__ __forceinline__ void operator()(int idx, pg8::Unit& u) const {
    u.pm = xcd * 8 + (idx & 7); u.pn = idx >> 3;
    const char* tokp = (const char*)(XB + (size_t)u.pm * 256 * DM); const char* colp = (const char*)(WinT + (size_t)u.pn * 256 * DM);
    if (u.pn == 12) { u.aptr = colp; u.bptr = tokp; } else { u.aptr = tokp; u.bptr = colp; }
  }
};
struct EpiInProj8 {
  static constexpr bool PERM = false, AFTER_DRAIN = false;
  bf16_t *QK, *V, *O, *NQ, *KVC, *KS, *KW, *VST, *VWT; float* SM; const float* RS1;
  __device__ __forceinline__ void operator()(const f32x4 (&acc)[2][2][4][2], const pg8::Unit& u, int wr, int wc, int fr, int fq) const {
    if (u.pn == 12) {
#pragma unroll
      for (int bj = 0; bj < 2; ++bj)
#pragma unroll
        for (int n = 0; n < 2; ++n) {
          const int tok = u.pm * 256 + bj * 128 + wc * 32 + n * 16 + 4 * fq; const f32x4 rs = *(const f32x4*)(RS1 + tok);
          const int b = tok >> 12, t = tok & 4095;
#pragma unroll
          for (int ai = 0; ai < 2; ++ai)
#pragma unroll
            for (int m = 0; m < 4; ++m) st_bf4((ai ? VWT : VST) + ((size_t)(b * 128 + wr * 64 + m * 16 + fr) << 12) + t, acc[ai][bj][m][n] * rs);
        }
      return;
    }
#pragma unroll
    for (int bj = 0; bj < 2; ++bj) {
      const int nh = u.pn * 256 + bj * 128;
      bf16_t* dst; int ld, cofs; float scale = 1.f;
      if (nh < 1024) { dst = QK; ld = 1024; cofs = nh; }
      else if (nh < 1536) { dst = V; ld = 512; cofs = nh - 1024; }
      else if (nh < 2048) { dst = O; ld = 512; cofs = nh - 1536; }
      else if (nh < 2560) { dst = NQ; ld = 512; cofs = nh - 2048; scale = 0.125f * 1.4426950408889634f; }
      else if (nh < 2816) { dst = KVC; ld = 256; cofs = nh - 2560; }
      else if (nh < 2944) { dst = KS; ld = 128; cofs = 0; }
      else if (nh < 3072) { dst = KW; ld = 128; cofs = 0; }
      else { dst = nullptr; ld = 0; cofs = 0; }
      if (!dst && nh != 3328) continue;
#pragma unroll
      for (int ai = 0; ai < 2; ++ai)
#pragma unroll
        for (int m = 0; m < 4; ++m) {
          const int row = u.pm * 256 + ai * 128 + wr * 64 + m * 16 + fr; const float rs = RS1[row] * scale;
          if (dst) {
#pragma unroll
            for (int n = 0; n < 2; ++n) st_bf4(dst + (size_t)row * ld + cofs + wc * 32 + n * 16 + 4 * fq, acc[ai][bj][m][n] * rs);
          } else if (wc == 0) {
#pragma unroll
            for (int n = 0; n < 2; ++n) *(f32x4*)(SM + (size_t)row * 32 + n * 16 + 4 * fq) = acc[ai][bj][m][n] * rs;
          }
        }
    }
  }
};

struct MapMoe {
  const int* CNT; const int* LIST; const bf16_t* Abase; const bf16_t* W; size_t wstride; int K, xcd, gather;
  __device__ __forceinline__ void operator()(int idx, pg8::Unit& u) const {
    int g = (idx >> 2) * 8 + xcd, e = 0, ce = CNT[0], pre = 0;
    while (g >= ((ce + 255) >> 8)) { g -= (ce + 255) >> 8; pre += ce; ++e; ce = CNT[e]; }
    u.e = e; u.ce = ce; u.rt = g; u.p0 = pre + g * 256; u.pm = 0; u.pn = idx & 3;
    u.bptr = (const char*)(W + (size_t)e * wstride + (size_t)u.pn * 256 * K);
    u.aptr = gather ? (const char*)Abase : (const char*)(Abase + (size_t)u.p0 * K);
  }
  __device__ __forceinline__ void avoff(const pg8::Unit& u, int tid, int K_, const unsigned (&voffA)[2], unsigned (&v0)[2], unsigned (&v1)[2]) const {
    if (!gather) { v0[0] = voffA[0]; v0[1] = voffA[1]; v1[0] = voffA[0] + 256u * K_; v1[1] = voffA[1] + 256u * K_; return; }
#pragma unroll
    for (int i = 0; i < 2; ++i) {
      int R, C; pg8::stage_rc(tid * 16 + i * 8192, R, C);
      int m0_ = u.rt * 256 + R, m1_ = m0_ + 128; if (m0_ >= u.ce) m0_ = u.ce - 1; if (m1_ >= u.ce) m1_ = u.ce - 1;
      v0[i] = (unsigned)((LIST[u.e * NTOK + m0_] >> 1) * K_ + C) * 2u; v1[i] = (unsigned)((LIST[u.e * NTOK + m1_] >> 1) * K_ + C) * 2u;
    }
  }
};
struct EpiMoe1 {
  static constexpr bool PERM = false, AFTER_DRAIN = false;
  const int* LIST; const float* RS3; bf16_t* ACT;
  __device__ __forceinline__ void operator()(const f32x4 (&acc)[2][2][4][2], const pg8::Unit& u, int wr, int wc, int fr, int fq) const {
#pragma unroll
    for (int ai = 0; ai < 2; ++ai)
#pragma unroll
      for (int m = 0; m < 4; ++m) {
        const int r = ai * 128 + wr * 64 + m * 16 + fr, ml = u.rt * 256 + r;
        if (ml < u.ce) {
          const float rs = RS3[LIST[u.e * NTOK + ml] >> 1];
#pragma unroll
          for (int bj = 0; bj < 2; ++bj) {
            const f32x4 a1 = acc[ai][bj][m][0] * rs, a3 = acc[ai][bj][m][1] * rs; f32x4 r4;
#pragma unroll
            for (int j = 0; j < 4; ++j) r4[j] = siluf_(a1[j]) * a3[j];
            st_bf4(ACT + (size_t)(u.p0 + r) * 512 + (u.pn * 8 + bj * 4 + wc) * 16 + 4 * fq, r4);
          }
        }
      }
  }
};
struct EpiMoe2 {
  static constexpr bool PERM = false, AFTER_DRAIN = false;
  const int* LIST; const float* RTW; bf16_t* Y;
  __device__ __forceinline__ void operator()(const f32x4 (&acc)[2][2][4][2], const pg8::Unit& u, int wr, int wc, int fr, int fq) const {
#pragma unroll
    for (int ai = 0; ai < 2; ++ai)
#pragma unroll
      for (int m = 0; m < 4; ++m) {
        const int r = ai * 128 + wr * 64 + m * 16 + fr, ml = u.rt * 256 + r;
        if (ml < u.ce) {
          const int entry = LIST[u.e * NTOK + ml]; const float w = RTW[entry];
#pragma unroll
          for (int bj = 0; bj < 2; ++bj)
#pragma unroll
            for (int n = 0; n < 2; ++n) st_bf4(Y + (size_t)entry * 1024 + u.pn * 256 + bj * 128 + wc * 32 + n * 16 + 4 * fq, acc[ai][bj][m][n] * w);
        }
      }
  }
};

#define XB_TMO      128
#define XB_XCNT(j)  (256  + 64 * (j))
#define XB_XSUB(j)  (1280 + 64 * (j))
#define XB_XGEN(j)  (2304 + 64 * (j))
#define XB_TOP      3328
#define XB_TOPGEN   3392
#define XCD_BAR_WORDS 3456
#define XB_SPIN_CAP (1u << 24)
__device__ __forceinline__ unsigned xb_ld(unsigned* p)              { return __hip_atomic_load(p, __ATOMIC_RELAXED, __HIP_MEMORY_SCOPE_AGENT); }
__device__ __forceinline__ unsigned xb_add(unsigned* p, unsigned v) { return __hip_atomic_fetch_add(p, v, __ATOMIC_RELAXED, __HIP_MEMORY_SCOPE_AGENT); }
__device__ __forceinline__ unsigned xb_xcc_id() { return (unsigned)__builtin_amdgcn_s_getreg((3 << 11) | 20) & 0xFu; }
#define XB_SPIN(cond, bar) do { unsigned _sp = 0; while (cond) { __builtin_amdgcn_s_sleep(1); \
    if ((++_sp & 255u) == 0u) { if (xb_ld(&(bar)[XB_TMO])) break; if (_sp > XB_SPIN_CAP) { atomicAdd(&(bar)[XB_TMO], 1u); break; } } } } while (0)
__device__ __forceinline__ void xcd_barrier_complete(unsigned* bar, unsigned x, unsigned G, unsigned& nloc, unsigned& nx) {
  unsigned sum, cnt, mine, sp = 0u;
  for (;;) {
    sum = 0u; cnt = 0u; mine = 0u;
#pragma unroll
    for (unsigned j = 0; j < 16; ++j) { const unsigned c = xb_ld(&bar[XB_XCNT(j)]); sum += c; cnt += (c > 0u) ? 1u : 0u; mine = (j == x) ? c : mine; }
    if (sum == G) break;
    __builtin_amdgcn_s_sleep(1);
    if ((++sp & 255u) == 0u) { if (xb_ld(&bar[XB_TMO])) break; if (sp > XB_SPIN_CAP) { atomicAdd(&bar[XB_TMO], 1u); break; } }
  }
  nloc = mine > 0u ? mine : 1u; nx = cnt > 0u ? cnt : 1u;
}
__device__ __forceinline__ void xcd_barrier(unsigned* bar, unsigned x, volatile unsigned* st, unsigned G, bool leader_thread) {
  asm volatile("s_waitcnt vmcnt(0)" ::: "memory");
  __syncthreads();
  if (leader_thread) {
    __builtin_amdgcn_s_waitcnt(0);
    unsigned nloc = st[0], nx = st[1];
    if (nloc == 0u) { xcd_barrier_complete(bar, x, G, nloc, nx); st[0] = nloc; st[1] = nx; }
    const unsigned old = xb_add(&bar[XB_XSUB(x)], 1u);
    const unsigned gen = old / nloc;
    if (old + 1u == (gen + 1u) * nloc) {
      __builtin_amdgcn_fence(__ATOMIC_RELEASE, "agent");
      asm volatile("s_waitcnt vmcnt(0)" ::: "memory");
      const unsigned og = xb_add(&bar[XB_TOP], 1u);
      const unsigned tg = og / nx;
      if (og + 1u == (tg + 1u) * nx) xb_add(&bar[XB_TOPGEN], 1u);
      else XB_SPIN(xb_ld(&bar[XB_TOPGEN]) == tg, bar);
      __builtin_amdgcn_fence(__ATOMIC_ACQUIRE, "agent");
      xb_add(&bar[XB_XGEN(x)], 1u);
      asm volatile("s_waitcnt vmcnt(0)" ::: "memory");
    } else {
      XB_SPIN(xb_ld(&bar[XB_XGEN(x)]) == gen, bar);
      __builtin_amdgcn_fence(__ATOMIC_ACQUIRE, "agent");
      asm volatile("s_waitcnt vmcnt(0)" ::: "memory");
    }
  }
  __syncthreads();
}

__device__ __forceinline__ void convert_range(const MegaArgs& a, int lo, int hi, int bid, int nblk, char* lds, int tid) {
  for (int it0 = lo; it0 < hi; it0 += nblk) {
    int it = it0 + bid; if (it >= hi) it = hi - 1;
    int r = it, di = 0;
    while (r >= a.td[di].nitems) { r -= a.td[di].nitems; ++di; }
    transpose_item(a.td[di], r, (float*)lds, tid);
  }
}
#define TILE_IDS unsigned tid_z = 0u; asm volatile("" : "+v"(tid_z)); int tid = (wave_s & 3) * 64 + (int)__builtin_amdgcn_mbcnt_hi(~0u, __builtin_amdgcn_mbcnt_lo(~0u, tid_z)); asm volatile("" : "+v"(tid)); const int half = wave_s >> 2; char* const lds = plds + half * HALF_LDS; const int bid = pbid * 2 + half, nblk = pnblk * 2, li = (pbid >> 3) * 2 + half, nloc = (pnblk >> 3) * 2; const int lane = tid & 63, wid = tid >> 6, wr = wid >> 1, wc = wid & 1, fr = lane & 15, fq = lane >> 4; (void)lane; (void)wid; (void)wr; (void)wc; (void)fr; (void)fq; (void)half; (void)lds; (void)bid; (void)nblk; (void)li; (void)nloc

__global__ void __launch_bounds__(512, 2) k_mega(MegaArgs a) {
  extern __shared__ __attribute__((aligned(16))) char lds_raw[];
  char* const plds = lds_raw;
  cg::grid_group grid = cg::this_grid();
  const int pnblk = gridDim.x, pbid = blockIdx.x;
  const int wave_s = __builtin_amdgcn_readfirstlane((int)(threadIdx.x >> 6));
  unsigned* const xbar = a.BAR + a.li * XCD_BAR_WORDS;
  volatile unsigned* const xst = (volatile unsigned*)(plds + CTRL_OFF);
  volatile int* const xch = (volatile int*)(plds + CTRL_OFF + 16);
  unsigned xcc;
  {
    const bool t0 = (wave_s == 0) && ((int)__builtin_amdgcn_mbcnt_hi(~0u, __builtin_amdgcn_mbcnt_lo(~0u, 0u)) == 0);
    if (t0) { xst[0] = 0u; xst[1] = 0u; }
    xcc = xb_xcc_id();
    if (t0) (void)xb_add(&xbar[XB_XCNT(xcc)], 1u);
    grid.sync();
  }
#define PH(k) (a.ph_lo <= (k) && (k) < a.ph_hi)
  const int xcd = pbid & 7;
#define GRID_BAR() do { const int ld_ = (wave_s == 0) && ((int)__builtin_amdgcn_mbcnt_hi(~0u, __builtin_amdgcn_mbcnt_lo(~0u, 0u)) == 0); xcd_barrier(xbar, xcc, xst, (unsigned)pnblk, ld_); } while (0)
#define SYNC_AFTER(k) do { if (PH(k) && PH((k) + 1)) GRID_BAR(); } while (0)
#pragma unroll 1
  for (int rp_ = PH(0) ? a.rep[0] : 0; rp_ > 0; --rp_) {
    TILE_IDS;
    convert_range(a, a.cv_lo[0], a.cv_hi[0], bid, nblk, lds, tid);
    for (int i = bid * 256 + tid; i < (NIN - DIN_A) * 1024 / 8; i += nblk * 256) ((u32x4*)(a.WinT + (size_t)DIN_A * 1024))[i] = (u32x4){0u, 0u, 0u, 0u};
    rows_to_bf16(a.x, a.XB, a.RS1, NTOK, bid * 4 + wid, nblk * 4, lane);
    rows_to_bf16(a.mem, a.MEMB, a.RSM, NB * MEMT, bid * 4 + wid, nblk * 4, lane);
    for (int o = bid * 4 + wid; o < 256; o += nblk * 4) {
      const int which = o >> 7, u = o & 127; const float* pos = which ? a.posv : a.posk; const float* w1 = which ? a.cvw1 : a.ckw1;
      float sacc = 0.f;
      for (int f = lane; f < 2048; f += 64) sacc += pos[f] * w1[(size_t)f * 128 + u];
      sacc = wave_sum(sacc);
      if (lane == 0) a.POSW[o] = sacc;
    }
  }
  SYNC_AFTER(0);
#pragma unroll 1
  for (int rp_ = PH(1) ? a.rep[1] : 0; rp_ > 0; --rp_) {
    TILE_IDS;
    {
      TILE8_IDS;
      ListSched<MapInProj> S8{pbid >> 3, pnblk >> 3, 112, MapInProj{a.XB, a.WinT, xcd}};
      EpiInProj8 E8{a.QK, a.V, a.O, a.NQ, a.KVC, a.KS, a.KW, a.VST, a.VWT, a.SM, a.RS1};
      pg8::gemm_phase<EpiInProj8, ListSched<MapInProj>, true, true>((PG8_LAS unsigned char*)plds, pg8::Gemm{DM}, S8, E8, t512, wave_s);
    }
    if ((pbid >> 3) >= 16) convert_range(a, a.cv_lo[1], a.cv_hi[1], ((xcd * 16 + (pbid >> 3) - 16) * 2 + half), (pnblk >> 1) * 2, lds, tid);
  }
  SYNC_AFTER(1);
#pragma unroll 1
  for (int rp_ = PH(2) ? a.rep[2] : 0; rp_ > 0; --rp_) {
    TILE_IDS;
    for (int it = bid; it < 128; it += nblk) {
      const int which = it >> 6, m0 = ((it >> 2) & 15) * 128, slab = it & 3;
      f32x4 acc[4][4]; zero_acc(acc);
      {
        int tid2 = tid; asm volatile("" : "+v"(tid2));
        unsigned ao[4], bo[4];
#pragma unroll
        for (int i = 0; i < 4; ++i) {
          const int row = st_row(tid2, i), lc = st_lc(tid2, i);
          const int m = m0 + row, bg = m >> 8, j = m & 255;
          ao[i] = (unsigned)((bg >> 1) * SEQ + 16 * j + slab * 8) * 256u + which * 128 + (bg & 1) * 64 + lc * 8;
          bo[i] = (unsigned)row * 2048u + slab * 512 + lc * 8;
        }
        gemm_core(acc, a.KVC, ao, 256u, which ? a.CV1T : a.CK1T, bo, 64u, 8, lds, tid2);
      }
      float* cp = a.CPART + (size_t)((which * 4 + slab) * 2048 + m0) * 128;
#pragma unroll
      for (int mi = 0; mi < 4; ++mi)
#pragma unroll
        for (int ni = 0; ni < 4; ++ni) *(f32x4*)(cp + (wr * 64 + mi * 16 + fr) * 128 + wc * 64 + ni * 16 + 4 * fq) = acc[mi][ni];
    }
    for (int q = nloc - 1 - li; q < 16; q += nloc) {
      f32x4 acc[4][4]; zero_acc(acc);
      const int tile = xcd * 16 + q; constexpr int T1 = 0, T2n = 16;
        const int t2 = tile - T1; const int m0 = (t2 / T2n) * 128, n0 = (t2 % T2n) * 128;
        if (n0 < 1024) {
          gemm_acc(acc, a.MEMB, DM, (const int*)nullptr, 0, 0, a.WkvT, DM, DM, lds, m0, n0, tid);
#pragma unroll
          for (int mi = 0; mi < 4; ++mi) {
            const int m = m0 + wr * 64 + mi * 16 + fr; const float rs = a.RSM[m];
#pragma unroll
            for (int ni = 0; ni < 4; ++ni) st_bf4(a.KVM + (size_t)m * 1024 + n0 + wc * 64 + ni * 16 + 4 * fq, acc[mi][ni] * rs);
          }
        } else {
          gemm_acc(acc, a.WkvT, DM, (const int*)nullptr, 0, 0, a.MEMB, DM, DM, lds, n0, m0, tid);
          bf16_t* vmt = a.KVM + (size_t)1024 * 1024;
#pragma unroll
          for (int ni = 0; ni < 4; ++ni) {
            const int tok = m0 + wc * 64 + ni * 16 + 4 * fq; const f32x4 rs = *(const f32x4*)(a.RSM + tok);
            const int b = tok >> 8, key = tok & 255;
#pragma unroll
            for (int mi = 0; mi < 4; ++mi) {
              const int col = n0 - 1024 + wr * 64 + mi * 16 + fr;
              st_bf4(vmt + ((size_t)(b * 1024 + col) << 8) + key, acc[mi][ni] * rs);
            }
          }
        }
    }
    for (int lp = pbid >> 3; lp < 32; lp += pnblk >> 3) nsa_win_item(a, ((((((xcd >> 1) & 1) * 2 + half) * 2 + (xcd & 1)) << 6)) | (63 - (2 * lp + (xcd >> 2))), lds, tid);
    {
      volatile int* wqw = (volatile int*)(lds + MEGA_LDS - 32);
      (void)wqw;
      for (;;) {
        if (wave_s == 0 && lane == 0) xch[2] = atomicAdd(a.WQ + 1, 2);
        __syncthreads();
        const int it0 = xch[2];
        __syncthreads();
        if (it0 >= 1024) break;
        ml_dc_item(a, a.ml, it0 + half, lds, tid);
      }
    }
  }
  SYNC_AFTER(2);
#pragma unroll 1
  for (int rp_ = PH(3) ? a.rep[3] : 0; rp_ > 0; --rp_) {
    TILE_IDS;
    if (rp_ == 1) for (int it = bid; it < 272; it += nblk) ml_scan_item(a.ml, it, tid);
    for (int it = nblk - 1 - bid; it < 128; it += nblk) {
      const int which = it >> 6, m0 = (it & 63) * 32;
      float* hid = (float*)lds;
      float* w2s = (float*)(lds + 16640);
      {
        const float* w2 = which ? a.cvw2 : a.ckw2;
#pragma unroll
        for (int c = 0; c < 8; ++c) *(f32x4*)(w2s + (tid + 256 * c) * 4) = *(const f32x4*)(w2 + (tid + 256 * c) * 4);
        const int row = tid >> 3, u0 = (tid & 7) * 16;
        const float* cp = a.CPART + (size_t)(which * 4 * 2048 + m0 + row) * 128 + u0;
#pragma unroll
        for (int c4 = 0; c4 < 4; ++c4) {
          f32x4 hv = *(const f32x4*)(cp + c4 * 4) + *(const f32x4*)(cp + 2048 * 128 + c4 * 4) + *(const f32x4*)(cp + 2 * 2048 * 128 + c4 * 4) + *(const f32x4*)(cp + 3 * 2048 * 128 + c4 * 4)
                   + *(const f32x4*)(a.POSW + which * 128 + u0 + c4 * 4);
#pragma unroll
          for (int j = 0; j < 4; ++j) hid[row * 129 + u0 + c4 * 4 + j] = gelu_tanh(hv[j]);
        }
      }
      __syncthreads();
      {
        const int row = tid >> 3, d0 = (tid & 7) * 8;
        float o[8];
#pragma unroll
        for (int d = 0; d < 8; ++d) o[d] = 0.f;
        for (int u = 0; u < 128; ++u) {
          const float hv = hid[row * 129 + u]; const f32x4 w0 = *(const f32x4*)(w2s + u * 64 + d0), w1 = *(const f32x4*)(w2s + u * 64 + d0 + 4);
          o[0] += hv * w0[0]; o[1] += hv * w0[1]; o[2] += hv * w0[2]; o[3] += hv * w0[3]; o[4] += hv * w1[0]; o[5] += hv * w1[1]; o[6] += hv * w1[2]; o[7] += hv * w1[3];
        }
        const int m = m0 + row, bg = m >> 8, j = m & 255;
        if (which == 0) {
#pragma unroll
          for (int d = 0; d < 8; ++d) a.KC[(size_t)m * 64 + d0 + d] = (j == 255) ? (bf16_t)0 : f2bf(o[d]);
        } else {
#pragma unroll
          for (int d = 0; d < 8; ++d) a.VCT[((size_t)(bg * 64 + d0 + d) << 8) + j] = (j == 255) ? (bf16_t)0 : f2bf(o[d]);
        }
      }
      __syncthreads();
    }
  }
  SYNC_AFTER(3);
#pragma unroll 1
  for (int rp_ = PH(4) ? a.rep[4] : 0; rp_ > 0; --rp_) {
    for (int lp = pbid >> 3; lp < 32; lp += pnblk >> 3) { TILE_IDS; nsa_main_item(a, ((((((xcd >> 1) & 1) * 2 + half) * 2 + (xcd & 1)) << 6)) | (63 - (2 * lp + (xcd >> 2))), lds, tid, xch, half); }
    { TILE_IDS;
      volatile int* wqw = (volatile int*)(lds + MEGA_LDS - 32);
      (void)wqw;
      for (;;) {
        if (wave_s == 0 && lane == 0) xch[2] = atomicAdd(a.WQ, 2);
        __syncthreads();
        const int it0 = xch[2];
        __syncthreads();
        if (it0 >= 1024) break;
        ml_out_item(a, a.ml, it0 + half, lds, tid);
      } }
  }
  SYNC_AFTER(4);
#pragma unroll 1
  for (int rp_ = PH(5) ? a.rep[5] : 0; rp_ > 0; --rp_) {
    TILE_IDS;
    for (int q = li; q < 128; q += nloc) {
      const int m0 = (xcd * 16 + (q >> 6) * 8 + (q & 7)) * 128, n0 = ((q >> 3) & 7) * 128;
      f32x4 acc[4][4]; u32x2 gp[4][4], rp[4][4];
#pragma unroll
      for (int mi = 0; mi < 4; ++mi)
#pragma unroll
        for (int ni = 0; ni < 4; ++ni) rp[mi][ni] = (u32x2){0u, 0u};
#pragma unroll 1
      for (int br = 0; br < 2; ++br) {
        zero_acc(acc);
        gemm_acc(acc, a.XB, DM, (const int*)nullptr, 0, 0, a.WgT + (size_t)br * 1024 * DM, DM, DM, lds, m0, n0, tid);
#pragma unroll
        for (int mi = 0; mi < 4; ++mi) {
          const float rs = a.RS1[m0 + wr * 64 + mi * 16 + fr];
#pragma unroll
          for (int ni = 0; ni < 4; ++ni) {
            f32x4 g = acc[mi][ni] * rs;
            gp[mi][ni].x = pk2bf(sigmoidf_(g[0]), sigmoidf_(g[1])); gp[mi][ni].y = pk2bf(sigmoidf_(g[2]), sigmoidf_(g[3]));
          }
        }
        zero_acc(acc);
        gemm_acc(acc, br ? a.ANS : a.AML, 512, (const int*)nullptr, 0, 0, br ? a.WnsT : a.WmlT, 512, 512, lds, m0, n0, tid);
#pragma unroll
        for (int mi = 0; mi < 4; ++mi)
#pragma unroll
          for (int ni = 0; ni < 4; ++ni) {
            f32x4 g; g[0] = __uint_as_float(gp[mi][ni].x << 16); g[1] = __uint_as_float(gp[mi][ni].x & 0xffff0000u);
            g[2] = __uint_as_float(gp[mi][ni].y << 16); g[3] = __uint_as_float(gp[mi][ni].y & 0xffff0000u);
            f32x4 r = g * acc[mi][ni];
            r[0] += __uint_as_float(rp[mi][ni].x << 16); r[1] += __uint_as_float(rp[mi][ni].x & 0xffff0000u);
            r[2] += __uint_as_float(rp[mi][ni].y << 16); r[3] += __uint_as_float(rp[mi][ni].y & 0xffff0000u);
            rp[mi][ni].x = pk2bf(r[0], r[1]); rp[mi][ni].y = pk2bf(r[2], r[3]);
          }
      }
#pragma unroll
      for (int mi = 0; mi < 4; ++mi) {
        const int m = m0 + wr * 64 + mi * 16 + fr;
#pragma unroll
        for (int ni = 0; ni < 4; ++ni) *(u32x2*)(a.MRG + (size_t)m * 1024 + n0 + wc * 64 + ni * 16 + 4 * fq) = rp[mi][ni];
      }
    }
    convert_range(a, a.cv_lo[5], a.cv_hi[5], bid, nblk, lds, tid);
  }
  SYNC_AFTER(5);
#pragma unroll 1
  for (int rp_ = PH(6) ? a.rep[6] : 0; rp_ > 0; --rp_) {
    TILE_IDS;
    {
      TILE8_IDS;
      ListSched<MapMN> S8{pbid >> 3, pnblk >> 3, 32, MapMN{a.MRG, a.WoutT, DM, xcd}};
      EpiX1 E8{a.x, a.X1B, a.PS2};
      pg8::gemm_phase<decltype(E8), ListSched<MapMN>, false, true>((PG8_LAS unsigned char*)plds, pg8::Gemm{DM}, S8, E8, t512, wave_s);
    }
    convert_range(a, a.cv_lo[6], a.cv_hi[6], bid, nblk, lds, tid);
  }
  SYNC_AFTER(6);
#pragma unroll 1
  for (int rp_ = PH(7) ? a.rep[7] : 0; rp_ > 0; --rp_) {
    TILE_IDS;
    {
      TILE8_IDS;
      ListSched<MapMN> S8{pbid >> 3, pnblk >> 3, 32, MapMN{a.X1B, a.WqT, DM, xcd}};
      EpiXQ E8{a.XQ, a.PS2};
      pg8::gemm_phase<decltype(E8), ListSched<MapMN>, false, true>((PG8_LAS unsigned char*)plds, pg8::Gemm{DM}, S8, E8, t512, wave_s);
    }
    convert_range(a, a.cv_lo[7], a.cv_hi[7], bid, nblk, lds, tid);
  }
  SYNC_AFTER(7);
#pragma unroll 1
  for (int rp_ = PH(8) ? a.rep[8] : 0; rp_ > 0; --rp_) {
    TILE_IDS;
    float* RMX = (float*)lds; float* RSUM = (float*)(lds + 1024);
    for (int q = li; q < 64; q += nloc) {
      const int m0 = (xcd * 16 + (q >> 2)) * 128, hh = q & 3, b = m0 >> 12;
      bf16_t* Qh = a.XQ + hh * 256;
      const bf16_t* Kh = a.KVM + (size_t)(b * 256) * 1024 + hh * 256;
      const bf16_t* Vh = a.KVM + (size_t)1024 * 1024 + ((size_t)(b * 1024 + hh * 256) << 8);
      f32x4 acc0[4][4], acc1[4][4]; zero_acc(acc0); zero_acc(acc1);
      gemm_acc(acc0, Qh, 1024, (const int*)nullptr, 0, 0, Kh, 1024, 256, lds, m0, 0, tid);
      gemm_acc(acc1, Qh, 1024, (const int*)nullptr, 0, 0, Kh, 1024, 256, lds, m0, 128, tid);
      float mloc[4];
#pragma unroll
      for (int mi = 0; mi < 4; ++mi) {
        float mx = -INFINITY;
#pragma unroll
        for (int ni = 0; ni < 4; ++ni)
#pragma unroll
          for (int j = 0; j < 4; ++j) mx = fmaxf(mx, fmaxf(acc0[mi][ni][j], acc1[mi][ni][j]));
        mx = max4(mx); mloc[mi] = mx;
        if (fq == 0) RMX[(wr * 64 + mi * 16 + fr) * 2 + wc] = mx;
      }
      __syncthreads();
#pragma unroll
      for (int mi = 0; mi < 4; ++mi) {
        const int r = wr * 64 + mi * 16 + fr;
        const float m = fmaxf(RMX[r * 2], RMX[r * 2 + 1]); float ls = 0.f;
#pragma unroll
        for (int ni = 0; ni < 4; ++ni)
#pragma unroll
          for (int j = 0; j < 4; ++j) {
            acc0[mi][ni][j] = __expf((acc0[mi][ni][j] - m) * 0.0625f); acc1[mi][ni][j] = __expf((acc1[mi][ni][j] - m) * 0.0625f);
            ls += acc0[mi][ni][j] + acc1[mi][ni][j];
          }
        ls = red4(ls);
        if (fq == 0) RSUM[r * 2 + wc] = ls;
      }
      __syncthreads();
#pragma unroll
      for (int mi = 0; mi < 4; ++mi) {
        const int r = wr * 64 + mi * 16 + fr;
        const float inv = 1.f / (RSUM[r * 2] + RSUM[r * 2 + 1]);
        bf16_t* pr = Qh + (size_t)(m0 + r) * 1024 + wc * 64 + 4 * fq;
#pragma unroll
        for (int ni = 0; ni < 4; ++ni) { st_bf4(pr + ni * 16, acc0[mi][ni] * inv); st_bf4(pr + 128 + ni * 16, acc1[mi][ni] * inv); }
      }
      asm volatile("s_waitcnt vmcnt(0)" ::: "memory");
      __threadfence_block();
      __syncthreads();
#pragma unroll 1
      for (int dh = 0; dh < 2; ++dh) {
        zero_acc(acc0);
        gemm_acc(acc0, Qh, 1024, (const int*)nullptr, 0, 0, Vh, 256, 256, lds, m0, dh * 128, tid);
#pragma unroll
        for (int mi = 0; mi < 4; ++mi) {
          const int r = wr * 64 + mi * 16 + fr;
#pragma unroll
          for (int ni = 0; ni < 4; ++ni) st_bf4(a.XO + (size_t)(m0 + r) * 1024 + hh * 256 + dh * 128 + wc * 64 + ni * 16 + 4 * fq, acc0[mi][ni]);
        }
      }
    }
    convert_range(a, a.cv_lo[8], a.cv_hi[8], bid, nblk, lds, tid);
  }
  SYNC_AFTER(8);
#pragma unroll 1
  for (int rp_ = PH(9) ? a.rep[9] : 0; rp_ > 0; --rp_) {
    TILE_IDS;
    {
      TILE8_IDS;
      ListSched<MapMN> S8{pbid >> 3, pnblk >> 3, 32, MapMN{a.XO, a.WoT, DM, xcd}};
      EpiX2 E8{a.X1B};
      pg8::gemm_phase<decltype(E8), ListSched<MapMN>, false, true>((PG8_LAS unsigned char*)plds, pg8::Gemm{DM}, S8, E8, t512, wave_s);
    }
    convert_range(a, a.cv_lo[9], a.cv_hi[9], bid, nblk, lds, tid);
  }
  SYNC_AFTER(9);
#pragma unroll 1
  for (int rp_ = PH(10) ? a.rep[10] : 0; rp_ > 0; --rp_) {
    TILE_IDS;
    const int tpb = NTOK / nblk;
    int* ex_l = (int*)(lds + 65536);
    float* we_l = (float*)lds;
    for (int c = tid; c < 4096; c += 256) { const int k = c >> 2, q = c & 3; *(f32x4*)(we_l + (q * 1024 + k) * 4) = *(const f32x4*)(a.we + k * 16 + q * 4); }
    __syncthreads();
    for (int k = 0; k < tpb / 4; ++k) {
      const int tl = wid * (tpb / 4) + k, n = bid * tpb + tl;
      int lane = tid & 63; asm volatile("" : "+v"(lane));
      const bf16_t* xr = a.H3 + (size_t)n * DM;
      float v[16]; float s = 0.f;
#pragma unroll
      for (int i = 0; i < 16; ++i) { v[i] = bf2f(xr[lane + 64 * i]); s += v[i] * v[i]; }
      s = wave_sum(s);
      const float rs = rsqrtf(s * (1.f / DM) + EPS);
      float lg[20];
#pragma unroll
      for (int e = 0; e < 20; ++e) lg[e] = 0.f;
#pragma unroll
      for (int i = 0; i < 16; ++i) {
        const int k2 = lane + 64 * i; const float hk = v[i] * rs * a.g_ffn[k2];
        const f32x4 wgv = *(const f32x4*)(a.wg + k2 * 4);
#pragma unroll
        for (int e = 0; e < 4; ++e) lg[e] += hk * wgv[e];
#pragma unroll
        for (int q = 0; q < 4; ++q) { const f32x4 wv = *(const f32x4*)(we_l + (q * 1024 + k2) * 4);
#pragma unroll
          for (int e = 0; e < 4; ++e) lg[4 + q * 4 + e] += hk * wv[e]; }
      }
#pragma unroll
      for (int e = 0; e < 20; ++e) lg[e] = wave_sum(lg[e]);
      if (lane == 0) {
        float gl[4]; float gm = -INFINITY; int gi = 0;
#pragma unroll
        for (int e = 0; e < 4; ++e) { gl[e] = lg[e] + a.bg[e]; if (gl[e] > gm) { gm = gl[e]; gi = e; } }
        float gs = 0.f;
#pragma unroll
        for (int e = 0; e < 4; ++e) gs += __expf(gl[e] - gm);
        const float gval = 1.f / gs;
        float el[4] = {0.f, 0.f, 0.f, 0.f};
#pragma unroll
        for (int gg = 0; gg < 4; ++gg) if (gi == gg) {
#pragma unroll
          for (int e = 0; e < 4; ++e) el[e] = lg[4 + gg * 4 + e] + a.be[gg * 4 + e];
        }
        int i0 = 0; float v0 = el[0];
#pragma unroll
        for (int e = 1; e < 4; ++e) if (el[e] > v0) { v0 = el[e]; i0 = e; }
        int i1 = -1; float v1 = -INFINITY;
#pragma unroll
        for (int e = 0; e < 4; ++e) if (e != i0 && el[e] > v1) { v1 = el[e]; i1 = e; }
        const float e1 = __expf(v1 - v0);
        ex_l[tl * 2] = gi * 4 + i0; ex_l[tl * 2 + 1] = gi * 4 + i1;
        a.RTW[n * 2] = gval / (1.f + e1); a.RTW[n * 2 + 1] = gval * e1 / (1.f + e1);
        a.RS3[n] = rs;
      }
    }
    __syncthreads();
    if (tid < 16) {
      int cnt = 0;
      for (int j = 0; j < 2 * tpb; ++j) cnt += (ex_l[j] == tid) ? 1 : 0;
      if (cnt > 0) {
        int pos = atomicAdd(&a.CNT[tid], cnt);
        for (int j = 0; j < 2 * tpb; ++j) if (ex_l[j] == tid) a.LIST[tid * NTOK + pos++] = (bid * tpb) * 2 + j;
      }
    }
    __syncthreads();
  }
  SYNC_AFTER(10);
#pragma unroll 1
  for (int ph = 11; ph <= 12; ++ph) {
#pragma unroll 1
    for (int rp_ = PH(ph) ? a.rep[ph] : 0; rp_ > 0; --rp_) {
      TILE8_IDS;
      int rtot = 0;
      for (int e = 0; e < 16; ++e) rtot += (a.CNT[e] + 255) >> 8;
      const int nmine = ((rtot - xcd + 7) >> 3) * 4;
      if (ph == 11) {
        ListSched<MapMoe> S8{pbid >> 3, pnblk >> 3, nmine, MapMoe{a.CNT, a.LIST, a.H3, a.W13T, (size_t)1024 * 1024, DM, xcd, 1}};
        EpiMoe1 E8{a.LIST, a.RS3, a.ACT};
        pg8::gemm_phase<EpiMoe1, ListSched<MapMoe>, true, true>((PG8_LAS unsigned char*)plds, pg8::Gemm{DM}, S8, E8, t512, wave_s);
      } else {
        ListSched<MapMoe> S8{pbid >> 3, pnblk >> 3, nmine, MapMoe{a.CNT, a.LIST, a.ACT, a.W2T, (size_t)1024 * 512, 512, xcd, 0}};
        EpiMoe2 E8{a.LIST, a.RTW, a.Y};
        pg8::gemm_phase<EpiMoe2, ListSched<MapMoe>, true, true>((PG8_LAS unsigned char*)plds, pg8::Gemm{512}, S8, E8, t512, wave_s);
      }
    }
    if (PH(ph) && PH(ph + 1)) GRID_BAR();
  }
#pragma unroll 1
  for (int rp_ = PH(13) ? a.rep[13] : 0; rp_ > 0; --rp_) {
    TILE_IDS;
    for (int row = bid * 4 + wid; row < NTOK; row += nblk * 4) {
      f32x4* xr = (f32x4*)(a.out + (size_t)row * DM) + lane;
      const u32x2* x2r = (const u32x2*)(a.H3 + (size_t)row * DM) + lane;
      const u32x2* y0 = (const u32x2*)(a.Y + (size_t)(row * 2) * DM) + lane; const u32x2* y1 = y0 + DM / 4;
      f32x4 v[4]; float s = 0.f;
#pragma unroll
      for (int j = 0; j < 4; ++j) {
        { const u32x2 xx = x2r[64 * j]; v[j][0] = __uint_as_float(xx.x << 16); v[j][1] = __uint_as_float(xx.x & 0xffff0000u); v[j][2] = __uint_as_float(xx.y << 16); v[j][3] = __uint_as_float(xx.y & 0xffff0000u); }
        const u32x2 p = y0[64 * j], q = y1[64 * j];
        v[j][0] += __uint_as_float(p.x << 16) + __uint_as_float(q.x << 16); v[j][1] += __uint_as_float(p.x & 0xffff0000u) + __uint_as_float(q.x & 0xffff0000u);
        v[j][2] += __uint_as_float(p.y << 16) + __uint_as_float(q.y << 16); v[j][3] += __uint_as_float(p.y & 0xffff0000u) + __uint_as_float(q.y & 0xffff0000u);
        s += v[j][0] * v[j][0] + v[j][1] * v[j][1] + v[j][2] * v[j][2] + v[j][3] * v[j][3];
      }
      s = wave_sum(s);
      const float rs = rsqrtf(s * (1.f / DM) + EPS);
#pragma unroll
      for (int j = 0; j < 4; ++j) xr[64 * j] = v[j] * rs * ((const f32x4*)a.g_final)[lane + 64 * j];
    }
  }
}

extern "C" void kernel_launch(void* const* d_in, const int* in_sizes, int n_in, void* d_out, int out_size, void* d_ws, size_t ws_size, hipStream_t stream) {
  const float* x = (const float*)d_in[0];
  const float* mem = (const float*)d_in[1];
  const float* norm_mix = (const float*)d_in[2];
  const float* w_in = (const float*)d_in[3];
  const float* conv_qk = (const float*)d_in[4];
  const float* b_igate = (const float*)d_in[5];
  const float* b_fgate = (const float*)d_in[6];
  const float* mlstm_norm = (const float*)d_in[7];
  const float* cmp_pos_k = (const float*)d_in[8];
  const float* cmp_pos_v = (const float*)d_in[9];
  const float* cmp_k_w1 = (const float*)d_in[10];
  const float* cmp_k_w2 = (const float*)d_in[11];
  const float* cmp_v_w1 = (const float*)d_in[12];
  const float* cmp_v_w2 = (const float*)d_in[13];
  const float* w_br_mlstm = (const float*)d_in[14];
  const float* w_br_nsa = (const float*)d_in[15];
  const float* w_mix_out = (const float*)d_in[16];
  const float* norm_xattn = (const float*)d_in[17];
  const float* norm_mem = (const float*)d_in[18];
  const float* xa_wq = (const float*)d_in[19];
  const float* xa_wkv = (const float*)d_in[20];
  const float* xa_wo = (const float*)d_in[21];
  const float* norm_ffn = (const float*)d_in[22];
  const float* router_group_w = (const float*)d_in[23];
  const float* router_group_b = (const float*)d_in[24];
  const float* router_expert_w = (const float*)d_in[25];
  const float* router_expert_b = (const float*)d_in[26];
  const float* moe_w1 = (const float*)d_in[27];
  const float* moe_w3 = (const float*)d_in[28];
  const float* moe_w2 = (const float*)d_in[29];
  const float* norm_final = (const float*)d_in[30];
  float* out = (float*)d_out;
  char* ws = (char*)d_ws;

  int* CNT = (int*)(ws + WS_CNT); int* LIST = (int*)(ws + WS_LIST); float* RTW = (float*)(ws + WS_RTW);
  float* SM = (float*)(ws + WS_SM); float* BCUM = (float*)(ws + WS_BCUM); float* IP = (float*)(ws + WS_IP);
  float* BL = (float*)(ws + WS_BL); float* MX = (float*)(ws + WS_MX); float* MST = (float*)(ws + WS_MST); float* NST = (float*)(ws + WS_NST);
  bf16_t* KC = (bf16_t*)(ws + WS_KC); bf16_t* VC = (bf16_t*)(ws + WS_VC);
  bf16_t* QK = (bf16_t*)(ws + WS_QK); bf16_t* V = (bf16_t*)(ws + WS_V); bf16_t* O = (bf16_t*)(ws + WS_O);
  bf16_t* NQ = (bf16_t*)(ws + WS_NQ); bf16_t* KV = (bf16_t*)(ws + WS_KV); bf16_t* CST = (bf16_t*)(ws + WS_CST);
  bf16_t* AML = (bf16_t*)(ws + WS_AML); bf16_t* ANS = (bf16_t*)(ws + WS_ANS); bf16_t* MRG = (bf16_t*)(ws + WS_MRG);
  bf16_t* KVM = (bf16_t*)(ws + WS_KVM); bf16_t* MEMN = (bf16_t*)(ws + WS_MEMN);
  bf16_t* H2 = (bf16_t*)(ws + WS_H2); bf16_t* XQ = (bf16_t*)(ws + WS_XQ); bf16_t* XO = (bf16_t*)(ws + WS_XO);
  bf16_t* H3 = H2; bf16_t* ACT = XQ; bf16_t* Y = (bf16_t*)(ws + 136 * MiB);
  bf16_t* H = (bf16_t*)d_out;
  bf16_t* T2 = (bf16_t*)((char*)d_out + 32 * MiB);

  (void)hipMemsetAsync(ws, 0, 131072, stream);
  static int grid_blocks = 0;
  if (!grid_blocks) {
    int dev = 0, cus = 0, per_cu = 0;
    (void)hipGetDevice(&dev);
    (void)hipDeviceGetAttribute(&cus, hipDeviceAttributeMultiprocessorCount, dev);
    (void)hipFuncSetAttribute((const void*)k_mega, hipFuncAttributeMaxDynamicSharedMemorySize, TOTAL_LDS);
    (void)hipOccupancyMaxActiveBlocksPerMultiprocessor(&per_cu, (const void*)k_mega, 512, TOTAL_LDS);
    if (per_cu > 1) per_cu = 1;
    if (per_cu < 1) per_cu = 1;
    grid_blocks = cus * per_cu;
  }
  MegaArgs fa{};
  fa.x = x; fa.mem = mem; fa.out = out; fa.BAR = (unsigned*)(ws + 65536);
  fa.ml.conv = conv_qk; fa.ml.b_i = b_igate; fa.ml.b_f = b_fgate; fa.ml.gain = mlstm_norm;
  fa.ml.BCUM = BCUM; fa.ml.IP = IP; fa.ml.BL = BL; fa.ml.MX = MX; fa.ml.MST = MST; fa.ml.NST = NST; fa.ml.CST = CST;
  fa.XB = (bf16_t*)d_out; fa.MEMB = (bf16_t*)(ws + WS_MEMB); fa.RS1 = (float*)(ws + WS_RS1); fa.RSM = (float*)(ws + WS_RSM); fa.PS2 = (float*)(ws + WS_PS2);
  fa.QK = QK; fa.V = V; fa.O = O; fa.NQ = NQ; fa.SM = SM;
  fa.KVC = (bf16_t*)(ws + WS_KVC); fa.KS = (bf16_t*)(ws + WS_KS); fa.KW = (bf16_t*)(ws + WS_KW); fa.VST = (bf16_t*)(ws + WS_VST); fa.VWT = (bf16_t*)(ws + WS_VWT);
  fa.KC = KC; fa.VCT = VC; fa.CK1T = (bf16_t*)(ws + WS_CK1T); fa.CV1T = (bf16_t*)(ws + WS_CV1T); fa.POSW = (float*)(ws + WS_POSW);
  fa.posk = cmp_pos_k; fa.posv = cmp_pos_v; fa.ckw1 = cmp_k_w1; fa.cvw1 = cmp_v_w1; fa.ckw2 = cmp_k_w2; fa.cvw2 = cmp_v_w2;
  fa.AML = AML; fa.ANS = ANS; fa.MRG = MRG; fa.X1B = H2; fa.XQ = XQ; fa.XO = XO; fa.KVM = KVM;
  fa.WinT = (bf16_t*)(ws + WS_WIN_T); fa.WgT = (bf16_t*)(ws + WS_WG_T); fa.WmlT = (bf16_t*)(ws + WS_WML_T); fa.WnsT = (bf16_t*)(ws + WS_WNS_T);
  fa.H3 = H3; fa.ACT = ACT; fa.Y = Y; fa.W13T = (bf16_t*)(ws + 104 * MiB); fa.W2T = (bf16_t*)(ws + 240 * MiB);
  fa.CPART = (float*)(ws + 176 * MiB); fa.WQ = (int*)(ws + 256);
  fa.RS3 = (float*)(ws + WS_RSM + 8192); fa.RTW = RTW; fa.CNT = CNT; fa.LIST = LIST;
  fa.g_ffn = norm_ffn; fa.wg = router_group_w; fa.bg = router_group_b; fa.we = router_expert_w; fa.be = router_expert_b; fa.g_final = norm_final;
  fa.WoutT = (bf16_t*)(ws + WS_WOUT_T); fa.WqT = (bf16_t*)(ws + WS_WQ_T); fa.WkvT = (bf16_t*)(ws + WS_WKV_T); fa.WoT = (bf16_t*)(ws + WS_WO_T);
  {
    auto mk = [&](const float* src, bf16_t* dst, const float* gain, int ldw, int K, int c0, int ncols, int drow0) {
      TDesc d{}; d.src = src; d.dst = dst; d.gain = gain; d.ldw = ldw; d.K = K; d.c0 = c0; d.ncols = ncols; d.drow0 = drow0; d.per = (K / 64) * ((ncols + 63) / 64); d.nitems = d.per; d.mode = 0; d.rofs = 0; d.sstride = 0; d.dstride = 0; d.pad = 0; return d; };
    int n = 0;
    fa.td[n++] = mk(w_in, fa.WinT, norm_mix, DIN, DM, 0, 2048, 0);
    fa.td[n++] = mk(w_in, fa.WinT, norm_mix, DIN, DM, 2056, 512, 2048);
    fa.td[n++] = mk(w_in, fa.WinT, norm_mix, DIN, DM, 2568, 384, 2560);
    fa.td[n++] = mk(w_in, fa.WinT, norm_mix, DIN, DM, 3080, 128, 2944);
    fa.td[n++] = mk(w_in, fa.WinT, norm_mix, DIN, DM, 2952, 128, 3072);
    fa.td[n++] = mk(w_in, fa.WinT, norm_mix, DIN, DM, 3208, 128, 3200);
    fa.td[n++] = mk(w_in, fa.WinT, norm_mix, DIN, DM, 2048, 8, 3328);
    fa.td[n++] = mk(w_in, fa.WinT, norm_mix, DIN, DM, 3336, 24, 3336);
    fa.td[n++] = mk(w_in, fa.WgT, norm_mix, DIN, DM, 3360, 2048, 0);
    fa.td[n++] = mk(w_br_mlstm, fa.WmlT, nullptr, 1024, 512, 0, 1024, 0);
    fa.td[n++] = mk(w_br_nsa, fa.WnsT, nullptr, 1024, 512, 0, 1024, 0);
    fa.td[n++] = mk(w_mix_out, fa.WoutT, nullptr, 1024, 1024, 0, 1024, 0);
    fa.td[n++] = mk(xa_wq, fa.WqT, norm_xattn, 1024, 1024, 0, 1024, 0);
    fa.td[n++] = mk(xa_wkv, fa.WkvT, norm_mem, 2048, 1024, 0, 2048, 0);
    fa.td[n++] = mk(xa_wo, fa.WoT, nullptr, 1024, 1024, 0, 1024, 0);
    fa.td[n++] = mk(cmp_k_w1, fa.CK1T, nullptr, 128, 2048, 0, 128, 0);
    fa.td[n++] = mk(cmp_v_w1, fa.CV1T, nullptr, 128, 2048, 0, 128, 0);
    fa.ntdA = n;
    { TDesc d = mk(moe_w1, fa.W13T, norm_ffn, 512, 1024, 0, 512, 0); d.mode = 2; d.rofs = 0; d.nitems = 16 * d.per; d.sstride = 1024 * 512; d.dstride = 1024 * 1024; fa.td[n++] = d; }
    { TDesc d = mk(moe_w3, fa.W13T, norm_ffn, 512, 1024, 0, 512, 0); d.mode = 2; d.rofs = 16; d.nitems = 16 * d.per; d.sstride = 1024 * 512; d.dstride = 1024 * 1024; fa.td[n++] = d; }
    { TDesc d = mk(moe_w2, fa.W2T, nullptr, 1024, 512, 0, 1024, 0); d.nitems = 16 * d.per; d.sstride = 512 * 1024; d.dstride = 1024 * 512; fa.td[n++] = d; }
    fa.ntdB = n;
    int cum[25]; cum[0] = 0; for (int i = 0; i < n; ++i) cum[i + 1] = cum[i] + fa.td[i].nitems;
    for (int k = 0; k < 16; ++k) { fa.cv_lo[k] = 0; fa.cv_hi[k] = 0; }
    fa.cv_lo[0] = 0; fa.cv_hi[0] = cum[8];
    fa.cv_lo[1] = cum[8]; fa.cv_hi[1] = cum[fa.ntdA];
    { const int lo = cum[fa.ntdA], tot = cum[n] - lo; const int phs[5] = {5, 6, 7, 8, 9};
      for (int i = 0; i < 5; ++i) { fa.cv_lo[phs[i]] = lo + (int)((long long)tot * i / 5); fa.cv_hi[phs[i]] = lo + (int)((long long)tot * (i + 1) / 5); } }
  }
  int launch_i = 0;
  auto mega = [&](int lo, int hi) {
    fa.ph_lo = lo; fa.ph_hi = hi; fa.li = launch_i++; fa.pad = 0;
    for (int k = 0; k < 16; ++k) fa.rep[k] = 1;

    void* args[] = {&fa};
    (void)hipLaunchCooperativeKernel((const void*)k_mega, dim3(grid_blocks), dim3(512), args, TOTAL_LDS, stream);
  };
  mega(0, 14);
}
```

```cpp
#include <hip/hip_runtime.h>
#include <stdint.h>

typedef unsigned short bf16_t;
__device__ __forceinline__ float bf2f(bf16_t v) { return __uint_as_float(((unsigned)v) << 16); }
__device__ __forceinline__ bf16_t f2bf(float f) { unsigned u = __float_as_uint(f); return (bf16_t)((u + 0x7fffu + ((u >> 16) & 1u)) >> 16); }

constexpr int NB = 4, SEQ = 4096, NTOK = NB * SEQ, DM = 1024;
constexpr int DIN = 5408, DIN_A = 3360;
constexpr int MEMT = 256;
constexpr float EPS = 1e-6f;
constexpr size_t MiB = 1u << 20;

constexpr size_t WS_CNT = 0;
constexpr size_t WS_LIST = 1 * MiB;
constexpr size_t WS_RTW = 2 * MiB;
constexpr size_t WS_SM = 3 * MiB;
constexpr size_t WS_BCUM = 5 * MiB;
constexpr size_t WS_IP = 5 * MiB + 256 * 1024;
constexpr size_t WS_BL = 5 * MiB + 512 * 1024;
constexpr size_t WS_MX = WS_BL + 4096;
constexpr size_t WS_MST = WS_MX + 4096;
constexpr size_t WS_NST = 6 * MiB;
constexpr size_t WS_KC = 7 * MiB;
constexpr size_t WS_VC = 7 * MiB + 512 * 1024;
constexpr size_t WS_QK = 8 * MiB;
constexpr size_t WS_V = 40 * MiB;
constexpr size_t WS_O = 56 * MiB;
constexpr size_t WS_NQ = 72 * MiB;
constexpr size_t WS_KV = 88 * MiB;
constexpr size_t WS_CST = 112 * MiB;
constexpr size_t WS_AML = 144 * MiB;
constexpr size_t WS_ANS = 160 * MiB;
constexpr size_t WS_MRG = 176 * MiB;
constexpr size_t WS_KVM = 233 * MiB;
constexpr size_t WS_MEMN = 237 * MiB;
constexpr size_t WS_H2 = 8 * MiB;
constexpr size_t WS_XQ = 40 * MiB;
constexpr size_t WS_XO = 72 * MiB;
constexpr size_t WS_Y = 72 * MiB;

__device__ __forceinline__ float wave_sum(float v) {
#pragma unroll
  for (int o = 32; o > 0; o >>= 1) v += __shfl_xor(v, o);
  return v;
}
__device__ __forceinline__ float wave_max(float v) {
#pragma unroll
  for (int o = 32; o > 0; o >>= 1) v = fmaxf(v, __shfl_xor(v, o));
  return v;
}
__device__ __forceinline__ float sigmoidf_(float x) { return 1.f / (1.f + __expf(-x)); }
__device__ __forceinline__ float siluf_(float x) { return x / (1.f + __expf(-x)); }
__device__ __forceinline__ float logsigmoidf_(float x) { return fminf(x, 0.f) - log1pf(__expf(-fabsf(x))); }
__device__ __forceinline__ float gelu_tanh(float x) { float u = 0.7978845608028654f * (x + 0.044715f * x * x * x); return 0.5f * x * (1.f + tanhf(u)); }

#include <hip/hip_cooperative_groups.h>
namespace cg = cooperative_groups;
#define LAS __attribute__((address_space(3)))
typedef short bf16x8 __attribute__((ext_vector_type(8)));
typedef float f32x4 __attribute__((ext_vector_type(4)));
typedef unsigned u32x2 __attribute__((ext_vector_type(2)));
typedef unsigned u32x4 __attribute__((ext_vector_type(4)));

constexpr size_t WS_RS1 = 5 * MiB + 768 * 1024;
constexpr size_t WS_RSM = WS_RS1 + 65536;
constexpr size_t WS_PS2 = 4 * MiB;
constexpr size_t WS_WIN_T = 208 * MiB;
constexpr size_t WS_WG_T = 216 * MiB;
constexpr size_t WS_WML_T = 220 * MiB;
constexpr size_t WS_WNS_T = 221 * MiB;
constexpr size_t WS_WOUT_T = 222 * MiB;
constexpr size_t WS_WQ_T = 224 * MiB;
constexpr size_t WS_WKV_T = 226 * MiB;
constexpr size_t WS_WO_T = 230 * MiB;
constexpr size_t WS_MEMB = 238 * MiB;
constexpr size_t WS_KVC = WS_KV;
constexpr size_t WS_KS = WS_KV + 8 * MiB;
constexpr size_t WS_KW = WS_KV + 12 * MiB;
constexpr size_t WS_VST = WS_KV + 16 * MiB;
constexpr size_t WS_VWT = WS_KV + 20 * MiB;
constexpr size_t WS_CK1T = 232 * MiB;
constexpr size_t WS_CV1T = 232 * MiB + 512 * 1024;
constexpr size_t WS_POSW = WS_RSM + 8192 + 65536;
constexpr int NIN = 3584;

__device__ __forceinline__ unsigned pk2bf(float lo, float hi) { return (unsigned)f2bf(lo) | ((unsigned)f2bf(hi) << 16); }
__device__ __forceinline__ void st_bf4(bf16_t* p, f32x4 v) { u32x2 o; o.x = pk2bf(v[0], v[1]); o.y = pk2bf(v[2], v[3]); *(u32x2*)p = o; }

struct TDesc { const float* src; bf16_t* dst; const float* gain; int ldw, K, c0, ncols, drow0, nitems, mode, rofs, per, sstride, dstride, pad; };
__device__ __forceinline__ void transpose_item(const TDesc& d, int item, float* t  , int tid) {
  const int bat = item / d.per; item -= bat * d.per;
  const float* src = d.src + (size_t)bat * d.sstride; bf16_t* dst = d.dst + (size_t)bat * d.dstride;
  const int ncb = (d.ncols + 63) >> 6; const int kb = item / ncb, cb = item % ncb; const int k0 = kb * 64, n0 = cb * 64;
  {
    const int c4 = (tid & 15) * 4, kq = tid >> 4;
    f32x4 v[4];
#pragma unroll
    for (int p = 0; p < 4; ++p) {
      const int kk = p * 16 + kq;
      v[p] = (n0 + c4 < d.ncols) ? *(const f32x4*)(src + (size_t)(k0 + kk) * d.ldw + d.c0 + n0 + c4) : (f32x4){0.f, 0.f, 0.f, 0.f};
    }
#pragma unroll
    for (int p = 0; p < 4; ++p) {
      const int kk = p * 16 + kq; const float g = d.gain ? d.gain[k0 + kk] : 1.f;
      float* tp = t + kk * 65 + c4; tp[0] = v[p][0] * g; tp[1] = v[p][1] * g; tp[2] = v[p][2] * g; tp[3] = v[p][3] * g;
    }
  }
  __syncthreads();
#pragma unroll
  for (int j = 0; j < 2; ++j) {
    int c = tid + j * 256; int n = c >> 3, kc = c & 7;
    if (n0 + n < d.ncols) {
      const float* p = t + (kc * 8) * 65 + n;
      u32x4 o; o.x = pk2bf(p[0], p[65]); o.y = pk2bf(p[130], p[195]); o.z = pk2bf(p[260], p[325]); o.w = pk2bf(p[390], p[455]);
      const int drow = d.mode == 2 ? (d.drow0 + (cb * 4 + (n >> 4)) * 32 + (n & 15) + d.rofs) : d.mode ? (d.drow0 + cb * 128 + (n >> 5) * 64 + (n & 31) + d.rofs) : (d.drow0 + n0 + n);
      *(u32x4*)(dst + (size_t)drow * d.K + k0 + kc * 8) = o;
    }
  }
  __syncthreads();
}

__device__ __forceinline__ void rows_to_bf16(const float* __restrict__ src, bf16_t* __restrict__ dst, float* __restrict__ rs, int nrows, int gw, int ngw, int lane) {
  for (int row = gw; row < nrows; row += ngw) {
    const f32x4* xr = (const f32x4*)(src + (size_t)row * DM) + lane;
    f32x4 v[4]; float s = 0.f;
#pragma unroll
    for (int j = 0; j < 4; ++j) { v[j] = xr[64 * j]; s += v[j][0] * v[j][0] + v[j][1] * v[j][1] + v[j][2] * v[j][2] + v[j][3] * v[j][3]; }
    s = wave_sum(s);
    if (lane == 0) rs[row] = rsqrtf(s * (1.f / DM) + EPS);
#pragma unroll
    for (int j = 0; j < 4; ++j) st_bf4(dst + (size_t)row * DM + (lane + 64 * j) * 4, v[j]);
  }
}

__device__ __forceinline__ void glds16(const void* g, char* l) {
  __builtin_amdgcn_global_load_lds((const unsigned*)g, (LAS unsigned*)l, 16, 0, 0);
}
__device__ __forceinline__ int st_row(int tid, int i) { return (tid >> 3) + 32 * i; }
__device__ __forceinline__ int st_lc(int tid, int i) { return (tid & 7) ^ ((st_row(tid, i) >> 1) & 7); }
__device__ __forceinline__ void gemm_core(f32x4 (&acc)[4][4], const bf16_t* __restrict__ A, const unsigned (&ao)[4], unsigned ksa,
                                          const bf16_t* __restrict__ Bt, const unsigned (&bo)[4], unsigned ksb, int nt, char* lds, int tid) {
  const int lane = tid & 63, wid = tid >> 6, wr = wid >> 1, wc = wid & 1, fr = lane & 15, fq = lane >> 4;
  char* ldst = lds + tid * 16;
#pragma unroll
  for (int i = 0; i < 4; ++i) { glds16(A + ao[i], ldst + i * 4096); glds16(Bt + bo[i], ldst + 16384 + i * 4096); }
  const int sw = fr >> 1;
  const int aoff = (wr * 64 + fr) * 128, boff = (wc * 64 + fr) * 128;
  for (int t = 0; t < nt; ++t) {
    asm volatile("s_waitcnt vmcnt(0)" ::: "memory");
    __syncthreads();
    const int cur = t & 1;
    if (t + 1 < nt) {
      char* nb = ldst + (cur ^ 1) * 32768; const unsigned ka = (t + 1) * ksa, kb = (t + 1) * ksb;
#pragma unroll
      for (int i = 0; i < 4; ++i) { glds16(A + (ao[i] + ka), nb + i * 4096); glds16(Bt + (bo[i] + kb), nb + 16384 + i * 4096); }
    }
    const char* sA = lds + cur * 32768 + aoff; const char* sB = lds + cur * 32768 + 16384 + boff;
#pragma unroll
    for (int ks = 0; ks < 2; ++ks) {
      bf16x8 a[4], b[4];
      const int co = ((ks * 4 + fq) ^ sw) << 4;
#pragma unroll
      for (int i = 0; i < 4; ++i) { a[i] = *(const bf16x8*)(sA + i * 2048 + co); b[i] = *(const bf16x8*)(sB + i * 2048 + co); }
#pragma unroll
      for (int i = 0; i < 4; ++i)
#pragma unroll
        for (int j = 0; j < 4; ++j) acc[i][j] = __builtin_amdgcn_mfma_f32_16x16x32_bf16(b[j], a[i], acc[i][j], 0, 0, 0);
    }
  }
  __syncthreads();
}
__device__ __forceinline__ void gemm_acc(f32x4 (&acc)[4][4], const bf16_t* __restrict__ A, size_t lda, const int* __restrict__ arow, int ashift, int mvalid,
                                         const bf16_t* __restrict__ Bt, size_t ldb, int K, char* lds, int m0, int n0, int tid) {
  asm volatile("" : "+v"(tid));
  unsigned ao[4], bo[4];
#pragma unroll
  for (int i = 0; i < 4; ++i) {
    const int row = st_row(tid, i), lc = st_lc(tid, i);
    int gr;
    if (arow) { int mm = m0 + row; if (mm >= mvalid) mm = mvalid - 1; gr = arow[mm] >> ashift; } else gr = m0 + row;
    ao[i] = (unsigned)gr * (unsigned)lda + lc * 8;
    bo[i] = (unsigned)(n0 + row) * (unsigned)ldb + lc * 8;
  }
  gemm_core(acc, A, ao, 64u, Bt, bo, 64u, K >> 6, lds, tid);
}
__device__ __forceinline__ void zero_acc(f32x4 (&acc)[4][4]) {
#pragma unroll
  for (int i = 0; i < 4; ++i)
#pragma unroll
    for (int j = 0; j < 4; ++j) acc[i][j] = (f32x4){0.f, 0.f, 0.f, 0.f};
}


namespace pg8 {
#define PG8_LAS __attribute__((address_space(3)))
typedef unsigned short bf16_t;
typedef short bf16x8 __attribute__((ext_vector_type(8)));
typedef float f32x4 __attribute__((ext_vector_type(4)));
typedef unsigned u32x4 __attribute__((ext_vector_type(4)));
constexpr int BM = 256, BK = 64, HALF = 128, HTB = HALF * BK * 2  , STAGE_BYTES = 8 * HTB, NXCD = 8, WGM = 8;

__host__ __device__ __forceinline__ int lds_byte(int r, int c) { const int st = (r >> 4) * 2 + (c >> 5), rr = r & 15, cc = c & 31, ob = rr * 64 + cc * 2; return st * 1024 + (ob ^ (((ob >> 9) & 1) << 5)); }
__host__ __device__ __forceinline__ void stage_rc(int b, int& R, int& C) { const int st = b / 1024, sb = b % 1024, swz = sb ^ (((sb >> 9) & 1) << 5); R = (st >> 1) * 16 + swz / 64; C = (st & 1) * 32 + (swz % 64) / 2; }
__host__ __device__ __forceinline__ int perm32(int rho) { const int n = rho >> 4, i = rho & 15; return 8 * (i >> 2) + 4 * n + (i & 3); }

struct Unit { int pm, pn; const char* aptr; const char* bptr; int e, ce, p0, rt; };
struct Gemm { int K; };
template <class Epi, class Sched, bool ALIGN_EPI = false, bool SP2 = false, bool ACOH = false  >
__device__ __forceinline__ void gemm_phase(PG8_LAS unsigned char* lds, const Gemm g, const Sched& S, const Epi& E, int tid  , int wid  ) {
    asm volatile("" : "+v"(tid));
    const int lane = tid & 63, wr = wid >> 2, wc = wid & 3, fr = lane & 15, fq = lane >> 4;
    const int K = g.K, nt = K / BK;
    unsigned voffA[2], voffB[2];
#pragma unroll
    for (int i = 0; i < 2; ++i) { int R, C; stage_rc(tid * 16 + i * 8192, R, C); const int Rb = Epi::PERM ? ((R & ~31) + perm32(R & 31)) : R;
        voffA[i] = (unsigned)(R * K + C) * 2u; voffB[i] = (unsigned)(Rb * K + C) * 2u; }
    unsigned cva0[2], cva1[2], nva0[2], nva1[2];
    const size_t kstep = (size_t)(BK * 2);
    const size_t hstep = (size_t)HALF * K * 2;
    const unsigned ldsw = (unsigned)wid * 1024u;
    const int aoff = lds_byte(wr * 64 + fr, fq * 8), boff = lds_byte(wc * 32 + fr, fq * 8);
#define PG8_SA(b, h) (((b) * 2 + (h)) * HTB)
#define PG8_SB(b, h) ((4 + (b) * 2 + (h)) * HTB)
#define PG8_STAGE(bufoff, gbase, voff) do { _Pragma("unroll") for (int _i = 0; _i < 2; ++_i) \
        __builtin_amdgcn_global_load_lds((const unsigned*)((const char*)(gbase) + (voff)[_i]), (PG8_LAS unsigned*)(lds + (bufoff) + ldsw + _i * 8192), 16, 0, 0); } while (0)
#define PG8_STAGEA(bufoff, gbase, voff) do { _Pragma("unroll") for (int _i = 0; _i < 2; ++_i) { \
        if constexpr (ACOH) __builtin_amdgcn_global_load_lds((const unsigned*)((const char*)(gbase) + (voff)[_i]), (PG8_LAS unsigned*)(lds + (bufoff) + ldsw + _i * 8192), 16, 0, 16  ); \
        else __builtin_amdgcn_global_load_lds((const unsigned*)((const char*)(gbase) + (voff)[_i]), (PG8_LAS unsigned*)(lds + (bufoff) + ldsw + _i * 8192), 16, 0, 0); } } while (0)
#define PG8_LDA(dst, b, h) do { _Pragma("unroll") for (int m = 0; m < 4; ++m) _Pragma("unroll") for (int k = 0; k < 2; ++k) dst[m][k] = *(const PG8_LAS bf16x8*)(lds + PG8_SA(b, h) + aoff + m * 2048 + k * 1024); } while (0)
#define PG8_LDB(dst, b, h) do { _Pragma("unroll") for (int n = 0; n < 2; ++n) _Pragma("unroll") for (int k = 0; k < 2; ++k) dst[n][k] = *(const PG8_LAS bf16x8*)(lds + PG8_SB(b, h) + boff + n * 2048 + k * 1024); } while (0)
#define PG8_MMA(ai, bj, At, Bt) do { __builtin_amdgcn_s_setprio(1); _Pragma("unroll") for (int m = 0; m < 4; ++m) _Pragma("unroll") for (int n = 0; n < 2; ++n) _Pragma("unroll") for (int k = 0; k < 2; ++k) \
        acc[ai][bj][m][n] = __builtin_amdgcn_mfma_f32_16x16x32_bf16(Bt[n][k], At[m][k], acc[ai][bj][m][n], 0, 0, 0); __builtin_amdgcn_s_setprio(0); } while (0)
#define PG8_WAIT_V(n) asm volatile("s_waitcnt vmcnt(" #n ")" ::: "memory")
#define PG8_WAIT_L(n) asm volatile("s_waitcnt lgkmcnt(" #n ")" ::: "memory")
#define PG8_BAR __builtin_amdgcn_s_barrier()
#define PG8_SCHED __builtin_amdgcn_sched_barrier(0)
    Unit cur, nxt; int ui = 0;
    if (!S.next(0, cur)) return;
    S.avoff(cur, tid, K, voffA, cva0, cva1);
    f32x4 acc[2][2][4][2];
#pragma unroll
    for (int a = 0; a < 2; ++a)
#pragma unroll
        for (int b = 0; b < 2; ++b)
#pragma unroll
            for (int m = 0; m < 4; ++m)
#pragma unroll
                for (int n = 0; n < 2; ++n) acc[a][b][m][n] = (f32x4){0.f, 0.f, 0.f, 0.f};
    bf16x8 At[4][2], B0[2][2], B1[2][2];
    const char* cA = cur.aptr; const char* cB = cur.bptr;
    S.a_ready(cur);
    if constexpr (SP2) {
        PG8_STAGE(PG8_SB(0, 0), cB, voffB); PG8_STAGE(PG8_SB(0, 1), cB + hstep, voffB); PG8_STAGEA(PG8_SA(0, 0), cA, cva0); PG8_STAGEA(PG8_SA(0, 1), cA, cva1);
        if (wr == 1) PG8_BAR;
        PG8_WAIT_V(2); PG8_BAR;
        PG8_STAGE(PG8_SB(1, 0), cB + kstep, voffB); PG8_STAGEA(PG8_SA(1, 0), cA + kstep, cva0); PG8_STAGE(PG8_SB(1, 1), cB + hstep + kstep, voffB);
        PG8_WAIT_V(6); PG8_BAR;
    } else {
        PG8_STAGE(PG8_SB(0, 0), cB, voffB); PG8_STAGEA(PG8_SA(0, 0), cA, cva0); PG8_STAGE(PG8_SB(0, 1), cB + hstep, voffB); PG8_STAGEA(PG8_SA(0, 1), cA, cva1);
        if (wr == 1) PG8_BAR;
        PG8_WAIT_V(4); PG8_BAR;
        PG8_STAGE(PG8_SB(1, 0), cB + kstep, voffB); PG8_STAGEA(PG8_SA(1, 0), cA + kstep, cva0); PG8_STAGE(PG8_SB(1, 1), cB + hstep + kstep, voffB);
        PG8_WAIT_V(6); PG8_BAR;
    }
    for (;;) {
        const bool has_next = S.next(ui + 1, nxt);
        if (has_next) S.avoff(nxt, tid, K, voffA, nva0, nva1); else { nva0[0] = cva0[0]; nva0[1] = cva0[1]; nva1[0] = cva1[0]; nva1[1] = cva1[1]; }
        const char* nA = has_next ? nxt.aptr : cA; const char* nB = has_next ? nxt.bptr : cB;
        for (int t = 0; t < nt; t += 2) {
            const bool last = (t == nt - 2);
            const char* a1 = cA + (size_t)(t + 1) * kstep;
            const char* a2 = last ? nA : cA + (size_t)(t + 2) * kstep; const char* b2 = last ? nB : cB + (size_t)(t + 2) * kstep;
            const char* a3 = a2 + kstep; const char* b3 = b2 + kstep;
            const unsigned xva0[2] = {last ? nva0[0] : cva0[0], last ? nva0[1] : cva0[1]}, xva1[2] = {last ? nva1[0] : cva1[0], last ? nva1[1] : cva1[1]};
            if (last && has_next) S.a_ready(nxt);
            if constexpr (SP2) {
            PG8_LDB(B0, 0, 0); PG8_LDB(B1, 0, 1); PG8_SCHED; PG8_LDA(At, 0, 0); PG8_STAGEA(PG8_SA(1, 1), a1, cva1);
            PG8_WAIT_V(8); PG8_WAIT_L(0); PG8_BAR; PG8_MMA(0, 0, At, B0); PG8_MMA(0, 1, At, B1); PG8_BAR; PG8_SCHED;
            PG8_LDA(At, 0, 1); PG8_STAGE(PG8_SB(0, 0), b2, voffB); PG8_STAGE(PG8_SB(0, 1), b2 + hstep, voffB); PG8_STAGEA(PG8_SA(0, 0), a2, xva0);
            PG8_WAIT_V(8); PG8_WAIT_L(0); PG8_BAR; PG8_MMA(1, 0, At, B0); PG8_MMA(1, 1, At, B1); PG8_BAR; PG8_SCHED;
            PG8_LDB(B0, 1, 0); PG8_LDB(B1, 1, 1); PG8_SCHED; PG8_LDA(At, 1, 0); PG8_STAGEA(PG8_SA(0, 1), a2, xva1);
            PG8_WAIT_V(8); PG8_WAIT_L(0); PG8_BAR; PG8_MMA(0, 0, At, B0); PG8_MMA(0, 1, At, B1); PG8_BAR; PG8_SCHED;
            PG8_LDA(At, 1, 1); PG8_STAGE(PG8_SB(1, 0), b3, voffB); PG8_STAGE(PG8_SB(1, 1), b3 + hstep, voffB); PG8_STAGEA(PG8_SA(1, 0), a3, xva0);
            PG8_WAIT_V(8); PG8_WAIT_L(0); PG8_BAR; PG8_MMA(1, 0, At, B0); PG8_MMA(1, 1, At, B1); PG8_BAR; PG8_SCHED;
            } else {
            PG8_LDB(B0, 0, 0); PG8_SCHED; PG8_LDA(At, 0, 0); PG8_STAGEA(PG8_SA(1, 1), a1, cva1);
            PG8_WAIT_L(8); PG8_BAR; PG8_WAIT_L(0); PG8_MMA(0, 0, At, B0); PG8_BAR; PG8_SCHED;
            PG8_LDB(B1, 0, 1); PG8_STAGE(PG8_SB(0, 0), b2, voffB);
            PG8_BAR; PG8_WAIT_L(0); PG8_MMA(0, 1, At, B1); PG8_BAR;
            PG8_LDA(At, 0, 1); PG8_STAGEA(PG8_SA(0, 0), a2, xva0);
            PG8_BAR; PG8_WAIT_L(0); PG8_MMA(1, 0, At, B0); PG8_BAR; PG8_SCHED;
            PG8_STAGE(PG8_SB(0, 1), b2 + hstep, voffB);
            PG8_WAIT_V(6); PG8_BAR; PG8_MMA(1, 1, At, B1); PG8_BAR;
            PG8_LDB(B0, 1, 0); PG8_SCHED; PG8_LDA(At, 1, 0); PG8_STAGEA(PG8_SA(0, 1), a2, xva1);
            PG8_WAIT_L(8); PG8_BAR; PG8_WAIT_L(0); PG8_MMA(0, 0, At, B0); PG8_BAR; PG8_SCHED;
            PG8_LDB(B1, 1, 1); PG8_STAGE(PG8_SB(1, 0), b3, voffB);
            PG8_BAR; PG8_WAIT_L(0); PG8_MMA(0, 1, At, B1); PG8_BAR;
            PG8_LDA(At, 1, 1); PG8_STAGEA(PG8_SA(1, 0), a3, xva0);
            PG8_BAR; PG8_WAIT_L(0); PG8_MMA(1, 0, At, B0); PG8_BAR; PG8_SCHED;
            PG8_STAGE(PG8_SB(1, 1), b3 + hstep, voffB);
            PG8_WAIT_V(6); PG8_BAR; PG8_MMA(1, 1, At, B1); PG8_BAR;
            }
        }
        if constexpr (ALIGN_EPI) { if (wr == 0) PG8_BAR; }
        if constexpr (!Epi::AFTER_DRAIN) { E(acc, cur, wr, wc, fr, fq); S.done(cur); }
        if (!has_next) break;
#pragma unroll
        for (int a = 0; a < 2; ++a)
#pragma unroll
            for (int b = 0; b < 2; ++b)
#pragma unroll
                for (int m = 0; m < 4; ++m)
#pragma unroll
                    for (int n = 0; n < 2; ++n) acc[a][b][m][n] = (f32x4){0.f, 0.f, 0.f, 0.f};
        cur = nxt; cA = nA; cB = nB; ++ui; cva0[0] = nva0[0]; cva0[1] = nva0[1]; cva1[0] = nva1[0]; cva1[1] = nva1[1];
        if constexpr (ALIGN_EPI) { if (wr == 1) PG8_BAR; }
    }
    PG8_WAIT_V(0);
    if constexpr (!ALIGN_EPI) { if (wr == 0) PG8_BAR; }
    PG8_BAR;
    if constexpr (Epi::AFTER_DRAIN) { E.fused(acc, cur, wr, wc, fr, fq, lds, wid, lane); S.done(cur); }
#undef PG8_SA
#undef PG8_SB
#undef PG8_STAGE
#undef PG8_STAGEA
#undef PG8_LDA
#undef PG8_LDB
#undef PG8_MMA
#undef PG8_WAIT_V
#undef PG8_WAIT_L
#undef PG8_BAR
#undef PG8_SCHED
}
}

#define TILE8_IDS unsigned t8_z = 0u; asm volatile("" : "+v"(t8_z)); int t512 = wave_s * 64 + (int)__builtin_amdgcn_mbcnt_hi(~0u, __builtin_amdgcn_mbcnt_lo(~0u, t8_z)); asm volatile("" : "+v"(t512))
template <class Map> struct ListSched {
  int first, stride, count; Map map;
  __device__ __forceinline__ bool next(int i, pg8::Unit& u) const { const int idx = first + i * stride; if (idx >= count) return false; map(idx, u); return true; }
  __device__ __forceinline__ void avoff(const pg8::Unit& u, int tid, int K, const unsigned (&voffA)[2], unsigned (&v0)[2], unsigned (&v1)[2]) const { map.avoff(u, tid, K, voffA, v0, v1); }
  __device__ __forceinline__ void a_ready(const pg8::Unit&) const {}
  __device__ __forceinline__ void done(const pg8::Unit&) const {}
};
struct MlArgs { const float *conv, *b_i, *b_f, *gain; float *BCUM, *IP, *BL, *MX, *MST, *NST; bf16_t* CST; };
struct MegaArgs {
  const float* x; const float* mem; float* out;
  bf16_t *XB, *MEMB; float *RS1, *RSM, *PS2;
  bf16_t *QK, *V, *O, *NQ, *KVC, *KS, *KW, *VST, *VWT, *KC, *VCT, *CK1T, *CV1T; float *SM, *POSW;
  const float *posk, *posv, *ckw1, *cvw1, *ckw2, *cvw2;
  bf16_t *AML, *ANS, *MRG, *X1B, *XQ, *XO, *KVM;
  bf16_t *WinT, *WgT, *WmlT, *WnsT, *WoutT, *WqT, *WkvT, *WoT;
  bf16_t *H3, *ACT, *Y, *W13T, *W2T; float *RS3, *RTW; int *CNT, *LIST;
  const float *g_ffn, *wg, *bg, *we, *be, *g_final;
  unsigned* BAR;
  MlArgs ml;
  float* CPART; int* WQ;
  TDesc td[24]; int ntdA, ntdB; int ph_lo, ph_hi, li, pad; int rep[16]; int cv_lo[16], cv_hi[16];
};


constexpr int NSA_LDS = 66112;
constexpr int MEGA_LDS = 73728;
constexpr int HALF_LDS = 73728, CTRL_OFF = 2 * HALF_LDS, TOTAL_LDS = CTRL_OFF + 64;
typedef unsigned long long u64;

template <bool WITH_V>
__device__ __forceinline__ void nsa_load_tile(const bf16_t* __restrict__ Ksrc, unsigned kstride, const bf16_t* __restrict__ Vsrc, unsigned vstride, char* lds, int tid) {
#pragma unroll
  for (int i = 0; i < 2; ++i) {
    const int idx = tid + 256 * i, row = idx >> 3, lc = (idx & 7) ^ ((row >> 1) & 7);
    glds16(Ksrc + (size_t)row * kstride + lc * 8, lds + idx * 16);
    if (WITH_V) glds16(Vsrc + (size_t)row * vstride + lc * 8, lds + 8192 + idx * 16);
  }
}

__device__ __forceinline__ void nsa_qk(f32x4 (&sacc)[4][2], const bf16x8 (&qf)[4][2], const char* lds, int hf, int fr, int fq) {
#pragma unroll
  for (int mi = 0; mi < 4; ++mi)
#pragma unroll
    for (int ni = 0; ni < 2; ++ni) sacc[mi][ni] = (f32x4){0.f, 0.f, 0.f, 0.f};
#pragma unroll
  for (int ks = 0; ks < 2; ++ks) {
    bf16x8 kf[2];
    const int co = ((ks * 4 + fq) ^ (fr >> 1)) << 4;
#pragma unroll
    for (int ni = 0; ni < 2; ++ni) kf[ni] = *(const bf16x8*)(lds + ((hf * 2 + ni) * 16 + fr) * 128 + co);
#pragma unroll
    for (int mi = 0; mi < 4; ++mi)
#pragma unroll
      for (int ni = 0; ni < 2; ++ni) sacc[mi][ni] = __builtin_amdgcn_mfma_f32_16x16x32_bf16(kf[ni], qf[mi][ks], sacc[mi][ni], 0, 0, 0);
  }
}
__device__ __forceinline__ void nsa_pv(f32x4 (&oacc)[4][4], const f32x4 (&p)[4][2], char* lds, char* pw, int hf, int fr, int fq) {
#pragma unroll
  for (int mi = 0; mi < 4; ++mi)
#pragma unroll
    for (int ni = 0; ni < 2; ++ni) {
      u32x2 o; o.x = pk2bf(p[mi][ni][0], p[mi][ni][1]); o.y = pk2bf(p[mi][ni][2], p[mi][ni][3]);
      *(u32x2*)(pw + (mi * 16 + fr) * 128 + ((((hf * 2 + ni) * 2 + (fq >> 1)) ^ (fr >> 1)) << 4) + (fq & 1) * 8) = o;
    }
  bf16x8 pf[4], vf[4];
  const int co = ((hf * 4 + fq) ^ (fr >> 1)) << 4;
#pragma unroll
  for (int i = 0; i < 4; ++i) { pf[i] = *(const bf16x8*)(pw + (i * 16 + fr) * 128 + co); vf[i] = *(const bf16x8*)(lds + 8192 + (i * 16 + fr) * 128 + co); }
#pragma unroll
  for (int mi = 0; mi < 4; ++mi)
#pragma unroll
    for (int ni = 0; ni < 4; ++ni) oacc[mi][ni] = __builtin_amdgcn_mfma_f32_16x16x32_bf16(vf[ni], pf[mi], oacc[mi][ni], 0, 0, 0);
}
__device__ __forceinline__ float red4(float v) { v += __shfl_xor(v, 16); v += __shfl_xor(v, 32); return v; }
__device__ __forceinline__ float max4(float v) { v = fmaxf(v, __shfl_xor(v, 16)); v = fmaxf(v, __shfl_xor(v, 32)); return v; }

__device__ __forceinline__ void nsa_online(f32x4 (&sv)[4][2], float (&m_run)[4], float (&l_run)[4], f32x4 (&oacc)[4][4]) {
#pragma unroll
  for (int mi = 0; mi < 4; ++mi) {
    float mx = fmaxf(fmaxf(fmaxf(sv[mi][0][0], sv[mi][0][1]), fmaxf(sv[mi][0][2], sv[mi][0][3])), fmaxf(fmaxf(sv[mi][1][0], sv[mi][1][1]), fmaxf(sv[mi][1][2], sv[mi][1][3])));
    mx = max4(mx);
    if (__any(mx > m_run[mi] + 8.f)) {
      const float mn = fmaxf(fmaxf(m_run[mi], mx), -1e20f);
      const float alpha = __builtin_amdgcn_exp2f(m_run[mi] - mn);
      m_run[mi] = mn; l_run[mi] *= alpha;
#pragma unroll
      for (int ni = 0; ni < 4; ++ni) oacc[mi][ni] *= alpha;
    }
    float ls = 0.f;
#pragma unroll
    for (int ni = 0; ni < 2; ++ni)
#pragma unroll
      for (int j = 0; j < 4; ++j) { const float pv = __builtin_amdgcn_exp2f(sv[mi][ni][j] - m_run[mi]); sv[mi][ni][j] = pv; ls += pv; }
    l_run[mi] += ls;
  }
}

__device__ __forceinline__ void nsa_main_item(const MegaArgs& a, int item, char* lds, int tid, volatile int* xch, int half) {
  asm volatile("" : "+v"(tid));
  const int lane = tid & 63, wid = tid >> 6, fr = lane & 15, fq = lane >> 4;
  const int i = item & 63, g = (item >> 6) & 1, b = item >> 7;
  const int h = g * 4 + wid, nb = b * SEQ, t0 = i * 64, bg = b * 2 + g;
  const float slope = exp2f(-(float)(h + 1)) * 1.4426950408889634f;
  char* pw = lds + 16384 + wid * 8192;
  float* PSLC = (float*)(lds + 49152);
  u64* SELM = (u64*)(lds + 65536);
  u64* UNI = (u64*)(lds + 66048);
  bf16x8 qf[4][2];
#pragma unroll
  for (int mi = 0; mi < 4; ++mi)
#pragma unroll
    for (int ks = 0; ks < 2; ++ks) qf[mi][ks] = *(const bf16x8*)(a.NQ + (size_t)(nb + t0 + wid * 16 + fr) * 512 + (g * 4 + mi) * 64 + ks * 32 + fq * 8);
  for (int e = tid; e < 4096; e += 256) PSLC[e] = 0.f;
  f32x4 sacc[4][2], oacc[4][4];
  float m_run[4], l_run[4];
  const int nct = ((4 * i + 2) >> 6) + 1;
  const bf16_t* kcb = a.KC + (size_t)bg * 256 * 64;
  const bf16_t* vcb = a.VCT + (size_t)bg * 64 * 256;
  const int tc = t0 + wid * 16 + fr;
  const float slope0 = exp2f(-(float)(g * 4 + 1)) * 1.4426950408889634f;
#pragma unroll
  for (int mi = 0; mi < 4; ++mi) { m_run[mi] = -1e30f; l_run[mi] = 0.f; }
  __syncthreads();
  nsa_load_tile<false>(kcb, 64u, nullptr, 0u, lds, tid);
  for (int jt = 0; jt < nct; ++jt) {
    asm volatile("s_waitcnt vmcnt(0)" ::: "memory");
    __syncthreads();
    char* tb = (jt & 1) ? (lds + 16384) : lds;
    if (jt + 1 < nct) nsa_load_tile<false>(kcb + (size_t)(jt + 1) * 64 * 64, 64u, nullptr, 0u, (jt & 1) ? lds : (lds + 16384), tid);
#pragma unroll 1
    for (int hf = 0; hf < 2; ++hf) {
      nsa_qk(sacc, qf, tb, hf, fr, fq);
#pragma unroll
      for (int mi = 0; mi < 4; ++mi) {
        const float slope = slope0 * (1.f / (float)(1 << mi)); float mx = -1e30f;
#pragma unroll
        for (int ni = 0; ni < 2; ++ni)
#pragma unroll
          for (int j = 0; j < 4; ++j) {
            const int jj = jt * 64 + hf * 32 + ni * 16 + 4 * fq + j; const bool ok = (16 * jj + 31 <= tc);
            const float v = sacc[mi][ni][j] - slope * ((float)tc - (16.f * jj + 15.5f));
            sacc[mi][ni][j] = ok ? v : -1e30f; mx = fmaxf(mx, sacc[mi][ni][j]);
          }
        mx = max4(mx);
        const float mn = fmaxf(m_run[mi], mx); float ls = 0.f;
#pragma unroll
        for (int ni = 0; ni < 2; ++ni)
#pragma unroll
          for (int j = 0; j < 4; ++j) ls += (sacc[mi][ni][j] > -1e29f) ? __builtin_amdgcn_exp2f(sacc[mi][ni][j] - mn) : 0.f;
        l_run[mi] = l_run[mi] * __builtin_amdgcn_exp2f(m_run[mi] - mn) + ls; m_run[mi] = mn;
      }
    }
  }
  float invl[4];
#pragma unroll
  for (int mi = 0; mi < 4; ++mi) { const float l = red4(l_run[mi]); invl[mi] = l > 0.f ? 1.f / l : 0.f; }
#pragma unroll
  for (int mi = 0; mi < 4; ++mi)
#pragma unroll
    for (int ni = 0; ni < 4; ++ni) oacc[mi][ni] = (f32x4){0.f, 0.f, 0.f, 0.f};
  for (int jt = 0; jt < nct; ++jt) {
    __syncthreads();
    nsa_load_tile<true>(kcb + (size_t)jt * 64 * 64, 64u, vcb + jt * 64, 256u, lds, tid);
    asm volatile("s_waitcnt vmcnt(0)" ::: "memory");
    __syncthreads();
#pragma unroll 1
    for (int hf = 0; hf < 2; ++hf) {
      nsa_qk(sacc, qf, lds, hf, fr, fq);
      float imp[2] = {0.f, 0.f}, car[2] = {0.f, 0.f};
#pragma unroll
      for (int mi = 0; mi < 4; ++mi) {
        const float slope = slope0 * (1.f / (float)(1 << mi));
#pragma unroll
        for (int ni = 0; ni < 2; ++ni) {
#pragma unroll
          for (int j = 0; j < 4; ++j) {
            const int jj = jt * 64 + hf * 32 + ni * 16 + 4 * fq + j; const bool ok = (16 * jj + 31 <= tc);
            const float v = sacc[mi][ni][j] - slope * ((float)tc - (16.f * jj + 15.5f));
            sacc[mi][ni][j] = ok ? __builtin_amdgcn_exp2f(v - m_run[mi]) * invl[mi] : 0.f;
          }
          imp[ni] += (sacc[mi][ni][0] + sacc[mi][ni][1]) + sacc[mi][ni][2] + 0.5f * sacc[mi][ni][3]; car[ni] += 0.5f * sacc[mi][ni][3];
        }
      }
      nsa_pv(oacc, sacc, lds, pw, hf, fr, fq);
#pragma unroll
      for (int ni = 0; ni < 2; ++ni) {
        const int sb = jt * 16 + hf * 8 + ni * 4 + fq; float* pp = PSLC + (wid * 16 + fr) * 64 + sb;
        atomicAdd(pp, imp[ni]);
        if (sb < 63) atomicAdd(pp + 1, car[ni]);
      }
    }
  }
  int frc = fr; asm volatile("" : "+v"(frc));
  {
    const size_t n = nb + t0 + wid * 16 + frc;
#pragma unroll
    for (int mi = 0; mi < 4; ++mi) {
      const int hh = g * 4 + mi; const float gt = sigmoidf_(a.SM[n * 32 + 8 + hh * 3]);
#pragma unroll
      for (int ni = 0; ni < 4; ++ni) {
        bf16_t* dp = a.ANS + n * 512 + hh * 64 + ni * 16 + 4 * fq; const u32x2 pr = *(const u32x2*)dp;
        f32x4 r = oacc[mi][ni] * gt;
        r[0] += __uint_as_float(pr.x << 16); r[1] += __uint_as_float(pr.x & 0xffff0000u); r[2] += __uint_as_float(pr.y << 16); r[3] += __uint_as_float(pr.y & 0xffff0000u);
        st_bf4(dp, r);
      }
    }
  }
  __syncthreads();
  {
    int tsel = tid, isel = i; asm volatile("" : "+v"(tsel), "+v"(isel));
    const int q = tsel >> 2, sub = tsel & 3;
    float mine[16]; int cnt[16];
#pragma unroll
    for (int k = 0; k < 16; ++k) {
      const int sb = sub * 16 + k; const float ps = PSLC[q * 64 + sb];
      mine[k] = (sb == 0 || sb == isel || sb == isel - 1) ? 1e4f : (sb > isel ? -1e4f : ps); cnt[k] = 0;
    }
#pragma unroll
    for (int k = 0; k < 16; ++k) PSLC[q * 64 + sub * 16 + k] = mine[k];
    __syncthreads();
    for (int s2 = 0; s2 <= isel; ++s2) {
      const float o = PSLC[q * 64 + s2];
#pragma unroll
      for (int k = 0; k < 16; ++k) cnt[k] += (o > mine[k] || (o == mine[k] && s2 < sub * 16 + k)) ? 1 : 0;
    }
    unsigned m16 = 0;
#pragma unroll
    for (int k = 0; k < 16; ++k) m16 |= (cnt[k] < 16 ? 1u : 0u) << k;
    unsigned mlo = (sub < 2) ? (m16 << (16 * sub)) : 0u, mhi = (sub >= 2) ? (m16 << (16 * (sub - 2))) : 0u;
    mlo |= __shfl_xor(mlo, 1); mlo |= __shfl_xor(mlo, 2); mhi |= __shfl_xor(mhi, 1); mhi |= __shfl_xor(mhi, 2);
    u64 m64 = ((u64)mhi << 32) | (u64)mlo;
    m64 &= (isel == 63) ? ~0ull : ((2ull << isel) - 1ull);
    if (sub == 0) SELM[q] = m64;
    u64 un = m64;
#pragma unroll
    for (int o = 4; o < 64; o <<= 1) un |= __shfl_xor(un, o);
    if (lane == 0) UNI[wid] = un;
  }
  __syncthreads();
  const u64 uni = UNI[0] | UNI[1] | UNI[2] | UNI[3];
#pragma unroll
  for (int mi = 0; mi < 4; ++mi)
#pragma unroll
    for (int ks = 0; ks < 2; ++ks) qf[mi][ks] = *(const bf16x8*)(a.NQ + (size_t)(nb + t0 + mi * 16 + fr) * 512 + h * 64 + ks * 32 + fq * 8);
#pragma unroll 1
  for (int br = 1; br <= 1; ++br) {
#pragma unroll
    for (int mi = 0; mi < 4; ++mi) { m_run[mi] = -1e30f; l_run[mi] = 0.f;
#pragma unroll
      for (int ni = 0; ni < 4; ++ni) oacc[mi][ni] = (f32x4){0.f, 0.f, 0.f, 0.f}; }
    const bf16_t* Kb = (br == 1 ? a.KS : a.KW) + (size_t)nb * 128 + g * 64;
    const bf16_t* Vb = (br == 1 ? a.VST : a.VWT) + ((size_t)(b * 128 + g * 64) << 12);
    u64 todo;
    if (br == 1) todo = uni;
    else { const int lo = i >= 8 ? i - 8 : 0; todo = ((i == 63) ? ~0ull : ((2ull << i) - 1ull)) & ~((1ull << lo) - 1ull); }
    int cur = __builtin_ctzll(todo), bsel = 0;
    if (tid == 0) xch[half] = __builtin_popcountll(todo);
    __syncthreads();
    const int ntile = max(xch[0], xch[1]);
    nsa_load_tile<true>(Kb + (size_t)cur * 64 * 128, 128u, Vb + cur * 64, 4096u, lds, tid);
    for (int kt = 0; kt < ntile; ++kt) {
      int nxt = -1;
      if (cur >= 0) { todo &= todo - 1ull; nxt = todo ? __builtin_ctzll(todo) : -1; }
      asm volatile("s_waitcnt vmcnt(0)" ::: "memory");
      __syncthreads();
      if (cur < 0) continue;
      char* tb = bsel ? (lds + 49152) : lds;
      if (nxt >= 0) nsa_load_tile<true>(Kb + (size_t)nxt * 64 * 128, 128u, Vb + nxt * 64, 4096u, bsel ? lds : (lds + 49152), tid);
      const int sb = cur;
#pragma unroll 1
      for (int hf = 0; hf < 2; ++hf) {
        nsa_qk(sacc, qf, tb, hf, fr, fq);
        const bool edge = (sb == i) || (br == 2 && sb == i - 8);
#pragma unroll
        for (int mi = 0; mi < 4; ++mi) {
          const int tq = mi * 16 + fr;
          const bool rsel = (br == 2) || ((SELM[tq] >> sb) & 1ull);
          const float rc = rsel ? -slope * (float)(64 * (i - sb) + tq - hf * 32 - 4 * fq) : -1e30f;
          if (!edge) {
#pragma unroll
            for (int ni = 0; ni < 2; ++ni)
#pragma unroll
              for (int j = 0; j < 4; ++j) sacc[mi][ni][j] += fmaf(slope, (float)(ni * 16 + j), rc);
          } else {
            const int tqh = tq - hf * 32;
#pragma unroll
            for (int ni = 0; ni < 2; ++ni)
#pragma unroll
              for (int j = 0; j < 4; ++j) {
                const int c = ni * 16 + 4 * fq + j;
                const bool okv = (sb == i) ? (c <= tqh) : (c > tqh);
                sacc[mi][ni][j] = okv ? sacc[mi][ni][j] + fmaf(slope, (float)(ni * 16 + j), rc) : -1e30f;
              }
          }
        }
        nsa_online(sacc, m_run, l_run, oacc);
        nsa_pv(oacc, sacc, tb, pw, hf, fr, fq);
      }
      cur = nxt; bsel ^= 1;
    }
    int fre = fr; asm volatile("" : "+v"(fre));
#pragma unroll
    for (int mi = 0; mi < 4; ++mi) {
      const size_t n = nb + t0 + mi * 16 + fre;
      const float l = red4(l_run[mi]); const float sc = sigmoidf_(a.SM[n * 32 + 8 + h * 3 + br]) / l;
#pragma unroll
      for (int ni = 0; ni < 4; ++ni) {
        bf16_t* dp = a.ANS + n * 512 + h * 64 + ni * 16 + 4 * fq; const u32x2 pr = *(const u32x2*)dp;
        f32x4 r = oacc[mi][ni] * sc;
        r[0] += __uint_as_float(pr.x << 16); r[1] += __uint_as_float(pr.x & 0xffff0000u); r[2] += __uint_as_float(pr.y << 16); r[3] += __uint_as_float(pr.y & 0xffff0000u);
        st_bf4(dp, r);
      }
    }
  }
  __syncthreads();
}


__device__ __forceinline__ void nsa_win_item(const MegaArgs& a, int item, char* lds, int tid) {
  asm volatile("" : "+v"(tid));
  const int lane = tid & 63, wid = tid >> 6, fr = lane & 15, fq = lane >> 4;
  const int i = item & 63, g = (item >> 6) & 1, b = item >> 7;
  const int h = g * 4 + wid, nb = b * SEQ, t0 = i * 64, bg = b * 2 + g;
  const float slope = exp2f(-(float)(h + 1)) * 1.4426950408889634f;
  char* pw = lds + 16384 + wid * 8192;
  float* PSLC = (float*)(lds + 49152);
  u64* SELM = (u64*)(lds + 65536);
  u64* UNI = (u64*)(lds + 66048);
  bf16x8 qf[4][2];
#pragma unroll
  for (int mi = 0; mi < 4; ++mi)
#pragma unroll
    for (int ks = 0; ks < 2; ++ks) qf[mi][ks] = *(const bf16x8*)(a.NQ + (size_t)(nb + t0 + mi * 16 + fr) * 512 + h * 64 + ks * 32 + fq * 8);
  f32x4 sacc[4][2], oacc[4][4];
  float m_run[4], l_run[4];
  (void)PSLC; (void)UNI; (void)bg;
  const u64 uni = 0ull;
#pragma unroll 1
  for (int br = 2; br <= 2; ++br) {
#pragma unroll
    for (int mi = 0; mi < 4; ++mi) { m_run[mi] = -1e30f; l_run[mi] = 0.f;
#pragma unroll
      for (int ni = 0; ni < 4; ++ni) oacc[mi][ni] = (f32x4){0.f, 0.f, 0.f, 0.f}; }
    const bf16_t* Kb = (br == 1 ? a.KS : a.KW) + (size_t)nb * 128 + g * 64;
    const bf16_t* Vb = (br == 1 ? a.VST : a.VWT) + ((size_t)(b * 128 + g * 64) << 12);
    u64 todo;
    if (br == 1) todo = uni;
    else { const int lo = i >= 8 ? i - 8 : 0; todo = ((i == 63) ? ~0ull : ((2ull << i) - 1ull)) & ~((1ull << lo) - 1ull); }
    int cur = 63 - __builtin_clzll(todo), bsel = 0;
    __syncthreads();
    nsa_load_tile<true>(Kb + (size_t)cur * 64 * 128, 128u, Vb + cur * 64, 4096u, lds, tid);
    while (cur >= 0) {
      todo &= ~(1ull << cur);
      const int nxt = todo ? 63 - __builtin_clzll(todo) : -1;
      asm volatile("s_waitcnt vmcnt(0)" ::: "memory");
      __syncthreads();
      char* tb = bsel ? (lds + 49152) : lds;
      if (nxt >= 0) nsa_load_tile<true>(Kb + (size_t)nxt * 64 * 128, 128u, Vb + nxt * 64, 4096u, bsel ? lds : (lds + 49152), tid);
      const int sb = cur;
#pragma unroll 1
      for (int hf = 0; hf < 2; ++hf) {
        nsa_qk(sacc, qf, tb, hf, fr, fq);
        const bool edge = (sb == i) || (br == 2 && sb == i - 8);
#pragma unroll
        for (int mi = 0; mi < 4; ++mi) {
          const int tq = mi * 16 + fr;
          const bool rsel = (br == 2) || ((SELM[tq] >> sb) & 1ull);
          const float rc = rsel ? -slope * (float)(64 * (i - sb) + tq - hf * 32 - 4 * fq) : -1e30f;
          if (!edge) {
#pragma unroll
            for (int ni = 0; ni < 2; ++ni)
#pragma unroll
              for (int j = 0; j < 4; ++j) sacc[mi][ni][j] += fmaf(slope, (float)(ni * 16 + j), rc);
          } else {
            const int tqh = tq - hf * 32;
#pragma unroll
            for (int ni = 0; ni < 2; ++ni)
#pragma unroll
              for (int j = 0; j < 4; ++j) {
                const int c = ni * 16 + 4 * fq + j;
                const bool okv = (sb == i) ? (c <= tqh) : (c > tqh);
                sacc[mi][ni][j] = okv ? sacc[mi][ni][j] + fmaf(slope, (float)(ni * 16 + j), rc) : -1e30f;
              }
          }
        }
        nsa_online(sacc, m_run, l_run, oacc);
        nsa_pv(oacc, sacc, tb, pw, hf, fr, fq);
      }
      cur = nxt; bsel ^= 1;
    }
#pragma unroll
    for (int mi = 0; mi < 4; ++mi) {
      const size_t n = nb + t0 + mi * 16 + fr;
      const float l = red4(l_run[mi]); const float sc = sigmoidf_(a.SM[n * 32 + 8 + h * 3 + br]) / l;
#pragma unroll
      for (int ni = 0; ni < 4; ++ni) {
        st_bf4(a.ANS + n * 512 + h * 64 + ni * 16 + 4 * fq, oacc[mi][ni] * sc);
      }
    }
  }
  __syncthreads();
}


__device__ __forceinline__ int img_off(int row, int k) { return row * 128 + ((((k >> 3) ^ ((row >> 1) & 7))) << 4) + (k & 7) * 2; }
__device__ __forceinline__ bf16x8 img_frag(const char* img, int r0, int ks, int fr, int fq) { return *(const bf16x8*)(img + (r0 + fr) * 128 + (((ks * 4 + fq) ^ (fr >> 1)) << 4)); }


__device__ __forceinline__ void stage_raw(const bf16_t* __restrict__ QK, int nb, int t0, int chbase, char* raw, int tid) {
  u32x4 v[5];
#pragma unroll
  for (int i = 0; i < 5; ++i) {
    const int c = tid + 256 * i, row = c >> 4, cc = c & 15, t = t0 - 3 + row;
    v[i] = (c < 1072 && t >= 0) ? *(const u32x4*)(QK + (size_t)(nb + t) * 1024 + chbase + cc * 8) : (u32x4){0u, 0u, 0u, 0u};
  }
#pragma unroll
  for (int i = 0; i < 5; ++i) { const int c = tid + 256 * i; if (c < 1072) *(u32x4*)(raw + c * 16) = v[i]; }
}
template <class Put>
__device__ __forceinline__ void conv_col(const char* raw, const float* __restrict__ conv, int j0, int nj, int ch, int d, float scale, Put put) {
  const float w0 = conv[ch], w1 = conv[1024 + ch], w2 = conv[2048 + ch], w3 = conv[3072 + ch];
  const bf16_t* r = (const bf16_t*)raw + d;
  float x0 = bf2f(r[(j0 + 0) * 128]), x1 = bf2f(r[(j0 + 1) * 128]), x2 = bf2f(r[(j0 + 2) * 128]);
  for (int j = j0; j < j0 + nj; ++j) {
    const float x3 = bf2f(r[(j + 3) * 128]);
    put(j, siluf_(w0 * x0 + w1 * x1 + w2 * x2 + w3 * x3) * scale);
    x0 = x1; x1 = x2; x2 = x3;
  }
}

__device__ __forceinline__ void ml_dc_item(const MegaArgs& a, const MlArgs& ml, int item, char* lds, int tid) {
  asm volatile("" : "+v"(tid));
  const int lane = tid & 63, wid = tid >> 6, wr = wid >> 1, wc = wid & 1, fr = lane & 15, fq = lane >> 4;
  const int bh = item >> 6, c = item & 63, b = bh >> 2, h = bh & 3, nb = b * SEQ, t0 = c * 64;
  char* KT = lds; char* VT = lds + 16384; float* sc = (float*)(lds + 32768); float* dnp = (float*)(lds + 33792);
  if (tid < 64) {
    const size_t n = nb + t0 + tid;
    sc[tid] = a.SM[n * 32 + h] + ml.b_i[h];
    sc[64 + tid] = logsigmoidf_(a.SM[n * 32 + 4 + h] + ml.b_f[h]);
  }
  __syncthreads();
  if (tid < 64) {
    float cs = sc[64 + tid];
#pragma unroll
    for (int o = 1; o < 64; o <<= 1) { const float up = __shfl_up(cs, o); if (tid >= o) cs += up; }
    const float bl = __shfl(cs, 63);
    const float lw = bl - cs + sc[tid];
    const float mx = wave_max(lw);
    sc[128 + tid] = cs; sc[192 + tid] = __expf(lw - mx);
    if (tid == 0) { ml.BL[bh * 64 + c] = bl; ml.MX[bh * 64 + c] = mx; }
  }
  __syncthreads();
  if (tid < 64) { ml.BCUM[bh * SEQ + t0 + tid] = sc[128 + tid]; ml.IP[bh * SEQ + t0 + tid] = sc[tid]; }
  char* RAW = lds + 36864;
  stage_raw(a.QK, nb, t0, 512 + h * 128, RAW, tid);
  __syncthreads();
  {
    const int d = tid & 127, jh = tid >> 7;
    float dn = 0.f;
    conv_col(RAW, ml.conv, jh * 32, 32, 512 + h * 128 + d, d, 0.08838834764831845f,
             [&](int j, float v) { *(bf16_t*)(KT + img_off(d, j)) = f2bf(v); dn += sc[192 + j] * v; });
    dnp[jh * 128 + d] = dn;
    {
      bf16_t tv[32];
#pragma unroll
      for (int u = 0; u < 32; ++u) tv[u] = a.V[(size_t)(nb + t0 + jh * 32 + u) * 512 + h * 128 + d];
#pragma unroll
      for (int u = 0; u < 32; ++u) *(bf16_t*)(VT + img_off(d, jh * 32 + u)) = f2bf(sc[192 + jh * 32 + u] * bf2f(tv[u]));
    }
  }
  __syncthreads();
  if (tid < 128) ml.NST[(size_t)(bh * 64 + c) * 128 + tid] = dnp[tid] + dnp[128 + tid];
  f32x4 acc[4][4]; zero_acc(acc);
#pragma unroll
  for (int ks = 0; ks < 2; ++ks) {
    bf16x8 av[4], bk[4];
#pragma unroll
    for (int i = 0; i < 4; ++i) { av[i] = img_frag(VT, wr * 64 + i * 16, ks, fr, fq); bk[i] = img_frag(KT, wc * 64 + i * 16, ks, fr, fq); }
#pragma unroll
    for (int i = 0; i < 4; ++i)
#pragma unroll
      for (int j = 0; j < 4; ++j) acc[i][j] = __builtin_amdgcn_mfma_f32_16x16x32_bf16(bk[j], av[i], acc[i][j], 0, 0, 0);
  }
  bf16_t* cst = ml.CST + (size_t)(bh * 64 + c) * 16384;
#pragma unroll
  for (int mi = 0; mi < 4; ++mi)
#pragma unroll
    for (int ni = 0; ni < 4; ++ni) st_bf4(cst + (wr * 64 + mi * 16 + fr) * 128 + wc * 64 + ni * 16 + 4 * fq, acc[mi][ni]);
  __syncthreads();
}

__device__ __forceinline__ void ml_scan_item(const MlArgs& ml, int item, int tid) {
  const int bh = item / 17, part = item % 17;
  float m = 0.f;
  if (part < 16) {
    float run[4] = {0.f, 0.f, 0.f, 0.f};
#pragma unroll 1
    for (int c0 = 0; c0 < 64; c0 += 8) {
      u32x2 vb[8]; float bl[8], mxv[8];
#pragma unroll
      for (int u = 0; u < 8; ++u) {
        vb[u] = *(const u32x2*)(ml.CST + (size_t)(bh * 64 + c0 + u) * 16384 + part * 1024 + tid * 4);
        bl[u] = ml.BL[bh * 64 + c0 + u]; mxv[u] = ml.MX[bh * 64 + c0 + u];
      }
#pragma unroll
      for (int u = 0; u < 8; ++u) {
        const float mn = fmaxf(bl[u] + m, mxv[u]), decay = __expf(bl[u] + m - mn), scl = __expf(mxv[u] - mn);
        u32x2 o; o.x = pk2bf(run[0], run[1]); o.y = pk2bf(run[2], run[3]);
        *(u32x2*)(ml.CST + (size_t)(bh * 64 + c0 + u) * 16384 + part * 1024 + tid * 4) = o;
        run[0] = decay * run[0] + scl * __uint_as_float(vb[u].x << 16); run[1] = decay * run[1] + scl * __uint_as_float(vb[u].x & 0xffff0000u);
        run[2] = decay * run[2] + scl * __uint_as_float(vb[u].y << 16); run[3] = decay * run[3] + scl * __uint_as_float(vb[u].y & 0xffff0000u);
        if (part == 0 && tid == 0) ml.MST[bh * 64 + c0 + u] = m;
        m = mn;
      }
    }
  } else if (tid < 128) {
    float run = 0.f;
    for (int c = 0; c < 64; ++c) {
      const float bl = ml.BL[bh * 64 + c], mx = ml.MX[bh * 64 + c];
      const float mn = fmaxf(bl + m, mx), decay = __expf(bl + m - mn), scl = __expf(mx - mn);
      float* p = ml.NST + (size_t)(bh * 64 + c) * 128 + tid;
      const float v = *p; *p = run; run = decay * run + scl * v;
      m = mn;
    }
  }
}

__device__ __forceinline__ void ml_out_item(const MegaArgs& a, const MlArgs& ml, int item, char* lds, int tid) {
  asm volatile("" : "+v"(tid));
  const int lane = tid & 63, wid = tid >> 6, wr = wid >> 1, wc = wid & 1, fr = lane & 15, fq = lane >> 4;
  const int bh = item >> 6, c = item & 63, b = bh >> 2, h = bh & 3, nb = b * SEQ, t0 = c * 64;
  char* Qi = lds; char* Ki = lds + 16384; char* VT = lds + 32768; char* SP = lds + 49152;
  float* sc = (float*)(lds + 57344);
  float* H = (float*)lds;
  {
    char* RAW = lds + 49152;
    const int d = tid & 127, jh = tid >> 7;
    stage_raw(a.QK, nb, t0, h * 128, RAW, tid);
    {
      bf16_t tv[32];
#pragma unroll
      for (int u = 0; u < 32; ++u) tv[u] = a.V[(size_t)(nb + t0 + jh * 32 + u) * 512 + h * 128 + d];
#pragma unroll
      for (int u = 0; u < 32; ++u) *(bf16_t*)(VT + img_off(d, jh * 32 + u)) = tv[u];
    }
    __syncthreads();
    conv_col(RAW, ml.conv, jh * 32, 32, h * 128 + d, d, 1.f, [&](int j, float v) { *(bf16_t*)(Qi + (d >> 6) * 8192 + img_off(j, d & 63)) = f2bf(v); });
    __syncthreads();
    stage_raw(a.QK, nb, t0, 512 + h * 128, RAW, tid);
    __syncthreads();
    conv_col(RAW, ml.conv, jh * 32, 32, 512 + h * 128 + d, d, 0.08838834764831845f, [&](int j, float v) { *(bf16_t*)(Ki + (d >> 6) * 8192 + img_off(j, d & 63)) = f2bf(v); });
    __syncthreads();
  }
  if (tid < 64) { sc[tid] = ml.BCUM[bh * SEQ + t0 + tid]; sc[64 + tid] = ml.IP[bh * SEQ + t0 + tid]; }
  if (tid < 128) sc[448 + tid] = ml.NST[(size_t)(bh * 64 + c) * 128 + tid];
  __syncthreads();
  const float m = ml.MST[bh * 64 + c];
  if (tid < 64) {
    const float bj = sc[tid]; float mxi = -INFINITY;
    for (int s2 = 0; s2 <= tid; ++s2) mxi = fmaxf(mxi, bj - sc[s2] + sc[64 + s2]);
    const float inter = bj + m, mt = fmaxf(mxi, inter);
    sc[128 + tid] = mt; sc[192 + tid] = __expf(inter - mt);
  } else if (tid < 128) {
    const int t = tid - 64; float nq = 0.f;
    for (int k = 0; k < 128; ++k) nq += sc[448 + k] * bf2f(*(const bf16_t*)(Qi + (k >> 6) * 8192 + img_off(t, k & 63)));
    sc[384 + t] = nq;
  }
  f32x4 sacc[2][2];
#pragma unroll
  for (int i = 0; i < 2; ++i)
#pragma unroll
    for (int j = 0; j < 2; ++j) sacc[i][j] = (f32x4){0.f, 0.f, 0.f, 0.f};
#pragma unroll
  for (int kt = 0; kt < 2; ++kt)
#pragma unroll
    for (int ks = 0; ks < 2; ++ks) {
      bf16x8 aq[2], bk[2];
#pragma unroll
      for (int i = 0; i < 2; ++i) { aq[i] = img_frag(Qi + kt * 8192, wr * 32 + i * 16, ks, fr, fq); bk[i] = img_frag(Ki + kt * 8192, wc * 32 + i * 16, ks, fr, fq); }
#pragma unroll
      for (int i = 0; i < 2; ++i)
#pragma unroll
        for (int j = 0; j < 2; ++j) sacc[i][j] = __builtin_amdgcn_mfma_f32_16x16x32_bf16(bk[j], aq[i], sacc[i][j], 0, 0, 0);
    }
  __syncthreads();
  const bf16_t* cst = ml.CST + (size_t)(bh * 64 + c) * 16384;
#pragma unroll
  for (int i = 0; i < 4; ++i) { const int idx = tid + 256 * i, row = idx >> 3, lc = (idx & 7) ^ ((row >> 1) & 7); glds16(cst + row * 128 + lc * 8, Ki + idx * 16); }
#pragma unroll
  for (int mi = 0; mi < 2; ++mi) {
    const int t = wr * 32 + mi * 16 + fr; const float bt = sc[t], mt = sc[128 + t]; float rsum = 0.f;
#pragma unroll
    for (int ni = 0; ni < 2; ++ni) {
      const int s0 = wc * 32 + ni * 16 + 4 * fq; f32x4 p;
#pragma unroll
      for (int j = 0; j < 4; ++j) { const int s2 = s0 + j; p[j] = (s2 <= t) ? sacc[mi][ni][j] * __expf(bt - sc[s2] + sc[64 + s2] - mt) : 0.f; rsum += p[j]; }
      u32x2 o; o.x = pk2bf(p[0], p[1]); o.y = pk2bf(p[2], p[3]);
      *(u32x2*)(SP + img_off(t, s0)) = o;
    }
    rsum += __shfl_xor(rsum, 16); rsum += __shfl_xor(rsum, 32);
    if (fq == 0) sc[256 + t * 2 + wc] = rsum;
  }
  asm volatile("s_waitcnt vmcnt(0)" ::: "memory");
  __syncthreads();
  f32x4 acc1[2][4], acc2[2][4];
#pragma unroll
  for (int i = 0; i < 2; ++i)
#pragma unroll
    for (int j = 0; j < 4; ++j) { acc1[i][j] = (f32x4){0.f, 0.f, 0.f, 0.f}; acc2[i][j] = (f32x4){0.f, 0.f, 0.f, 0.f}; }
#pragma unroll
  for (int ks = 0; ks < 2; ++ks) {
    bf16x8 as[2], bv[4];
#pragma unroll
    for (int i = 0; i < 2; ++i) as[i] = img_frag(SP, wr * 32 + i * 16, ks, fr, fq);
#pragma unroll
    for (int j = 0; j < 4; ++j) bv[j] = img_frag(VT, wc * 64 + j * 16, ks, fr, fq);
#pragma unroll
    for (int i = 0; i < 2; ++i)
#pragma unroll
      for (int j = 0; j < 4; ++j) acc1[i][j] = __builtin_amdgcn_mfma_f32_16x16x32_bf16(bv[j], as[i], acc1[i][j], 0, 0, 0);
  }
#pragma unroll 1
  for (int kt = 0; kt < 2; ++kt) {
    if (kt == 1) {
      __syncthreads();
#pragma unroll
      for (int i = 0; i < 4; ++i) { const int idx = tid + 256 * i, row = idx >> 3, lc = (idx & 7) ^ ((row >> 1) & 7); glds16(cst + row * 128 + 64 + lc * 8, Ki + idx * 16); }
      asm volatile("s_waitcnt vmcnt(0)" ::: "memory");
      __syncthreads();
    }
#pragma unroll
    for (int ks = 0; ks < 2; ++ks) {
      bf16x8 aq[2], bc[4];
#pragma unroll
      for (int i = 0; i < 2; ++i) aq[i] = img_frag(Qi + kt * 8192, wr * 32 + i * 16, ks, fr, fq);
#pragma unroll
      for (int j = 0; j < 4; ++j) bc[j] = img_frag(Ki, wc * 64 + j * 16, ks, fr, fq);
#pragma unroll
      for (int i = 0; i < 2; ++i)
#pragma unroll
        for (int j = 0; j < 4; ++j) acc2[i][j] = __builtin_amdgcn_mfma_f32_16x16x32_bf16(bc[j], aq[i], acc2[i][j], 0, 0, 0);
    }
  }
  __syncthreads();
#pragma unroll
  for (int mi = 0; mi < 2; ++mi) {
    const int t = wr * 32 + mi * 16 + fr; const float wi = sc[192 + t];
    const float den = sc[256 + t * 2] + sc[256 + t * 2 + 1] + wi * sc[384 + t];
    const float inv = 1.f / fmaxf(fabsf(den), __expf(-sc[128 + t]));
#pragma unroll
    for (int ni = 0; ni < 4; ++ni) *(f32x4*)(H + t * 132 + wc * 64 + ni * 16 + 4 * fq) = (acc1[mi][ni] + acc2[mi][ni] * wi) * inv;
  }
  __syncthreads();
  {
    bf16_t og0[16], og1[16];
#pragma unroll
    for (int r = 0; r < 16; ++r) { const size_t n = nb + t0 + wid * 16 + r; og0[r] = a.O[n * 512 + h * 128 + lane]; og1[r] = a.O[n * 512 + h * 128 + 64 + lane]; }
    const float g0 = ml.gain[h * 128 + lane], g1 = ml.gain[h * 128 + 64 + lane];
#pragma unroll
    for (int r = 0; r < 16; ++r) {
      const int j = wid * 16 + r;
      const float a0 = H[j * 132 + lane], a1 = H[j * 132 + 64 + lane];
      const float ss = wave_sum(a0 * a0 + a1 * a1);
      const float rs = rsqrtf(ss * (1.f / 128.f) + EPS);
      const size_t n = nb + t0 + j; const int c0 = h * 128 + lane, c1 = c0 + 64;
      a.AML[n * 512 + c0] = f2bf(sigmoidf_(bf2f(og0[r])) * a0 * rs * g0);
      a.AML[n * 512 + c1] = f2bf(sigmoidf_(bf2f(og1[r])) * a1 * rs * g1);
    }
  }
  __syncthreads();
}


struct EpiX1 {
  static constexpr bool PERM = false, AFTER_DRAIN = false;
  const float* x; bf16_t* X1B; float* PS2;
  __device__ __forceinline__ void operator()(const f32x4 (&acc)[2][2][4][2], const pg8::Unit& u, int wr, int wc, int fr, int fq) const {
#pragma unroll
    for (int ai = 0; ai < 2; ++ai)
#pragma unroll
      for (int m = 0; m < 4; ++m) {
        const int row = u.pm * 256 + ai * 128 + wr * 64 + m * 16 + fr;
#pragma unroll
        for (int bj = 0; bj < 2; ++bj) {
          float ss = 0.f;
#pragma unroll
          for (int n = 0; n < 2; ++n) {
            const size_t off = (size_t)row * 1024 + u.pn * 256 + bj * 128 + wc * 32 + n * 16 + 4 * fq;
            const f32x4 v = *(const f32x4*)(x + off) + acc[ai][bj][m][n];
            st_bf4(X1B + off, v);
            ss += v[0] * v[0] + v[1] * v[1] + v[2] * v[2] + v[3] * v[3];
          }
          ss += __shfl_xor(ss, 16); ss += __shfl_xor(ss, 32);
          if (fq == 0) PS2[(size_t)row * 32 + u.pn * 8 + bj * 4 + wc] = ss;
        }
      }
  }
};
struct EpiXQ {
  static constexpr bool PERM = false, AFTER_DRAIN = false;
  bf16_t* XQ; const float* PS2;
  __device__ __forceinline__ void operator()(const f32x4 (&acc)[2][2][4][2], const pg8::Unit& u, int wr, int wc, int fr, int fq) const {
#pragma unroll
    for (int ai = 0; ai < 2; ++ai)
#pragma unroll
      for (int m = 0; m < 4; ++m) {
        const int row = u.pm * 256 + ai * 128 + wr * 64 + m * 16 + fr;
        const f32x4* pp = (const f32x4*)(PS2 + (size_t)row * 32);
        float ss = 0.f;
#pragma unroll
        for (int c = 0; c < 8; ++c) { const f32x4 p = pp[c]; ss += (p[0] + p[1]) + (p[2] + p[3]); }
        const float rs = rsqrtf(ss * (1.f / DM) + EPS);
#pragma unroll
        for (int bj = 0; bj < 2; ++bj)
#pragma unroll
          for (int n = 0; n < 2; ++n) st_bf4(XQ + (size_t)row * 1024 + u.pn * 256 + bj * 128 + wc * 32 + n * 16 + 4 * fq, acc[ai][bj][m][n] * rs);
      }
  }
};
struct EpiX2 {
  static constexpr bool PERM = false, AFTER_DRAIN = false;
  bf16_t* X1B;
  __device__ __forceinline__ void operator()(const f32x4 (&acc)[2][2][4][2], const pg8::Unit& u, int wr, int wc, int fr, int fq) const {
#pragma unroll
    for (int ai = 0; ai < 2; ++ai)
#pragma unroll
      for (int m = 0; m < 4; ++m) {
        const int row = u.pm * 256 + ai * 128 + wr * 64 + m * 16 + fr;
#pragma unroll
        for (int bj = 0; bj < 2; ++bj)
#pragma unroll
          for (int n = 0; n < 2; ++n) {
            bf16_t* p = X1B + (size_t)row * 1024 + u.pn * 256 + bj * 128 + wc * 32 + n * 16 + 4 * fq;
            const u32x2 pr = *(const u32x2*)p; f32x4 r = acc[ai][bj][m][n];
            r[0] += __uint_as_float(pr.x << 16); r[1] += __uint_as_float(pr.x & 0xffff0000u); r[2] += __uint_as_float(pr.y << 16); r[3] += __uint_as_float(pr.y & 0xffff0000u);
            st_bf4(p, r);
          }
      }
  }
};
struct MapMN {
  const bf16_t* A; const bf16_t* Bt; int K, xcd;
  __device__ __forceinline__ void avoff(const pg8::Unit&, int, int K, const unsigned (&voffA)[2], unsigned (&v0)[2], unsigned (&v1)[2]) const { v0[0] = voffA[0]; v0[1] = voffA[1]; v1[0] = voffA[0] + 256u * K; v1[1] = voffA[1] + 256u * K; }
  __device__ __forceinline__ void operator()(int idx, pg8::Unit& u) const {
    u.pm = xcd * 8 + (idx & 7); u.pn = idx >> 3;
    u.aptr = (const char*)(A + (size_t)u.pm * 256 * K); u.bptr = (const char*)(Bt + (size_t)u.pn * 256 * K);
  }
};

struct MapInProj {
  const bf16_t* XB; const bf16_t* WinT; int xcd;
  __device__ __forceinline__ void avoff(const pg8::Unit&, int, int K, const unsigned (&voffA)[2], unsigned (&v0)[2], unsigned (&v1)[2]) const { v0[0] = voffA[0]; v0[1] = voffA[1]; v1[0] = voffA[0] + 256u * K; v1[1] = voffA[1] + 256u * K; }
  __device__ __forceinline__ void operator()(int idx, pg8::Unit& u) const {
    u.pm = xcd * 8 + (idx & 7); u.pn = idx >> 3;
    const char* tokp = (const char*)(XB + (size_t)u.pm * 256 * DM); const char* colp = (const char*)(WinT + (size_t)u.pn * 256 * DM);
    if (u.pn == 12) { u.aptr = colp; u.bptr = tokp; } else { u.aptr = tokp; u.bptr = colp; }
  }
};
struct EpiInProj8 {
  static constexpr bool PERM = false, AFTER_DRAIN = false;
  bf16_t *QK, *V, *O, *NQ, *KVC, *KS, *KW, *VST, *VWT; float* SM; const float* RS1;
  __device__ __forceinline__ void operator()(const f32x4 (&acc)[2][2][4][2], const pg8::Unit& u, int wr, int wc, int fr, int fq) const {
    if (u.pn == 12) {
#pragma unroll
      for (int bj = 0; bj < 2; ++bj)
#pragma unroll
        for (int n = 0; n < 2; ++n) {
          const int tok = u.pm * 256 + bj * 128 + wc * 32 + n * 16 + 4 * fq; const f32x4 rs = *(const f32x4*)(RS1 + tok);
          const int b = tok >> 12, t = tok & 4095;
#pragma unroll
          for (int ai = 0; ai < 2; ++ai)
#pragma unroll
            for (int m = 0; m < 4; ++m) st_bf4((ai ? VWT : VST) + ((size_t)(b * 128 + wr * 64 + m * 16 + fr) << 12) + t, acc[ai][bj][m][n] * rs);
        }
      return;
    }
#pragma unroll
    for (int bj = 0; bj < 2; ++bj) {
      const int nh = u.pn * 256 + bj * 128;
      bf16_t* dst; int ld, cofs; float scale = 1.f;
      if (nh < 1024) { dst = QK; ld = 1024; cofs = nh; }
      else if (nh < 1536) { dst = V; ld = 512; cofs = nh - 1024; }
      else if (nh < 2048) { dst = O; ld = 512; cofs = nh - 1536; }
      else if (nh < 2560) { dst = NQ; ld = 512; cofs = nh - 2048; scale = 0.125f * 1.4426950408889634f; }
      else if (nh < 2816) { dst = KVC; ld = 256; cofs = nh - 2560; }
      else if (nh < 2944) { dst = KS; ld = 128; cofs = 0; }
      else if (nh < 3072) { dst = KW; ld = 128; cofs = 0; }
      else { dst = nullptr; ld = 0; cofs = 0; }
      if (!dst && nh != 3328) continue;
#pragma unroll
      for (int ai = 0; ai < 2; ++ai)
#pragma unroll
        for (int m = 0; m < 4; ++m) {
          const int row = u.pm * 256 + ai * 128 + wr * 64 + m * 16 + fr; const float rs = RS1[row] * scale;
          if (dst) {
#pragma unroll
            for (int n = 0; n < 2; ++n) st_bf4(dst + (size_t)row * ld + cofs + wc * 32 + n * 16 + 4 * fq, acc[ai][bj][m][n] * rs);
          } else if (wc == 0) {
#pragma unroll
            for (int n = 0; n < 2; ++n) *(f32x4*)(SM + (size_t)row * 32 + n * 16 + 4 * fq) = acc[ai][bj][m][n] * rs;
          }
        }
    }
  }
};

struct MapMoe {
  const int* CNT; const int* LIST; const bf16_t* Abase; const bf16_t* W; size_t wstride; int K, xcd, gather;
  __device__ __forceinline__ void operator()(int idx, pg8::Unit& u) const {
    int g = (idx >> 2) * 8 + xcd, e = 0, ce = CNT[0], pre = 0;
    u.pm = g;
    while (g >= ((ce + 255) >> 8)) { g -= (ce + 255) >> 8; pre += ce; ++e; ce = CNT[e]; }
    u.e = e; u.ce = ce; u.rt = g; u.p0 = pre + g * 256; u.pn = idx & 3;
    u.bptr = (const char*)(W + (size_t)e * wstride + (size_t)u.pn * 256 * K);
    u.aptr = gather ? (const char*)Abase : (const char*)(Abase + (size_t)u.p0 * K);
  }
  __device__ __forceinline__ void avoff(const pg8::Unit& u, int tid, int K_, const unsigned (&voffA)[2], unsigned (&v0)[2], unsigned (&v1)[2]) const {
    if (!gather) { v0[0] = voffA[0]; v0[1] = voffA[1]; v1[0] = voffA[0] + 256u * K_; v1[1] = voffA[1] + 256u * K_; return; }
#pragma unroll
    for (int i = 0; i < 2; ++i) {
      int R, C; pg8::stage_rc(tid * 16 + i * 8192, R, C);
      int m0_ = u.rt * 256 + R, m1_ = m0_ + 128; if (m0_ >= u.ce) m0_ = u.ce - 1; if (m1_ >= u.ce) m1_ = u.ce - 1;
      v0[i] = (unsigned)((LIST[u.e * NTOK + m0_] >> 1) * K_ + C) * 2u; v1[i] = (unsigned)((LIST[u.e * NTOK + m1_] >> 1) * K_ + C) * 2u;
    }
  }
};
struct EpiMoe1 {
  static constexpr bool PERM = false, AFTER_DRAIN = false;
  const int* LIST; const float* RS3; bf16_t* ACT;
  __device__ __forceinline__ void operator()(const f32x4 (&acc)[2][2][4][2], const pg8::Unit& u, int wr, int wc, int fr, int fq) const {
#pragma unroll
    for (int ai = 0; ai < 2; ++ai)
#pragma unroll
      for (int m = 0; m < 4; ++m) {
        const int r = ai * 128 + wr * 64 + m * 16 + fr, ml = u.rt * 256 + r;
        if (ml < u.ce) {
          const float rs = RS3[LIST[u.e * NTOK + ml] >> 1];
#pragma unroll
          for (int bj = 0; bj < 2; ++bj) {
            const f32x4 a1 = acc[ai][bj][m][0] * rs, a3 = acc[ai][bj][m][1] * rs; f32x4 r4;
#pragma unroll
            for (int j = 0; j < 4; ++j) r4[j] = siluf_(a1[j]) * a3[j];
            {
              const unsigned long long pk = (unsigned long long)pk2bf(r4[0], r4[1]) | ((unsigned long long)pk2bf(r4[2], r4[3]) << 32);
              __hip_atomic_store((unsigned long long*)(ACT + (size_t)(u.p0 + r) * 512 + (u.pn * 8 + bj * 4 + wc) * 16 + 4 * fq), pk, __ATOMIC_RELAXED, __HIP_MEMORY_SCOPE_AGENT);
            }
          }
        }
      }
  }
};
struct EpiMoe2 {
  static constexpr bool PERM = false, AFTER_DRAIN = false;
  const int* LIST; const float* RTW; bf16_t* Y;
  __device__ __forceinline__ void operator()(const f32x4 (&acc)[2][2][4][2], const pg8::Unit& u, int wr, int wc, int fr, int fq) const {
#pragma unroll
    for (int ai = 0; ai < 2; ++ai)
#pragma unroll
      for (int m = 0; m < 4; ++m) {
        const int r = ai * 128 + wr * 64 + m * 16 + fr, ml = u.rt * 256 + r;
        if (ml < u.ce) {
          const int entry = LIST[u.e * NTOK + ml]; const float w = RTW[entry];
#pragma unroll
          for (int bj = 0; bj < 2; ++bj)
#pragma unroll
            for (int n = 0; n < 2; ++n) st_bf4(Y + (size_t)entry * 1024 + u.pn * 256 + bj * 128 + wc * 32 + n * 16 + 4 * fq, acc[ai][bj][m][n] * w);
        }
      }
  }
};

constexpr int DEP_STRIDE = 16;
struct MoeUpSched {
  int first, stride, count; MapMoe map; unsigned* DEP; bool wave0;
  __device__ __forceinline__ bool next(int i, pg8::Unit& u) const { const int idx = first + i * stride; if (idx >= count) return false; map(idx, u); return true; }
  __device__ __forceinline__ void avoff(const pg8::Unit& u, int tid, int K, const unsigned (&voffA)[2], unsigned (&v0)[2], unsigned (&v1)[2]) const { map.avoff(u, tid, K, voffA, v0, v1); }
  __device__ __forceinline__ void a_ready(const pg8::Unit&) const {}
  __device__ __forceinline__ void done(const pg8::Unit& u) const {
    asm volatile("s_waitcnt vmcnt(0)" ::: "memory");
    __builtin_amdgcn_s_barrier();
    if (wave0 && __builtin_amdgcn_mbcnt_hi(~0u, __builtin_amdgcn_mbcnt_lo(~0u, 0u)) == 0u) (void)__hip_atomic_fetch_add(&DEP[u.pm * DEP_STRIDE], 1u, __ATOMIC_RELAXED, __HIP_MEMORY_SCOPE_AGENT);
  }
};
struct MoeDownSched {
  int li, L, n1, r, fp, nfirst; MapMoe map; unsigned* DEP; bool wave0;
  __device__ __forceinline__ bool next(int i, pg8::Unit& u) const {
    const int j = (i < nfirst) ? 2 * (li - r) + i : fp + li + (i - nfirst) * L;
    if (j >= n1) return false; map(j, u); return true;
  }
  __device__ __forceinline__ void avoff(const pg8::Unit& u, int tid, int K, const unsigned (&voffA)[2], unsigned (&v0)[2], unsigned (&v1)[2]) const { map.avoff(u, tid, K, voffA, v0, v1); }
  __device__ __forceinline__ void a_ready(const pg8::Unit& u) const {
    if (!wave0) return;
    unsigned sp = 0;
    while (__hip_atomic_load(&DEP[u.pm * DEP_STRIDE], __ATOMIC_RELAXED, __HIP_MEMORY_SCOPE_AGENT) < 4u) { __builtin_amdgcn_s_sleep(2); if (++sp > (1u << 22)) break; }
    asm volatile("" ::: "memory");
  }
  __device__ __forceinline__ void done(const pg8::Unit&) const {}
};

struct MapGate {
  const bf16_t* XB; const bf16_t* WgT; int pm, pn;
  __device__ __forceinline__ void avoff(const pg8::Unit&, int, int K, const unsigned (&voffA)[2], unsigned (&v0)[2], unsigned (&v1)[2]) const { v0[0] = voffA[0]; v0[1] = voffA[1]; v1[0] = voffA[0] + 256u * K; v1[1] = voffA[1] + 256u * K; }
  __device__ __forceinline__ void operator()(int idx, pg8::Unit& u) const {
    u.pm = pm; u.pn = pn; u.e = idx;
    u.aptr = (const char*)(XB + (size_t)pm * 256 * DM); u.bptr = (const char*)(WgT + (size_t)(idx * 1024 + pn * 256) * DM);
  }
};
struct EpiGate {
  static constexpr bool PERM = false, AFTER_DRAIN = false;
  bf16_t* G0; bf16_t* G1; const float* RS1;
  __device__ __forceinline__ void operator()(const f32x4 (&acc)[2][2][4][2], const pg8::Unit& u, int wr, int wc, int fr, int fq) const {
    bf16_t* G = u.e ? G1 : G0;
#pragma unroll
    for (int ai = 0; ai < 2; ++ai)
#pragma unroll
      for (int m = 0; m < 4; ++m) {
        const int row = u.pm * 256 + ai * 128 + wr * 64 + m * 16 + fr; const float rs = RS1[row];
#pragma unroll
        for (int bj = 0; bj < 2; ++bj)
#pragma unroll
          for (int n = 0; n < 2; ++n) {
            const f32x4 g = acc[ai][bj][m][n] * rs; f32x4 sg;
#pragma unroll
            for (int j = 0; j < 4; ++j) sg[j] = sigmoidf_(g[j]);
            st_bf4(G + (size_t)row * 1024 + u.pn * 256 + bj * 128 + wc * 32 + n * 16 + 4 * fq, sg);
          }
      }
  }
};

#define XB_TMO      128
#define XB_XCNT(j)  (256  + 64 * (j))
#define XB_XSUB(j)  (1280 + 64 * (j))
#define XB_XGEN(j)  (2304 + 64 * (j))
#define XB_TOP      3328
#define XB_TOPGEN   3392
#define XCD_BAR_WORDS 3456
#define XB_SPIN_CAP (1u << 24)
__device__ __forceinline__ unsigned xb_ld(unsigned* p)              { return __hip_atomic_load(p, __ATOMIC_RELAXED, __HIP_MEMORY_SCOPE_AGENT); }
__device__ __forceinline__ unsigned xb_add(unsigned* p, unsigned v) { return __hip_atomic_fetch_add(p, v, __ATOMIC_RELAXED, __HIP_MEMORY_SCOPE_AGENT); }
__device__ __forceinline__ unsigned xb_xcc_id() { return (unsigned)__builtin_amdgcn_s_getreg((3 << 11) | 20) & 0xFu; }
#define XB_SPIN(cond, bar) do { unsigned _sp = 0; while (cond) { __builtin_amdgcn_s_sleep(1); \
    if ((++_sp & 255u) == 0u) { if (xb_ld(&(bar)[XB_TMO])) break; if (_sp > XB_SPIN_CAP) { atomicAdd(&(bar)[XB_TMO], 1u); break; } } } } while (0)
__device__ __forceinline__ void xcd_barrier_complete(unsigned* bar, unsigned x, unsigned G, unsigned& nloc, unsigned& nx) {
  unsigned sum, cnt, mine, sp = 0u;
  for (;;) {
    sum = 0u; cnt = 0u; mine = 0u;
#pragma unroll
    for (unsigned j = 0; j < 16; ++j) { const unsigned c = xb_ld(&bar[XB_XCNT(j)]); sum += c; cnt += (c > 0u) ? 1u : 0u; mine = (j == x) ? c : mine; }
    if (sum == G) break;
    __builtin_amdgcn_s_sleep(1);
    if ((++sp & 255u) == 0u) { if (xb_ld(&bar[XB_TMO])) break; if (sp > XB_SPIN_CAP) { atomicAdd(&bar[XB_TMO], 1u); break; } }
  }
  nloc = mine > 0u ? mine : 1u; nx = cnt > 0u ? cnt : 1u;
}
__device__ __forceinline__ void xcd_barrier(unsigned* bar, unsigned x, volatile unsigned* st, unsigned G, bool leader_thread) {
  asm volatile("s_waitcnt vmcnt(0)" ::: "memory");
  __syncthreads();
  if (leader_thread) {
    __builtin_amdgcn_s_waitcnt(0);
    unsigned nloc = st[0], nx = st[1];
    if (nloc == 0u) { xcd_barrier_complete(bar, x, G, nloc, nx); st[0] = nloc; st[1] = nx; }
    const unsigned old = xb_add(&bar[XB_XSUB(x)], 1u);
    const unsigned gen = old / nloc;
    if (old + 1u == (gen + 1u) * nloc) {
      __builtin_amdgcn_fence(__ATOMIC_RELEASE, "agent");
      asm volatile("s_waitcnt vmcnt(0)" ::: "memory");
      const unsigned og = xb_add(&bar[XB_TOP], 1u);
      const unsigned tg = og / nx;
      if (og + 1u == (tg + 1u) * nx) xb_add(&bar[XB_TOPGEN], 1u);
      else XB_SPIN(xb_ld(&bar[XB_TOPGEN]) == tg, bar);
      __builtin_amdgcn_fence(__ATOMIC_ACQUIRE, "agent");
      xb_add(&bar[XB_XGEN(x)], 1u);
      asm volatile("s_waitcnt vmcnt(0)" ::: "memory");
    } else {
      XB_SPIN(xb_ld(&bar[XB_XGEN(x)]) == gen, bar);
      __builtin_amdgcn_fence(__ATOMIC_ACQUIRE, "agent");
      asm volatile("s_waitcnt vmcnt(0)" ::: "memory");
    }
  }
  __syncthreads();
}

__device__ __forceinline__ void convert_range(const MegaArgs& a, int lo, int hi, int bid, int nblk, char* lds, int tid) {
  for (int it0 = lo; it0 < hi; it0 += nblk) {
    int it = it0 + bid; if (it >= hi) it = hi - 1;
    int r = it, di = 0;
    while (r >= a.td[di].nitems) { r -= a.td[di].nitems; ++di; }
    transpose_item(a.td[di], r, (float*)lds, tid);
  }
}
#define TILE_IDS unsigned tid_z = 0u; asm volatile("" : "+v"(tid_z)); int tid = (wave_s & 3) * 64 + (int)__builtin_amdgcn_mbcnt_hi(~0u, __builtin_amdgcn_mbcnt_lo(~0u, tid_z)); asm volatile("" : "+v"(tid)); const int half = wave_s >> 2; char* const lds = plds + half * HALF_LDS; const int bid = pbid * 2 + half, nblk = pnblk * 2, li = (pbid >> 3) * 2 + half, nloc = (pnblk >> 3) * 2; const int lane = tid & 63, wid = tid >> 6, wr = wid >> 1, wc = wid & 1, fr = lane & 15, fq = lane >> 4; (void)lane; (void)wid; (void)wr; (void)wc; (void)fr; (void)fq; (void)half; (void)lds; (void)bid; (void)nblk; (void)li; (void)nloc

__global__ void __launch_bounds__(512, 2) k_mega(MegaArgs a) {
  extern __shared__ __attribute__((aligned(16))) char lds_raw[];
  char* const plds = lds_raw;
  cg::grid_group grid = cg::this_grid();
  const int pnblk = gridDim.x, pbid = blockIdx.x;
  const int wave_s = __builtin_amdgcn_readfirstlane((int)(threadIdx.x >> 6));
  unsigned* const xbar = a.BAR + a.li * XCD_BAR_WORDS;
  volatile unsigned* const xst = (volatile unsigned*)(plds + CTRL_OFF);
  volatile int* const xch = (volatile int*)(plds + CTRL_OFF + 16);
  unsigned xcc;
  {
    const bool t0 = (wave_s == 0) && ((int)__builtin_amdgcn_mbcnt_hi(~0u, __builtin_amdgcn_mbcnt_lo(~0u, 0u)) == 0);
    if (t0) { xst[0] = 0u; xst[1] = 0u; }
    xcc = xb_xcc_id();
    if (t0) (void)xb_add(&xbar[XB_XCNT(xcc)], 1u);
    grid.sync();
  }
#define PH(k) (a.ph_lo <= (k) && (k) < a.ph_hi)
  const int xcd = pbid & 7;
#define GRID_BAR() do { const int ld_ = (wave_s == 0) && ((int)__builtin_amdgcn_mbcnt_hi(~0u, __builtin_amdgcn_mbcnt_lo(~0u, 0u)) == 0); xcd_barrier(xbar, xcc, xst, (unsigned)pnblk, ld_); } while (0)
#define SYNC_AFTER(k) do { if (PH(k) && PH((k) + 1)) GRID_BAR(); } while (0)
#pragma unroll 1
  for (int rp_ = PH(0) ? a.rep[0] : 0; rp_ > 0; --rp_) {
    TILE_IDS;
    convert_range(a, a.cv_lo[0], a.cv_hi[0], bid, nblk, lds, tid);
    for (int i = bid * 256 + tid; i < (NIN - DIN_A) * 1024 / 8; i += nblk * 256) ((u32x4*)(a.WinT + (size_t)DIN_A * 1024))[i] = (u32x4){0u, 0u, 0u, 0u};
    rows_to_bf16(a.x, a.XB, a.RS1, NTOK, bid * 4 + wid, nblk * 4, lane);
    rows_to_bf16(a.mem, a.MEMB, a.RSM, NB * MEMT, bid * 4 + wid, nblk * 4, lane);
    for (int o = bid * 4 + wid; o < 256; o += nblk * 4) {
      const int which = o >> 7, u = o & 127; const float* pos = which ? a.posv : a.posk; const float* w1 = which ? a.cvw1 : a.ckw1;
      float sacc = 0.f;
      for (int f = lane; f < 2048; f += 64) sacc += pos[f] * w1[(size_t)f * 128 + u];
      sacc = wave_sum(sacc);
      if (lane == 0) a.POSW[o] = sacc;
    }
  }
  SYNC_AFTER(0);
#pragma unroll 1
  for (int rp_ = PH(1) ? a.rep[1] : 0; rp_ > 0; --rp_) {
    TILE_IDS;
    {
      TILE8_IDS;
      ListSched<MapInProj> S8{pbid >> 3, pnblk >> 3, 112, MapInProj{a.XB, a.WinT, xcd}};
      EpiInProj8 E8{a.QK, a.V, a.O, a.NQ, a.KVC, a.KS, a.KW, a.VST, a.VWT, a.SM, a.RS1};
      pg8::gemm_phase<EpiInProj8, ListSched<MapInProj>, true, true>((PG8_LAS unsigned char*)plds, pg8::Gemm{DM}, S8, E8, t512, wave_s);
    }
    if ((pbid >> 3) >= 16) convert_range(a, a.cv_lo[1], a.cv_hi[1], ((xcd * 16 + (pbid >> 3) - 16) * 2 + half), (pnblk >> 1) * 2, lds, tid);
  }
  SYNC_AFTER(1);
#pragma unroll 1
  for (int rp_ = PH(2) ? a.rep[2] : 0; rp_ > 0; --rp_) {
    TILE_IDS;
    for (int it = bid; it < 128; it += nblk) {
      const int which = it >> 6, m0 = ((it >> 2) & 15) * 128, slab = it & 3;
      f32x4 acc[4][4]; zero_acc(acc);
      {
        int tid2 = tid; asm volatile("" : "+v"(tid2));
        unsigned ao[4], bo[4];
#pragma unroll
        for (int i = 0; i < 4; ++i) {
          const int row = st_row(tid2, i), lc = st_lc(tid2, i);
          const int m = m0 + row, bg = m >> 8, j = m & 255;
          ao[i] = (unsigned)((bg >> 1) * SEQ + 16 * j + slab * 8) * 256u + which * 128 + (bg & 1) * 64 + lc * 8;
          bo[i] = (unsigned)row * 2048u + slab * 512 + lc * 8;
        }
        gemm_core(acc, a.KVC, ao, 256u, which ? a.CV1T : a.CK1T, bo, 64u, 8, lds, tid2);
      }
      float* cp = a.CPART + (size_t)((which * 4 + slab) * 2048 + m0) * 128;
#pragma unroll
      for (int mi = 0; mi < 4; ++mi)
#pragma unroll
        for (int ni = 0; ni < 4; ++ni) *(f32x4*)(cp + (wr * 64 + mi * 16 + fr) * 128 + wc * 64 + ni * 16 + 4 * fq) = acc[mi][ni];
    }
    for (int q = nloc - 1 - li; q < 16; q += nloc) {
      f32x4 acc[4][4]; zero_acc(acc);
      const int tile = xcd * 16 + q; constexpr int T1 = 0, T2n = 16;
        const int t2 = tile - T1; const int m0 = (t2 / T2n) * 128, n0 = (t2 % T2n) * 128;
        if (n0 < 1024) {
          gemm_acc(acc, a.MEMB, DM, (const int*)nullptr, 0, 0, a.WkvT, DM, DM, lds, m0, n0, tid);
#pragma unroll
          for (int mi = 0; mi < 4; ++mi) {
            const int m = m0 + wr * 64 + mi * 16 + fr; const float rs = a.RSM[m];
#pragma unroll
            for (int ni = 0; ni < 4; ++ni) st_bf4(a.KVM + (size_t)m * 1024 + n0 + wc * 64 + ni * 16 + 4 * fq, acc[mi][ni] * rs);
          }
        } else {
          gemm_acc(acc, a.WkvT, DM, (const int*)nullptr, 0, 0, a.MEMB, DM, DM, lds, n0, m0, tid);
          bf16_t* vmt = a.KVM + (size_t)1024 * 1024;
#pragma unroll
          for (int ni = 0; ni < 4; ++ni) {
            const int tok = m0 + wc * 64 + ni * 16 + 4 * fq; const f32x4 rs = *(const f32x4*)(a.RSM + tok);
            const int b = tok >> 8, key = tok & 255;
#pragma unroll
            for (int mi = 0; mi < 4; ++mi) {
              const int col = n0 - 1024 + wr * 64 + mi * 16 + fr;
              st_bf4(vmt + ((size_t)(b * 1024 + col) << 8) + key, acc[mi][ni] * rs);
            }
          }
        }
    }
    for (int lp = pbid >> 3; lp < 32; lp += pnblk >> 3) nsa_win_item(a, ((((((xcd >> 1) & 1) * 2 + half) * 2 + (xcd & 1)) << 6)) | (63 - (2 * lp + (xcd >> 2))), lds, tid);
    {
      volatile int* wqw = (volatile int*)(lds + MEGA_LDS - 32);
      (void)wqw;
      for (;;) {
        if (wave_s == 0 && lane == 0) xch[2] = atomicAdd(a.WQ + 1, 2);
        __syncthreads();
        const int it0 = xch[2];
        __syncthreads();
        if (it0 >= 1024) break;
        ml_dc_item(a, a.ml, it0 + half, lds, tid);
      }
    }
  }
  SYNC_AFTER(2);
#pragma unroll 1
  for (int rp_ = PH(3) ? a.rep[3] : 0; rp_ > 0; --rp_) {
    TILE_IDS;
    if (rp_ == 1) for (int it = bid; it < 272; it += nblk) ml_scan_item(a.ml, it, tid);
    for (int it = nblk - 1 - bid; it < 128; it += nblk) {
      const int which = it >> 6, m0 = (it & 63) * 32;
      float* hid = (float*)lds;
      float* w2s = (float*)(lds + 16640);
      {
        const float* w2 = which ? a.cvw2 : a.ckw2;
#pragma unroll
        for (int c = 0; c < 8; ++c) *(f32x4*)(w2s + (tid + 256 * c) * 4) = *(const f32x4*)(w2 + (tid + 256 * c) * 4);
        const int row = tid >> 3, u0 = (tid & 7) * 16;
        const float* cp = a.CPART + (size_t)(which * 4 * 2048 + m0 + row) * 128 + u0;
#pragma unroll
        for (int c4 = 0; c4 < 4; ++c4) {
          f32x4 hv = *(const f32x4*)(cp + c4 * 4) + *(const f32x4*)(cp + 2048 * 128 + c4 * 4) + *(const f32x4*)(cp + 2 * 2048 * 128 + c4 * 4) + *(const f32x4*)(cp + 3 * 2048 * 128 + c4 * 4)
                   + *(const f32x4*)(a.POSW + which * 128 + u0 + c4 * 4);
#pragma unroll
          for (int j = 0; j < 4; ++j) hid[row * 129 + u0 + c4 * 4 + j] = gelu_tanh(hv[j]);
        }
      }
      __syncthreads();
      {
        const int row = tid >> 3, d0 = (tid & 7) * 8;
        float o[8];
#pragma unroll
        for (int d = 0; d < 8; ++d) o[d] = 0.f;
        for (int u = 0; u < 128; ++u) {
          const float hv = hid[row * 129 + u]; const f32x4 w0 = *(const f32x4*)(w2s + u * 64 + d0), w1 = *(const f32x4*)(w2s + u * 64 + d0 + 4);
          o[0] += hv * w0[0]; o[1] += hv * w0[1]; o[2] += hv * w0[2]; o[3] += hv * w0[3]; o[4] += hv * w1[0]; o[5] += hv * w1[1]; o[6] += hv * w1[2]; o[7] += hv * w1[3];
        }
        const int m = m0 + row, bg = m >> 8, j = m & 255;
        if (which == 0) {
#pragma unroll
          for (int d = 0; d < 8; ++d) a.KC[(size_t)m * 64 + d0 + d] = (j == 255) ? (bf16_t)0 : f2bf(o[d]);
        } else {
#pragma unroll
          for (int d = 0; d < 8; ++d) a.VCT[((size_t)(bg * 64 + d0 + d) << 8) + j] = (j == 255) ? (bf16_t)0 : f2bf(o[d]);
        }
      }
      __syncthreads();
    }
  }
  SYNC_AFTER(3);
#pragma unroll 1
  for (int rp_ = PH(4) ? a.rep[4] : 0; rp_ > 0; --rp_) {
    for (int lp = pbid >> 3; lp < 32; lp += pnblk >> 3) { TILE_IDS; nsa_main_item(a, ((((((xcd >> 1) & 1) * 2 + half) * 2 + (xcd & 1)) << 6)) | (63 - (2 * lp + (xcd >> 2))), lds, tid, xch, half); }
    { TILE_IDS;
      volatile int* wqw = (volatile int*)(lds + MEGA_LDS - 32);
      (void)wqw;
      for (;;) {
        if (wave_s == 0 && lane == 0) xch[2] = atomicAdd(a.WQ, 2);
        __syncthreads();
        const int it0 = xch[2];
        __syncthreads();
        if (it0 >= 1024) break;
        ml_out_item(a, a.ml, it0 + half, lds, tid);
      } }
  }
  SYNC_AFTER(4);
#pragma unroll 1
  for (int rp_ = PH(5) ? a.rep[5] : 0; rp_ > 0; --rp_) {
    bf16_t* const G1 = (bf16_t*)((char*)a.out + 32 * MiB);
    const int xcd = pbid & 7;
    for (int lp = pbid >> 3; lp < 32; lp += pnblk >> 3) {
      const int pm = xcd * 8 + (lp & 7), pn = lp >> 3;
      {
        TILE8_IDS;
        ListSched<MapGate> S8{0, 1, 2, MapGate{a.XB, a.WgT, pm, pn}}; EpiGate E8{a.MRG, G1, a.RS1};
        pg8::gemm_phase<EpiGate, ListSched<MapGate>, false, true>((PG8_LAS unsigned char*)plds, pg8::Gemm{DM}, S8, E8, t512, wave_s);
      }
      asm volatile("s_waitcnt vmcnt(0)" ::: "memory");
      __threadfence_block();
      __syncthreads();
      TILE_IDS;
#pragma unroll 1
      for (int tt = 0; tt < 2; ++tt) {
        const int m0 = pm * 256 + half * 128, n0 = pn * 256 + tt * 128;
        f32x4 acc[4][4]; u32x2 rp[4][4];
#pragma unroll 1
        for (int br = 0; br < 2; ++br) {
          zero_acc(acc);
          gemm_acc(acc, br ? a.ANS : a.AML, 512, (const int*)nullptr, 0, 0, br ? a.WnsT : a.WmlT, 512, 512, lds, m0, n0, tid);
          const bf16_t* G = br ? G1 : a.MRG;
#pragma unroll
          for (int mi = 0; mi < 4; ++mi) {
            const int m = m0 + wr * 64 + mi * 16 + fr;
#pragma unroll
            for (int ni = 0; ni < 4; ++ni) {
              const u32x2 gv = *(const u32x2*)(G + (size_t)m * 1024 + n0 + wc * 64 + ni * 16 + 4 * fq);
              f32x4 g; g[0] = __uint_as_float(gv.x << 16); g[1] = __uint_as_float(gv.x & 0xffff0000u); g[2] = __uint_as_float(gv.y << 16); g[3] = __uint_as_float(gv.y & 0xffff0000u);
              f32x4 r = g * acc[mi][ni];
              if (br == 1) { r[0] += __uint_as_float(rp[mi][ni].x << 16); r[1] += __uint_as_float(rp[mi][ni].x & 0xffff0000u);
                             r[2] += __uint_as_float(rp[mi][ni].y << 16); r[3] += __uint_as_float(rp[mi][ni].y & 0xffff0000u); }
              rp[mi][ni].x = pk2bf(r[0], r[1]); rp[mi][ni].y = pk2bf(r[2], r[3]);
            }
          }
        }
#pragma unroll
        for (int mi = 0; mi < 4; ++mi) {
          const int m = m0 + wr * 64 + mi * 16 + fr;
#pragma unroll
          for (int ni = 0; ni < 4; ++ni) *(u32x2*)(a.MRG + (size_t)m * 1024 + n0 + wc * 64 + ni * 16 + 4 * fq) = rp[mi][ni];
        }
      }
    }
    { TILE_IDS; convert_range(a, a.cv_lo[5], a.cv_hi[5], bid, nblk, lds, tid); }
  }
  SYNC_AFTER(5);
#pragma unroll 1
  for (int rp_ = PH(6) ? a.rep[6] : 0; rp_ > 0; --rp_) {
    TILE_IDS;
    {
      TILE8_IDS;
      ListSched<MapMN> S8{pbid >> 3, pnblk >> 3, 32, MapMN{a.MRG, a.WoutT, DM, xcd}};
      EpiX1 E8{a.x, a.X1B, a.PS2};
      pg8::gemm_phase<decltype(E8), ListSched<MapMN>, false, true>((PG8_LAS unsigned char*)plds, pg8::Gemm{DM}, S8, E8, t512, wave_s);
    }
    convert_range(a, a.cv_lo[6], a.cv_hi[6], bid, nblk, lds, tid);
  }
  SYNC_AFTER(6);
#pragma unroll 1
  for (int rp_ = PH(7) ? a.rep[7] : 0; rp_ > 0; --rp_) {
    TILE_IDS;
    {
      TILE8_IDS;
      ListSched<MapMN> S8{pbid >> 3, pnblk >> 3, 32, MapMN{a.X1B, a.WqT, DM, xcd}};
      EpiXQ E8{a.XQ, a.PS2};
      pg8::gemm_phase<decltype(E8), ListSched<MapMN>, false, true>((PG8_LAS unsigned char*)plds, pg8::Gemm{DM}, S8, E8, t512, wave_s);
    }
    convert_range(a, a.cv_lo[7], a.cv_hi[7], bid, nblk, lds, tid);
  }
  SYNC_AFTER(7);
#pragma unroll 1
  for (int rp_ = PH(8) ? a.rep[8] : 0; rp_ > 0; --rp_) {
    TILE_IDS;
    float* RMX = (float*)lds; float* RSUM = (float*)(lds + 1024);
    for (int q = li; q < 64; q += nloc) {
      const int m0 = (xcd * 16 + (q >> 2)) * 128, hh = q & 3, b = m0 >> 12;
      bf16_t* Qh = a.XQ + hh * 256;
      const bf16_t* Kh = a.KVM + (size_t)(b * 256) * 1024 + hh * 256;
      const bf16_t* Vh = a.KVM + (size_t)1024 * 1024 + ((size_t)(b * 1024 + hh * 256) << 8);
      f32x4 acc0[4][4], acc1[4][4]; zero_acc(acc0); zero_acc(acc1);
      gemm_acc(acc0, Qh, 1024, (const int*)nullptr, 0, 0, Kh, 1024, 256, lds, m0, 0, tid);
      gemm_acc(acc1, Qh, 1024, (const int*)nullptr, 0, 0, Kh, 1024, 256, lds, m0, 128, tid);
      float mloc[4];
#pragma unroll
      for (int mi = 0; mi < 4; ++mi) {
        float mx = -INFINITY;
#pragma unroll
        for (int ni = 0; ni < 4; ++ni)
#pragma unroll
          for (int j = 0; j < 4; ++j) mx = fmaxf(mx, fmaxf(acc0[mi][ni][j], acc1[mi][ni][j]));
        mx = max4(mx); mloc[mi] = mx;
        if (fq == 0) RMX[(wr * 64 + mi * 16 + fr) * 2 + wc] = mx;
      }
      __syncthreads();
#pragma unroll
      for (int mi = 0; mi < 4; ++mi) {
        const int r = wr * 64 + mi * 16 + fr;
        const float m = fmaxf(RMX[r * 2], RMX[r * 2 + 1]); float ls = 0.f;
#pragma unroll
        for (int ni = 0; ni < 4; ++ni)
#pragma unroll
          for (int j = 0; j < 4; ++j) {
            acc0[mi][ni][j] = __expf((acc0[mi][ni][j] - m) * 0.0625f); acc1[mi][ni][j] = __expf((acc1[mi][ni][j] - m) * 0.0625f);
            ls += acc0[mi][ni][j] + acc1[mi][ni][j];
          }
        ls = red4(ls);
        if (fq == 0) RSUM[r * 2 + wc] = ls;
      }
      __syncthreads();
#pragma unroll
      for (int mi = 0; mi < 4; ++mi) {
        const int r = wr * 64 + mi * 16 + fr;
        const float inv = 1.f / (RSUM[r * 2] + RSUM[r * 2 + 1]);
        bf16_t* pr = Qh + (size_t)(m0 + r) * 1024 + wc * 64 + 4 * fq;
#pragma unroll
        for (int ni = 0; ni < 4; ++ni) { st_bf4(pr + ni * 16, acc0[mi][ni] * inv); st_bf4(pr + 128 + ni * 16, acc1[mi][ni] * inv); }
      }
      asm volatile("s_waitcnt vmcnt(0)" ::: "memory");
      __threadfence_block();
      __syncthreads();
#pragma unroll 1
      for (int dh = 0; dh < 2; ++dh) {
        zero_acc(acc0);
        gemm_acc(acc0, Qh, 1024, (const int*)nullptr, 0, 0, Vh, 256, 256, lds, m0, dh * 128, tid);
#pragma unroll
        for (int mi = 0; mi < 4; ++mi) {
          const int r = wr * 64 + mi * 16 + fr;
#pragma unroll
          for (int ni = 0; ni < 4; ++ni) st_bf4(a.XO + (size_t)(m0 + r) * 1024 + hh * 256 + dh * 128 + wc * 64 + ni * 16 + 4 * fq, acc0[mi][ni]);
        }
      }
    }
    convert_range(a, a.cv_lo[8], a.cv_hi[8], bid, nblk, lds, tid);
  }
  SYNC_AFTER(8);
#pragma unroll 1
  for (int rp_ = PH(9) ? a.rep[9] : 0; rp_ > 0; --rp_) {
    TILE_IDS;
    {
      TILE8_IDS;
      ListSched<MapMN> S8{pbid >> 3, pnblk >> 3, 32, MapMN{a.XO, a.WoT, DM, xcd}};
      EpiX2 E8{a.X1B};
      pg8::gemm_phase<decltype(E8), ListSched<MapMN>, false, true>((PG8_LAS unsigned char*)plds, pg8::Gemm{DM}, S8, E8, t512, wave_s);
    }
    convert_range(a, a.cv_lo[9], a.cv_hi[9], bid, nblk, lds, tid);
  }
  SYNC_AFTER(9);
#pragma unroll 1
  for (int rp_ = PH(10) ? a.rep[10] : 0; rp_ > 0; --rp_) {
    TILE_IDS;
    const int tpb = NTOK / nblk;
    int* ex_l = (int*)(lds + 65536);
    float* we_l = (float*)lds;
    for (int c = tid; c < 4096; c += 256) { const int k = c >> 2, q = c & 3; *(f32x4*)(we_l + (q * 1024 + k) * 4) = *(const f32x4*)(a.we + k * 16 + q * 4); }
    __syncthreads();
    for (int k = 0; k < tpb / 4; ++k) {
      const int tl = wid * (tpb / 4) + k, n = bid * tpb + tl;
      int lane = tid & 63; asm volatile("" : "+v"(lane));
      const bf16_t* xr = a.H3 + (size_t)n * DM;
      float v[16]; float s = 0.f;
#pragma unroll
      for (int i = 0; i < 16; ++i) { v[i] = bf2f(xr[lane + 64 * i]); s += v[i] * v[i]; }
      s = wave_sum(s);
      const float rs = rsqrtf(s * (1.f / DM) + EPS);
      float lg[20];
#pragma unroll
      for (int e = 0; e < 20; ++e) lg[e] = 0.f;
#pragma unroll
      for (int i = 0; i < 16; ++i) {
        const int k2 = lane + 64 * i; const float hk = v[i] * rs * a.g_ffn[k2];
        const f32x4 wgv = *(const f32x4*)(a.wg + k2 * 4);
#pragma unroll
        for (int e = 0; e < 4; ++e) lg[e] += hk * wgv[e];
#pragma unroll
        for (int q = 0; q < 4; ++q) { const f32x4 wv = *(const f32x4*)(we_l + (q * 1024 + k2) * 4);
#pragma unroll
          for (int e = 0; e < 4; ++e) lg[4 + q * 4 + e] += hk * wv[e]; }
      }
#pragma unroll
      for (int e = 0; e < 20; ++e) lg[e] = wave_sum(lg[e]);
      if (lane == 0) {
        float gl[4]; float gm = -INFINITY; int gi = 0;
#pragma unroll
        for (int e = 0; e < 4; ++e) { gl[e] = lg[e] + a.bg[e]; if (gl[e] > gm) { gm = gl[e]; gi = e; } }
        float gs = 0.f;
#pragma unroll
        for (int e = 0; e < 4; ++e) gs += __expf(gl[e] - gm);
        const float gval = 1.f / gs;
        float el[4] = {0.f, 0.f, 0.f, 0.f};
#pragma unroll
        for (int gg = 0; gg < 4; ++gg) if (gi == gg) {
#pragma unroll
          for (int e = 0; e < 4; ++e) el[e] = lg[4 + gg * 4 + e] + a.be[gg * 4 + e];
        }
        int i0 = 0; float v0 = el[0];
#pragma unroll
        for (int e = 1; e < 4; ++e) if (el[e] > v0) { v0 = el[e]; i0 = e; }
        int i1 = -1; float v1 = -INFINITY;
#pragma unroll
        for (int e = 0; e < 4; ++e) if (e != i0 && el[e] > v1) { v1 = el[e]; i1 = e; }
        const float e1 = __expf(v1 - v0);
        ex_l[tl * 2] = gi * 4 + i0; ex_l[tl * 2 + 1] = gi * 4 + i1;
        a.RTW[n * 2] = gval / (1.f + e1); a.RTW[n * 2 + 1] = gval * e1 / (1.f + e1);
        a.RS3[n] = rs;
      }
    }
    __syncthreads();
    if (tid < 16) {
      int cnt = 0;
      for (int j = 0; j < 2 * tpb; ++j) cnt += (ex_l[j] == tid) ? 1 : 0;
      if (cnt > 0) {
        int pos = atomicAdd(&a.CNT[tid], cnt);
        for (int j = 0; j < 2 * tpb; ++j) if (ex_l[j] == tid) a.LIST[tid * NTOK + pos++] = (bid * tpb) * 2 + j;
      }
    }
    __syncthreads();
  }
  SYNC_AFTER(10);
#pragma unroll 1
  for (int rp_ = PH(11) ? a.rep[11] : 0; rp_ > 0; --rp_) {
    TILE8_IDS;
    int rtot = 0;
    for (int e = 0; e < 16; ++e) rtot += (a.CNT[e] + 255) >> 8;
    const int n1 = ((rtot - xcd + 7) >> 3) * 4;
    const int li8 = pbid >> 3, L8 = pnblk >> 3;
    unsigned* const DEP = (unsigned*)a.CNT + 1024;
    {
      MoeUpSched S8{li8, L8, n1, MapMoe{a.CNT, a.LIST, a.H3, a.W13T, (size_t)1024 * 1024, DM, xcd, 1}, DEP, wave_s == 0};
      EpiMoe1 E8{a.LIST, a.RS3, a.ACT};
      pg8::gemm_phase<EpiMoe1, MoeUpSched, true, true>((PG8_LAS unsigned char*)plds, pg8::Gemm{DM}, S8, E8, t512, wave_s);
    }
    {
      const int r = n1 % L8, fp = r ? min(n1, 2 * (L8 - r)) : 0;
      const int nfirst = (r && li8 >= r) ? max(0, min(2, n1 - 2 * (li8 - r))) : 0;
      MoeDownSched S8{li8, L8, n1, r, fp, nfirst, MapMoe{a.CNT, a.LIST, a.ACT, a.W2T, (size_t)1024 * 512, 512, xcd, 0}, DEP, wave_s == 0};
      EpiMoe2 E8{a.LIST, a.RTW, a.Y};
      { pg8::Unit u0; if (S8.next(0, u0)) S8.a_ready(u0); }
      __syncthreads();
      pg8::gemm_phase<EpiMoe2, MoeDownSched, true, true, true>((PG8_LAS unsigned char*)plds, pg8::Gemm{512}, S8, E8, t512, wave_s);
    }
  }
  if (PH(11) && PH(13)) GRID_BAR();
#pragma unroll 1
  for (int rp_ = PH(13) ? a.rep[13] : 0; rp_ > 0; --rp_) {
    TILE_IDS;
    for (int row = bid * 4 + wid; row < NTOK; row += nblk * 4) {
      f32x4* xr = (f32x4*)(a.out + (size_t)row * DM) + lane;
      const u32x2* x2r = (const u32x2*)(a.H3 + (size_t)row * DM) + lane;
      const u32x2* y0 = (const u32x2*)(a.Y + (size_t)(row * 2) * DM) + lane; const u32x2* y1 = y0 + DM / 4;
      f32x4 v[4]; float s = 0.f;
#pragma unroll
      for (int j = 0; j < 4; ++j) {
        { const u32x2 xx = x2r[64 * j]; v[j][0] = __uint_as_float(xx.x << 16); v[j][1] = __uint_as_float(xx.x & 0xffff0000u); v[j][2] = __uint_as_float(xx.y << 16); v[j][3] = __uint_as_float(xx.y & 0xffff0000u); }
        const u32x2 p = y0[64 * j], q = y1[64 * j];
        v[j][0] += __uint_as_float(p.x << 16) + __uint_as_float(q.x << 16); v[j][1] += __uint_as_float(p.x & 0xffff0000u) + __uint_as_float(q.x & 0xffff0000u);
        v[j][2] += __uint_as_float(p.y << 16) + __uint_as_float(q.y << 16); v[j][3] += __uint_as_float(p.y & 0xffff0000u) + __uint_as_float(q.y & 0xffff0000u);
        s += v[j][0] * v[j][0] + v[j][1] * v[j][1] + v[j][2] * v[j][2] + v[j][3] * v[j][3];
      }
      s = wave_sum(s);
      const float rs = rsqrtf(s * (1.f / DM) + EPS);
#pragma unroll
      for (int j = 0; j < 4; ++j) xr[64 * j] = v[j] * rs * ((const f32x4*)a.g_final)[lane + 64 * j];
    }
  }
}

extern "C" void kernel_launch(void* const* d_in, const int* in_sizes, int n_in, void* d_out, int out_size, void* d_ws, size_t ws_size, hipStream_t stream) {
  const float* x = (const float*)d_in[0];
  const float* mem = (const float*)d_in[1];
  const float* norm_mix = (const float*)d_in[2];
  const float* w_in = (const float*)d_in[3];
  const float* conv_qk = (const float*)d_in[4];
  const float* b_igate = (const float*)d_in[5];
  const float* b_fgate = (const float*)d_in[6];
  const float* mlstm_norm = (const float*)d_in[7];
  const float* cmp_pos_k = (const float*)d_in[8];
  const float* cmp_pos_v = (const float*)d_in[9];
  const float* cmp_k_w1 = (const float*)d_in[10];
  const float* cmp_k_w2 = (const float*)d_in[11];
  const float* cmp_v_w1 = (const float*)d_in[12];
  const float* cmp_v_w2 = (const float*)d_in[13];
  const float* w_br_mlstm = (const float*)d_in[14];
  const float* w_br_nsa = (const float*)d_in[15];
  const float* w_mix_out = (const float*)d_in[16];
  const float* norm_xattn = (const float*)d_in[17];
  const float* norm_mem = (const float*)d_in[18];
  const float* xa_wq = (const float*)d_in[19];
  const float* xa_wkv = (const float*)d_in[20];
  const float* xa_wo = (const float*)d_in[21];
  const float* norm_ffn = (const float*)d_in[22];
  const float* router_group_w = (const float*)d_in[23];
  const float* router_group_b = (const float*)d_in[24];
  const float* router_expert_w = (const float*)d_in[25];
  const float* router_expert_b = (const float*)d_in[26];
  const float* moe_w1 = (const float*)d_in[27];
  const float* moe_w3 = (const float*)d_in[28];
  const float* moe_w2 = (const float*)d_in[29];
  const float* norm_final = (const float*)d_in[30];
  float* out = (float*)d_out;
  char* ws = (char*)d_ws;

  int* CNT = (int*)(ws + WS_CNT); int* LIST = (int*)(ws + WS_LIST); float* RTW = (float*)(ws + WS_RTW);
  float* SM = (float*)(ws + WS_SM); float* BCUM = (float*)(ws + WS_BCUM); float* IP = (float*)(ws + WS_IP);
  float* BL = (float*)(ws + WS_BL); float* MX = (float*)(ws + WS_MX); float* MST = (float*)(ws + WS_MST); float* NST = (float*)(ws + WS_NST);
  bf16_t* KC = (bf16_t*)(ws + WS_KC); bf16_t* VC = (bf16_t*)(ws + WS_VC);
  bf16_t* QK = (bf16_t*)(ws + WS_QK); bf16_t* V = (bf16_t*)(ws + WS_V); bf16_t* O = (bf16_t*)(ws + WS_O);
  bf16_t* NQ = (bf16_t*)(ws + WS_NQ); bf16_t* KV = (bf16_t*)(ws + WS_KV); bf16_t* CST = (bf16_t*)(ws + WS_CST);
  bf16_t* AML = (bf16_t*)(ws + WS_AML); bf16_t* ANS = (bf16_t*)(ws + WS_ANS); bf16_t* MRG = (bf16_t*)(ws + WS_MRG);
  bf16_t* KVM = (bf16_t*)(ws + WS_KVM); bf16_t* MEMN = (bf16_t*)(ws + WS_MEMN);
  bf16_t* H2 = (bf16_t*)(ws + WS_H2); bf16_t* XQ = (bf16_t*)(ws + WS_XQ); bf16_t* XO = (bf16_t*)(ws + WS_XO);
  bf16_t* H3 = H2; bf16_t* ACT = XQ; bf16_t* Y = (bf16_t*)(ws + 136 * MiB);
  bf16_t* H = (bf16_t*)d_out;
  bf16_t* T2 = (bf16_t*)((char*)d_out + 32 * MiB);

  (void)hipMemsetAsync(ws, 0, 131072, stream);
  static int grid_blocks = 0;
  if (!grid_blocks) {
    int dev = 0, cus = 0, per_cu = 0;
    (void)hipGetDevice(&dev);
    (void)hipDeviceGetAttribute(&cus, hipDeviceAttributeMultiprocessorCount, dev);
    (void)hipFuncSetAttribute((const void*)k_mega, hipFuncAttributeMaxDynamicSharedMemorySize, TOTAL_LDS);
    (void)hipOccupancyMaxActiveBlocksPerMultiprocessor(&per_cu, (const void*)k_mega, 512, TOTAL_LDS);
    if (per_cu > 1) per_cu = 1;
    if (per_cu < 1) per_cu = 1;
    grid_blocks = cus * per_cu;
  }
  MegaArgs fa{};
  fa.x = x; fa.mem = mem; fa.out = out; fa.BAR = (unsigned*)(ws + 65536);
  fa.ml.conv = conv_qk; fa.ml.b_i = b_igate; fa.ml.b_f = b_fgate; fa.ml.gain = mlstm_norm;
  fa.ml.BCUM = BCUM; fa.ml.IP = IP; fa.ml.BL = BL; fa.ml.MX = MX; fa.ml.MST = MST; fa.ml.NST = NST; fa.ml.CST = CST;
  fa.XB = (bf16_t*)d_out; fa.MEMB = (bf16_t*)(ws + WS_MEMB); fa.RS1 = (float*)(ws + WS_RS1); fa.RSM = (float*)(ws + WS_RSM); fa.PS2 = (float*)(ws + WS_PS2);
  fa.QK = QK; fa.V = V; fa.O = O; fa.NQ = NQ; fa.SM = SM;
  fa.KVC = (bf16_t*)(ws + WS_KVC); fa.KS = (bf16_t*)(ws + WS_KS); fa.KW = (bf16_t*)(ws + WS_KW); fa.VST = (bf16_t*)(ws + WS_VST); fa.VWT = (bf16_t*)(ws + WS_VWT);
  fa.KC = KC; fa.VCT = VC; fa.CK1T = (bf16_t*)(ws + WS_CK1T); fa.CV1T = (bf16_t*)(ws + WS_CV1T); fa.POSW = (float*)(ws + WS_POSW);
  fa.posk = cmp_pos_k; fa.posv = cmp_pos_v; fa.ckw1 = cmp_k_w1; fa.cvw1 = cmp_v_w1; fa.ckw2 = cmp_k_w2; fa.cvw2 = cmp_v_w2;
  fa.AML = AML; fa.ANS = ANS; fa.MRG = MRG; fa.X1B = H2; fa.XQ = XQ; fa.XO = XO; fa.KVM = KVM;
  fa.WinT = (bf16_t*)(ws + WS_WIN_T); fa.WgT = (bf16_t*)(ws + WS_WG_T); fa.WmlT = (bf16_t*)(ws + WS_WML_T); fa.WnsT = (bf16_t*)(ws + WS_WNS_T);
  fa.H3 = H3; fa.ACT = ACT; fa.Y = Y; fa.W13T = (bf16_t*)(ws + 104 * MiB); fa.W2T = (bf16_t*)(ws + 240 * MiB);
  fa.CPART = (float*)(ws + 176 * MiB); fa.WQ = (int*)(ws + 256);
  fa.RS3 = (float*)(ws + WS_RSM + 8192); fa.RTW = RTW; fa.CNT = CNT; fa.LIST = LIST;
  fa.g_ffn = norm_ffn; fa.wg = router_group_w; fa.bg = router_group_b; fa.we = router_expert_w; fa.be = router_expert_b; fa.g_final = norm_final;
  fa.WoutT = (bf16_t*)(ws + WS_WOUT_T); fa.WqT = (bf16_t*)(ws + WS_WQ_T); fa.WkvT = (bf16_t*)(ws + WS_WKV_T); fa.WoT = (bf16_t*)(ws + WS_WO_T);
  {
    auto mk = [&](const float* src, bf16_t* dst, const float* gain, int ldw, int K, int c0, int ncols, int drow0) {
      TDesc d{}; d.src = src; d.dst = dst; d.gain = gain; d.ldw = ldw; d.K = K; d.c0 = c0; d.ncols = ncols; d.drow0 = drow0; d.per = (K / 64) * ((ncols + 63) / 64); d.nitems = d.per; d.mode = 0; d.rofs = 0; d.sstride = 0; d.dstride = 0; d.pad = 0; return d; };
    int n = 0;
    fa.td[n++] = mk(w_in, fa.WinT, norm_mix, DIN, DM, 0, 2048, 0);
    fa.td[n++] = mk(w_in, fa.WinT, norm_mix, DIN, DM, 2056, 512, 2048);
    fa.td[n++] = mk(w_in, fa.WinT, norm_mix, DIN, DM, 2568, 384, 2560);
    fa.td[n++] = mk(w_in, fa.WinT, norm_mix, DIN, DM, 3080, 128, 2944);
    fa.td[n++] = mk(w_in, fa.WinT, norm_mix, DIN, DM, 2952, 128, 3072);
    fa.td[n++] = mk(w_in, fa.WinT, norm_mix, DIN, DM, 3208, 128, 3200);
    fa.td[n++] = mk(w_in, fa.WinT, norm_mix, DIN, DM, 2048, 8, 3328);
    fa.td[n++] = mk(w_in, fa.WinT, norm_mix, DIN, DM, 3336, 24, 3336);
    fa.td[n++] = mk(w_in, fa.WgT, norm_mix, DIN, DM, 3360, 2048, 0);
    fa.td[n++] = mk(w_br_mlstm, fa.WmlT, nullptr, 1024, 512, 0, 1024, 0);
    fa.td[n++] = mk(w_br_nsa, fa.WnsT, nullptr, 1024, 512, 0, 1024, 0);
    fa.td[n++] = mk(w_mix_out, fa.WoutT, nullptr, 1024, 1024, 0, 1024, 0);
    fa.td[n++] = mk(xa_wq, fa.WqT, norm_xattn, 1024, 1024, 0, 1024, 0);
    fa.td[n++] = mk(xa_wkv, fa.WkvT, norm_mem, 2048, 1024, 0, 2048, 0);
    fa.td[n++] = mk(xa_wo, fa.WoT, nullptr, 1024, 1024, 0, 1024, 0);
    fa.td[n++] = mk(cmp_k_w1, fa.CK1T, nullptr, 128, 2048, 0, 128, 0);
    fa.td[n++] = mk(cmp_v_w1, fa.CV1T, nullptr, 128, 2048, 0, 128, 0);
    fa.ntdA = n;
    { TDesc d = mk(moe_w1, fa.W13T, norm_ffn, 512, 1024, 0, 512, 0); d.mode = 2; d.rofs = 0; d.nitems = 16 * d.per; d.sstride = 1024 * 512; d.dstride = 1024 * 1024; fa.td[n++] = d; }
    { TDesc d = mk(moe_w3, fa.W13T, norm_ffn, 512, 1024, 0, 512, 0); d.mode = 2; d.rofs = 16; d.nitems = 16 * d.per; d.sstride = 1024 * 512; d.dstride = 1024 * 1024; fa.td[n++] = d; }
    { TDesc d = mk(moe_w2, fa.W2T, nullptr, 1024, 512, 0, 1024, 0); d.nitems = 16 * d.per; d.sstride = 512 * 1024; d.dstride = 1024 * 512; fa.td[n++] = d; }
    fa.ntdB = n;
    int cum[25]; cum[0] = 0; for (int i = 0; i < n; ++i) cum[i + 1] = cum[i] + fa.td[i].nitems;
    for (int k = 0; k < 16; ++k) { fa.cv_lo[k] = 0; fa.cv_hi[k] = 0; }
    fa.cv_lo[0] = 0; fa.cv_hi[0] = cum[8];
    fa.cv_lo[1] = cum[8]; fa.cv_hi[1] = cum[fa.ntdA];
    { const int lo = cum[fa.ntdA], tot = cum[n] - lo; const int phs[5] = {5, 6, 7, 8, 9};
      for (int i = 0; i < 5; ++i) { fa.cv_lo[phs[i]] = lo + (int)((long long)tot * i / 5); fa.cv_hi[phs[i]] = lo + (int)((long long)tot * (i + 1) / 5); } }
  }
  int launch_i = 0;
  auto mega = [&](int lo, int hi) {
    fa.ph_lo = lo; fa.ph_hi = hi; fa.li = launch_i++; fa.pad = 0;
    for (int k = 0; k < 16; ++k) fa.rep[k] = 1;

    void* args[] = {&fa};
    (void)hipLaunchCooperativeKernel((const void*)k_mega, dim3(grid_blocks), dim3(512), args, TOTAL_LDS, stream);
  };
  mega(0, 14);
}
```

```cpp
#include <hip/hip_runtime.h>
#include <stdint.h>

typedef unsigned short bf16_t;
__device__ __forceinline__ float bf2f(bf16_t v) { return __uint_as_float(((unsigned)v) << 16); }
__device__ __forceinline__ bf16_t f2bf(float f) { unsigned u = __float_as_uint(f); return (bf16_t)((u + 0x7fffu + ((u >> 16) & 1u)) >> 16); }

constexpr int NB = 4, SEQ = 4096, NTOK = NB * SEQ, DM = 1024;
constexpr int DIN = 5408, DIN_A = 3360;
constexpr int MEMT = 256;
constexpr float EPS = 1e-6f;
constexpr size_t MiB = 1u << 20;

constexpr size_t WS_CNT = 0;
constexpr size_t WS_LIST = 1 * MiB;
constexpr size_t WS_RTW = 2 * MiB;
constexpr size_t WS_SM = 3 * MiB;
constexpr size_t WS_BCUM = 5 * MiB;
constexpr size_t WS_IP = 5 * MiB + 256 * 1024;
constexpr size_t WS_BL = 5 * MiB + 512 * 1024;
constexpr size_t WS_MX = WS_BL + 4096;
constexpr size_t WS_MST = WS_MX + 4096;
constexpr size_t WS_NST = 6 * MiB;
constexpr size_t WS_KC = 7 * MiB;
constexpr size_t WS_VC = 7 * MiB + 512 * 1024;
constexpr size_t WS_QK = 8 * MiB;
constexpr size_t WS_V = 40 * MiB;
constexpr size_t WS_O = 56 * MiB;
constexpr size_t WS_NQ = 72 * MiB;
constexpr size_t WS_KV = 88 * MiB;
constexpr size_t WS_CST = 112 * MiB;
constexpr size_t WS_AML = 144 * MiB;
constexpr size_t WS_ANS = 160 * MiB;
constexpr size_t WS_MRG = 176 * MiB;
constexpr size_t WS_KVM = 233 * MiB;
constexpr size_t WS_MEMN = 237 * MiB;
constexpr size_t WS_H2 = 8 * MiB;
constexpr size_t WS_XQ = 40 * MiB;
constexpr size_t WS_XO = 72 * MiB;
constexpr size_t WS_Y = 72 * MiB;

__device__ __forceinline__ float wave_sum(float v) {
#pragma unroll
  for (int o = 32; o > 0; o >>= 1) v += __shfl_xor(v, o);
  return v;
}
__device__ __forceinline__ float wave_max(float v) {
#pragma unroll
  for (int o = 32; o > 0; o >>= 1) v = fmaxf(v, __shfl_xor(v, o));
  return v;
}
__device__ __forceinline__ float sigmoidf_(float x) { return 1.f / (1.f + __expf(-x)); }
__device__ __forceinline__ float siluf_(float x) { return x / (1.f + __expf(-x)); }
__device__ __forceinline__ float logsigmoidf_(float x) { return fminf(x, 0.f) - log1pf(__expf(-fabsf(x))); }
__device__ __forceinline__ float gelu_tanh(float x) { float u = 0.7978845608028654f * (x + 0.044715f * x * x * x); return 0.5f * x * (1.f + tanhf(u)); }

#include <hip/hip_cooperative_groups.h>
namespace cg = cooperative_groups;
#define LAS __attribute__((address_space(3)))
typedef short bf16x8 __attribute__((ext_vector_type(8)));
typedef float f32x4 __attribute__((ext_vector_type(4)));
typedef unsigned u32x2 __attribute__((ext_vector_type(2)));
typedef unsigned u32x4 __attribute__((ext_vector_type(4)));

constexpr size_t WS_RS1 = 5 * MiB + 768 * 1024;
constexpr size_t WS_RSM = WS_RS1 + 65536;
constexpr size_t WS_PS2 = 4 * MiB;
constexpr size_t WS_WIN_T = 208 * MiB;
constexpr size_t WS_WG_T = 216 * MiB;
constexpr size_t WS_WML_T = 220 * MiB;
constexpr size_t WS_WNS_T = 221 * MiB;
constexpr size_t WS_WOUT_T = 222 * MiB;
constexpr size_t WS_WQ_T = 224 * MiB;
constexpr size_t WS_WKV_T = 226 * MiB;
constexpr size_t WS_WO_T = 230 * MiB;
constexpr size_t WS_MEMB = 238 * MiB;
constexpr size_t WS_KVC = WS_KV;
constexpr size_t WS_KS = WS_KV + 8 * MiB;
constexpr size_t WS_KW = WS_KV + 12 * MiB;
constexpr size_t WS_VST = WS_KV + 16 * MiB;
constexpr size_t WS_VWT = WS_KV + 20 * MiB;
constexpr size_t WS_CK1T = 232 * MiB;
constexpr size_t WS_CV1T = 232 * MiB + 512 * 1024;
constexpr size_t WS_POSW = WS_RSM + 8192 + 65536;
constexpr int NIN = 3584;

__device__ __forceinline__ unsigned pk2bf(float lo, float hi) { return (unsigned)f2bf(lo) | ((unsigned)f2bf(hi) << 16); }
__device__ __forceinline__ void st_bf4(bf16_t* p, f32x4 v) { u32x2 o; o.x = pk2bf(v[0], v[1]); o.y = pk2bf(v[2], v[3]); *(u32x2*)p = o; }
__device__ __forceinline__ void swap8(const f32x4& v0, const f32x4& v1, float (&o)[8]) {
#pragma unroll
  for (int j = 0; j < 4; ++j) { const auto r = __builtin_amdgcn_permlane16_swap(__float_as_uint(v0[j]), __float_as_uint(v1[j]), false, false); o[j] = __uint_as_float(r[0]); o[4 + j] = __uint_as_float(r[1]); }
}
__device__ __forceinline__ void bf8_to_f32(const u32x4 p, float (&o)[8]) {
  o[0] = __uint_as_float(p.x << 16); o[1] = __uint_as_float(p.x & 0xffff0000u); o[2] = __uint_as_float(p.y << 16); o[3] = __uint_as_float(p.y & 0xffff0000u);
  o[4] = __uint_as_float(p.z << 16); o[5] = __uint_as_float(p.z & 0xffff0000u); o[6] = __uint_as_float(p.w << 16); o[7] = __uint_as_float(p.w & 0xffff0000u);
}
__device__ __forceinline__ u32x4 pk8bf(const float (&v)[8]) { u32x4 o; o.x = pk2bf(v[0], v[1]); o.y = pk2bf(v[2], v[3]); o.z = pk2bf(v[4], v[5]); o.w = pk2bf(v[6], v[7]); return o; }
__device__ __forceinline__ void st_bf8_pair(bf16_t* p, int fq, f32x4 v0, f32x4 v1) {
  const auto sx = __builtin_amdgcn_permlane16_swap(pk2bf(v0[0], v0[1]), pk2bf(v1[0], v1[1]), false, false);
  const auto sy = __builtin_amdgcn_permlane16_swap(pk2bf(v0[2], v0[3]), pk2bf(v1[2], v1[3]), false, false);
  u32x4 o; o.x = sx[0]; o.y = sy[0]; o.z = sx[1]; o.w = sy[1];
  __builtin_nontemporal_store(o, (u32x4*)(p + (fq & 1) * 16 + (fq >> 1) * 8));
}
__device__ __forceinline__ void st_bf8_pair_c(bf16_t* p, int fq, f32x4 v0, f32x4 v1) {
  const auto sx = __builtin_amdgcn_permlane16_swap(pk2bf(v0[0], v0[1]), pk2bf(v1[0], v1[1]), false, false);
  const auto sy = __builtin_amdgcn_permlane16_swap(pk2bf(v0[2], v0[3]), pk2bf(v1[2], v1[3]), false, false);
  u32x4 o; o.x = sx[0]; o.y = sy[0]; o.z = sx[1]; o.w = sy[1];
  *(u32x4*)(p + (fq & 1) * 16 + (fq >> 1) * 8) = o;
}

struct TDesc { const float* src; bf16_t* dst; const float* gain; int ldw, K, c0, ncols, drow0, nitems, mode, rofs, per, sstride, dstride, pad; };
__device__ __forceinline__ void transpose_item(const TDesc& d, int item, float* t  , int tid) {
  const int bat = item / d.per; item -= bat * d.per;
  const float* src = d.src + (size_t)bat * d.sstride; bf16_t* dst = d.dst + (size_t)bat * d.dstride;
  const int ncb = (d.ncols + 63) >> 6; const int kb = item / ncb, cb = item % ncb; const int k0 = kb * 64, n0 = cb * 64;
  {
    const int c4 = (tid & 15) * 4, kq = tid >> 4;
    f32x4 v[4];
#pragma unroll
    for (int p = 0; p < 4; ++p) {
      const int kk = p * 16 + kq;
      v[p] = (n0 + c4 < d.ncols) ? *(const f32x4*)(src + (size_t)(k0 + kk) * d.ldw + d.c0 + n0 + c4) : (f32x4){0.f, 0.f, 0.f, 0.f};
    }
#pragma unroll
    for (int p = 0; p < 4; ++p) {
      const int kk = p * 16 + kq; const float g = d.gain ? d.gain[k0 + kk] : 1.f;
      float* tp = t + kk * 65 + c4; tp[0] = v[p][0] * g; tp[1] = v[p][1] * g; tp[2] = v[p][2] * g; tp[3] = v[p][3] * g;
    }
  }
  __syncthreads();
#pragma unroll
  for (int j = 0; j < 2; ++j) {
    int c = tid + j * 256; int n = c >> 3, kc = c & 7;
    if (n0 + n < d.ncols) {
      const float* p = t + (kc * 8) * 65 + n;
      u32x4 o; o.x = pk2bf(p[0], p[65]); o.y = pk2bf(p[130], p[195]); o.z = pk2bf(p[260], p[325]); o.w = pk2bf(p[390], p[455]);
      const int drow = d.mode == 2 ? (d.drow0 + (cb * 4 + (n >> 4)) * 32 + (n & 15) + d.rofs) : d.mode ? (d.drow0 + cb * 128 + (n >> 5) * 64 + (n & 31) + d.rofs) : (d.drow0 + n0 + n);
      *(u32x4*)(dst + (size_t)drow * d.K + k0 + kc * 8) = o;
    }
  }
  __syncthreads();
}

__device__ __forceinline__ void rows_to_bf16(const float* __restrict__ src, bf16_t* __restrict__ dst, float* __restrict__ rs, int nrows, int gw, int ngw, int lane) {
  for (int row = gw; row < nrows; row += ngw) {
    const f32x4* xr = (const f32x4*)(src + (size_t)row * DM) + lane;
    f32x4 v[4]; float s = 0.f;
#pragma unroll
    for (int j = 0; j < 4; ++j) { v[j] = xr[64 * j]; s += v[j][0] * v[j][0] + v[j][1] * v[j][1] + v[j][2] * v[j][2] + v[j][3] * v[j][3]; }
    s = wave_sum(s);
    if (lane == 0) rs[row] = rsqrtf(s * (1.f / DM) + EPS);
#pragma unroll
    for (int j = 0; j < 4; ++j) st_bf4(dst + (size_t)row * DM + (lane + 64 * j) * 4, v[j]);
  }
}

__device__ __forceinline__ void glds16(const void* g, char* l) {
  __builtin_amdgcn_global_load_lds((const unsigned*)g, (LAS unsigned*)l, 16, 0, 0);
}
__device__ __forceinline__ int st_row(int tid, int i) { return (tid >> 3) + 32 * i; }
__device__ __forceinline__ int st_lc(int tid, int i) { return (tid & 7) ^ ((st_row(tid, i) >> 1) & 7); }
__device__ __forceinline__ void gemm_core(f32x4 (&acc)[4][4], const bf16_t* __restrict__ A, const unsigned (&ao)[4], unsigned ksa,
                                          const bf16_t* __restrict__ Bt, const unsigned (&bo)[4], unsigned ksb, int nt, char* lds, int tid) {
  const int lane = tid & 63, wid = tid >> 6, wr = wid >> 1, wc = wid & 1, fr = lane & 15, fq = lane >> 4;
  char* ldst = lds + tid * 16;
#pragma unroll
  for (int i = 0; i < 4; ++i) { glds16(A + ao[i], ldst + i * 4096); glds16(Bt + bo[i], ldst + 16384 + i * 4096); }
  const int sw = fr >> 1;
  const int aoff = (wr * 64 + fr) * 128, boff = (wc * 64 + fr) * 128;
  for (int t = 0; t < nt; ++t) {
    asm volatile("s_waitcnt vmcnt(0)" ::: "memory");
    __syncthreads();
    const int cur = t & 1;
    if (t + 1 < nt) {
      char* nb = ldst + (cur ^ 1) * 32768; const unsigned ka = (t + 1) * ksa, kb = (t + 1) * ksb;
#pragma unroll
      for (int i = 0; i < 4; ++i) { glds16(A + (ao[i] + ka), nb + i * 4096); glds16(Bt + (bo[i] + kb), nb + 16384 + i * 4096); }
    }
    const char* sA = lds + cur * 32768 + aoff; const char* sB = lds + cur * 32768 + 16384 + boff;
#pragma unroll
    for (int ks = 0; ks < 2; ++ks) {
      bf16x8 a[4], b[4];
      const int co = ((ks * 4 + fq) ^ sw) << 4;
#pragma unroll
      for (int i = 0; i < 4; ++i) { a[i] = *(const bf16x8*)(sA + i * 2048 + co); b[i] = *(const bf16x8*)(sB + i * 2048 + co); }
#pragma unroll
      for (int i = 0; i < 4; ++i)
#pragma unroll
        for (int j = 0; j < 4; ++j) acc[i][j] = __builtin_amdgcn_mfma_f32_16x16x32_bf16(b[j], a[i], acc[i][j], 0, 0, 0);
    }
  }
  __syncthreads();
}
__device__ __forceinline__ void gemm_acc(f32x4 (&acc)[4][4], const bf16_t* __restrict__ A, size_t lda, const int* __restrict__ arow, int ashift, int mvalid,
                                         const bf16_t* __restrict__ Bt, size_t ldb, int K, char* lds, int m0, int n0, int tid) {
  asm volatile("" : "+v"(tid));
  unsigned ao[4], bo[4];
#pragma unroll
  for (int i = 0; i < 4; ++i) {
    const int row = st_row(tid, i), lc = st_lc(tid, i);
    int gr;
    if (arow) { int mm = m0 + row; if (mm >= mvalid) mm = mvalid - 1; gr = arow[mm] >> ashift; } else gr = m0 + row;
    ao[i] = (unsigned)gr * (unsigned)lda + lc * 8;
    bo[i] = (unsigned)(n0 + row) * (unsigned)ldb + lc * 8;
  }
  gemm_core(acc, A, ao, 64u, Bt, bo, 64u, K >> 6, lds, tid);
}
__device__ __forceinline__ void zero_acc(f32x4 (&acc)[4][4]) {
#pragma unroll
  for (int i = 0; i < 4; ++i)
#pragma unroll
    for (int j = 0; j < 4; ++j) acc[i][j] = (f32x4){0.f, 0.f, 0.f, 0.f};
}


namespace pg8 {
#define PG8_LAS __attribute__((address_space(3)))
typedef unsigned short bf16_t;
typedef short bf16x8 __attribute__((ext_vector_type(8)));
typedef float f32x4 __attribute__((ext_vector_type(4)));
typedef unsigned u32x4 __attribute__((ext_vector_type(4)));
constexpr int BM = 256, BK = 64, HALF = 128, HTB = HALF * BK * 2  , STAGE_BYTES = 8 * HTB, NXCD = 8, WGM = 8;

__host__ __device__ __forceinline__ int lds_byte(int r, int c) { const int st = (r >> 4) * 2 + (c >> 5), rr = r & 15, cc = c & 31, ob = rr * 64 + cc * 2; return st * 1024 + (ob ^ (((ob >> 9) & 1) << 5)); }
__host__ __device__ __forceinline__ void stage_rc(int b, int& R, int& C) { const int st = b / 1024, sb = b % 1024, swz = sb ^ (((sb >> 9) & 1) << 5); R = (st >> 1) * 16 + swz / 64; C = (st & 1) * 32 + (swz % 64) / 2; }
__host__ __device__ __forceinline__ int perm32(int rho) { const int n = rho >> 4, i = rho & 15; return 8 * (i >> 2) + 4 * n + (i & 3); }

struct Unit { int pm, pn; const char* aptr; const char* bptr; int e, ce, p0, rt; };
struct Gemm { int K; };
template <class Epi, class Sched, bool ALIGN_EPI = false, bool SP2 = false, bool ACOH = false  >
__device__ __forceinline__ void gemm_phase(PG8_LAS unsigned char* lds, const Gemm g, const Sched& S, const Epi& E, int tid  , int wid  ) {
    asm volatile("" : "+v"(tid));
    const int lane = tid & 63, wr = wid >> 2, wc = wid & 3, fr = lane & 15, fq = lane >> 4;
    const int K = g.K, nt = K / BK;
    unsigned voffA[2], voffB[2];
#pragma unroll
    for (int i = 0; i < 2; ++i) { int R, C; stage_rc(tid * 16 + i * 8192, R, C); const int Rb = Epi::PERM ? ((R & ~31) + perm32(R & 31)) : R;
        voffA[i] = (unsigned)(R * K + C) * 2u; voffB[i] = (unsigned)(Rb * K + C) * 2u; }
    unsigned cva0[2], cva1[2], nva0[2], nva1[2];
    const size_t kstep = (size_t)(BK * 2);
    const size_t hstep = (size_t)HALF * K * 2;
    const unsigned ldsw = (unsigned)wid * 1024u;
    const int aoff = lds_byte(wr * 64 + fr, fq * 8), boff = lds_byte(wc * 32 + fr, fq * 8);
#define PG8_SA(b, h) (((b) * 2 + (h)) * HTB)
#define PG8_SB(b, h) ((4 + (b) * 2 + (h)) * HTB)
#define PG8_STAGE(bufoff, gbase, voff) do { _Pragma("unroll") for (int _i = 0; _i < 2; ++_i) \
        __builtin_amdgcn_global_load_lds((const unsigned*)((const char*)(gbase) + (voff)[_i]), (PG8_LAS unsigned*)(lds + (bufoff) + ldsw + _i * 8192), 16, 0, 0); } while (0)
#define PG8_STAGEA(bufoff, gbase, voff) do { _Pragma("unroll") for (int _i = 0; _i < 2; ++_i) { \
        if constexpr (ACOH) __builtin_amdgcn_global_load_lds((const unsigned*)((const char*)(gbase) + (voff)[_i]), (PG8_LAS unsigned*)(lds + (bufoff) + ldsw + _i * 8192), 16, 0, 16  ); \
        else __builtin_amdgcn_global_load_lds((const unsigned*)((const char*)(gbase) + (voff)[_i]), (PG8_LAS unsigned*)(lds + (bufoff) + ldsw + _i * 8192), 16, 0, 0); } } while (0)
#define PG8_LDA(dst, b, h) do { _Pragma("unroll") for (int m = 0; m < 4; ++m) _Pragma("unroll") for (int k = 0; k < 2; ++k) dst[m][k] = *(const PG8_LAS bf16x8*)(lds + PG8_SA(b, h) + aoff + m * 2048 + k * 1024); } while (0)
#define PG8_LDB(dst, b, h) do { _Pragma("unroll") for (int n = 0; n < 2; ++n) _Pragma("unroll") for (int k = 0; k < 2; ++k) dst[n][k] = *(const PG8_LAS bf16x8*)(lds + PG8_SB(b, h) + boff + n * 2048 + k * 1024); } while (0)
#define PG8_MMA(ai, bj, At, Bt) do { __builtin_amdgcn_s_setprio(1); _Pragma("unroll") for (int m = 0; m < 4; ++m) _Pragma("unroll") for (int n = 0; n < 2; ++n) _Pragma("unroll") for (int k = 0; k < 2; ++k) \
        acc[ai][bj][m][n] = __builtin_amdgcn_mfma_f32_16x16x32_bf16(Bt[n][k], At[m][k], acc[ai][bj][m][n], 0, 0, 0); __builtin_amdgcn_s_setprio(0); } while (0)
#define PG8_WAIT_V(n) asm volatile("s_waitcnt vmcnt(" #n ")" ::: "memory")
#define PG8_WAIT_L(n) asm volatile("s_waitcnt lgkmcnt(" #n ")" ::: "memory")
#define PG8_BAR __builtin_amdgcn_s_barrier()
#define PG8_SCHED __builtin_amdgcn_sched_barrier(0)
    Unit cur, nxt; int ui = 0;
    if (!S.next(0, cur)) return;
    S.avoff(cur, tid, K, voffA, cva0, cva1);
    f32x4 acc[2][2][4][2];
#pragma unroll
    for (int a = 0; a < 2; ++a)
#pragma unroll
        for (int b = 0; b < 2; ++b)
#pragma unroll
            for (int m = 0; m < 4; ++m)
#pragma unroll
                for (int n = 0; n < 2; ++n) acc[a][b][m][n] = (f32x4){0.f, 0.f, 0.f, 0.f};
    bf16x8 At[4][2], B0[2][2], B1[2][2];
    const char* cA = cur.aptr; const char* cB = cur.bptr;
    S.a_ready(cur);
    if constexpr (SP2) {
        PG8_STAGE(PG8_SB(0, 0), cB, voffB); PG8_STAGE(PG8_SB(0, 1), cB + hstep, voffB); PG8_STAGEA(PG8_SA(0, 0), cA, cva0); PG8_STAGEA(PG8_SA(0, 1), cA, cva1);
        if (wr == 1) PG8_BAR;
        PG8_WAIT_V(2); PG8_BAR;
        PG8_STAGE(PG8_SB(1, 0), cB + kstep, voffB); PG8_STAGEA(PG8_SA(1, 0), cA + kstep, cva0); PG8_STAGE(PG8_SB(1, 1), cB + hstep + kstep, voffB);
        PG8_WAIT_V(6); PG8_BAR;
    } else {
        PG8_STAGE(PG8_SB(0, 0), cB, voffB); PG8_STAGEA(PG8_SA(0, 0), cA, cva0); PG8_STAGE(PG8_SB(0, 1), cB + hstep, voffB); PG8_STAGEA(PG8_SA(0, 1), cA, cva1);
        if (wr == 1) PG8_BAR;
        PG8_WAIT_V(4); PG8_BAR;
        PG8_STAGE(PG8_SB(1, 0), cB + kstep, voffB); PG8_STAGEA(PG8_SA(1, 0), cA + kstep, cva0); PG8_STAGE(PG8_SB(1, 1), cB + hstep + kstep, voffB);
        PG8_WAIT_V(6); PG8_BAR;
    }
    for (;;) {
        const bool has_next = S.next(ui + 1, nxt);
        if (has_next) S.avoff(nxt, tid, K, voffA, nva0, nva1); else { nva0[0] = cva0[0]; nva0[1] = cva0[1]; nva1[0] = cva1[0]; nva1[1] = cva1[1]; }
        const char* nA = has_next ? nxt.aptr : cA; const char* nB = has_next ? nxt.bptr : cB;
        for (int t = 0; t < nt; t += 2) {
            const bool last = (t == nt - 2);
            const char* a1 = cA + (size_t)(t + 1) * kstep;
            const char* a2 = last ? nA : cA + (size_t)(t + 2) * kstep; const char* b2 = last ? nB : cB + (size_t)(t + 2) * kstep;
            const char* a3 = a2 + kstep; const char* b3 = b2 + kstep;
            const unsigned xva0[2] = {last ? nva0[0] : cva0[0], last ? nva0[1] : cva0[1]}, xva1[2] = {last ? nva1[0] : cva1[0], last ? nva1[1] : cva1[1]};
            if (last && has_next) S.a_ready(nxt);
            if constexpr (SP2) {
            PG8_LDB(B0, 0, 0); PG8_LDB(B1, 0, 1); PG8_SCHED; PG8_LDA(At, 0, 0); PG8_STAGEA(PG8_SA(1, 1), a1, cva1);
            PG8_WAIT_V(8); PG8_WAIT_L(0); PG8_BAR; PG8_MMA(0, 0, At, B0); PG8_MMA(0, 1, At, B1); PG8_BAR; PG8_SCHED;
            PG8_LDA(At, 0, 1); PG8_STAGE(PG8_SB(0, 0), b2, voffB); PG8_STAGE(PG8_SB(0, 1), b2 + hstep, voffB); PG8_STAGEA(PG8_SA(0, 0), a2, xva0);
            PG8_WAIT_V(8); PG8_WAIT_L(0); PG8_BAR; PG8_MMA(1, 0, At, B0); PG8_MMA(1, 1, At, B1); PG8_BAR; PG8_SCHED;
            PG8_LDB(B0, 1, 0); PG8_LDB(B1, 1, 1); PG8_SCHED; PG8_LDA(At, 1, 0); PG8_STAGEA(PG8_SA(0, 1), a2, xva1);
            PG8_WAIT_V(8); PG8_WAIT_L(0); PG8_BAR; PG8_MMA(0, 0, At, B0); PG8_MMA(0, 1, At, B1); PG8_BAR; PG8_SCHED;
            PG8_LDA(At, 1, 1); PG8_STAGE(PG8_SB(1, 0), b3, voffB); PG8_STAGE(PG8_SB(1, 1), b3 + hstep, voffB); PG8_STAGEA(PG8_SA(1, 0), a3, xva0);
            PG8_WAIT_V(8); PG8_WAIT_L(0); PG8_BAR; PG8_MMA(1, 0, At, B0); PG8_MMA(1, 1, At, B1); PG8_BAR; PG8_SCHED;
            } else {
            PG8_LDB(B0, 0, 0); PG8_SCHED; PG8_LDA(At, 0, 0); PG8_STAGEA(PG8_SA(1, 1), a1, cva1);
            PG8_WAIT_L(8); PG8_BAR; PG8_WAIT_L(0); PG8_MMA(0, 0, At, B0); PG8_BAR; PG8_SCHED;
            PG8_LDB(B1, 0, 1); PG8_STAGE(PG8_SB(0, 0), b2, voffB);
            PG8_BAR; PG8_WAIT_L(0); PG8_MMA(0, 1, At, B1); PG8_BAR;
            PG8_LDA(At, 0, 1); PG8_STAGEA(PG8_SA(0, 0), a2, xva0);
            PG8_BAR; PG8_WAIT_L(0); PG8_MMA(1, 0, At, B0); PG8_BAR; PG8_SCHED;
            PG8_STAGE(PG8_SB(0, 1), b2 + hstep, voffB);
            PG8_WAIT_V(6); PG8_BAR; PG8_MMA(1, 1, At, B1); PG8_BAR;
            PG8_LDB(B0, 1, 0); PG8_SCHED; PG8_LDA(At, 1, 0); PG8_STAGEA(PG8_SA(0, 1), a2, xva1);
            PG8_WAIT_L(8); PG8_BAR; PG8_WAIT_L(0); PG8_MMA(0, 0, At, B0); PG8_BAR; PG8_SCHED;
            PG8_LDB(B1, 1, 1); PG8_STAGE(PG8_SB(1, 0), b3, voffB);
            PG8_BAR; PG8_WAIT_L(0); PG8_MMA(0, 1, At, B1); PG8_BAR;
            PG8_LDA(At, 1, 1); PG8_STAGEA(PG8_SA(1, 0), a3, xva0);
            PG8_BAR; PG8_WAIT_L(0); PG8_MMA(1, 0, At, B0); PG8_BAR; PG8_SCHED;
            PG8_STAGE(PG8_SB(1, 1), b3 + hstep, voffB);
            PG8_WAIT_V(6); PG8_BAR; PG8_MMA(1, 1, At, B1); PG8_BAR;
            }
        }
        if constexpr (ALIGN_EPI) { if (wr == 0) PG8_BAR; }
        if constexpr (!Epi::AFTER_DRAIN) { E(acc, cur, wr, wc, fr, fq); S.done(cur); }
        if (!has_next) break;
#pragma unroll
        for (int a = 0; a < 2; ++a)
#pragma unroll
            for (int b = 0; b < 2; ++b)
#pragma unroll
                for (int m = 0; m < 4; ++m)
#pragma unroll
                    for (int n = 0; n < 2; ++n) acc[a][b][m][n] = (f32x4){0.f, 0.f, 0.f, 0.f};
        cur = nxt; cA = nA; cB = nB; ++ui; cva0[0] = nva0[0]; cva0[1] = nva0[1]; cva1[0] = nva1[0]; cva1[1] = nva1[1];
        if constexpr (ALIGN_EPI) { if (wr == 1) PG8_BAR; }
    }
    PG8_WAIT_V(0);
    if constexpr (!ALIGN_EPI) { if (wr == 0) PG8_BAR; }
    PG8_BAR;
    if constexpr (Epi::AFTER_DRAIN) { E.fused(acc, cur, wr, wc, fr, fq, lds, wid, lane); S.done(cur); }
#undef PG8_SA
#undef PG8_SB
#undef PG8_STAGE
#undef PG8_STAGEA
#undef PG8_LDA
#undef PG8_LDB
#undef PG8_MMA
#undef PG8_WAIT_V
#undef PG8_WAIT_L
#undef PG8_BAR
#undef PG8_SCHED
}
}

#define TILE8_IDS unsigned t8_z = 0u; asm volatile("" : "+v"(t8_z)); int t512 = wave_s * 64 + (int)__builtin_amdgcn_mbcnt_hi(~0u, __builtin_amdgcn_mbcnt_lo(~0u, t8_z)); asm volatile("" : "+v"(t512))
template <class Map> struct ListSched {
  int first, stride, count; Map map;
  __device__ __forceinline__ bool next(int i, pg8::Unit& u) const { const int idx = first + i * stride; if (idx >= count) return false; map(idx, u); return true; }
  __device__ __forceinline__ void avoff(const pg8::Unit& u, int tid, int K, const unsigned (&voffA)[2], unsigned (&v0)[2], unsigned (&v1)[2]) const { map.avoff(u, tid, K, voffA, v0, v1); }
  __device__ __forceinline__ void a_ready(const pg8::Unit&) const {}
  __device__ __forceinline__ void done(const pg8::Unit&) const {}
};
struct MlArgs { const float *conv, *b_i, *b_f, *gain; float *BCUM, *IP, *BL, *MX, *MST, *NST; bf16_t* CST; };
struct MegaArgs {
  const float* x; const float* mem; float* out;
  bf16_t *XB, *MEMB; float *RS1, *RSM, *PS2;
  bf16_t *QK, *V, *O, *NQ, *KVC, *KS, *KW, *VST, *VWT, *KC, *VCT, *CK1T, *CV1T; float *SM, *POSW;
  const float *posk, *posv, *ckw1, *cvw1, *ckw2, *cvw2;
  bf16_t *AML, *ANS, *MRG, *X1B, *XQ, *XO, *KVM;
  bf16_t *WinT, *WgT, *WmlT, *WnsT, *WoutT, *WqT, *WkvT, *WoT;
  bf16_t *H3, *ACT, *Y, *W13T, *W2T; float *RS3, *RTW; int *CNT, *LIST;
  const float *g_ffn, *wg, *bg, *we, *be, *g_final;
  unsigned* BAR;
  MlArgs ml;
  float* CPART; int* WQ;
  TDesc td[24]; int ntdA, ntdB; int ph_lo, ph_hi, li, pad; int rep[16]; int cv_lo[16], cv_hi[16];
};


constexpr int NSA_LDS = 66112;
constexpr int MEGA_LDS = 73728;
constexpr int HALF_LDS = 73728, CTRL_OFF = 2 * HALF_LDS, TOTAL_LDS = CTRL_OFF + 64;
typedef unsigned long long u64;

template <bool WITH_V>
__device__ __forceinline__ void nsa_load_tile(const bf16_t* __restrict__ Ksrc, unsigned kstride, const bf16_t* __restrict__ Vsrc, unsigned vstride, char* lds, int tid) {
#pragma unroll
  for (int i = 0; i < 2; ++i) {
    const int idx = tid + 256 * i, row = idx >> 3, lc = (idx & 7) ^ ((row >> 1) & 7);
    glds16(Ksrc + (size_t)row * kstride + lc * 8, lds + idx * 16);
    if (WITH_V) glds16(Vsrc + (size_t)row * vstride + lc * 8, lds + 8192 + idx * 16);
  }
}

__device__ __forceinline__ void nsa_qk(f32x4 (&sacc)[4][2], const bf16x8 (&qf)[4][2], const char* lds, int hf, int fr, int fq) {
#pragma unroll
  for (int mi = 0; mi < 4; ++mi)
#pragma unroll
    for (int ni = 0; ni < 2; ++ni) sacc[mi][ni] = (f32x4){0.f, 0.f, 0.f, 0.f};
#pragma unroll
  for (int ks = 0; ks < 2; ++ks) {
    bf16x8 kf[2];
    const int co = ((ks * 4 + fq) ^ (fr >> 1)) << 4;
#pragma unroll
    for (int ni = 0; ni < 2; ++ni) kf[ni] = *(const bf16x8*)(lds + ((hf * 2 + ni) * 16 + fr) * 128 + co);
#pragma unroll
    for (int mi = 0; mi < 4; ++mi)
#pragma unroll
      for (int ni = 0; ni < 2; ++ni) sacc[mi][ni] = __builtin_amdgcn_mfma_f32_16x16x32_bf16(kf[ni], qf[mi][ks], sacc[mi][ni], 0, 0, 0);
  }
}
__device__ __forceinline__ void nsa_pv(f32x4 (&oacc)[4][4], const f32x4 (&p)[4][2], char* lds, char* pw, int hf, int fr, int fq) {
#pragma unroll
  for (int mi = 0; mi < 4; ++mi)
#pragma unroll
    for (int ni = 0; ni < 2; ++ni) {
      u32x2 o; o.x = pk2bf(p[mi][ni][0], p[mi][ni][1]); o.y = pk2bf(p[mi][ni][2], p[mi][ni][3]);
      *(u32x2*)(pw + (mi * 16 + fr) * 128 + ((((hf * 2 + ni) * 2 + (fq >> 1)) ^ (fr >> 1)) << 4) + (fq & 1) * 8) = o;
    }
  bf16x8 pf[4], vf[4];
  const int co = ((hf * 4 + fq) ^ (fr >> 1)) << 4;
#pragma unroll
  for (int i = 0; i < 4; ++i) { pf[i] = *(const bf16x8*)(pw + (i * 16 + fr) * 128 + co); vf[i] = *(const bf16x8*)(lds + 8192 + (i * 16 + fr) * 128 + co); }
#pragma unroll
  for (int mi = 0; mi < 4; ++mi)
#pragma unroll
    for (int ni = 0; ni < 4; ++ni) oacc[mi][ni] = __builtin_amdgcn_mfma_f32_16x16x32_bf16(vf[ni], pf[mi], oacc[mi][ni], 0, 0, 0);
}
__device__ __forceinline__ float red4(float v) { v += __shfl_xor(v, 16); v += __shfl_xor(v, 32); return v; }
__device__ __forceinline__ float max4(float v) { v = fmaxf(v, __shfl_xor(v, 16)); v = fmaxf(v, __shfl_xor(v, 32)); return v; }

__device__ __forceinline__ void nsa_online(f32x4 (&sv)[4][2], float (&m_run)[4], float (&l_run)[4], f32x4 (&oacc)[4][4]) {
#pragma unroll
  for (int mi = 0; mi < 4; ++mi) {
    float mx = fmaxf(fmaxf(fmaxf(sv[mi][0][0], sv[mi][0][1]), fmaxf(sv[mi][0][2], sv[mi][0][3])), fmaxf(fmaxf(sv[mi][1][0], sv[mi][1][1]), fmaxf(sv[mi][1][2], sv[mi][1][3])));
    mx = max4(mx);
    if (__any(mx > m_run[mi] + 8.f)) {
      const float mn = fmaxf(fmaxf(m_run[mi], mx), -1e20f);
      const float alpha = __builtin_amdgcn_exp2f(m_run[mi] - mn);
      m_run[mi] = mn; l_run[mi] *= alpha;
#pragma unroll
      for (int ni = 0; ni < 4; ++ni) oacc[mi][ni] *= alpha;
    }
    float ls = 0.f;
#pragma unroll
    for (int ni = 0; ni < 2; ++ni)
#pragma unroll
      for (int j = 0; j < 4; ++j) { const float pv = __builtin_amdgcn_exp2f(sv[mi][ni][j] - m_run[mi]); sv[mi][ni][j] = pv; ls += pv; }
    l_run[mi] += ls;
  }
}

__device__ __forceinline__ void nsa_main_item(const MegaArgs& a, int item, char* lds, int tid, volatile int* xch, int half) {
  asm volatile("" : "+v"(tid));
  const int lane = tid & 63, wid = tid >> 6, fr = lane & 15, fq = lane >> 4;
  const int i = item & 63, g = (item >> 6) & 1, b = item >> 7;
  const int h = g * 4 + wid, nb = b * SEQ, t0 = i * 64, bg = b * 2 + g;
  const float slope = exp2f(-(float)(h + 1)) * 1.4426950408889634f;
  char* pw = lds + 16384 + wid * 8192;
  float* PSLC = (float*)(lds + 49152);
  u64* SELM = (u64*)(lds + 65536);
  u64* UNI = (u64*)(lds + 66048);
  bf16x8 qf[4][2];
#pragma unroll
  for (int mi = 0; mi < 4; ++mi)
#pragma unroll
    for (int ks = 0; ks < 2; ++ks) qf[mi][ks] = *(const bf16x8*)(a.NQ + (size_t)(nb + t0 + wid * 16 + fr) * 512 + (g * 4 + mi) * 64 + ks * 32 + fq * 8);
  for (int e = tid; e < 4096; e += 256) PSLC[e] = 0.f;
  f32x4 sacc[4][2], oacc[4][4];
  float m_run[4], l_run[4];
  const int nct = ((4 * i + 2) >> 6) + 1;
  const bf16_t* kcb = a.KC + (size_t)bg * 256 * 64;
  const bf16_t* vcb = a.VCT + (size_t)bg * 64 * 256;
  const int tc = t0 + wid * 16 + fr;
  const float slope0 = exp2f(-(float)(g * 4 + 1)) * 1.4426950408889634f;
#pragma unroll
  for (int mi = 0; mi < 4; ++mi) { m_run[mi] = -1e30f; l_run[mi] = 0.f; }
  __syncthreads();
  nsa_load_tile<false>(kcb, 64u, nullptr, 0u, lds, tid);
  for (int jt = 0; jt < nct; ++jt) {
    asm volatile("s_waitcnt vmcnt(0)" ::: "memory");
    __syncthreads();
    char* tb = (jt & 1) ? (lds + 16384) : lds;
    if (jt + 1 < nct) nsa_load_tile<false>(kcb + (size_t)(jt + 1) * 64 * 64, 64u, nullptr, 0u, (jt & 1) ? lds : (lds + 16384), tid);
#pragma unroll 1
    for (int hf = 0; hf < 2; ++hf) {
      nsa_qk(sacc, qf, tb, hf, fr, fq);
#pragma unroll
      for (int mi = 0; mi < 4; ++mi) {
        const float slope = slope0 * (1.f / (float)(1 << mi)); float mx = -1e30f;
#pragma unroll
        for (int ni = 0; ni < 2; ++ni)
#pragma unroll
          for (int j = 0; j < 4; ++j) {
            const int jj = jt * 64 + hf * 32 + ni * 16 + 4 * fq + j; const bool ok = (16 * jj + 31 <= tc);
            const float v = sacc[mi][ni][j] - slope * ((float)tc - (16.f * jj + 15.5f));
            sacc[mi][ni][j] = ok ? v : -1e30f; mx = fmaxf(mx, sacc[mi][ni][j]);
          }
        mx = max4(mx);
        const float mn = fmaxf(m_run[mi], mx); float ls = 0.f;
#pragma unroll
        for (int ni = 0; ni < 2; ++ni)
#pragma unroll
          for (int j = 0; j < 4; ++j) ls += (sacc[mi][ni][j] > -1e29f) ? __builtin_amdgcn_exp2f(sacc[mi][ni][j] - mn) : 0.f;
        l_run[mi] = l_run[mi] * __builtin_amdgcn_exp2f(m_run[mi] - mn) + ls; m_run[mi] = mn;
      }
    }
  }
  float invl[4];
#pragma unroll
  for (int mi = 0; mi < 4; ++mi) { const float l = red4(l_run[mi]); invl[mi] = l > 0.f ? 1.f / l : 0.f; }
#pragma unroll
  for (int mi = 0; mi < 4; ++mi)
#pragma unroll
    for (int ni = 0; ni < 4; ++ni) oacc[mi][ni] = (f32x4){0.f, 0.f, 0.f, 0.f};
  for (int jt = 0; jt < nct; ++jt) {
    __syncthreads();
    nsa_load_tile<true>(kcb + (size_t)jt * 64 * 64, 64u, vcb + jt * 64, 256u, lds, tid);
    asm volatile("s_waitcnt vmcnt(0)" ::: "memory");
    __syncthreads();
#pragma unroll 1
    for (int hf = 0; hf < 2; ++hf) {
      nsa_qk(sacc, qf, lds, hf, fr, fq);
      float imp[2] = {0.f, 0.f}, car[2] = {0.f, 0.f};
#pragma unroll
      for (int mi = 0; mi < 4; ++mi) {
        const float slope = slope0 * (1.f / (float)(1 << mi));
#pragma unroll
        for (int ni = 0; ni < 2; ++ni) {
#pragma unroll
          for (int j = 0; j < 4; ++j) {
            const int jj = jt * 64 + hf * 32 + ni * 16 + 4 * fq + j; const bool ok = (16 * jj + 31 <= tc);
            const float v = sacc[mi][ni][j] - slope * ((float)tc - (16.f * jj + 15.5f));
            sacc[mi][ni][j] = ok ? __builtin_amdgcn_exp2f(v - m_run[mi]) * invl[mi] : 0.f;
          }
          imp[ni] += (sacc[mi][ni][0] + sacc[mi][ni][1]) + sacc[mi][ni][2] + 0.5f * sacc[mi][ni][3]; car[ni] += 0.5f * sacc[mi][ni][3];
        }
      }
      nsa_pv(oacc, sacc, lds, pw, hf, fr, fq);
#pragma unroll
      for (int ni = 0; ni < 2; ++ni) {
        const int sb = jt * 16 + hf * 8 + ni * 4 + fq; float* pp = PSLC + (wid * 16 + fr) * 64 + sb;
        atomicAdd(pp, imp[ni]);
        if (sb < 63) atomicAdd(pp + 1, car[ni]);
      }
    }
  }
  int frc = fr; asm volatile("" : "+v"(frc));
  {
    const size_t n = nb + t0 + wid * 16 + frc;
#pragma unroll
    for (int mi = 0; mi < 4; ++mi) {
      const int hh = g * 4 + mi; const float gt = sigmoidf_(a.SM[n * 32 + 8 + hh * 3]);
#pragma unroll
      for (int ni = 0; ni < 4; ++ni) {
        bf16_t* dp = a.ANS + n * 512 + hh * 64 + ni * 16 + 4 * fq; const u32x2 pr = *(const u32x2*)dp;
        f32x4 r = oacc[mi][ni] * gt;
        r[0] += __uint_as_float(pr.x << 16); r[1] += __uint_as_float(pr.x & 0xffff0000u); r[2] += __uint_as_float(pr.y << 16); r[3] += __uint_as_float(pr.y & 0xffff0000u);
        st_bf4(dp, r);
      }
    }
  }
  __syncthreads();
  {
    int tsel = tid, isel = i; asm volatile("" : "+v"(tsel), "+v"(isel));
    const int q = tsel >> 2, sub = tsel & 3;
    float mine[16]; int cnt[16];
#pragma unroll
    for (int k = 0; k < 16; ++k) {
      const int sb = sub * 16 + k; const float ps = PSLC[q * 64 + sb];
      mine[k] = (sb == 0 || sb == isel || sb == isel - 1) ? 1e4f : (sb > isel ? -1e4f : ps); cnt[k] = 0;
    }
#pragma unroll
    for (int k = 0; k < 16; ++k) PSLC[q * 64 + sub * 16 + k] = mine[k];
    __syncthreads();
    for (int s2 = 0; s2 <= isel; ++s2) {
      const float o = PSLC[q * 64 + s2];
#pragma unroll
      for (int k = 0; k < 16; ++k) cnt[k] += (o > mine[k] || (o == mine[k] && s2 < sub * 16 + k)) ? 1 : 0;
    }
    unsigned m16 = 0;
#pragma unroll
    for (int k = 0; k < 16; ++k) m16 |= (cnt[k] < 16 ? 1u : 0u) << k;
    unsigned mlo = (sub < 2) ? (m16 << (16 * sub)) : 0u, mhi = (sub >= 2) ? (m16 << (16 * (sub - 2))) : 0u;
    mlo |= __shfl_xor(mlo, 1); mlo |= __shfl_xor(mlo, 2); mhi |= __shfl_xor(mhi, 1); mhi |= __shfl_xor(mhi, 2);
    u64 m64 = ((u64)mhi << 32) | (u64)mlo;
    m64 &= (isel == 63) ? ~0ull : ((2ull << isel) - 1ull);
    if (sub == 0) SELM[q] = m64;
    u64 un = m64;
#pragma unroll
    for (int o = 4; o < 64; o <<= 1) un |= __shfl_xor(un, o);
    if (lane == 0) UNI[wid] = un;
  }
  __syncthreads();
  const u64 uni = UNI[0] | UNI[1] | UNI[2] | UNI[3];
#pragma unroll
  for (int mi = 0; mi < 4; ++mi)
#pragma unroll
    for (int ks = 0; ks < 2; ++ks) qf[mi][ks] = *(const bf16x8*)(a.NQ + (size_t)(nb + t0 + mi * 16 + fr) * 512 + h * 64 + ks * 32 + fq * 8);
#pragma unroll 1
  for (int br = 1; br <= 1; ++br) {
#pragma unroll
    for (int mi = 0; mi < 4; ++mi) { m_run[mi] = -1e30f; l_run[mi] = 0.f;
#pragma unroll
      for (int ni = 0; ni < 4; ++ni) oacc[mi][ni] = (f32x4){0.f, 0.f, 0.f, 0.f}; }
    const bf16_t* Kb = (br == 1 ? a.KS : a.KW) + (size_t)nb * 128 + g * 64;
    const bf16_t* Vb = (br == 1 ? a.VST : a.VWT) + ((size_t)(b * 128 + g * 64) << 12);
    u64 todo;
    if (br == 1) todo = uni;
    else { const int lo = i >= 8 ? i - 8 : 0; todo = ((i == 63) ? ~0ull : ((2ull << i) - 1ull)) & ~((1ull << lo) - 1ull); }
    int cur = __builtin_ctzll(todo), bsel = 0;
    if (tid == 0) xch[half] = __builtin_popcountll(todo);
    __syncthreads();
    const int ntile = max(xch[0], xch[1]);
    nsa_load_tile<true>(Kb + (size_t)cur * 64 * 128, 128u, Vb + cur * 64, 4096u, lds, tid);
    for (int kt = 0; kt < ntile; ++kt) {
      int nxt = -1;
      if (cur >= 0) { todo &= todo - 1ull; nxt = todo ? __builtin_ctzll(todo) : -1; }
      asm volatile("s_waitcnt vmcnt(0)" ::: "memory");
      __syncthreads();
      if (cur < 0) continue;
      char* tb = bsel ? (lds + 49152) : lds;
      if (nxt >= 0) nsa_load_tile<true>(Kb + (size_t)nxt * 64 * 128, 128u, Vb + nxt * 64, 4096u, bsel ? lds : (lds + 49152), tid);
      const int sb = cur;
#pragma unroll 1
      for (int hf = 0; hf < 2; ++hf) {
        nsa_qk(sacc, qf, tb, hf, fr, fq);
        const bool edge = (sb == i) || (br == 2 && sb == i - 8);
#pragma unroll
        for (int mi = 0; mi < 4; ++mi) {
          const int tq = mi * 16 + fr;
          const bool rsel = (br == 2) || ((SELM[tq] >> sb) & 1ull);
          const float rc = rsel ? -slope * (float)(64 * (i - sb) + tq - hf * 32 - 4 * fq) : -1e30f;
          if (!edge) {
#pragma unroll
            for (int ni = 0; ni < 2; ++ni)
#pragma unroll
              for (int j = 0; j < 4; ++j) sacc[mi][ni][j] += fmaf(slope, (float)(ni * 16 + j), rc);
          } else {
            const int tqh = tq - hf * 32;
#pragma unroll
            for (int ni = 0; ni < 2; ++ni)
#pragma unroll
              for (int j = 0; j < 4; ++j) {
                const int c = ni * 16 + 4 * fq + j;
                const bool okv = (sb == i) ? (c <= tqh) : (c > tqh);
                sacc[mi][ni][j] = okv ? sacc[mi][ni][j] + fmaf(slope, (float)(ni * 16 + j), rc) : -1e30f;
              }
          }
        }
        nsa_online(sacc, m_run, l_run, oacc);
        nsa_pv(oacc, sacc, tb, pw, hf, fr, fq);
      }
      cur = nxt; bsel ^= 1;
    }
    int fre = fr; asm volatile("" : "+v"(fre));
#pragma unroll
    for (int mi = 0; mi < 4; ++mi) {
      const size_t n = nb + t0 + mi * 16 + fre;
      const float l = red4(l_run[mi]); const float sc = sigmoidf_(a.SM[n * 32 + 8 + h * 3 + br]) / l;
#pragma unroll
      for (int ni = 0; ni < 4; ++ni) {
        bf16_t* dp = a.ANS + n * 512 + h * 64 + ni * 16 + 4 * fq; const u32x2 pr = *(const u32x2*)dp;
        f32x4 r = oacc[mi][ni] * sc;
        r[0] += __uint_as_float(pr.x << 16); r[1] += __uint_as_float(pr.x & 0xffff0000u); r[2] += __uint_as_float(pr.y << 16); r[3] += __uint_as_float(pr.y & 0xffff0000u);
        st_bf4(dp, r);
      }
    }
  }
  __syncthreads();
}


__device__ __forceinline__ void nsa_win_item(const MegaArgs& a, int item, char* lds, int tid) {
  asm volatile("" : "+v"(tid));
  const int lane = tid & 63, wid = tid >> 6, fr = lane & 15, fq = lane >> 4;
  const int i = item & 63, g = (item >> 6) & 1, b = item >> 7;
  const int h = g * 4 + wid, nb = b * SEQ, t0 = i * 64, bg = b * 2 + g;
  const float slope = exp2f(-(float)(h + 1)) * 1.4426950408889634f;
  char* pw = lds + 16384 + wid * 8192;
  float* PSLC = (float*)(lds + 49152);
  u64* SELM = (u64*)(lds + 65536);
  u64* UNI = (u64*)(lds + 66048);
  bf16x8 qf[4][2];
#pragma unroll
  for (int mi = 0; mi < 4; ++mi)
#pragma unroll
    for (int ks = 0; ks < 2; ++ks) qf[mi][ks] = *(const bf16x8*)(a.NQ + (size_t)(nb + t0 + mi * 16 + fr) * 512 + h * 64 + ks * 32 + fq * 8);
  f32x4 sacc[4][2], oacc[4][4];
  float m_run[4], l_run[4];
  (void)PSLC; (void)UNI; (void)bg;
  const u64 uni = 0ull;
#pragma unroll 1
  for (int br = 2; br <= 2; ++br) {
#pragma unroll
    for (int mi = 0; mi < 4; ++mi) { m_run[mi] = -1e30f; l_run[mi] = 0.f;
#pragma unroll
      for (int ni = 0; ni < 4; ++ni) oacc[mi][ni] = (f32x4){0.f, 0.f, 0.f, 0.f}; }
    const bf16_t* Kb = (br == 1 ? a.KS : a.KW) + (size_t)nb * 128 + g * 64;
    const bf16_t* Vb = (br == 1 ? a.VST : a.VWT) + ((size_t)(b * 128 + g * 64) << 12);
    u64 todo;
    if (br == 1) todo = uni;
    else { const int lo = i >= 8 ? i - 8 : 0; todo = ((i == 63) ? ~0ull : ((2ull << i) - 1ull)) & ~((1ull << lo) - 1ull); }
    int cur = 63 - __builtin_clzll(todo), bsel = 0;
    __syncthreads();
    nsa_load_tile<true>(Kb + (size_t)cur * 64 * 128, 128u, Vb + cur * 64, 4096u, lds, tid);
    while (cur >= 0) {
      todo &= ~(1ull << cur);
      const int nxt = todo ? 63 - __builtin_clzll(todo) : -1;
      asm volatile("s_waitcnt vmcnt(0)" ::: "memory");
      __syncthreads();
      char* tb = bsel ? (lds + 49152) : lds;
      if (nxt >= 0) nsa_load_tile<true>(Kb + (size_t)nxt * 64 * 128, 128u, Vb + nxt * 64, 4096u, bsel ? lds : (lds + 49152), tid);
      const int sb = cur;
#pragma unroll 1
      for (int hf = 0; hf < 2; ++hf) {
        nsa_qk(sacc, qf, tb, hf, fr, fq);
        const bool edge = (sb == i) || (br == 2 && sb == i - 8);
#pragma unroll
        for (int mi = 0; mi < 4; ++mi) {
          const int tq = mi * 16 + fr;
          const bool rsel = (br == 2) || ((SELM[tq] >> sb) & 1ull);
          const float rc = rsel ? -slope * (float)(64 * (i - sb) + tq - hf * 32 - 4 * fq) : -1e30f;
          if (!edge) {
#pragma unroll
            for (int ni = 0; ni < 2; ++ni)
#pragma unroll
              for (int j = 0; j < 4; ++j) sacc[mi][ni][j] += fmaf(slope, (float)(ni * 16 + j), rc);
          } else {
            const int tqh = tq - hf * 32;
#pragma unroll
            for (int ni = 0; ni < 2; ++ni)
#pragma unroll
              for (int j = 0; j < 4; ++j) {
                const int c = ni * 16 + 4 * fq + j;
                const bool okv = (sb == i) ? (c <= tqh) : (c > tqh);
                sacc[mi][ni][j] = okv ? sacc[mi][ni][j] + fmaf(slope, (float)(ni * 16 + j), rc) : -1e30f;
              }
          }
        }
        nsa_online(sacc, m_run, l_run, oacc);
        nsa_pv(oacc, sacc, tb, pw, hf, fr, fq);
      }
      cur = nxt; bsel ^= 1;
    }
#pragma unroll
    for (int mi = 0; mi < 4; ++mi) {
      const size_t n = nb + t0 + mi * 16 + fr;
      const float l = red4(l_run[mi]); const float sc = sigmoidf_(a.SM[n * 32 + 8 + h * 3 + br]) / l;
#pragma unroll
      for (int ni = 0; ni < 4; ++ni) {
        st_bf4(a.ANS + n * 512 + h * 64 + ni * 16 + 4 * fq, oacc[mi][ni] * sc);
      }
    }
  }
  __syncthreads();
}


__device__ __forceinline__ int img_off(int row, int k) { return row * 128 + ((((k >> 3) ^ ((row >> 1) & 7))) << 4) + (k & 7) * 2; }
__device__ __forceinline__ bf16x8 img_frag(const char* img, int r0, int ks, int fr, int fq) { return *(const bf16x8*)(img + (r0 + fr) * 128 + (((ks * 4 + fq) ^ (fr >> 1)) << 4)); }


__device__ __forceinline__ void stage_raw(const bf16_t* __restrict__ QK, int nb, int t0, int chbase, char* raw, int tid) {
  u32x4 v[5];
#pragma unroll
  for (int i = 0; i < 5; ++i) {
    const int c = tid + 256 * i, row = c >> 4, cc = c & 15, t = t0 - 3 + row;
    v[i] = (c < 1072 && t >= 0) ? *(const u32x4*)(QK + (size_t)(nb + t) * 1024 + chbase + cc * 8) : (u32x4){0u, 0u, 0u, 0u};
  }
#pragma unroll
  for (int i = 0; i < 5; ++i) { const int c = tid + 256 * i; if (c < 1072) *(u32x4*)(raw + c * 16) = v[i]; }
}
template <class Put>
__device__ __forceinline__ void conv_col(const char* raw, const float* __restrict__ conv, int j0, int nj, int ch, int d, float scale, Put put) {
  const float w0 = conv[ch], w1 = conv[1024 + ch], w2 = conv[2048 + ch], w3 = conv[3072 + ch];
  const bf16_t* r = (const bf16_t*)raw + d;
  float x0 = bf2f(r[(j0 + 0) * 128]), x1 = bf2f(r[(j0 + 1) * 128]), x2 = bf2f(r[(j0 + 2) * 128]);
  for (int j = j0; j < j0 + nj; ++j) {
    const float x3 = bf2f(r[(j + 3) * 128]);
    put(j, siluf_(w0 * x0 + w1 * x1 + w2 * x2 + w3 * x3) * scale);
    x0 = x1; x1 = x2; x2 = x3;
  }
}

__device__ __forceinline__ void ml_dc_item(const MegaArgs& a, const MlArgs& ml, int item, char* lds, int tid) {
  asm volatile("" : "+v"(tid));
  const int lane = tid & 63, wid = tid >> 6, wr = wid >> 1, wc = wid & 1, fr = lane & 15, fq = lane >> 4;
  const int bh = item >> 6, c = item & 63, b = bh >> 2, h = bh & 3, nb = b * SEQ, t0 = c * 64;
  char* KT = lds; char* VT = lds + 16384; float* sc = (float*)(lds + 32768); float* dnp = (float*)(lds + 33792);
  if (tid < 64) {
    const size_t n = nb + t0 + tid;
    sc[tid] = a.SM[n * 32 + h] + ml.b_i[h];
    sc[64 + tid] = logsigmoidf_(a.SM[n * 32 + 4 + h] + ml.b_f[h]);
  }
  __syncthreads();
  if (tid < 64) {
    float cs = sc[64 + tid];
#pragma unroll
    for (int o = 1; o < 64; o <<= 1) { const float up = __shfl_up(cs, o); if (tid >= o) cs += up; }
    const float bl = __shfl(cs, 63);
    const float lw = bl - cs + sc[tid];
    const float mx = wave_max(lw);
    sc[128 + tid] = cs; sc[192 + tid] = __expf(lw - mx);
    if (tid == 0) { ml.BL[bh * 64 + c] = bl; ml.MX[bh * 64 + c] = mx; }
  }
  __syncthreads();
  if (tid < 64) { ml.BCUM[bh * SEQ + t0 + tid] = sc[128 + tid]; ml.IP[bh * SEQ + t0 + tid] = sc[tid]; }
  char* RAW = lds + 36864;
  stage_raw(a.QK, nb, t0, 512 + h * 128, RAW, tid);
  __syncthreads();
  {
    const int d = tid & 127, jh = tid >> 7;
    float dn = 0.f;
    conv_col(RAW, ml.conv, jh * 32, 32, 512 + h * 128 + d, d, 0.08838834764831845f,
             [&](int j, float v) { *(bf16_t*)(KT + img_off(d, j)) = f2bf(v); dn += sc[192 + j] * v; });
    dnp[jh * 128 + d] = dn;
    {
      bf16_t tv[32];
#pragma unroll
      for (int u = 0; u < 32; ++u) tv[u] = a.V[(size_t)(nb + t0 + jh * 32 + u) * 512 + h * 128 + d];
#pragma unroll
      for (int u = 0; u < 32; ++u) *(bf16_t*)(VT + img_off(d, jh * 32 + u)) = f2bf(sc[192 + jh * 32 + u] * bf2f(tv[u]));
    }
  }
  __syncthreads();
  if (tid < 128) ml.NST[(size_t)(bh * 64 + c) * 128 + tid] = dnp[tid] + dnp[128 + tid];
  f32x4 acc[4][4]; zero_acc(acc);
#pragma unroll
  for (int ks = 0; ks < 2; ++ks) {
    bf16x8 av[4], bk[4];
#pragma unroll
    for (int i = 0; i < 4; ++i) { av[i] = img_frag(VT, wr * 64 + i * 16, ks, fr, fq); bk[i] = img_frag(KT, wc * 64 + i * 16, ks, fr, fq); }
#pragma unroll
    for (int i = 0; i < 4; ++i)
#pragma unroll
      for (int j = 0; j < 4; ++j) acc[i][j] = __builtin_amdgcn_mfma_f32_16x16x32_bf16(bk[j], av[i], acc[i][j], 0, 0, 0);
  }
  bf16_t* cst = ml.CST + (size_t)(bh * 64 + c) * 16384;
#pragma unroll
  for (int mi = 0; mi < 4; ++mi)
#pragma unroll
    for (int ni = 0; ni < 4; ++ni) st_bf4(cst + (wr * 64 + mi * 16 + fr) * 128 + wc * 64 + ni * 16 + 4 * fq, acc[mi][ni]);
  __syncthreads();
}

__device__ __forceinline__ void ml_scan_item(const MlArgs& ml, int item, int tid) {
  const int bh = item / 17, part = item % 17;
  float m = 0.f;
  if (part < 16) {
    float run[4] = {0.f, 0.f, 0.f, 0.f};
#pragma unroll 1
    for (int c0 = 0; c0 < 64; c0 += 8) {
      u32x2 vb[8]; float bl[8], mxv[8];
#pragma unroll
      for (int u = 0; u < 8; ++u) {
        vb[u] = *(const u32x2*)(ml.CST + (size_t)(bh * 64 + c0 + u) * 16384 + part * 1024 + tid * 4);
        bl[u] = ml.BL[bh * 64 + c0 + u]; mxv[u] = ml.MX[bh * 64 + c0 + u];
      }
#pragma unroll
      for (int u = 0; u < 8; ++u) {
        const float mn = fmaxf(bl[u] + m, mxv[u]), decay = __expf(bl[u] + m - mn), scl = __expf(mxv[u] - mn);
        u32x2 o; o.x = pk2bf(run[0], run[1]); o.y = pk2bf(run[2], run[3]);
        *(u32x2*)(ml.CST + (size_t)(bh * 64 + c0 + u) * 16384 + part * 1024 + tid * 4) = o;
        run[0] = decay * run[0] + scl * __uint_as_float(vb[u].x << 16); run[1] = decay * run[1] + scl * __uint_as_float(vb[u].x & 0xffff0000u);
        run[2] = decay * run[2] + scl * __uint_as_float(vb[u].y << 16); run[3] = decay * run[3] + scl * __uint_as_float(vb[u].y & 0xffff0000u);
        if (part == 0 && tid == 0) ml.MST[bh * 64 + c0 + u] = m;
        m = mn;
      }
    }
  } else if (tid < 128) {
    float run = 0.f;
    for (int c = 0; c < 64; ++c) {
      const float bl = ml.BL[bh * 64 + c], mx = ml.MX[bh * 64 + c];
      const float mn = fmaxf(bl + m, mx), decay = __expf(bl + m - mn), scl = __expf(mx - mn);
      float* p = ml.NST + (size_t)(bh * 64 + c) * 128 + tid;
      const float v = *p; *p = run; run = decay * run + scl * v;
      m = mn;
    }
  }
}

__device__ __forceinline__ void ml_out_item(const MegaArgs& a, const MlArgs& ml, int item, char* lds, int tid) {
  asm volatile("" : "+v"(tid));
  const int lane = tid & 63, wid = tid >> 6, wr = wid >> 1, wc = wid & 1, fr = lane & 15, fq = lane >> 4;
  const int bh = item >> 6, c = item & 63, b = bh >> 2, h = bh & 3, nb = b * SEQ, t0 = c * 64;
  char* Qi = lds; char* Ki = lds + 16384; char* VT = lds + 32768; char* SP = lds + 49152;
  float* sc = (float*)(lds + 57344);
  float* H = (float*)lds;
  {
    char* RAW = lds + 49152;
    const int d = tid & 127, jh = tid >> 7;
    stage_raw(a.QK, nb, t0, h * 128, RAW, tid);
    {
      bf16_t tv[32];
#pragma unroll
      for (int u = 0; u < 32; ++u) tv[u] = a.V[(size_t)(nb + t0 + jh * 32 + u) * 512 + h * 128 + d];
#pragma unroll
      for (int u = 0; u < 32; ++u) *(bf16_t*)(VT + img_off(d, jh * 32 + u)) = tv[u];
    }
    __syncthreads();
    conv_col(RAW, ml.conv, jh * 32, 32, h * 128 + d, d, 1.f, [&](int j, float v) { *(bf16_t*)(Qi + (d >> 6) * 8192 + img_off(j, d & 63)) = f2bf(v); });
    __syncthreads();
    stage_raw(a.QK, nb, t0, 512 + h * 128, RAW, tid);
    __syncthreads();
    conv_col(RAW, ml.conv, jh * 32, 32, 512 + h * 128 + d, d, 0.08838834764831845f, [&](int j, float v) { *(bf16_t*)(Ki + (d >> 6) * 8192 + img_off(j, d & 63)) = f2bf(v); });
    __syncthreads();
  }
  if (tid < 64) { sc[tid] = ml.BCUM[bh * SEQ + t0 + tid]; sc[64 + tid] = ml.IP[bh * SEQ + t0 + tid]; }
  if (tid < 128) sc[448 + tid] = ml.NST[(size_t)(bh * 64 + c) * 128 + tid];
  __syncthreads();
  const float m = ml.MST[bh * 64 + c];
  if (tid < 64) {
    const float bj = sc[tid]; float mxi = -INFINITY;
    for (int s2 = 0; s2 <= tid; ++s2) mxi = fmaxf(mxi, bj - sc[s2] + sc[64 + s2]);
    const float inter = bj + m, mt = fmaxf(mxi, inter);
    sc[128 + tid] = mt; sc[192 + tid] = __expf(inter - mt);
  } else if (tid < 128) {
    const int t = tid - 64; float nq = 0.f;
    for (int k = 0; k < 128; ++k) nq += sc[448 + k] * bf2f(*(const bf16_t*)(Qi + (k >> 6) * 8192 + img_off(t, k & 63)));
    sc[384 + t] = nq;
  }
  f32x4 sacc[2][2];
#pragma unroll
  for (int i = 0; i < 2; ++i)
#pragma unroll
    for (int j = 0; j < 2; ++j) sacc[i][j] = (f32x4){0.f, 0.f, 0.f, 0.f};
#pragma unroll
  for (int kt = 0; kt < 2; ++kt)
#pragma unroll
    for (int ks = 0; ks < 2; ++ks) {
      bf16x8 aq[2], bk[2];
#pragma unroll
      for (int i = 0; i < 2; ++i) { aq[i] = img_frag(Qi + kt * 8192, wr * 32 + i * 16, ks, fr, fq); bk[i] = img_frag(Ki + kt * 8192, wc * 32 + i * 16, ks, fr, fq); }
#pragma unroll
      for (int i = 0; i < 2; ++i)
#pragma unroll
        for (int j = 0; j < 2; ++j) sacc[i][j] = __builtin_amdgcn_mfma_f32_16x16x32_bf16(bk[j], aq[i], sacc[i][j], 0, 0, 0);
    }
  __syncthreads();
  const bf16_t* cst = ml.CST + (size_t)(bh * 64 + c) * 16384;
#pragma unroll
  for (int i = 0; i < 4; ++i) { const int idx = tid + 256 * i, row = idx >> 3, lc = (idx & 7) ^ ((row >> 1) & 7); glds16(cst + row * 128 + lc * 8, Ki + idx * 16); }
#pragma unroll
  for (int mi = 0; mi < 2; ++mi) {
    const int t = wr * 32 + mi * 16 + fr; const float bt = sc[t], mt = sc[128 + t]; float rsum = 0.f;
#pragma unroll
    for (int ni = 0; ni < 2; ++ni) {
      const int s0 = wc * 32 + ni * 16 + 4 * fq; f32x4 p;
#pragma unroll
      for (int j = 0; j < 4; ++j) { const int s2 = s0 + j; p[j] = (s2 <= t) ? sacc[mi][ni][j] * __expf(bt - sc[s2] + sc[64 + s2] - mt) : 0.f; rsum += p[j]; }
      u32x2 o; o.x = pk2bf(p[0], p[1]); o.y = pk2bf(p[2], p[3]);
      *(u32x2*)(SP + img_off(t, s0)) = o;
    }
    rsum += __shfl_xor(rsum, 16); rsum += __shfl_xor(rsum, 32);
    if (fq == 0) sc[256 + t * 2 + wc] = rsum;
  }
  asm volatile("s_waitcnt vmcnt(0)" ::: "memory");
  __syncthreads();
  f32x4 acc1[2][4], acc2[2][4];
#pragma unroll
  for (int i = 0; i < 2; ++i)
#pragma unroll
    for (int j = 0; j < 4; ++j) { acc1[i][j] = (f32x4){0.f, 0.f, 0.f, 0.f}; acc2[i][j] = (f32x4){0.f, 0.f, 0.f, 0.f}; }
#pragma unroll
  for (int ks = 0; ks < 2; ++ks) {
    bf16x8 as[2], bv[4];
#pragma unroll
    for (int i = 0; i < 2; ++i) as[i] = img_frag(SP, wr * 32 + i * 16, ks, fr, fq);
#pragma unroll
    for (int j = 0; j < 4; ++j) bv[j] = img_frag(VT, wc * 64 + j * 16, ks, fr, fq);
#pragma unroll
    for (int i = 0; i < 2; ++i)
#pragma unroll
      for (int j = 0; j < 4; ++j) acc1[i][j] = __builtin_amdgcn_mfma_f32_16x16x32_bf16(bv[j], as[i], acc1[i][j], 0, 0, 0);
  }
#pragma unroll 1
  for (int kt = 0; kt < 2; ++kt) {
    if (kt == 1) {
      __syncthreads();
#pragma unroll
      for (int i = 0; i < 4; ++i) { const int idx = tid + 256 * i, row = idx >> 3, lc = (idx & 7) ^ ((row >> 1) & 7); glds16(cst + row * 128 + 64 + lc * 8, Ki + idx * 16); }
      asm volatile("s_waitcnt vmcnt(0)" ::: "memory");
      __syncthreads();
    }
#pragma unroll
    for (int ks = 0; ks < 2; ++ks) {
      bf16x8 aq[2], bc[4];
#pragma unroll
      for (int i = 0; i < 2; ++i) aq[i] = img_frag(Qi + kt * 8192, wr * 32 + i * 16, ks, fr, fq);
#pragma unroll
      for (int j = 0; j < 4; ++j) bc[j] = img_frag(Ki, wc * 64 + j * 16, ks, fr, fq);
#pragma unroll
      for (int i = 0; i < 2; ++i)
#pragma unroll
        for (int j = 0; j < 4; ++j) acc2[i][j] = __builtin_amdgcn_mfma_f32_16x16x32_bf16(bc[j], aq[i], acc2[i][j], 0, 0, 0);
    }
  }
  __syncthreads();
#pragma unroll
  for (int mi = 0; mi < 2; ++mi) {
    const int t = wr * 32 + mi * 16 + fr; const float wi = sc[192 + t];
    const float den = sc[256 + t * 2] + sc[256 + t * 2 + 1] + wi * sc[384 + t];
    const float inv = 1.f / fmaxf(fabsf(den), __expf(-sc[128 + t]));
#pragma unroll
    for (int ni = 0; ni < 4; ++ni) *(f32x4*)(H + t * 132 + wc * 64 + ni * 16 + 4 * fq) = (acc1[mi][ni] + acc2[mi][ni] * wi) * inv;
  }
  __syncthreads();
  {
    bf16_t og0[16], og1[16];
#pragma unroll
    for (int r = 0; r < 16; ++r) { const size_t n = nb + t0 + wid * 16 + r; og0[r] = a.O[n * 512 + h * 128 + lane]; og1[r] = a.O[n * 512 + h * 128 + 64 + lane]; }
    const float g0 = ml.gain[h * 128 + lane], g1 = ml.gain[h * 128 + 64 + lane];
#pragma unroll
    for (int r = 0; r < 16; ++r) {
      const int j = wid * 16 + r;
      const float a0 = H[j * 132 + lane], a1 = H[j * 132 + 64 + lane];
      const float ss = wave_sum(a0 * a0 + a1 * a1);
      const float rs = rsqrtf(ss * (1.f / 128.f) + EPS);
      const size_t n = nb + t0 + j; const int c0 = h * 128 + lane, c1 = c0 + 64;
      a.AML[n * 512 + c0] = f2bf(sigmoidf_(bf2f(og0[r])) * a0 * rs * g0);
      a.AML[n * 512 + c1] = f2bf(sigmoidf_(bf2f(og1[r])) * a1 * rs * g1);
    }
  }
  __syncthreads();
}


struct EpiX1 {
  static constexpr bool PERM = false, AFTER_DRAIN = false;
  const bf16_t* XB; bf16_t* X1B; float* PS2;
  __device__ __forceinline__ void operator()(const f32x4 (&acc)[2][2][4][2], const pg8::Unit& u, int wr, int wc, int fr, int fq) const {
    const int c8 = (fq & 1) * 16 + (fq >> 1) * 8;
#pragma unroll
    for (int ai = 0; ai < 2; ++ai)
#pragma unroll
      for (int m = 0; m < 4; ++m) {
        const int row = u.pm * 256 + ai * 128 + wr * 64 + m * 16 + fr;
#pragma unroll
        for (int bj = 0; bj < 2; ++bj) {
          const size_t off = (size_t)row * 1024 + u.pn * 256 + bj * 128 + wc * 32 + c8;
          float v[8], xr[8]; swap8(acc[ai][bj][m][0], acc[ai][bj][m][1], v); bf8_to_f32(*(const u32x4*)(XB + off), xr);
          float ss = 0.f;
#pragma unroll
          for (int j = 0; j < 8; ++j) { v[j] += xr[j]; ss += v[j] * v[j]; }
          __builtin_nontemporal_store(pk8bf(v), (u32x4*)(X1B + off));
          ss += __shfl_xor(ss, 16); ss += __shfl_xor(ss, 32);
          if (fq == 0) PS2[(size_t)row * 32 + u.pn * 8 + bj * 4 + wc] = ss;
        }
      }
  }
};
struct EpiXQ {
  static constexpr bool PERM = false, AFTER_DRAIN = false;
  bf16_t* XQ; const PG8_LAS float* rsl;
  __device__ __forceinline__ void operator()(const f32x4 (&acc)[2][2][4][2], const pg8::Unit& u, int wr, int wc, int fr, int fq) const {
#pragma unroll
    for (int ai = 0; ai < 2; ++ai)
#pragma unroll
      for (int m = 0; m < 4; ++m) {
        const int rl = ai * 128 + wr * 64 + m * 16 + fr, row = u.pm * 256 + rl;
        const float rs = rsl[rl];
#pragma unroll
        for (int bj = 0; bj < 2; ++bj) st_bf8_pair(XQ + (size_t)row * 1024 + u.pn * 256 + bj * 128 + wc * 32, fq, acc[ai][bj][m][0] * rs, acc[ai][bj][m][1] * rs);
      }
  }
};
struct EpiX2 {
  static constexpr bool PERM = false, AFTER_DRAIN = false;
  bf16_t* X1B;
  __device__ __forceinline__ void operator()(const f32x4 (&acc)[2][2][4][2], const pg8::Unit& u, int wr, int wc, int fr, int fq) const {
    const int c8 = (fq & 1) * 16 + (fq >> 1) * 8;
#pragma unroll
    for (int ai = 0; ai < 2; ++ai)
#pragma unroll
      for (int m = 0; m < 4; ++m) {
        const int row = u.pm * 256 + ai * 128 + wr * 64 + m * 16 + fr;
#pragma unroll
        for (int bj = 0; bj < 2; ++bj) {
          bf16_t* p = X1B + (size_t)row * 1024 + u.pn * 256 + bj * 128 + wc * 32 + c8;
          float v[8], xr[8]; swap8(acc[ai][bj][m][0], acc[ai][bj][m][1], v); bf8_to_f32(*(const u32x4*)p, xr);
#pragma unroll
          for (int j = 0; j < 8; ++j) v[j] += xr[j];
          __builtin_nontemporal_store(pk8bf(v), (u32x4*)p);
        }
      }
  }
};
struct MapMN {
  const bf16_t* A; const bf16_t* Bt; int K, xcd;
  __device__ __forceinline__ void avoff(const pg8::Unit&, int, int K, const unsigned (&voffA)[2], unsigned (&v0)[2], unsigned (&v1)[2]) const { v0[0] = voffA[0]; v0[1] = voffA[1]; v1[0] = voffA[0] + 256u * K; v1[1] = voffA[1] + 256u * K; }
  __device__ __forceinline__ void operator()(int idx, pg8::Unit& u) const {
    u.pm = xcd * 8 + (idx & 7); u.pn = idx >> 3;
    u.aptr = (const char*)(A + (size_t)u.pm * 256 * K); u.bptr = (const char*)(Bt + (size_t)u.pn * 256 * K);
  }
};

struct MapInProj {
  const bf16_t* XB; const bf16_t* WinT; int xcd;
  __device__ __forceinline__ void avoff(const pg8::Unit&, int, int K, const unsigned (&voffA)[2], unsigned (&v0)[2], unsigned (&v1)[2]) const { v0[0] = voffA[0]; v0[1] = voffA[1]; v1[0] = voffA[0] + 256u * K; v1[1] = voffA[1] + 256u * K; }
  __device__ __forceinline__ void operator()(int idx, pg8::Unit& u) const {
    u.pm = xcd * 8 + (idx & 7); u.pn = idx >> 3;
    const char* tokp = (const char*)(XB + (size_t)u.pm * 256 * DM); const char* colp = (const char*)(WinT + (size_t)u.pn * 256 * DM);
    if (u.pn == 12) { u.aptr = colp; u.bptr = tokp; } else { u.aptr = tokp; u.bptr = colp; }
  }
};
struct EpiInProj8 {
  static constexpr bool PERM = false, AFTER_DRAIN = false;
  bf16_t *QK, *V, *O, *NQ, *KVC, *KS, *KW, *VST, *VWT; float* SM; const float* RS1;
  __device__ __forceinline__ void operator()(const f32x4 (&acc)[2][2][4][2], const pg8::Unit& u, int wr, int wc, int fr, int fq) const {
    if (u.pn == 12) {
#pragma unroll
      for (int bj = 0; bj < 2; ++bj) {
        const int tok = u.pm * 256 + bj * 128 + wc * 32;
        const f32x4 rs0 = *(const f32x4*)(RS1 + tok + 4 * fq), rs1 = *(const f32x4*)(RS1 + tok + 16 + 4 * fq);
        const int b = tok >> 12, t = tok & 4095;
#pragma unroll
        for (int ai = 0; ai < 2; ++ai)
#pragma unroll
          for (int m = 0; m < 4; ++m) st_bf8_pair((ai ? VWT : VST) + ((size_t)(b * 128 + wr * 64 + m * 16 + fr) << 12) + t, fq, acc[ai][bj][m][0] * rs0, acc[ai][bj][m][1] * rs1);
      }
      return;
    }
    float rsv[8];
#pragma unroll
    for (int i = 0; i < 8; ++i) rsv[i] = RS1[u.pm * 256 + (i >> 2) * 128 + wr * 64 + (i & 3) * 16 + fr];
#pragma unroll
    for (int bj = 0; bj < 2; ++bj) {
      const int nh = u.pn * 256 + bj * 128;
      bf16_t* dst; int ld, cofs; float scale = 1.f;
      if (nh < 1024) { dst = QK; ld = 1024; cofs = nh; }
      else if (nh < 1536) { dst = V; ld = 512; cofs = nh - 1024; }
      else if (nh < 2048) { dst = O; ld = 512; cofs = nh - 1536; }
      else if (nh < 2560) { dst = NQ; ld = 512; cofs = nh - 2048; scale = 0.125f * 1.4426950408889634f; }
      else if (nh < 2816) { dst = KVC; ld = 256; cofs = nh - 2560; }
      else if (nh < 2944) { dst = KS; ld = 128; cofs = 0; }
      else if (nh < 3072) { dst = KW; ld = 128; cofs = 0; }
      else { dst = nullptr; ld = 0; cofs = 0; }
      if (!dst && nh != 3328) continue;
#pragma unroll
      for (int ai = 0; ai < 2; ++ai)
#pragma unroll
        for (int m = 0; m < 4; ++m) {
          const int row = u.pm * 256 + ai * 128 + wr * 64 + m * 16 + fr; const float rs = rsv[ai * 4 + m] * scale;
          if (dst) {
            st_bf8_pair(dst + (size_t)row * ld + cofs + wc * 32, fq, acc[ai][bj][m][0] * rs, acc[ai][bj][m][1] * rs);
          } else if (wc == 0) {
#pragma unroll
            for (int n = 0; n < 2; ++n) *(f32x4*)(SM + (size_t)row * 32 + n * 16 + 4 * fq) = acc[ai][bj][m][n] * rs;
          }
        }
    }
  }
};

struct MapMoe {
  const int* CNT; const int* LIST; const bf16_t* Abase; const bf16_t* W; size_t wstride; int K, xcd, gather;
  __device__ __forceinline__ void operator()(int idx, pg8::Unit& u) const {
    int g = (idx >> 2) * 8 + xcd, e = 0, ce = 0, pre = 0;
    u.pm = g;
    int cn[16];
#pragma unroll
    for (int k = 0; k < 16; ++k) cn[k] = CNT[k];
    bool fnd = false;
#pragma unroll
    for (int k = 0; k < 16; ++k) {
      const int np = (cn[k] + 255) >> 8;
      const bool stop = !fnd && (g < np || k == 15);
      if (stop) { e = k; ce = cn[k]; fnd = true; }
      if (!fnd) { g -= np; pre += cn[k]; }
    }
    u.e = e; u.ce = ce; u.rt = g; u.p0 = pre + g * 256; u.pn = idx & 3;
    u.bptr = (const char*)(W + (size_t)e * wstride + (size_t)u.pn * 256 * K);
    u.aptr = gather ? (const char*)Abase : (const char*)(Abase + (size_t)u.p0 * K);
  }
  __device__ __forceinline__ void avoff(const pg8::Unit& u, int tid, int K_, const unsigned (&voffA)[2], unsigned (&v0)[2], unsigned (&v1)[2]) const {
    if (!gather) { v0[0] = voffA[0]; v0[1] = voffA[1]; v1[0] = voffA[0] + 256u * K_; v1[1] = voffA[1] + 256u * K_; return; }
#pragma unroll
    for (int i = 0; i < 2; ++i) {
      int R, C; pg8::stage_rc(tid * 16 + i * 8192, R, C);
      int m0_ = u.rt * 256 + R, m1_ = m0_ + 128; if (m0_ >= u.ce) m0_ = u.ce - 1; if (m1_ >= u.ce) m1_ = u.ce - 1;
      v0[i] = (unsigned)((LIST[u.e * NTOK + m0_] >> 1) * K_ + C) * 2u; v1[i] = (unsigned)((LIST[u.e * NTOK + m1_] >> 1) * K_ + C) * 2u;
    }
  }
};
struct EpiMoe1 {
  static constexpr bool PERM = false, AFTER_DRAIN = false;
  const int* LIST; const float* RS3; bf16_t* ACT;
  __device__ __forceinline__ void operator()(const f32x4 (&acc)[2][2][4][2], const pg8::Unit& u, int wr, int wc, int fr, int fq) const {
    int tok[8]; float rsv[8];
#pragma unroll
    for (int i = 0; i < 8; ++i) {
      const int ml = u.rt * 256 + (i >> 2) * 128 + wr * 64 + (i & 3) * 16 + fr;
      tok[i] = LIST[u.e * NTOK + min(ml, u.ce - 1)] >> 1;
    }
#pragma unroll
    for (int i = 0; i < 8; ++i) rsv[i] = RS3[tok[i]];
#pragma unroll
    for (int ai = 0; ai < 2; ++ai)
#pragma unroll
      for (int m = 0; m < 4; ++m) {
        const int r = ai * 128 + wr * 64 + m * 16 + fr, ml = u.rt * 256 + r;
        if (ml < u.ce) {
          const float rs = rsv[ai * 4 + m];
#pragma unroll
          for (int bj = 0; bj < 2; ++bj) {
            const f32x4 a1 = acc[ai][bj][m][0] * rs, a3 = acc[ai][bj][m][1] * rs; f32x4 r4;
#pragma unroll
            for (int j = 0; j < 4; ++j) r4[j] = siluf_(a1[j]) * a3[j];
            {
              const unsigned long long pk = (unsigned long long)pk2bf(r4[0], r4[1]) | ((unsigned long long)pk2bf(r4[2], r4[3]) << 32);
              __hip_atomic_store((unsigned long long*)(ACT + (size_t)(u.p0 + r) * 512 + (u.pn * 8 + bj * 4 + wc) * 16 + 4 * fq), pk, __ATOMIC_RELAXED, __HIP_MEMORY_SCOPE_AGENT);
            }
          }
        }
      }
  }
};
struct EpiMoe2 {
  static constexpr bool PERM = false, AFTER_DRAIN = false;
  const int* LIST; const float* RTW; bf16_t* Y;
  __device__ __forceinline__ void operator()(const f32x4 (&acc)[2][2][4][2], const pg8::Unit& u, int wr, int wc, int fr, int fq) const {
    int ent[8]; float wv[8];
#pragma unroll
    for (int i = 0; i < 8; ++i) {
      const int ml = u.rt * 256 + (i >> 2) * 128 + wr * 64 + (i & 3) * 16 + fr;
      ent[i] = LIST[u.e * NTOK + min(ml, u.ce - 1)];
    }
#pragma unroll
    for (int i = 0; i < 8; ++i) wv[i] = RTW[ent[i]];
#pragma unroll
    for (int ai = 0; ai < 2; ++ai)
#pragma unroll
      for (int m = 0; m < 4; ++m) {
        const int r = ai * 128 + wr * 64 + m * 16 + fr, ml = u.rt * 256 + r;
        {
          const int entry = ent[ai * 4 + m]; const float w = wv[ai * 4 + m];
#pragma unroll
          for (int bj = 0; bj < 2; ++bj) {
            const f32x4 v0 = acc[ai][bj][m][0] * w, v1 = acc[ai][bj][m][1] * w;
            const auto sx = __builtin_amdgcn_permlane16_swap(pk2bf(v0[0], v0[1]), pk2bf(v1[0], v1[1]), false, false);
            const auto sy = __builtin_amdgcn_permlane16_swap(pk2bf(v0[2], v0[3]), pk2bf(v1[2], v1[3]), false, false);
            u32x4 o; o.x = sx[0]; o.y = sy[0]; o.z = sx[1]; o.w = sy[1];
            if (ml < u.ce) __builtin_nontemporal_store(o, (u32x4*)(Y + (size_t)entry * 1024 + u.pn * 256 + bj * 128 + wc * 32 + (fq & 1) * 16 + (fq >> 1) * 8));
          }
        }
      }
  }
};

constexpr int DEP_STRIDE = 16;
struct MoeUpSched {
  int first, stride, count; MapMoe map; unsigned* DEP; bool wave0;
  __device__ __forceinline__ bool next(int i, pg8::Unit& u) const { const int idx = first + i * stride; if (idx >= count) return false; map(idx, u); return true; }
  __device__ __forceinline__ void avoff(const pg8::Unit& u, int tid, int K, const unsigned (&voffA)[2], unsigned (&v0)[2], unsigned (&v1)[2]) const { map.avoff(u, tid, K, voffA, v0, v1); }
  __device__ __forceinline__ void a_ready(const pg8::Unit&) const {}
  __device__ __forceinline__ void done(const pg8::Unit& u) const {
    asm volatile("s_waitcnt vmcnt(0)" ::: "memory");
    __builtin_amdgcn_s_barrier();
    if (wave0 && __builtin_amdgcn_mbcnt_hi(~0u, __builtin_amdgcn_mbcnt_lo(~0u, 0u)) == 0u) (void)__hip_atomic_fetch_add(&DEP[u.pm * DEP_STRIDE], 1u, __ATOMIC_RELAXED, __HIP_MEMORY_SCOPE_AGENT);
  }
};
struct MoeDownSched {
  int li, L, n1, r, fp, nfirst; MapMoe map; unsigned* DEP; bool wave0;
  __device__ __forceinline__ bool next(int i, pg8::Unit& u) const {
    const int j = (i < nfirst) ? 2 * (li - r) + i : fp + li + (i - nfirst) * L;
    if (j >= n1) return false; map(j, u); return true;
  }
  __device__ __forceinline__ void avoff(const pg8::Unit& u, int tid, int K, const unsigned (&voffA)[2], unsigned (&v0)[2], unsigned (&v1)[2]) const { map.avoff(u, tid, K, voffA, v0, v1); }
  __device__ __forceinline__ void a_ready(const pg8::Unit& u) const {
    if (!wave0) return;
    unsigned sp = 0;
    while (__hip_atomic_load(&DEP[u.pm * DEP_STRIDE], __ATOMIC_RELAXED, __HIP_MEMORY_SCOPE_AGENT) < 4u) { __builtin_amdgcn_s_sleep(2); if (++sp > (1u << 22)) break; }
    asm volatile("" ::: "memory");
  }
  __device__ __forceinline__ void done(const pg8::Unit&) const {}
};

struct MapGate {
  const bf16_t* XB; const bf16_t* WgT; int pm, pn;
  __device__ __forceinline__ void avoff(const pg8::Unit&, int, int K, const unsigned (&voffA)[2], unsigned (&v0)[2], unsigned (&v1)[2]) const { v0[0] = voffA[0]; v0[1] = voffA[1]; v1[0] = voffA[0] + 256u * K; v1[1] = voffA[1] + 256u * K; }
  __device__ __forceinline__ void operator()(int idx, pg8::Unit& u) const {
    u.pm = pm; u.pn = pn; u.e = idx;
    u.aptr = (const char*)(XB + (size_t)pm * 256 * DM); u.bptr = (const char*)(WgT + (size_t)(idx * 1024 + pn * 256) * DM);
  }
};
struct EpiGate {
  static constexpr bool PERM = false, AFTER_DRAIN = false;
  bf16_t* G0; bf16_t* G1; const float* RS1;
  __device__ __forceinline__ void operator()(const f32x4 (&acc)[2][2][4][2], const pg8::Unit& u, int wr, int wc, int fr, int fq) const {
    bf16_t* G = u.e ? G1 : G0;
#pragma unroll
    for (int ai = 0; ai < 2; ++ai)
#pragma unroll
      for (int m = 0; m < 4; ++m) {
        const int row = u.pm * 256 + ai * 128 + wr * 64 + m * 16 + fr; const float rs = RS1[row];
#pragma unroll
        for (int bj = 0; bj < 2; ++bj) {
          u32x2 pk[2];
#pragma unroll
          for (int n = 0; n < 2; ++n) {
            const f32x4 g = acc[ai][bj][m][n] * rs;
            pk[n].x = pk2bf(sigmoidf_(g[0]), sigmoidf_(g[1])); pk[n].y = pk2bf(sigmoidf_(g[2]), sigmoidf_(g[3]));
          }
          const auto sx = __builtin_amdgcn_permlane16_swap(pk[0].x, pk[1].x, false, false);
          const auto sy = __builtin_amdgcn_permlane16_swap(pk[0].y, pk[1].y, false, false);
          u32x4 o; o.x = sx[0]; o.y = sy[0]; o.z = sx[1]; o.w = sy[1];
          *(u32x4*)(G + (size_t)row * 1024 + u.pn * 256 + bj * 128 + wc * 32 + (fq & 1) * 16 + (fq >> 1) * 8) = o;
        }
      }
  }
};

#define XB_TMO      128
#define XB_XCNT(j)  (256  + 64 * (j))
#define XB_XSUB(j)  (1280 + 64 * (j))
#define XB_XGEN(j)  (2304 + 64 * (j))
#define XB_TOP      3328
#define XB_TOPGEN   3392
#define XCD_BAR_WORDS 3456
#define XB_SPIN_CAP (1u << 24)
__device__ __forceinline__ unsigned xb_ld(unsigned* p)              { return __hip_atomic_load(p, __ATOMIC_RELAXED, __HIP_MEMORY_SCOPE_AGENT); }
__device__ __forceinline__ unsigned xb_add(unsigned* p, unsigned v) { return __hip_atomic_fetch_add(p, v, __ATOMIC_RELAXED, __HIP_MEMORY_SCOPE_AGENT); }
__device__ __forceinline__ unsigned xb_xcc_id() { return (unsigned)__builtin_amdgcn_s_getreg((3 << 11) | 20) & 0xFu; }
#define XB_SPIN(cond, bar) do { unsigned _sp = 0; while (cond) { __builtin_amdgcn_s_sleep(1); \
    if ((++_sp & 255u) == 0u) { if (xb_ld(&(bar)[XB_TMO])) break; if (_sp > XB_SPIN_CAP) { atomicAdd(&(bar)[XB_TMO], 1u); break; } } } } while (0)
__device__ __forceinline__ void xcd_barrier_complete(unsigned* bar, unsigned x, unsigned G, unsigned& nloc, unsigned& nx) {
  unsigned sum, cnt, mine, sp = 0u;
  for (;;) {
    sum = 0u; cnt = 0u; mine = 0u;
#pragma unroll
    for (unsigned j = 0; j < 16; ++j) { const unsigned c = xb_ld(&bar[XB_XCNT(j)]); sum += c; cnt += (c > 0u) ? 1u : 0u; mine = (j == x) ? c : mine; }
    if (sum == G) break;
    __builtin_amdgcn_s_sleep(1);
    if ((++sp & 255u) == 0u) { if (xb_ld(&bar[XB_TMO])) break; if (sp > XB_SPIN_CAP) { atomicAdd(&bar[XB_TMO], 1u); break; } }
  }
  nloc = mine > 0u ? mine : 1u; nx = cnt > 0u ? cnt : 1u;
}
__device__ __forceinline__ void xcd_barrier(unsigned* bar, unsigned x, volatile unsigned* st, unsigned G, bool leader_thread) {
  asm volatile("s_waitcnt vmcnt(0)" ::: "memory");
  __syncthreads();
  if (leader_thread) {
    __builtin_amdgcn_s_waitcnt(0);
    unsigned nloc = st[0], nx = st[1];
    if (nloc == 0u) { xcd_barrier_complete(bar, x, G, nloc, nx); st[0] = nloc; st[1] = nx; }
    const unsigned old = xb_add(&bar[XB_XSUB(x)], 1u);
    const unsigned gen = old / nloc;
    if (old + 1u == (gen + 1u) * nloc) {
      __builtin_amdgcn_fence(__ATOMIC_RELEASE, "agent");
      asm volatile("s_waitcnt vmcnt(0)" ::: "memory");
      const unsigned og = xb_add(&bar[XB_TOP], 1u);
      const unsigned tg = og / nx;
      if (og + 1u == (tg + 1u) * nx) xb_add(&bar[XB_TOPGEN], 1u);
      else XB_SPIN(xb_ld(&bar[XB_TOPGEN]) == tg, bar);
      __builtin_amdgcn_fence(__ATOMIC_ACQUIRE, "agent");
      xb_add(&bar[XB_XGEN(x)], 1u);
      asm volatile("s_waitcnt vmcnt(0)" ::: "memory");
    } else {
      XB_SPIN(xb_ld(&bar[XB_XGEN(x)]) == gen, bar);
      __builtin_amdgcn_fence(__ATOMIC_ACQUIRE, "agent");
      asm volatile("s_waitcnt vmcnt(0)" ::: "memory");
    }
  }
  __syncthreads();
}

__device__ __forceinline__ void convert_range(const MegaArgs& a, int lo, int hi, int bid, int nblk, char* lds, int tid) {
  for (int it0 = lo; it0 < hi; it0 += nblk) {
    int it = it0 + bid; if (it >= hi) it = hi - 1;
    int r = it, di = 0;
    while (r >= a.td[di].nitems) { r -= a.td[di].nitems; ++di; }
    transpose_item(a.td[di], r, (float*)lds, tid);
  }
}
#define TILE_IDS unsigned tid_z = 0u; asm volatile("" : "+v"(tid_z)); int tid = (wave_s & 3) * 64 + (int)__builtin_amdgcn_mbcnt_hi(~0u, __builtin_amdgcn_mbcnt_lo(~0u, tid_z)); asm volatile("" : "+v"(tid)); const int half = wave_s >> 2; char* const lds = plds + half * HALF_LDS; const int bid = pbid * 2 + half, nblk = pnblk * 2, li = (pbid >> 3) * 2 + half, nloc = (pnblk >> 3) * 2; const int lane = tid & 63, wid = tid >> 6, wr = wid >> 1, wc = wid & 1, fr = lane & 15, fq = lane >> 4; (void)lane; (void)wid; (void)wr; (void)wc; (void)fr; (void)fq; (void)half; (void)lds; (void)bid; (void)nblk; (void)li; (void)nloc

__global__ void __launch_bounds__(512, 2) k_mega(MegaArgs a) {
  extern __shared__ __attribute__((aligned(16))) char lds_raw[];
  char* const plds = lds_raw;
  cg::grid_group grid = cg::this_grid();
  const int pnblk = gridDim.x, pbid = blockIdx.x;
  const int wave_s = __builtin_amdgcn_readfirstlane((int)(threadIdx.x >> 6));
  unsigned* const xbar = a.BAR + a.li * XCD_BAR_WORDS;
  volatile unsigned* const xst = (volatile unsigned*)(plds + CTRL_OFF);
  volatile int* const xch = (volatile int*)(plds + CTRL_OFF + 16);
  unsigned xcc;
  {
    const bool t0 = (wave_s == 0) && ((int)__builtin_amdgcn_mbcnt_hi(~0u, __builtin_amdgcn_mbcnt_lo(~0u, 0u)) == 0);
    if (t0) { xst[0] = 0u; xst[1] = 0u; }
    xcc = xb_xcc_id();
    if (t0) (void)xb_add(&xbar[XB_XCNT(xcc)], 1u);
    grid.sync();
  }
#define PH(k) (a.ph_lo <= (k) && (k) < a.ph_hi)
  const int xcd = pbid & 7;
#define GRID_BAR() do { const int ld_ = (wave_s == 0) && ((int)__builtin_amdgcn_mbcnt_hi(~0u, __builtin_amdgcn_mbcnt_lo(~0u, 0u)) == 0); xcd_barrier(xbar, xcc, xst, (unsigned)pnblk, ld_); } while (0)
#define SYNC_AFTER(k) do { if (PH(k) && PH((k) + 1)) GRID_BAR(); } while (0)
#pragma unroll 1
  for (int rp_ = PH(0) ? a.rep[0] : 0; rp_ > 0; --rp_) {
    TILE_IDS;
    convert_range(a, a.cv_lo[0], a.cv_hi[0], bid, nblk, lds, tid);
    for (int i = bid * 256 + tid; i < (NIN - DIN_A) * 1024 / 8; i += nblk * 256) ((u32x4*)(a.WinT + (size_t)DIN_A * 1024))[i] = (u32x4){0u, 0u, 0u, 0u};
    rows_to_bf16(a.x, a.XB, a.RS1, NTOK, bid * 4 + wid, nblk * 4, lane);
    rows_to_bf16(a.mem, a.MEMB, a.RSM, NB * MEMT, bid * 4 + wid, nblk * 4, lane);
    for (int o = bid * 4 + wid; o < 256; o += nblk * 4) {
      const int which = o >> 7, u = o & 127; const float* pos = which ? a.posv : a.posk; const float* w1 = which ? a.cvw1 : a.ckw1;
      float sacc = 0.f;
      for (int f = lane; f < 2048; f += 64) sacc += pos[f] * w1[(size_t)f * 128 + u];
      sacc = wave_sum(sacc);
      if (lane == 0) a.POSW[o] = sacc;
    }
  }
  SYNC_AFTER(0);
#pragma unroll 1
  for (int rp_ = PH(1) ? a.rep[1] : 0; rp_ > 0; --rp_) {
    TILE_IDS;
    {
      TILE8_IDS;
      ListSched<MapInProj> S8{pbid >> 3, pnblk >> 3, 112, MapInProj{a.XB, a.WinT, xcd}};
      EpiInProj8 E8{a.QK, a.V, a.O, a.NQ, a.KVC, a.KS, a.KW, a.VST, a.VWT, a.SM, a.RS1};
      pg8::gemm_phase<EpiInProj8, ListSched<MapInProj>, true, true>((PG8_LAS unsigned char*)plds, pg8::Gemm{DM}, S8, E8, t512, wave_s);
    }
    if ((pbid >> 3) >= 16) convert_range(a, a.cv_lo[1], a.cv_hi[1], ((xcd * 16 + (pbid >> 3) - 16) * 2 + half), (pnblk >> 1) * 2, lds, tid);
  }
  SYNC_AFTER(1);
#pragma unroll 1
  for (int rp_ = PH(2) ? a.rep[2] : 0; rp_ > 0; --rp_) {
    TILE_IDS;
    for (int it = bid; it < 128; it += nblk) {
      const int which = it >> 6, m0 = ((it >> 2) & 15) * 128, slab = it & 3;
      f32x4 acc[4][4]; zero_acc(acc);
      {
        int tid2 = tid; asm volatile("" : "+v"(tid2));
        unsigned ao[4], bo[4];
#pragma unroll
        for (int i = 0; i < 4; ++i) {
          const int row = st_row(tid2, i), lc = st_lc(tid2, i);
          const int m = m0 + row, bg = m >> 8, j = m & 255;
          ao[i] = (unsigned)((bg >> 1) * SEQ + 16 * j + slab * 8) * 256u + which * 128 + (bg & 1) * 64 + lc * 8;
          bo[i] = (unsigned)row * 2048u + slab * 512 + lc * 8;
        }
        gemm_core(acc, a.KVC, ao, 256u, which ? a.CV1T : a.CK1T, bo, 64u, 8, lds, tid2);
      }
      float* cp = a.CPART + (size_t)((which * 4 + slab) * 2048 + m0) * 128;
#pragma unroll
      for (int mi = 0; mi < 4; ++mi)
#pragma unroll
        for (int ni = 0; ni < 4; ++ni) *(f32x4*)(cp + (wr * 64 + mi * 16 + fr) * 128 + wc * 64 + ni * 16 + 4 * fq) = acc[mi][ni];
    }
    for (int q = nloc - 1 - li; q < 16; q += nloc) {
      f32x4 acc[4][4]; zero_acc(acc);
      const int tile = xcd * 16 + q; constexpr int T1 = 0, T2n = 16;
        const int t2 = tile - T1; const int m0 = (t2 / T2n) * 128, n0 = (t2 % T2n) * 128;
        if (n0 < 1024) {
          gemm_acc(acc, a.MEMB, DM, (const int*)nullptr, 0, 0, a.WkvT, DM, DM, lds, m0, n0, tid);
#pragma unroll
          for (int mi = 0; mi < 4; ++mi) {
            const int m = m0 + wr * 64 + mi * 16 + fr; const float rs = a.RSM[m];
#pragma unroll
            for (int ni = 0; ni < 4; ++ni) st_bf4(a.KVM + (size_t)m * 1024 + n0 + wc * 64 + ni * 16 + 4 * fq, acc[mi][ni] * rs);
          }
        } else {
          gemm_acc(acc, a.WkvT, DM, (const int*)nullptr, 0, 0, a.MEMB, DM, DM, lds, n0, m0, tid);
          bf16_t* vmt = a.KVM + (size_t)1024 * 1024;
#pragma unroll
          for (int ni = 0; ni < 4; ++ni) {
            const int tok = m0 + wc * 64 + ni * 16 + 4 * fq; const f32x4 rs = *(const f32x4*)(a.RSM + tok);
            const int b = tok >> 8, key = tok & 255;
#pragma unroll
            for (int mi = 0; mi < 4; ++mi) {
              const int col = n0 - 1024 + wr * 64 + mi * 16 + fr;
              st_bf4(vmt + ((size_t)(b * 1024 + col) << 8) + key, acc[mi][ni] * rs);
            }
          }
        }
    }
    for (int lp = pbid >> 3; lp < 32; lp += pnblk >> 3) nsa_win_item(a, ((((((xcd >> 1) & 1) * 2 + half) * 2 + (xcd & 1)) << 6)) | (63 - (2 * lp + (xcd >> 2))), lds, tid);
    {
      volatile int* wqw = (volatile int*)(lds + MEGA_LDS - 32);
      (void)wqw;
      for (;;) {
        if (wave_s == 0 && lane == 0) xch[2] = atomicAdd(a.WQ + 1, 2);
        __syncthreads();
        const int it0 = xch[2];
        __syncthreads();
        if (it0 >= 1024) break;
        ml_dc_item(a, a.ml, it0 + half, lds, tid);
      }
    }
  }
  SYNC_AFTER(2);
#pragma unroll 1
  for (int rp_ = PH(3) ? a.rep[3] : 0; rp_ > 0; --rp_) {
    TILE_IDS;
    if (rp_ == 1) for (int it = bid; it < 272; it += nblk) ml_scan_item(a.ml, it, tid);
    for (int it = nblk - 1 - bid; it < 128; it += nblk) {
      const int which = it >> 6, m0 = (it & 63) * 32;
      float* hid = (float*)lds;
      float* w2s = (float*)(lds + 16640);
      {
        const float* w2 = which ? a.cvw2 : a.ckw2;
#pragma unroll
        for (int c = 0; c < 8; ++c) *(f32x4*)(w2s + (tid + 256 * c) * 4) = *(const f32x4*)(w2 + (tid + 256 * c) * 4);
        const int row = tid >> 3, u0 = (tid & 7) * 16;
        const float* cp = a.CPART + (size_t)(which * 4 * 2048 + m0 + row) * 128 + u0;
#pragma unroll
        for (int c4 = 0; c4 < 4; ++c4) {
          f32x4 hv = *(const f32x4*)(cp + c4 * 4) + *(const f32x4*)(cp + 2048 * 128 + c4 * 4) + *(const f32x4*)(cp + 2 * 2048 * 128 + c4 * 4) + *(const f32x4*)(cp + 3 * 2048 * 128 + c4 * 4)
                   + *(const f32x4*)(a.POSW + which * 128 + u0 + c4 * 4);
#pragma unroll
          for (int j = 0; j < 4; ++j) hid[row * 129 + u0 + c4 * 4 + j] = gelu_tanh(hv[j]);
        }
      }
      __syncthreads();
      {
        const int row = tid >> 3, d0 = (tid & 7) * 8;
        float o[8];
#pragma unroll
        for (int d = 0; d < 8; ++d) o[d] = 0.f;
        for (int u = 0; u < 128; ++u) {
          const float hv = hid[row * 129 + u]; const f32x4 w0 = *(const f32x4*)(w2s + u * 64 + d0), w1 = *(const f32x4*)(w2s + u * 64 + d0 + 4);
          o[0] += hv * w0[0]; o[1] += hv * w0[1]; o[2] += hv * w0[2]; o[3] += hv * w0[3]; o[4] += hv * w1[0]; o[5] += hv * w1[1]; o[6] += hv * w1[2]; o[7] += hv * w1[3];
        }
        const int m = m0 + row, bg = m >> 8, j = m & 255;
        if (which == 0) {
#pragma unroll
          for (int d = 0; d < 8; ++d) a.KC[(size_t)m * 64 + d0 + d] = (j == 255) ? (bf16_t)0 : f2bf(o[d]);
        } else {
#pragma unroll
          for (int d = 0; d < 8; ++d) a.VCT[((size_t)(bg * 64 + d0 + d) << 8) + j] = (j == 255) ? (bf16_t)0 : f2bf(o[d]);
        }
      }
      __syncthreads();
    }
  }
  SYNC_AFTER(3);
#pragma unroll 1
  for (int rp_ = PH(4) ? a.rep[4] : 0; rp_ > 0; --rp_) {
    for (int lp = pbid >> 3; lp < 32; lp += pnblk >> 3) { TILE_IDS; nsa_main_item(a, ((((((xcd >> 1) & 1) * 2 + half) * 2 + (xcd & 1)) << 6)) | (63 - (2 * lp + (xcd >> 2))), lds, tid, xch, half); }
    { TILE_IDS;
      volatile int* wqw = (volatile int*)(lds + MEGA_LDS - 32);
      (void)wqw;
      for (;;) {
        if (wave_s == 0 && lane == 0) xch[2] = atomicAdd(a.WQ, 2);
        __syncthreads();
        const int it0 = xch[2];
        __syncthreads();
        if (it0 >= 1024) break;
        ml_out_item(a, a.ml, it0 + half, lds, tid);
      } }
  }
  SYNC_AFTER(4);
#pragma unroll 1
  for (int rp_ = PH(5) ? a.rep[5] : 0; rp_ > 0; --rp_) {
    bf16_t* const G1 = (bf16_t*)((char*)a.out + 32 * MiB);
    const int xcd = pbid & 7;
    for (int lp = pbid >> 3; lp < 32; lp += pnblk >> 3) {
      const int pm = xcd * 8 + (lp & 7), pn = lp >> 3;
      {
        TILE8_IDS;
        ListSched<MapGate> S8{0, 1, 2, MapGate{a.XB, a.WgT, pm, pn}}; EpiGate E8{a.MRG, G1, a.RS1};
        pg8::gemm_phase<EpiGate, ListSched<MapGate>, false, true>((PG8_LAS unsigned char*)plds, pg8::Gemm{DM}, S8, E8, t512, wave_s);
      }
      asm volatile("s_waitcnt vmcnt(0)" ::: "memory");
      __threadfence_block();
      __syncthreads();
      TILE_IDS;
#pragma unroll 1
      for (int tt = 0; tt < 2; ++tt) {
        const int m0 = pm * 256 + half * 128, n0 = pn * 256 + tt * 128;
        f32x4 acc[4][4]; u32x2 rp[4][4];
#pragma unroll 1
        for (int br = 0; br < 2; ++br) {
          zero_acc(acc);
          gemm_acc(acc, br ? a.ANS : a.AML, 512, (const int*)nullptr, 0, 0, br ? a.WnsT : a.WmlT, 512, 512, lds, m0, n0, tid);
          const bf16_t* G = br ? G1 : a.MRG;
#pragma unroll
          for (int mi = 0; mi < 4; ++mi) {
            const int m = m0 + wr * 64 + mi * 16 + fr;
#pragma unroll
            for (int ni = 0; ni < 4; ++ni) {
              const u32x2 gv = *(const u32x2*)(G + (size_t)m * 1024 + n0 + wc * 64 + ni * 16 + 4 * fq);
              f32x4 g; g[0] = __uint_as_float(gv.x << 16); g[1] = __uint_as_float(gv.x & 0xffff0000u); g[2] = __uint_as_float(gv.y << 16); g[3] = __uint_as_float(gv.y & 0xffff0000u);
              f32x4 r = g * acc[mi][ni];
              if (br == 1) { r[0] += __uint_as_float(rp[mi][ni].x << 16); r[1] += __uint_as_float(rp[mi][ni].x & 0xffff0000u);
                             r[2] += __uint_as_float(rp[mi][ni].y << 16); r[3] += __uint_as_float(rp[mi][ni].y & 0xffff0000u); }
              rp[mi][ni].x = pk2bf(r[0], r[1]); rp[mi][ni].y = pk2bf(r[2], r[3]);
            }
          }
        }
#pragma unroll
        for (int mi = 0; mi < 4; ++mi) {
          const int m = m0 + wr * 64 + mi * 16 + fr;
#pragma unroll
          for (int ni = 0; ni < 4; ++ni) *(u32x2*)(a.MRG + (size_t)m * 1024 + n0 + wc * 64 + ni * 16 + 4 * fq) = rp[mi][ni];
        }
      }
    }
    { TILE_IDS; convert_range(a, a.cv_lo[5], a.cv_hi[5], bid, nblk, lds, tid); }
  }
  SYNC_AFTER(5);
#pragma unroll 1
  for (int rp_ = PH(6) ? a.rep[6] : 0; rp_ > 0; --rp_) {
    TILE_IDS;
    {
      TILE8_IDS;
      ListSched<MapMN> S8{pbid >> 3, pnblk >> 3, 32, MapMN{a.MRG, a.WoutT, DM, xcd}};
      EpiX1 E8{a.XB, a.X1B, a.PS2};
      pg8::gemm_phase<decltype(E8), ListSched<MapMN>, false, true>((PG8_LAS unsigned char*)plds, pg8::Gemm{DM}, S8, E8, t512, wave_s);
    }
    convert_range(a, a.cv_lo[6], a.cv_hi[6], bid, nblk, lds, tid);
  }
  SYNC_AFTER(6);
#pragma unroll 1
  for (int rp_ = PH(7) ? a.rep[7] : 0; rp_ > 0; --rp_) {
    TILE_IDS;
    {
      TILE8_IDS;
      for (int idx = pbid >> 3; idx < 32; idx += pnblk >> 3) {
        __syncthreads();
        if (t512 < 256) {
          const f32x4* pp = (const f32x4*)(a.PS2 + (size_t)((xcd * 8 + (idx & 7)) * 256 + t512) * 32);
          float ss = 0.f;
#pragma unroll
          for (int c = 0; c < 8; ++c) { const f32x4 p = pp[c]; ss += (p[0] + p[1]) + (p[2] + p[3]); }
          ((float*)(plds + 131072))[t512] = rsqrtf(ss * (1.f / DM) + EPS);
        }
        __syncthreads();
        ListSched<MapMN> S8{idx, 1 << 20, 32, MapMN{a.X1B, a.WqT, DM, xcd}};
        EpiXQ E8{a.XQ, (const PG8_LAS float*)(plds + 131072)};
        pg8::gemm_phase<decltype(E8), ListSched<MapMN>, false, true>((PG8_LAS unsigned char*)plds, pg8::Gemm{DM}, S8, E8, t512, wave_s);
      }
    }
    convert_range(a, a.cv_lo[7], a.cv_hi[7], bid, nblk, lds, tid);
  }
  SYNC_AFTER(7);
#pragma unroll 1
  for (int rp_ = PH(8) ? a.rep[8] : 0; rp_ > 0; --rp_) {
    TILE_IDS;
    float* RMX = (float*)lds; float* RSUM = (float*)(lds + 1024);
    for (int q = li; q < 64; q += nloc) {
      const int m0 = (xcd * 16 + (q >> 2)) * 128, hh = q & 3, b = m0 >> 12;
      bf16_t* Qh = a.XQ + hh * 256;
      const bf16_t* Kh = a.KVM + (size_t)(b * 256) * 1024 + hh * 256;
      const bf16_t* Vh = a.KVM + (size_t)1024 * 1024 + ((size_t)(b * 1024 + hh * 256) << 8);
      f32x4 acc0[4][4], acc1[4][4]; zero_acc(acc0); zero_acc(acc1);
      gemm_acc(acc0, Qh, 1024, (const int*)nullptr, 0, 0, Kh, 1024, 256, lds, m0, 0, tid);
      gemm_acc(acc1, Qh, 1024, (const int*)nullptr, 0, 0, Kh, 1024, 256, lds, m0, 128, tid);
      float mloc[4];
#pragma unroll
      for (int mi = 0; mi < 4; ++mi) {
        float mx = -INFINITY;
#pragma unroll
        for (int ni = 0; ni < 4; ++ni)
#pragma unroll
          for (int j = 0; j < 4; ++j) mx = fmaxf(mx, fmaxf(acc0[mi][ni][j], acc1[mi][ni][j]));
        mx = max4(mx); mloc[mi] = mx;
        if (fq == 0) RMX[(wr * 64 + mi * 16 + fr) * 2 + wc] = mx;
      }
      __syncthreads();
#pragma unroll
      for (int mi = 0; mi < 4; ++mi) {
        const int r = wr * 64 + mi * 16 + fr;
        const float m = fmaxf(RMX[r * 2], RMX[r * 2 + 1]); float ls = 0.f;
#pragma unroll
        for (int ni = 0; ni < 4; ++ni)
#pragma unroll
          for (int j = 0; j < 4; ++j) {
            acc0[mi][ni][j] = __expf((acc0[mi][ni][j] - m) * 0.0625f); acc1[mi][ni][j] = __expf((acc1[mi][ni][j] - m) * 0.0625f);
            ls += acc0[mi][ni][j] + acc1[mi][ni][j];
          }
        ls = red4(ls);
        if (fq == 0) RSUM[r * 2 + wc] = ls;
      }
      __syncthreads();
#pragma unroll
      for (int mi = 0; mi < 4; ++mi) {
        const int r = wr * 64 + mi * 16 + fr;
        const float inv = 1.f / (RSUM[r * 2] + RSUM[r * 2 + 1]);
        bf16_t* pr = Qh + (size_t)(m0 + r) * 1024 + wc * 64 + 4 * fq;
#pragma unroll
        for (int ni = 0; ni < 4; ++ni) { st_bf4(pr + ni * 16, acc0[mi][ni] * inv); st_bf4(pr + 128 + ni * 16, acc1[mi][ni] * inv); }
      }
      asm volatile("s_waitcnt vmcnt(0)" ::: "memory");
      __threadfence_block();
      __syncthreads();
#pragma unroll 1
      for (int dh = 0; dh < 2; ++dh) {
        zero_acc(acc0);
        gemm_acc(acc0, Qh, 1024, (const int*)nullptr, 0, 0, Vh, 256, 256, lds, m0, dh * 128, tid);
#pragma unroll
        for (int mi = 0; mi < 4; ++mi) {
          const int r = wr * 64 + mi * 16 + fr;
#pragma unroll
          for (int ni = 0; ni < 4; ++ni) st_bf4(a.XO + (size_t)(m0 + r) * 1024 + hh * 256 + dh * 128 + wc * 64 + ni * 16 + 4 * fq, acc0[mi][ni]);
        }
      }
    }
    convert_range(a, a.cv_lo[8], a.cv_hi[8], bid, nblk, lds, tid);
  }
  SYNC_AFTER(8);
#pragma unroll 1
  for (int rp_ = PH(9) ? a.rep[9] : 0; rp_ > 0; --rp_) {
    TILE_IDS;
    {
      TILE8_IDS;
      ListSched<MapMN> S8{pbid >> 3, pnblk >> 3, 32, MapMN{a.XO, a.WoT, DM, xcd}};
      EpiX2 E8{a.X1B};
      pg8::gemm_phase<decltype(E8), ListSched<MapMN>, false, true>((PG8_LAS unsigned char*)plds, pg8::Gemm{DM}, S8, E8, t512, wave_s);
    }
    convert_range(a, a.cv_lo[9], a.cv_hi[9], bid, nblk, lds, tid);
  }
  SYNC_AFTER(9);
#pragma unroll 1
  for (int rp_ = PH(10) ? a.rep[10] : 0; rp_ > 0; --rp_) {
    TILE_IDS;
    const int tpb = NTOK / nblk;
    int* ex_l = (int*)(lds + 65536);
    float* we_l = (float*)lds;
    for (int c = tid; c < 4096; c += 256) { const int k = c >> 2, q = c & 3; *(f32x4*)(we_l + (q * 1024 + k) * 4) = *(const f32x4*)(a.we + k * 16 + q * 4); }
    __syncthreads();
    for (int k = 0; k < tpb / 4; ++k) {
      const int tl = wid * (tpb / 4) + k, n = bid * tpb + tl;
      int lane = tid & 63; asm volatile("" : "+v"(lane));
      const bf16_t* xr = a.H3 + (size_t)n * DM;
      float v[16]; float s = 0.f;
#pragma unroll
      for (int i = 0; i < 16; ++i) { v[i] = bf2f(xr[lane + 64 * i]); s += v[i] * v[i]; }
      s = wave_sum(s);
      const float rs = rsqrtf(s * (1.f / DM) + EPS);
      float lg[20];
#pragma unroll
      for (int e = 0; e < 20; ++e) lg[e] = 0.f;
#pragma unroll
      for (int i = 0; i < 16; ++i) {
        const int k2 = lane + 64 * i; const float hk = v[i] * rs * a.g_ffn[k2];
        const f32x4 wgv = *(const f32x4*)(a.wg + k2 * 4);
#pragma unroll
        for (int e = 0; e < 4; ++e) lg[e] += hk * wgv[e];
#pragma unroll
        for (int q = 0; q < 4; ++q) { const f32x4 wv = *(const f32x4*)(we_l + (q * 1024 + k2) * 4);
#pragma unroll
          for (int e = 0; e < 4; ++e) lg[4 + q * 4 + e] += hk * wv[e]; }
      }
#pragma unroll
      for (int e = 0; e < 20; ++e) lg[e] = wave_sum(lg[e]);
      if (lane == 0) {
        float gl[4]; float gm = -INFINITY; int gi = 0;
#pragma unroll
        for (int e = 0; e < 4; ++e) { gl[e] = lg[e] + a.bg[e]; if (gl[e] > gm) { gm = gl[e]; gi = e; } }
        float gs = 0.f;
#pragma unroll
        for (int e = 0; e < 4; ++e) gs += __expf(gl[e] - gm);
        const float gval = 1.f / gs;
        float el[4] = {0.f, 0.f, 0.f, 0.f};
#pragma unroll
        for (int gg = 0; gg < 4; ++gg) if (gi == gg) {
#pragma unroll
          for (int e = 0; e < 4; ++e) el[e] = lg[4 + gg * 4 + e] + a.be[gg * 4 + e];
        }
        int i0 = 0; float v0 = el[0];
#pragma unroll
        for (int e = 1; e < 4; ++e) if (el[e] > v0) { v0 = el[e]; i0 = e; }
        int i1 = -1; float v1 = -INFINITY;
#pragma unroll
        for (int e = 0; e < 4; ++e) if (e != i0 && el[e] > v1) { v1 = el[e]; i1 = e; }
        const float e1 = __expf(v1 - v0);
        ex_l[tl * 2] = gi * 4 + i0; ex_l[tl * 2 + 1] = gi * 4 + i1;
        a.RTW[n * 2] = gval / (1.f + e1); a.RTW[n * 2 + 1] = gval * e1 / (1.f + e1);
        a.RS3[n] = rs;
      }
    }
    __syncthreads();
    if (tid < 16) {
      int cnt = 0;
      for (int j = 0; j < 2 * tpb; ++j) cnt += (ex_l[j] == tid) ? 1 : 0;
      if (cnt > 0) {
        int pos = atomicAdd(&a.CNT[tid], cnt);
        for (int j = 0; j < 2 * tpb; ++j) if (ex_l[j] == tid) a.LIST[tid * NTOK + pos++] = (bid * tpb) * 2 + j;
      }
    }
    __syncthreads();
  }
  SYNC_AFTER(10);
#pragma unroll 1
  for (int rp_ = PH(11) ? a.rep[11] : 0; rp_ > 0; --rp_) {
    TILE8_IDS;
    int rtot = 0;
    for (int e = 0; e < 16; ++e) rtot += (a.CNT[e] + 255) >> 8;
    const int n1 = ((rtot - xcd + 7) >> 3) * 4;
    const int li8 = pbid >> 3, L8 = pnblk >> 3;
    unsigned* const DEP = (unsigned*)a.CNT + 1024;
    {
      MoeUpSched S8{li8, L8, n1, MapMoe{a.CNT, a.LIST, a.H3, a.W13T, (size_t)1024 * 1024, DM, xcd, 1}, DEP, wave_s == 0};
      EpiMoe1 E8{a.LIST, a.RS3, a.ACT};
      pg8::gemm_phase<EpiMoe1, MoeUpSched, true, true>((PG8_LAS unsigned char*)plds, pg8::Gemm{DM}, S8, E8, t512, wave_s);
    }
    {
      const int r = n1 % L8, fp = r ? min(n1, 2 * (L8 - r)) : 0;
      const int nfirst = (r && li8 >= r) ? max(0, min(2, n1 - 2 * (li8 - r))) : 0;
      MoeDownSched S8{li8, L8, n1, r, fp, nfirst, MapMoe{a.CNT, a.LIST, a.ACT, a.W2T, (size_t)1024 * 512, 512, xcd, 0}, DEP, wave_s == 0};
      EpiMoe2 E8{a.LIST, a.RTW, a.Y};
      { pg8::Unit u0; if (S8.next(0, u0)) S8.a_ready(u0); }
      __syncthreads();
      pg8::gemm_phase<EpiMoe2, MoeDownSched, true, true, true>((PG8_LAS unsigned char*)plds, pg8::Gemm{512}, S8, E8, t512, wave_s);
    }
  }
  if (PH(11) && PH(13)) GRID_BAR();
#pragma unroll 1
  for (int rp_ = PH(13) ? a.rep[13] : 0; rp_ > 0; --rp_) {
    TILE_IDS;
    for (int row = bid * 4 + wid; row < NTOK; row += nblk * 4) {
      f32x4* xr = (f32x4*)(a.out + (size_t)row * DM) + lane;
      const u32x2* x2r = (const u32x2*)(a.H3 + (size_t)row * DM) + lane;
      const u32x2* y0 = (const u32x2*)(a.Y + (size_t)(row * 2) * DM) + lane; const u32x2* y1 = y0 + DM / 4;
      f32x4 v[4]; float s = 0.f;
#pragma unroll
      for (int j = 0; j < 4; ++j) {
        { const u32x2 xx = x2r[64 * j]; v[j][0] = __uint_as_float(xx.x << 16); v[j][1] = __uint_as_float(xx.x & 0xffff0000u); v[j][2] = __uint_as_float(xx.y << 16); v[j][3] = __uint_as_float(xx.y & 0xffff0000u); }
        const u32x2 p = y0[64 * j], q = y1[64 * j];
        v[j][0] += __uint_as_float(p.x << 16) + __uint_as_float(q.x << 16); v[j][1] += __uint_as_float(p.x & 0xffff0000u) + __uint_as_float(q.x & 0xffff0000u);
        v[j][2] += __uint_as_float(p.y << 16) + __uint_as_float(q.y << 16); v[j][3] += __uint_as_float(p.y & 0xffff0000u) + __uint_as_float(q.y & 0xffff0000u);
        s += v[j][0] * v[j][0] + v[j][1] * v[j][1] + v[j][2] * v[j][2] + v[j][3] * v[j][3];
      }
      s = wave_sum(s);
      const float rs = rsqrtf(s * (1.f / DM) + EPS);
#pragma unroll
      for (int j = 0; j < 4; ++j) xr[64 * j] = v[j] * rs * ((const f32x4*)a.g_final)[lane + 64 * j];
    }
  }
}

extern "C" void kernel_launch(void* const* d_in, const int* in_sizes, int n_in, void* d_out, int out_size, void* d_ws, size_t ws_size, hipStream_t stream) {
  const float* x = (const float*)d_in[0];
  const float* mem = (const float*)d_in[1];
  const float* norm_mix = (const float*)d_in[2];
  const float* w_in = (const float*)d_in[3];
  const float* conv_qk = (const float*)d_in[4];
  const float* b_igate = (const float*)d_in[5];
  const float* b_fgate = (const float*)d_in[6];
  const float* mlstm_norm = (const float*)d_in[7];
  const float* cmp_pos_k = (const float*)d_in[8];
  const float* cmp_pos_v = (const float*)d_in[9];
  const float* cmp_k_w1 = (const float*)d_in[10];
  const float* cmp_k_w2 = (const float*)d_in[11];
  const float* cmp_v_w1 = (const float*)d_in[12];
  const float* cmp_v_w2 = (const float*)d_in[13];
  const float* w_br_mlstm = (const float*)d_in[14];
  const float* w_br_nsa = (const float*)d_in[15];
  const float* w_mix_out = (const float*)d_in[16];
  const float* norm_xattn = (const float*)d_in[17];
  const float* norm_mem = (const float*)d_in[18];
  const float* xa_wq = (const float*)d_in[19];
  const float* xa_wkv = (const float*)d_in[20];
  const float* xa_wo = (const float*)d_in[21];
  const float* norm_ffn = (const float*)d_in[22];
  const float* router_group_w = (const float*)d_in[23];
  const float* router_group_b = (const float*)d_in[24];
  const float* router_expert_w = (const float*)d_in[25];
  const float* router_expert_b = (const float*)d_in[26];
  const float* moe_w1 = (const float*)d_in[27];
  const float* moe_w3 = (const float*)d_in[28];
  const float* moe_w2 = (const float*)d_in[29];
  const float* norm_final = (const float*)d_in[30];
  float* out = (float*)d_out;
  char* ws = (char*)d_ws;

  int* CNT = (int*)(ws + WS_CNT); int* LIST = (int*)(ws + WS_LIST); float* RTW = (float*)(ws + WS_RTW);
  float* SM = (float*)(ws + WS_SM); float* BCUM = (float*)(ws + WS_BCUM); float* IP = (float*)(ws + WS_IP);
  float* BL = (float*)(ws + WS_BL); float* MX = (float*)(ws + WS_MX); float* MST = (float*)(ws + WS_MST); float* NST = (float*)(ws + WS_NST);
  bf16_t* KC = (bf16_t*)(ws + WS_KC); bf16_t* VC = (bf16_t*)(ws + WS_VC);
  bf16_t* QK = (bf16_t*)(ws + WS_QK); bf16_t* V = (bf16_t*)(ws + WS_V); bf16_t* O = (bf16_t*)(ws + WS_O);
  bf16_t* NQ = (bf16_t*)(ws + WS_NQ); bf16_t* KV = (bf16_t*)(ws + WS_KV); bf16_t* CST = (bf16_t*)(ws + WS_CST);
  bf16_t* AML = (bf16_t*)(ws + WS_AML); bf16_t* ANS = (bf16_t*)(ws + WS_ANS); bf16_t* MRG = (bf16_t*)(ws + WS_MRG);
  bf16_t* KVM = (bf16_t*)(ws + WS_KVM); bf16_t* MEMN = (bf16_t*)(ws + WS_MEMN);
  bf16_t* H2 = (bf16_t*)(ws + WS_H2); bf16_t* XQ = (bf16_t*)(ws + WS_XQ); bf16_t* XO = (bf16_t*)(ws + WS_XO);
  bf16_t* H3 = H2; bf16_t* ACT = XQ; bf16_t* Y = (bf16_t*)(ws + 136 * MiB);
  bf16_t* H = (bf16_t*)d_out;
  bf16_t* T2 = (bf16_t*)((char*)d_out + 32 * MiB);

  (void)hipMemsetAsync(ws, 0, 131072, stream);
  static int grid_blocks = 0;
  if (!grid_blocks) {
    int dev = 0, cus = 0, per_cu = 0;
    (void)hipGetDevice(&dev);
    (void)hipDeviceGetAttribute(&cus, hipDeviceAttributeMultiprocessorCount, dev);
    (void)hipFuncSetAttribute((const void*)k_mega, hipFuncAttributeMaxDynamicSharedMemorySize, TOTAL_LDS);
    (void)hipOccupancyMaxActiveBlocksPerMultiprocessor(&per_cu, (const void*)k_mega, 512, TOTAL_LDS);
    if (per_cu > 1) per_cu = 1;
    if (per_cu < 1) per_cu = 1;
    grid_blocks = cus * per_cu;
  }
  MegaArgs fa{};
  fa.x = x; fa.mem = mem; fa.out = out; fa.BAR = (unsigned*)(ws + 65536);
  fa.ml.conv = conv_qk; fa.ml.b_i = b_igate; fa.ml.b_f = b_fgate; fa.ml.gain = mlstm_norm;
  fa.ml.BCUM = BCUM; fa.ml.IP = IP; fa.ml.BL = BL; fa.ml.MX = MX; fa.ml.MST = MST; fa.ml.NST = NST; fa.ml.CST = CST;
  fa.XB = (bf16_t*)d_out; fa.MEMB = (bf16_t*)(ws + WS_MEMB); fa.RS1 = (float*)(ws + WS_RS1); fa.RSM = (float*)(ws + WS_RSM); fa.PS2 = (float*)(ws + WS_PS2);
  fa.QK = QK; fa.V = V; fa.O = O; fa.NQ = NQ; fa.SM = SM;
  fa.KVC = (bf16_t*)(ws + WS_KVC); fa.KS = (bf16_t*)(ws + WS_KS); fa.KW = (bf16_t*)(ws + WS_KW); fa.VST = (bf16_t*)(ws + WS_VST); fa.VWT = (bf16_t*)(ws + WS_VWT);
  fa.KC = KC; fa.VCT = VC; fa.CK1T = (bf16_t*)(ws + WS_CK1T); fa.CV1T = (bf16_t*)(ws + WS_CV1T); fa.POSW = (float*)(ws + WS_POSW);
  fa.posk = cmp_pos_k; fa.posv = cmp_pos_v; fa.ckw1 = cmp_k_w1; fa.cvw1 = cmp_v_w1; fa.ckw2 = cmp_k_w2; fa.cvw2 = cmp_v_w2;
  fa.AML = AML; fa.ANS = ANS; fa.MRG = MRG; fa.X1B = H2; fa.XQ = XQ; fa.XO = XO; fa.KVM = KVM;
  fa.WinT = (bf16_t*)(ws + WS_WIN_T); fa.WgT = (bf16_t*)(ws + WS_WG_T); fa.WmlT = (bf16_t*)(ws + WS_WML_T); fa.WnsT = (bf16_t*)(ws + WS_WNS_T);
  fa.H3 = H3; fa.ACT = ACT; fa.Y = Y; fa.W13T = (bf16_t*)(ws + 104 * MiB); fa.W2T = (bf16_t*)(ws + 240 * MiB);
  fa.CPART = (float*)(ws + 176 * MiB); fa.WQ = (int*)(ws + 256);
  fa.RS3 = (float*)(ws + WS_RSM + 8192); fa.RTW = RTW; fa.CNT = CNT; fa.LIST = LIST;
  fa.g_ffn = norm_ffn; fa.wg = router_group_w; fa.bg = router_group_b; fa.we = router_expert_w; fa.be = router_expert_b; fa.g_final = norm_final;
  fa.WoutT = (bf16_t*)(ws + WS_WOUT_T); fa.WqT = (bf16_t*)(ws + WS_WQ_T); fa.WkvT = (bf16_t*)(ws + WS_WKV_T); fa.WoT = (bf16_t*)(ws + WS_WO_T);
  {
    auto mk = [&](const float* src, bf16_t* dst, const float* gain, int ldw, int K, int c0, int ncols, int drow0) {
      TDesc d{}; d.src = src; d.dst = dst; d.gain = gain; d.ldw = ldw; d.K = K; d.c0 = c0; d.ncols = ncols; d.drow0 = drow0; d.per = (K / 64) * ((ncols + 63) / 64); d.nitems = d.per; d.mode = 0; d.rofs = 0; d.sstride = 0; d.dstride = 0; d.pad = 0; return d; };
    int n = 0;
    fa.td[n++] = mk(w_in, fa.WinT, norm_mix, DIN, DM, 0, 2048, 0);
    fa.td[n++] = mk(w_in, fa.WinT, norm_mix, DIN, DM, 2056, 512, 2048);
    fa.td[n++] = mk(w_in, fa.WinT, norm_mix, DIN, DM, 2568, 384, 2560);
    fa.td[n++] = mk(w_in, fa.WinT, norm_mix, DIN, DM, 3080, 128, 2944);
    fa.td[n++] = mk(w_in, fa.WinT, norm_mix, DIN, DM, 2952, 128, 3072);
    fa.td[n++] = mk(w_in, fa.WinT, norm_mix, DIN, DM, 3208, 128, 3200);
    fa.td[n++] = mk(w_in, fa.WinT, norm_mix, DIN, DM, 2048, 8, 3328);
    fa.td[n++] = mk(w_in, fa.WinT, norm_mix, DIN, DM, 3336, 24, 3336);
    fa.td[n++] = mk(w_in, fa.WgT, norm_mix, DIN, DM, 3360, 2048, 0);
    fa.td[n++] = mk(w_br_mlstm, fa.WmlT, nullptr, 1024, 512, 0, 1024, 0);
    fa.td[n++] = mk(w_br_nsa, fa.WnsT, nullptr, 1024, 512, 0, 1024, 0);
    fa.td[n++] = mk(w_mix_out, fa.WoutT, nullptr, 1024, 1024, 0, 1024, 0);
    fa.td[n++] = mk(xa_wq, fa.WqT, norm_xattn, 1024, 1024, 0, 1024, 0);
    fa.td[n++] = mk(xa_wkv, fa.WkvT, norm_mem, 2048, 1024, 0, 2048, 0);
    fa.td[n++] = mk(xa_wo, fa.WoT, nullptr, 1024, 1024, 0, 1024, 0);
    fa.td[n++] = mk(cmp_k_w1, fa.CK1T, nullptr, 128, 2048, 0, 128, 0);
    fa.td[n++] = mk(cmp_v_w1, fa.CV1T, nullptr, 128, 2048, 0, 128, 0);
    fa.ntdA = n;
    { TDesc d = mk(moe_w1, fa.W13T, norm_ffn, 512, 1024, 0, 512, 0); d.mode = 2; d.rofs = 0; d.nitems = 16 * d.per; d.sstride = 1024 * 512; d.dstride = 1024 * 1024; fa.td[n++] = d; }
    { TDesc d = mk(moe_w3, fa.W13T, norm_ffn, 512, 1024, 0, 512, 0); d.mode = 2; d.rofs = 16; d.nitems = 16 * d.per; d.sstride = 1024 * 512; d.dstride = 1024 * 1024; fa.td[n++] = d; }
    { TDesc d = mk(moe_w2, fa.W2T, nullptr, 1024, 512, 0, 1024, 0); d.nitems = 16 * d.per; d.sstride = 512 * 1024; d.dstride = 1024 * 512; fa.td[n++] = d; }
    fa.ntdB = n;
    int cum[25]; cum[0] = 0; for (int i = 0; i < n; ++i) cum[i + 1] = cum[i] + fa.td[i].nitems;
    for (int k = 0; k < 16; ++k) { fa.cv_lo[k] = 0; fa.cv_hi[k] = 0; }
    fa.cv_lo[0] = 0; fa.cv_hi[0] = cum[8];
    fa.cv_lo[1] = cum[8]; fa.cv_hi[1] = cum[fa.ntdA];
    { const int lo = cum[fa.ntdA], tot = cum[n] - lo; const int phs[5] = {5, 6, 7, 8, 9};
      for (int i = 0; i < 5; ++i) { fa.cv_lo[phs[i]] = lo + (int)((long long)tot * i / 5); fa.cv_hi[phs[i]] = lo + (int)((long long)tot * (i + 1) / 5); } }
  }
  int launch_i = 0;
  auto mega = [&](int lo, int hi) {
    fa.ph_lo = lo; fa.ph_hi = hi; fa.li = launch_i++; fa.pad = 0;
    for (int k = 0; k < 16; ++k) fa.rep[k] = 1;

    void* args[] = {&fa};
    (void)hipLaunchCooperativeKernel((const void*)k_mega, dim3(grid_blocks), dim3(512), args, TOTAL_LDS, stream);
  };
  mega(0, 14);
}
```

```cpp
#include <hip/hip_runtime.h>
#include <stdint.h>

typedef unsigned short bf16_t;
__device__ __forceinline__ float bf2f(bf16_t v) { return __uint_as_float(((unsigned)v) << 16); }
__device__ __forceinline__ bf16_t f2bf(float f) { unsigned u = __float_as_uint(f); return (bf16_t)((u + 0x7fffu + ((u >> 16) & 1u)) >> 16); }

constexpr int NB = 4, SEQ = 4096, NTOK = NB * SEQ, DM = 1024;
constexpr int DIN = 5408, DIN_A = 3360;
constexpr int MEMT = 256;
constexpr float EPS = 1e-6f;
constexpr size_t MiB = 1u << 20;

constexpr size_t WS_CNT = 0;
constexpr size_t WS_LIST = 1 * MiB;
constexpr size_t WS_RTW = 2 * MiB;
constexpr size_t WS_SM = 3 * MiB;
constexpr size_t WS_BCUM = 5 * MiB;
constexpr size_t WS_IP = 5 * MiB + 256 * 1024;
constexpr size_t WS_BL = 5 * MiB + 512 * 1024;
constexpr size_t WS_MX = WS_BL + 4096;
constexpr size_t WS_MST = WS_MX + 4096;
constexpr size_t WS_NST = 6 * MiB;
constexpr size_t WS_KC = 7 * MiB;
constexpr size_t WS_VC = 7 * MiB + 512 * 1024;
constexpr size_t WS_QK = 8 * MiB;
constexpr size_t WS_V = 40 * MiB;
constexpr size_t WS_O = 56 * MiB;
constexpr size_t WS_NQ = 72 * MiB;
constexpr size_t WS_KV = 88 * MiB;
constexpr size_t WS_CST = 112 * MiB;
constexpr size_t WS_AML = 144 * MiB;
constexpr size_t WS_ANS = 160 * MiB;
constexpr size_t WS_MRG = 176 * MiB;
constexpr size_t WS_KVM = 233 * MiB;
constexpr size_t WS_MEMN = 237 * MiB;
constexpr size_t WS_H2 = 8 * MiB;
constexpr size_t WS_XQ = 40 * MiB;
constexpr size_t WS_XO = 72 * MiB;
constexpr size_t WS_Y = 72 * MiB;

__device__ __forceinline__ float wave_sum(float v) {
#pragma unroll
  for (int o = 32; o > 0; o >>= 1) v += __shfl_xor(v, o);
  return v;
}
__device__ __forceinline__ float wave_max(float v) {
#pragma unroll
  for (int o = 32; o > 0; o >>= 1) v = fmaxf(v, __shfl_xor(v, o));
  return v;
}
__device__ __forceinline__ float sigmoidf_(float x) { return 1.f / (1.f + __expf(-x)); }
__device__ __forceinline__ float siluf_(float x) { return x / (1.f + __expf(-x)); }
__device__ __forceinline__ float logsigmoidf_(float x) { return fminf(x, 0.f) - log1pf(__expf(-fabsf(x))); }
__device__ __forceinline__ float gelu_tanh(float x) { float u = 0.7978845608028654f * (x + 0.044715f * x * x * x); return 0.5f * x * (1.f + tanhf(u)); }

#include <hip/hip_cooperative_groups.h>
namespace cg = cooperative_groups;
#define LAS __attribute__((address_space(3)))
typedef short bf16x8 __attribute__((ext_vector_type(8)));
typedef float f32x4 __attribute__((ext_vector_type(4)));
typedef unsigned u32x2 __attribute__((ext_vector_type(2)));
typedef unsigned u32x4 __attribute__((ext_vector_type(4)));

constexpr size_t WS_RS1 = 5 * MiB + 768 * 1024;
constexpr size_t WS_RSM = WS_RS1 + 65536;
constexpr size_t WS_PS2 = 4 * MiB;
constexpr size_t WS_WIN_T = 208 * MiB;
constexpr size_t WS_WG_T = 216 * MiB;
constexpr size_t WS_WML_T = 220 * MiB;
constexpr size_t WS_WNS_T = 221 * MiB;
constexpr size_t WS_WOUT_T = 222 * MiB;
constexpr size_t WS_WQ_T = 224 * MiB;
constexpr size_t WS_WKV_T = 226 * MiB;
constexpr size_t WS_WO_T = 230 * MiB;
constexpr size_t WS_MEMB = 238 * MiB;
constexpr size_t WS_KVC = WS_KV;
constexpr size_t WS_KS = WS_KV + 8 * MiB;
constexpr size_t WS_KW = WS_KV + 12 * MiB;
constexpr size_t WS_VST = WS_KV + 16 * MiB;
constexpr size_t WS_VWT = WS_KV + 20 * MiB;
constexpr size_t WS_CK1T = 232 * MiB;
constexpr size_t WS_CV1T = 232 * MiB + 512 * 1024;
constexpr size_t WS_POSW = WS_RSM + 8192 + 65536;
constexpr int NIN = 3584;

__device__ __forceinline__ unsigned pk2bf(float lo, float hi) { return (unsigned)f2bf(lo) | ((unsigned)f2bf(hi) << 16); }
__device__ __forceinline__ void st_bf4(bf16_t* p, f32x4 v) { u32x2 o; o.x = pk2bf(v[0], v[1]); o.y = pk2bf(v[2], v[3]); *(u32x2*)p = o; }
__device__ __forceinline__ void swap8(const f32x4& v0, const f32x4& v1, float (&o)[8]) {
#pragma unroll
  for (int j = 0; j < 4; ++j) { const auto r = __builtin_amdgcn_permlane16_swap(__float_as_uint(v0[j]), __float_as_uint(v1[j]), false, false); o[j] = __uint_as_float(r[0]); o[4 + j] = __uint_as_float(r[1]); }
}
__device__ __forceinline__ void bf8_to_f32(const u32x4 p, float (&o)[8]) {
  o[0] = __uint_as_float(p.x << 16); o[1] = __uint_as_float(p.x & 0xffff0000u); o[2] = __uint_as_float(p.y << 16); o[3] = __uint_as_float(p.y & 0xffff0000u);
  o[4] = __uint_as_float(p.z << 16); o[5] = __uint_as_float(p.z & 0xffff0000u); o[6] = __uint_as_float(p.w << 16); o[7] = __uint_as_float(p.w & 0xffff0000u);
}
__device__ __forceinline__ u32x4 pk8bf(const float (&v)[8]) { u32x4 o; o.x = pk2bf(v[0], v[1]); o.y = pk2bf(v[2], v[3]); o.z = pk2bf(v[4], v[5]); o.w = pk2bf(v[6], v[7]); return o; }
__device__ __forceinline__ void st_bf8_pair(bf16_t* p, int fq, f32x4 v0, f32x4 v1) {
  const auto sx = __builtin_amdgcn_permlane16_swap(pk2bf(v0[0], v0[1]), pk2bf(v1[0], v1[1]), false, false);
  const auto sy = __builtin_amdgcn_permlane16_swap(pk2bf(v0[2], v0[3]), pk2bf(v1[2], v1[3]), false, false);
  u32x4 o; o.x = sx[0]; o.y = sy[0]; o.z = sx[1]; o.w = sy[1];
  __builtin_nontemporal_store(o, (u32x4*)(p + (fq & 1) * 16 + (fq >> 1) * 8));
}
__device__ __forceinline__ void st_bf8_pair_c(bf16_t* p, int fq, f32x4 v0, f32x4 v1) {
  const auto sx = __builtin_amdgcn_permlane16_swap(pk2bf(v0[0], v0[1]), pk2bf(v1[0], v1[1]), false, false);
  const auto sy = __builtin_amdgcn_permlane16_swap(pk2bf(v0[2], v0[3]), pk2bf(v1[2], v1[3]), false, false);
  u32x4 o; o.x = sx[0]; o.y = sy[0]; o.z = sx[1]; o.w = sy[1];
  *(u32x4*)(p + (fq & 1) * 16 + (fq >> 1) * 8) = o;
}

struct TDesc { const float* src; bf16_t* dst; const float* gain; int ldw, K, c0, ncols, drow0, nitems, mode, rofs, per, sstride, dstride, pad; };
__device__ __forceinline__ void transpose_item(const TDesc& d, int item, float* t  , int tid) {
  const int bat = item / d.per; item -= bat * d.per;
  const float* src = d.src + (size_t)bat * d.sstride; bf16_t* dst = d.dst + (size_t)bat * d.dstride;
  const int ncb = (d.ncols + 63) >> 6; const int kb = item / ncb, cb = item % ncb; const int k0 = kb * 64, n0 = cb * 64;
  {
    const int c4 = (tid & 15) * 4, kq = tid >> 4;
    f32x4 v[4];
#pragma unroll
    for (int p = 0; p < 4; ++p) {
      const int kk = p * 16 + kq;
      v[p] = (n0 + c4 < d.ncols) ? *(const f32x4*)(src + (size_t)(k0 + kk) * d.ldw + d.c0 + n0 + c4) : (f32x4){0.f, 0.f, 0.f, 0.f};
    }
#pragma unroll
    for (int p = 0; p < 4; ++p) {
      const int kk = p * 16 + kq; const float g = d.gain ? d.gain[k0 + kk] : 1.f;
      float* tp = t + kk * 65 + c4; tp[0] = v[p][0] * g; tp[1] = v[p][1] * g; tp[2] = v[p][2] * g; tp[3] = v[p][3] * g;
    }
  }
  __syncthreads();
#pragma unroll
  for (int j = 0; j < 2; ++j) {
    int c = tid + j * 256; int n = c >> 3, kc = c & 7;
    if (n0 + n < d.ncols) {
      const float* p = t + (kc * 8) * 65 + n;
      u32x4 o; o.x = pk2bf(p[0], p[65]); o.y = pk2bf(p[130], p[195]); o.z = pk2bf(p[260], p[325]); o.w = pk2bf(p[390], p[455]);
      const int drow = d.mode == 2 ? (d.drow0 + (cb * 4 + (n >> 4)) * 32 + (n & 15) + d.rofs) : d.mode ? (d.drow0 + cb * 128 + (n >> 5) * 64 + (n & 31) + d.rofs) : (d.drow0 + n0 + n);
      *(u32x4*)(dst + (size_t)drow * d.K + k0 + kc * 8) = o;
    }
  }
  __syncthreads();
}

__device__ __forceinline__ void rows_to_bf16(const float* __restrict__ src, bf16_t* __restrict__ dst, float* __restrict__ rs, int nrows, int gw, int ngw, int lane) {
  for (int row = gw; row < nrows; row += ngw) {
    const f32x4* xr = (const f32x4*)(src + (size_t)row * DM) + lane;
    f32x4 v[4]; float s = 0.f;
#pragma unroll
    for (int j = 0; j < 4; ++j) { v[j] = xr[64 * j]; s += v[j][0] * v[j][0] + v[j][1] * v[j][1] + v[j][2] * v[j][2] + v[j][3] * v[j][3]; }
    s = wave_sum(s);
    if (lane == 0) rs[row] = rsqrtf(s * (1.f / DM) + EPS);
#pragma unroll
    for (int j = 0; j < 4; ++j) st_bf4(dst + (size_t)row * DM + (lane + 64 * j) * 4, v[j]);
  }
}

__device__ __forceinline__ void glds16(const void* g, char* l) {
  __builtin_amdgcn_global_load_lds((const unsigned*)g, (LAS unsigned*)l, 16, 0, 0);
}
__device__ __forceinline__ int st_row(int tid, int i) { return (tid >> 3) + 32 * i; }
__device__ __forceinline__ int st_lc(int tid, int i) { return (tid & 7) ^ ((st_row(tid, i) >> 1) & 7); }
__device__ __forceinline__ void gemm_core(f32x4 (&acc)[4][4], const bf16_t* __restrict__ A, const unsigned (&ao)[4], unsigned ksa,
                                          const bf16_t* __restrict__ Bt, const unsigned (&bo)[4], unsigned ksb, int nt, char* lds, int tid) {
  const int lane = tid & 63, wid = tid >> 6, wr = wid >> 1, wc = wid & 1, fr = lane & 15, fq = lane >> 4;
  char* ldst = lds + tid * 16;
#pragma unroll
  for (int i = 0; i < 4; ++i) { glds16(A + ao[i], ldst + i * 4096); glds16(Bt + bo[i], ldst + 16384 + i * 4096); }
  const int sw = fr >> 1;
  const int aoff = (wr * 64 + fr) * 128, boff = (wc * 64 + fr) * 128;
  for (int t = 0; t < nt; ++t) {
    asm volatile("s_waitcnt vmcnt(0)" ::: "memory");
    __syncthreads();
    const int cur = t & 1;
    if (t + 1 < nt) {
      char* nb = ldst + (cur ^ 1) * 32768; const unsigned ka = (t + 1) * ksa, kb = (t + 1) * ksb;
#pragma unroll
      for (int i = 0; i < 4; ++i) { glds16(A + (ao[i] + ka), nb + i * 4096); glds16(Bt + (bo[i] + kb), nb + 16384 + i * 4096); }
    }
    const char* sA = lds + cur * 32768 + aoff; const char* sB = lds + cur * 32768 + 16384 + boff;
#pragma unroll
    for (int ks = 0; ks < 2; ++ks) {
      bf16x8 a[4], b[4];
      const int co = ((ks * 4 + fq) ^ sw) << 4;
#pragma unroll
      for (int i = 0; i < 4; ++i) { a[i] = *(const bf16x8*)(sA + i * 2048 + co); b[i] = *(const bf16x8*)(sB + i * 2048 + co); }
#pragma unroll
      for (int i = 0; i < 4; ++i)
#pragma unroll
        for (int j = 0; j < 4; ++j) acc[i][j] = __builtin_amdgcn_mfma_f32_16x16x32_bf16(b[j], a[i], acc[i][j], 0, 0, 0);
    }
  }
  __syncthreads();
}
__device__ __forceinline__ void gemm_acc(f32x4 (&acc)[4][4], const bf16_t* __restrict__ A, size_t lda, const int* __restrict__ arow, int ashift, int mvalid,
                                         const bf16_t* __restrict__ Bt, size_t ldb, int K, char* lds, int m0, int n0, int tid) {
  asm volatile("" : "+v"(tid));
  unsigned ao[4], bo[4];
#pragma unroll
  for (int i = 0; i < 4; ++i) {
    const int row = st_row(tid, i), lc = st_lc(tid, i);
    int gr;
    if (arow) { int mm = m0 + row; if (mm >= mvalid) mm = mvalid - 1; gr = arow[mm] >> ashift; } else gr = m0 + row;
    ao[i] = (unsigned)gr * (unsigned)lda + lc * 8;
    bo[i] = (unsigned)(n0 + row) * (unsigned)ldb + lc * 8;
  }
  gemm_core(acc, A, ao, 64u, Bt, bo, 64u, K >> 6, lds, tid);
}
__device__ __forceinline__ void zero_acc(f32x4 (&acc)[4][4]) {
#pragma unroll
  for (int i = 0; i < 4; ++i)
#pragma unroll
    for (int j = 0; j < 4; ++j) acc[i][j] = (f32x4){0.f, 0.f, 0.f, 0.f};
}


namespace pg8 {
#define PG8_LAS __attribute__((address_space(3)))
typedef unsigned short bf16_t;
typedef short bf16x8 __attribute__((ext_vector_type(8)));
typedef float f32x4 __attribute__((ext_vector_type(4)));
typedef unsigned u32x4 __attribute__((ext_vector_type(4)));
constexpr int BM = 256, BK = 64, HALF = 128, HTB = HALF * BK * 2  , STAGE_BYTES = 8 * HTB, NXCD = 8, WGM = 8;

__host__ __device__ __forceinline__ int lds_byte(int r, int c) { const int st = (r >> 4) * 2 + (c >> 5), rr = r & 15, cc = c & 31, ob = rr * 64 + cc * 2; return st * 1024 + (ob ^ (((ob >> 9) & 1) << 5)); }
__host__ __device__ __forceinline__ void stage_rc(int b, int& R, int& C) { const int st = b / 1024, sb = b % 1024, swz = sb ^ (((sb >> 9) & 1) << 5); R = (st >> 1) * 16 + swz / 64; C = (st & 1) * 32 + (swz % 64) / 2; }
__host__ __device__ __forceinline__ int perm32(int rho) { const int n = rho >> 4, i = rho & 15; return 8 * (i >> 2) + 4 * n + (i & 3); }

struct Unit { int pm, pn; const char* aptr; const char* bptr; int e, ce, p0, rt, K; };
struct Gemm { int K; };
template <class Epi, class Sched, bool ALIGN_EPI = false, bool SP2 = false, bool ACOH = false  >
__device__ __forceinline__ void gemm_phase(PG8_LAS unsigned char* lds, const Gemm g, const Sched& S, const Epi& E, int tid  , int wid  ) {
    asm volatile("" : "+v"(tid));
    const int lane = tid & 63, wr = wid >> 2, wc = wid & 3, fr = lane & 15, fq = lane >> 4;
    const int K = g.K, nt = K / BK;
    unsigned voffA[2], voffB[2];
#pragma unroll
    for (int i = 0; i < 2; ++i) { int R, C; stage_rc(tid * 16 + i * 8192, R, C); const int Rb = Epi::PERM ? ((R & ~31) + perm32(R & 31)) : R;
        voffA[i] = (unsigned)(R * K + C) * 2u; voffB[i] = (unsigned)(Rb * K + C) * 2u; }
    unsigned cva0[2], cva1[2], nva0[2], nva1[2];
    const size_t kstep = (size_t)(BK * 2);
    const size_t hstep = (size_t)HALF * K * 2;
    const unsigned ldsw = (unsigned)wid * 1024u;
    const int aoff = lds_byte(wr * 64 + fr, fq * 8), boff = lds_byte(wc * 32 + fr, fq * 8);
#define PG8_SA(b, h) (((b) * 2 + (h)) * HTB)
#define PG8_SB(b, h) ((4 + (b) * 2 + (h)) * HTB)
#define PG8_STAGE(bufoff, gbase, voff) do { _Pragma("unroll") for (int _i = 0; _i < 2; ++_i) \
        __builtin_amdgcn_global_load_lds((const unsigned*)((const char*)(gbase) + (voff)[_i]), (PG8_LAS unsigned*)(lds + (bufoff) + ldsw + _i * 8192), 16, 0, 0); } while (0)
#define PG8_STAGEA(bufoff, gbase, voff) do { _Pragma("unroll") for (int _i = 0; _i < 2; ++_i) { \
        if constexpr (ACOH) __builtin_amdgcn_global_load_lds((const unsigned*)((const char*)(gbase) + (voff)[_i]), (PG8_LAS unsigned*)(lds + (bufoff) + ldsw + _i * 8192), 16, 0, 16  ); \
        else __builtin_amdgcn_global_load_lds((const unsigned*)((const char*)(gbase) + (voff)[_i]), (PG8_LAS unsigned*)(lds + (bufoff) + ldsw + _i * 8192), 16, 0, 0); } } while (0)
#define PG8_LDA(dst, b, h) do { _Pragma("unroll") for (int m = 0; m < 4; ++m) _Pragma("unroll") for (int k = 0; k < 2; ++k) dst[m][k] = *(const PG8_LAS bf16x8*)(lds + PG8_SA(b, h) + aoff + m * 2048 + k * 1024); } while (0)
#define PG8_LDB(dst, b, h) do { _Pragma("unroll") for (int n = 0; n < 2; ++n) _Pragma("unroll") for (int k = 0; k < 2; ++k) dst[n][k] = *(const PG8_LAS bf16x8*)(lds + PG8_SB(b, h) + boff + n * 2048 + k * 1024); } while (0)
#define PG8_MMA(ai, bj, At, Bt) do { __builtin_amdgcn_s_setprio(1); _Pragma("unroll") for (int m = 0; m < 4; ++m) _Pragma("unroll") for (int n = 0; n < 2; ++n) _Pragma("unroll") for (int k = 0; k < 2; ++k) \
        acc[ai][bj][m][n] = __builtin_amdgcn_mfma_f32_16x16x32_bf16(Bt[n][k], At[m][k], acc[ai][bj][m][n], 0, 0, 0); __builtin_amdgcn_s_setprio(0); } while (0)
#define PG8_WAIT_V(n) asm volatile("s_waitcnt vmcnt(" #n ")" ::: "memory")
#define PG8_WAIT_L(n) asm volatile("s_waitcnt lgkmcnt(" #n ")" ::: "memory")
#define PG8_BAR __builtin_amdgcn_s_barrier()
#define PG8_SCHED __builtin_amdgcn_sched_barrier(0)
    Unit cur, nxt; int ui = 0;
    if (!S.next(0, cur)) return;
    S.avoff(cur, tid, K, voffA, cva0, cva1);
    f32x4 acc[2][2][4][2];
#pragma unroll
    for (int a = 0; a < 2; ++a)
#pragma unroll
        for (int b = 0; b < 2; ++b)
#pragma unroll
            for (int m = 0; m < 4; ++m)
#pragma unroll
                for (int n = 0; n < 2; ++n) acc[a][b][m][n] = (f32x4){0.f, 0.f, 0.f, 0.f};
    bf16x8 At[4][2], B0[2][2], B1[2][2];
    const char* cA = cur.aptr; const char* cB = cur.bptr;
    S.a_ready(cur);
    if constexpr (SP2) {
        PG8_STAGE(PG8_SB(0, 0), cB, voffB); PG8_STAGE(PG8_SB(0, 1), cB + hstep, voffB); PG8_STAGEA(PG8_SA(0, 0), cA, cva0); PG8_STAGEA(PG8_SA(0, 1), cA, cva1);
        if (wr == 1) PG8_BAR;
        PG8_WAIT_V(2); PG8_BAR;
        PG8_STAGE(PG8_SB(1, 0), cB + kstep, voffB); PG8_STAGEA(PG8_SA(1, 0), cA + kstep, cva0); PG8_STAGE(PG8_SB(1, 1), cB + hstep + kstep, voffB);
        PG8_WAIT_V(6); PG8_BAR;
    } else {
        PG8_STAGE(PG8_SB(0, 0), cB, voffB); PG8_STAGEA(PG8_SA(0, 0), cA, cva0); PG8_STAGE(PG8_SB(0, 1), cB + hstep, voffB); PG8_STAGEA(PG8_SA(0, 1), cA, cva1);
        if (wr == 1) PG8_BAR;
        PG8_WAIT_V(4); PG8_BAR;
        PG8_STAGE(PG8_SB(1, 0), cB + kstep, voffB); PG8_STAGEA(PG8_SA(1, 0), cA + kstep, cva0); PG8_STAGE(PG8_SB(1, 1), cB + hstep + kstep, voffB);
        PG8_WAIT_V(6); PG8_BAR;
    }
    for (;;) {
        const bool has_next = S.next(ui + 1, nxt);
        if (has_next) S.avoff(nxt, tid, K, voffA, nva0, nva1); else { nva0[0] = cva0[0]; nva0[1] = cva0[1]; nva1[0] = cva1[0]; nva1[1] = cva1[1]; }
        const char* nA = has_next ? nxt.aptr : cA; const char* nB = has_next ? nxt.bptr : cB;
        for (int t = 0; t < nt; t += 2) {
            const bool last = (t == nt - 2);
            const char* a1 = cA + (size_t)(t + 1) * kstep;
            const char* a2 = last ? nA : cA + (size_t)(t + 2) * kstep; const char* b2 = last ? nB : cB + (size_t)(t + 2) * kstep;
            const char* a3 = a2 + kstep; const char* b3 = b2 + kstep;
            const unsigned xva0[2] = {last ? nva0[0] : cva0[0], last ? nva0[1] : cva0[1]}, xva1[2] = {last ? nva1[0] : cva1[0], last ? nva1[1] : cva1[1]};
            if (last && has_next) S.a_ready(nxt);
            if constexpr (SP2) {
            PG8_LDB(B0, 0, 0); PG8_LDB(B1, 0, 1); PG8_SCHED; PG8_LDA(At, 0, 0); PG8_STAGEA(PG8_SA(1, 1), a1, cva1);
            PG8_WAIT_V(8); PG8_WAIT_L(0); PG8_BAR; PG8_MMA(0, 0, At, B0); PG8_MMA(0, 1, At, B1); PG8_BAR; PG8_SCHED;
            PG8_LDA(At, 0, 1); PG8_STAGE(PG8_SB(0, 0), b2, voffB); PG8_STAGE(PG8_SB(0, 1), b2 + hstep, voffB); PG8_STAGEA(PG8_SA(0, 0), a2, xva0);
            PG8_WAIT_V(8); PG8_WAIT_L(0); PG8_BAR; PG8_MMA(1, 0, At, B0); PG8_MMA(1, 1, At, B1); PG8_BAR; PG8_SCHED;
            PG8_LDB(B0, 1, 0); PG8_LDB(B1, 1, 1); PG8_SCHED; PG8_LDA(At, 1, 0); PG8_STAGEA(PG8_SA(0, 1), a2, xva1);
            PG8_WAIT_V(8); PG8_WAIT_L(0); PG8_BAR; PG8_MMA(0, 0, At, B0); PG8_MMA(0, 1, At, B1); PG8_BAR; PG8_SCHED;
            PG8_LDA(At, 1, 1); PG8_STAGE(PG8_SB(1, 0), b3, voffB); PG8_STAGE(PG8_SB(1, 1), b3 + hstep, voffB); PG8_STAGEA(PG8_SA(1, 0), a3, xva0);
            PG8_WAIT_V(8); PG8_WAIT_L(0); PG8_BAR; PG8_MMA(1, 0, At, B0); PG8_MMA(1, 1, At, B1); PG8_BAR; PG8_SCHED;
            } else {
            PG8_LDB(B0, 0, 0); PG8_SCHED; PG8_LDA(At, 0, 0); PG8_STAGEA(PG8_SA(1, 1), a1, cva1);
            PG8_WAIT_L(8); PG8_BAR; PG8_WAIT_L(0); PG8_MMA(0, 0, At, B0); PG8_BAR; PG8_SCHED;
            PG8_LDB(B1, 0, 1); PG8_STAGE(PG8_SB(0, 0), b2, voffB);
            PG8_BAR; PG8_WAIT_L(0); PG8_MMA(0, 1, At, B1); PG8_BAR;
            PG8_LDA(At, 0, 1); PG8_STAGEA(PG8_SA(0, 0), a2, xva0);
            PG8_BAR; PG8_WAIT_L(0); PG8_MMA(1, 0, At, B0); PG8_BAR; PG8_SCHED;
            PG8_STAGE(PG8_SB(0, 1), b2 + hstep, voffB);
            PG8_WAIT_V(6); PG8_BAR; PG8_MMA(1, 1, At, B1); PG8_BAR;
            PG8_LDB(B0, 1, 0); PG8_SCHED; PG8_LDA(At, 1, 0); PG8_STAGEA(PG8_SA(0, 1), a2, xva1);
            PG8_WAIT_L(8); PG8_BAR; PG8_WAIT_L(0); PG8_MMA(0, 0, At, B0); PG8_BAR; PG8_SCHED;
            PG8_LDB(B1, 1, 1); PG8_STAGE(PG8_SB(1, 0), b3, voffB);
            PG8_BAR; PG8_WAIT_L(0); PG8_MMA(0, 1, At, B1); PG8_BAR;
            PG8_LDA(At, 1, 1); PG8_STAGEA(PG8_SA(1, 0), a3, xva0);
            PG8_BAR; PG8_WAIT_L(0); PG8_MMA(1, 0, At, B0); PG8_BAR; PG8_SCHED;
            PG8_STAGE(PG8_SB(1, 1), b3 + hstep, voffB);
            PG8_WAIT_V(6); PG8_BAR; PG8_MMA(1, 1, At, B1); PG8_BAR;
            }
        }
        if constexpr (ALIGN_EPI) { if (wr == 0) PG8_BAR; }
        if constexpr (!Epi::AFTER_DRAIN) { E(acc, cur, wr, wc, fr, fq); S.done(cur); }
        if (!has_next) break;
#pragma unroll
        for (int a = 0; a < 2; ++a)
#pragma unroll
            for (int b = 0; b < 2; ++b)
#pragma unroll
                for (int m = 0; m < 4; ++m)
#pragma unroll
                    for (int n = 0; n < 2; ++n) acc[a][b][m][n] = (f32x4){0.f, 0.f, 0.f, 0.f};
        cur = nxt; cA = nA; cB = nB; ++ui; cva0[0] = nva0[0]; cva0[1] = nva0[1]; cva1[0] = nva1[0]; cva1[1] = nva1[1];
        if constexpr (ALIGN_EPI) { if (wr == 1) PG8_BAR; }
    }
    PG8_WAIT_V(0);
    if constexpr (!ALIGN_EPI) { if (wr == 0) PG8_BAR; }
    PG8_BAR;
    if constexpr (Epi::AFTER_DRAIN) { E.fused(acc, cur, wr, wc, fr, fq, lds, wid, lane); S.done(cur); }
#undef PG8_SA
#undef PG8_SB
#undef PG8_STAGE
#undef PG8_STAGEA
#undef PG8_LDA
#undef PG8_LDB
#undef PG8_MMA
#undef PG8_WAIT_V
#undef PG8_WAIT_L
#undef PG8_BAR
#undef PG8_SCHED
}
template <class Epi, class Sched, bool ALIGN_EPI = false, bool SP2 = true, bool ACOH = false>
__device__ __forceinline__ void gemm_phase_vk(PG8_LAS unsigned char* lds, const Gemm g, const Sched& S, const Epi& E, int tid  , int wid  ) {
    static_assert(!Epi::PERM, "no row permutation in the per-unit-K body");
    asm volatile("" : "+v"(tid));
    const int lane = tid & 63, wr = wid >> 2, wc = wid & 3, fr = lane & 15, fq = lane >> 4;
    (void)g;
    unsigned vR2[2], vC2[2];
#pragma unroll
    for (int i = 0; i < 2; ++i) { int R, C; stage_rc(tid * 16 + i * 8192, R, C); vR2[i] = (unsigned)R * 2u; vC2[i] = (unsigned)C * 2u; }
    unsigned cvb[2], nvb[2];
    unsigned cva0[2], cva1[2], nva0[2], nva1[2];
    const size_t kstep = (size_t)(BK * 2);
    const unsigned ldsw = (unsigned)wid * 1024u;
    const int aoff = lds_byte(wr * 64 + fr, fq * 8), boff = lds_byte(wc * 32 + fr, fq * 8);
#define PG8_SA(b, h) (((b) * 2 + (h)) * HTB)
#define PG8_SB(b, h) ((4 + (b) * 2 + (h)) * HTB)
#define PG8_STAGE(bufoff, gbase, voff) do { _Pragma("unroll") for (int _i = 0; _i < 2; ++_i) \
        __builtin_amdgcn_global_load_lds((const unsigned*)((const char*)(gbase) + (voff)[_i]), (PG8_LAS unsigned*)(lds + (bufoff) + ldsw + _i * 8192), 16, 0, 0); } while (0)
#define PG8_STAGEA(bufoff, gbase, voff) do { _Pragma("unroll") for (int _i = 0; _i < 2; ++_i) { \
        if constexpr (ACOH) __builtin_amdgcn_global_load_lds((const unsigned*)((const char*)(gbase) + (voff)[_i]), (PG8_LAS unsigned*)(lds + (bufoff) + ldsw + _i * 8192), 16, 0, 16  ); \
        else __builtin_amdgcn_global_load_lds((const unsigned*)((const char*)(gbase) + (voff)[_i]), (PG8_LAS unsigned*)(lds + (bufoff) + ldsw + _i * 8192), 16, 0, 0); } } while (0)
#define PG8_LDA(dst, b, h) do { _Pragma("unroll") for (int m = 0; m < 4; ++m) _Pragma("unroll") for (int k = 0; k < 2; ++k) dst[m][k] = *(const PG8_LAS bf16x8*)(lds + PG8_SA(b, h) + aoff + m * 2048 + k * 1024); } while (0)
#define PG8_LDB(dst, b, h) do { _Pragma("unroll") for (int n = 0; n < 2; ++n) _Pragma("unroll") for (int k = 0; k < 2; ++k) dst[n][k] = *(const PG8_LAS bf16x8*)(lds + PG8_SB(b, h) + boff + n * 2048 + k * 1024); } while (0)
#define PG8_MMA(ai, bj, At, Bt) do { __builtin_amdgcn_s_setprio(1); _Pragma("unroll") for (int m = 0; m < 4; ++m) _Pragma("unroll") for (int n = 0; n < 2; ++n) _Pragma("unroll") for (int k = 0; k < 2; ++k) \
        acc[ai][bj][m][n] = __builtin_amdgcn_mfma_f32_16x16x32_bf16(Bt[n][k], At[m][k], acc[ai][bj][m][n], 0, 0, 0); __builtin_amdgcn_s_setprio(0); } while (0)
#define PG8_WAIT_V(n) asm volatile("s_waitcnt vmcnt(" #n ")" ::: "memory")
#define PG8_WAIT_L(n) asm volatile("s_waitcnt lgkmcnt(" #n ")" ::: "memory")
#define PG8_BAR __builtin_amdgcn_s_barrier()
#define PG8_SCHED __builtin_amdgcn_sched_barrier(0)
    Unit cur, nxt; int ui = 0;
    if (!S.next(0, cur)) return;
    int cK = cur.K, nK = cur.K;
    size_t chs = (size_t)HALF * cK * 2, nhs = chs;
    { const unsigned va[2] = {vR2[0] * (unsigned)cK + vC2[0], vR2[1] * (unsigned)cK + vC2[1]}; cvb[0] = va[0]; cvb[1] = va[1]; S.avoff(cur, tid, cK, va, cva0, cva1); }
    f32x4 acc[2][2][4][2];
#pragma unroll
    for (int a = 0; a < 2; ++a)
#pragma unroll
        for (int b = 0; b < 2; ++b)
#pragma unroll
            for (int m = 0; m < 4; ++m)
#pragma unroll
                for (int n = 0; n < 2; ++n) acc[a][b][m][n] = (f32x4){0.f, 0.f, 0.f, 0.f};
    bf16x8 At[4][2], B0[2][2], B1[2][2];
    const char* cA = cur.aptr; const char* cB = cur.bptr;
    S.a_ready(cur);
    if constexpr (SP2) {
        PG8_STAGE(PG8_SB(0, 0), cB, cvb); PG8_STAGE(PG8_SB(0, 1), cB + chs, cvb); PG8_STAGEA(PG8_SA(0, 0), cA, cva0); PG8_STAGEA(PG8_SA(0, 1), cA, cva1);
        if (wr == 1) PG8_BAR;
        PG8_WAIT_V(2); PG8_BAR;
        PG8_STAGE(PG8_SB(1, 0), cB + kstep, cvb); PG8_STAGEA(PG8_SA(1, 0), cA + kstep, cva0); PG8_STAGE(PG8_SB(1, 1), cB + chs + kstep, cvb);
        PG8_WAIT_V(6); PG8_BAR;
    } else {
        PG8_STAGE(PG8_SB(0, 0), cB, cvb); PG8_STAGEA(PG8_SA(0, 0), cA, cva0); PG8_STAGE(PG8_SB(0, 1), cB + chs, cvb); PG8_STAGEA(PG8_SA(0, 1), cA, cva1);
        if (wr == 1) PG8_BAR;
        PG8_WAIT_V(4); PG8_BAR;
        PG8_STAGE(PG8_SB(1, 0), cB + kstep, cvb); PG8_STAGEA(PG8_SA(1, 0), cA + kstep, cva0); PG8_STAGE(PG8_SB(1, 1), cB + chs + kstep, cvb);
        PG8_WAIT_V(6); PG8_BAR;
    }
    for (;;) {
        const bool has_next = S.next(ui + 1, nxt);
        if (has_next) { nK = nxt.K; nhs = (size_t)HALF * nK * 2; const unsigned va[2] = {vR2[0] * (unsigned)nK + vC2[0], vR2[1] * (unsigned)nK + vC2[1]}; nvb[0] = va[0]; nvb[1] = va[1]; S.avoff(nxt, tid, nK, va, nva0, nva1); }
        else { nK = cK; nhs = chs; nvb[0] = cvb[0]; nvb[1] = cvb[1]; nva0[0] = cva0[0]; nva0[1] = cva0[1]; nva1[0] = cva1[0]; nva1[1] = cva1[1]; }
        const int nt = cK / BK;
        const char* nA = has_next ? nxt.aptr : cA; const char* nB = has_next ? nxt.bptr : cB;
        for (int t = 0; t < nt; t += 2) {
            const bool last = (t == nt - 2);
            const char* a1 = cA + (size_t)(t + 1) * kstep;
            const char* a2 = last ? nA : cA + (size_t)(t + 2) * kstep; const char* b2 = last ? nB : cB + (size_t)(t + 2) * kstep;
            const char* a3 = a2 + kstep; const char* b3 = b2 + kstep;
            const unsigned xva0[2] = {last ? nva0[0] : cva0[0], last ? nva0[1] : cva0[1]}, xva1[2] = {last ? nva1[0] : cva1[0], last ? nva1[1] : cva1[1]};
            const unsigned xvb[2] = {last ? nvb[0] : cvb[0], last ? nvb[1] : cvb[1]}; const size_t xhs = last ? nhs : chs;
            if (last && has_next) S.a_ready(nxt);
            if constexpr (SP2) {
            PG8_LDB(B0, 0, 0); PG8_LDB(B1, 0, 1); PG8_SCHED; PG8_LDA(At, 0, 0); PG8_STAGEA(PG8_SA(1, 1), a1, cva1);
            PG8_WAIT_V(8); PG8_WAIT_L(0); PG8_BAR; PG8_MMA(0, 0, At, B0); PG8_MMA(0, 1, At, B1); PG8_BAR; PG8_SCHED;
            PG8_LDA(At, 0, 1); PG8_STAGE(PG8_SB(0, 0), b2, xvb); PG8_STAGE(PG8_SB(0, 1), b2 + xhs, xvb); PG8_STAGEA(PG8_SA(0, 0), a2, xva0);
            PG8_WAIT_V(8); PG8_WAIT_L(0); PG8_BAR; PG8_MMA(1, 0, At, B0); PG8_MMA(1, 1, At, B1); PG8_BAR; PG8_SCHED;
            PG8_LDB(B0, 1, 0); PG8_LDB(B1, 1, 1); PG8_SCHED; PG8_LDA(At, 1, 0); PG8_STAGEA(PG8_SA(0, 1), a2, xva1);
            PG8_WAIT_V(8); PG8_WAIT_L(0); PG8_BAR; PG8_MMA(0, 0, At, B0); PG8_MMA(0, 1, At, B1); PG8_BAR; PG8_SCHED;
            PG8_LDA(At, 1, 1); PG8_STAGE(PG8_SB(1, 0), b3, xvb); PG8_STAGE(PG8_SB(1, 1), b3 + xhs, xvb); PG8_STAGEA(PG8_SA(1, 0), a3, xva0);
            PG8_WAIT_V(8); PG8_WAIT_L(0); PG8_BAR; PG8_MMA(1, 0, At, B0); PG8_MMA(1, 1, At, B1); PG8_BAR; PG8_SCHED;
            } else {
            PG8_LDB(B0, 0, 0); PG8_SCHED; PG8_LDA(At, 0, 0); PG8_STAGEA(PG8_SA(1, 1), a1, cva1);
            PG8_WAIT_L(8); PG8_BAR; PG8_WAIT_L(0); PG8_MMA(0, 0, At, B0); PG8_BAR; PG8_SCHED;
            PG8_LDB(B1, 0, 1); PG8_STAGE(PG8_SB(0, 0), b2, xvb);
            PG8_BAR; PG8_WAIT_L(0); PG8_MMA(0, 1, At, B1); PG8_BAR;
            PG8_LDA(At, 0, 1); PG8_STAGEA(PG8_SA(0, 0), a2, xva0);
            PG8_BAR; PG8_WAIT_L(0); PG8_MMA(1, 0, At, B0); PG8_BAR; PG8_SCHED;
            PG8_STAGE(PG8_SB(0, 1), b2 + xhs, xvb);
            PG8_WAIT_V(6); PG8_BAR; PG8_MMA(1, 1, At, B1); PG8_BAR;
            PG8_LDB(B0, 1, 0); PG8_SCHED; PG8_LDA(At, 1, 0); PG8_STAGEA(PG8_SA(0, 1), a2, xva1);
            PG8_WAIT_L(8); PG8_BAR; PG8_WAIT_L(0); PG8_MMA(0, 0, At, B0); PG8_BAR; PG8_SCHED;
            PG8_LDB(B1, 1, 1); PG8_STAGE(PG8_SB(1, 0), b3, xvb);
            PG8_BAR; PG8_WAIT_L(0); PG8_MMA(0, 1, At, B1); PG8_BAR;
            PG8_LDA(At, 1, 1); PG8_STAGEA(PG8_SA(1, 0), a3, xva0);
            PG8_BAR; PG8_WAIT_L(0); PG8_MMA(1, 0, At, B0); PG8_BAR; PG8_SCHED;
            PG8_STAGE(PG8_SB(1, 1), b3 + xhs, xvb);
            PG8_WAIT_V(6); PG8_BAR; PG8_MMA(1, 1, At, B1); PG8_BAR;
            }
        }
        if constexpr (ALIGN_EPI) { if (wr == 0) PG8_BAR; }
        if constexpr (!Epi::AFTER_DRAIN) { E(acc, cur, wr, wc, fr, fq); S.done(cur); }
        if (!has_next) break;
#pragma unroll
        for (int a = 0; a < 2; ++a)
#pragma unroll
            for (int b = 0; b < 2; ++b)
#pragma unroll
                for (int m = 0; m < 4; ++m)
#pragma unroll
                    for (int n = 0; n < 2; ++n) acc[a][b][m][n] = (f32x4){0.f, 0.f, 0.f, 0.f};
        cur = nxt; cA = nA; cB = nB; ++ui; cva0[0] = nva0[0]; cva0[1] = nva0[1]; cva1[0] = nva1[0]; cva1[1] = nva1[1]; cvb[0] = nvb[0]; cvb[1] = nvb[1]; cK = nK; chs = nhs;
        if constexpr (ALIGN_EPI) { if (wr == 1) PG8_BAR; }
    }
    PG8_WAIT_V(0);
    if constexpr (!ALIGN_EPI) { if (wr == 0) PG8_BAR; }
    PG8_BAR;
    if constexpr (Epi::AFTER_DRAIN) { E.fused(acc, cur, wr, wc, fr, fq, lds, wid, lane); S.done(cur); }
#undef PG8_SA
#undef PG8_SB
#undef PG8_STAGE
#undef PG8_STAGEA
#undef PG8_LDA
#undef PG8_LDB
#undef PG8_MMA
#undef PG8_WAIT_V
#undef PG8_WAIT_L
#undef PG8_BAR
#undef PG8_SCHED
}
}

#define TILE8_IDS unsigned t8_z = 0u; asm volatile("" : "+v"(t8_z)); int t512 = wave_s * 64 + (int)__builtin_amdgcn_mbcnt_hi(~0u, __builtin_amdgcn_mbcnt_lo(~0u, t8_z)); asm volatile("" : "+v"(t512))
template <class Map> struct ListSched {
  int first, stride, count; Map map;
  __device__ __forceinline__ bool next(int i, pg8::Unit& u) const { const int idx = first + i * stride; if (idx >= count) return false; map(idx, u); return true; }
  __device__ __forceinline__ void avoff(const pg8::Unit& u, int tid, int K, const unsigned (&voffA)[2], unsigned (&v0)[2], unsigned (&v1)[2]) const { map.avoff(u, tid, K, voffA, v0, v1); }
  __device__ __forceinline__ void a_ready(const pg8::Unit&) const {}
  __device__ __forceinline__ void done(const pg8::Unit&) const {}
};
struct MlArgs { const float *conv, *b_i, *b_f, *gain; float *BCUM, *IP, *BL, *MX, *MST, *NST; bf16_t* CST; };
struct MegaArgs {
  const float* x; const float* mem; float* out;
  bf16_t *XB, *MEMB; float *RS1, *RSM, *PS2;
  bf16_t *QK, *V, *O, *NQ, *KVC, *KS, *KW, *VST, *VWT, *KC, *VCT, *CK1T, *CV1T; float *SM, *POSW;
  const float *posk, *posv, *ckw1, *cvw1, *ckw2, *cvw2;
  bf16_t *AML, *ANS, *MRG, *X1B, *XQ, *XO, *KVM;
  bf16_t *WinT, *WgT, *WmlT, *WnsT, *WoutT, *WqT, *WkvT, *WoT;
  bf16_t *H3, *ACT, *Y, *W13T, *W2T; float *RS3, *RTW; int *CNT, *LIST;
  const float *g_ffn, *wg, *bg, *we, *be, *g_final;
  unsigned* BAR;
  MlArgs ml;
  float* CPART; int* WQ;
  TDesc td[24]; int ntdA, ntdB; int ph_lo, ph_hi, li, pad; int rep[16]; int cv_lo[16], cv_hi[16];
};


constexpr int NSA_LDS = 66112;
constexpr int MEGA_LDS = 73728;
constexpr int HALF_LDS = 73728, CTRL_OFF = 2 * HALF_LDS, TOTAL_LDS = CTRL_OFF + 64;
typedef unsigned long long u64;

template <bool WITH_V>
__device__ __forceinline__ void nsa_load_tile(const bf16_t* __restrict__ Ksrc, unsigned kstride, const bf16_t* __restrict__ Vsrc, unsigned vstride, char* lds, int tid) {
#pragma unroll
  for (int i = 0; i < 2; ++i) {
    const int idx = tid + 256 * i, row = idx >> 3, lc = (idx & 7) ^ ((row >> 1) & 7);
    glds16(Ksrc + (size_t)row * kstride + lc * 8, lds + idx * 16);
    if (WITH_V) glds16(Vsrc + (size_t)row * vstride + lc * 8, lds + 8192 + idx * 16);
  }
}

__device__ __forceinline__ void nsa_qk(f32x4 (&sacc)[4][2], const bf16x8 (&qf)[4][2], const char* lds, int hf, int fr, int fq) {
#pragma unroll
  for (int mi = 0; mi < 4; ++mi)
#pragma unroll
    for (int ni = 0; ni < 2; ++ni) sacc[mi][ni] = (f32x4){0.f, 0.f, 0.f, 0.f};
#pragma unroll
  for (int ks = 0; ks < 2; ++ks) {
    bf16x8 kf[2];
    const int co = ((ks * 4 + fq) ^ (fr >> 1)) << 4;
#pragma unroll
    for (int ni = 0; ni < 2; ++ni) kf[ni] = *(const bf16x8*)(lds + ((hf * 2 + ni) * 16 + fr) * 128 + co);
#pragma unroll
    for (int mi = 0; mi < 4; ++mi)
#pragma unroll
      for (int ni = 0; ni < 2; ++ni) sacc[mi][ni] = __builtin_amdgcn_mfma_f32_16x16x32_bf16(kf[ni], qf[mi][ks], sacc[mi][ni], 0, 0, 0);
  }
}
__device__ __forceinline__ void nsa_pv(f32x4 (&oacc)[4][4], const f32x4 (&p)[4][2], char* lds, char* pw, int hf, int fr, int fq) {
#pragma unroll
  for (int mi = 0; mi < 4; ++mi)
#pragma unroll
    for (int ni = 0; ni < 2; ++ni) {
      u32x2 o; o.x = pk2bf(p[mi][ni][0], p[mi][ni][1]); o.y = pk2bf(p[mi][ni][2], p[mi][ni][3]);
      *(u32x2*)(pw + (mi * 16 + fr) * 128 + ((((hf * 2 + ni) * 2 + (fq >> 1)) ^ (fr >> 1)) << 4) + (fq & 1) * 8) = o;
    }
  bf16x8 pf[4], vf[4];
  const int co = ((hf * 4 + fq) ^ (fr >> 1)) << 4;
#pragma unroll
  for (int i = 0; i < 4; ++i) { pf[i] = *(const bf16x8*)(pw + (i * 16 + fr) * 128 + co); vf[i] = *(const bf16x8*)(lds + 8192 + (i * 16 + fr) * 128 + co); }
#pragma unroll
  for (int mi = 0; mi < 4; ++mi)
#pragma unroll
    for (int ni = 0; ni < 4; ++ni) oacc[mi][ni] = __builtin_amdgcn_mfma_f32_16x16x32_bf16(vf[ni], pf[mi], oacc[mi][ni], 0, 0, 0);
}
__device__ __forceinline__ float red4(float v) { v += __shfl_xor(v, 16); v += __shfl_xor(v, 32); return v; }
__device__ __forceinline__ float max4(float v) { v = fmaxf(v, __shfl_xor(v, 16)); v = fmaxf(v, __shfl_xor(v, 32)); return v; }

__device__ __forceinline__ void nsa_online(f32x4 (&sv)[4][2], float (&m_run)[4], float (&l_run)[4], f32x4 (&oacc)[4][4]) {
#pragma unroll
  for (int mi = 0; mi < 4; ++mi) {
    float mx = fmaxf(fmaxf(fmaxf(sv[mi][0][0], sv[mi][0][1]), fmaxf(sv[mi][0][2], sv[mi][0][3])), fmaxf(fmaxf(sv[mi][1][0], sv[mi][1][1]), fmaxf(sv[mi][1][2], sv[mi][1][3])));
    mx = max4(mx);
    if (__any(mx > m_run[mi] + 8.f)) {
      const float mn = fmaxf(fmaxf(m_run[mi], mx), -1e20f);
      const float alpha = __builtin_amdgcn_exp2f(m_run[mi] - mn);
      m_run[mi] = mn; l_run[mi] *= alpha;
#pragma unroll
      for (int ni = 0; ni < 4; ++ni) oacc[mi][ni] *= alpha;
    }
    float ls = 0.f;
#pragma unroll
    for (int ni = 0; ni < 2; ++ni)
#pragma unroll
      for (int j = 0; j < 4; ++j) { const float pv = __builtin_amdgcn_exp2f(sv[mi][ni][j] - m_run[mi]); sv[mi][ni][j] = pv; ls += pv; }
    l_run[mi] += ls;
  }
}

__device__ __forceinline__ void nsa_main_item(const MegaArgs& a, int item, char* lds, int tid, volatile int* xch, int half) {
  asm volatile("" : "+v"(tid));
  const int lane = tid & 63, wid = tid >> 6, fr = lane & 15, fq = lane >> 4;
  const int i = item & 63, g = (item >> 6) & 1, b = item >> 7;
  const int h = g * 4 + wid, nb = b * SEQ, t0 = i * 64, bg = b * 2 + g;
  const float slope = exp2f(-(float)(h + 1)) * 1.4426950408889634f;
  char* pw = lds + 16384 + wid * 8192;
  float* PSLC = (float*)(lds + 49152);
  u64* SELM = (u64*)(lds + 65536);
  u64* UNI = (u64*)(lds + 66048);
  bf16x8 qf[4][2];
#pragma unroll
  for (int mi = 0; mi < 4; ++mi)
#pragma unroll
    for (int ks = 0; ks < 2; ++ks) qf[mi][ks] = *(const bf16x8*)(a.NQ + (size_t)(nb + t0 + wid * 16 + fr) * 512 + (g * 4 + mi) * 64 + ks * 32 + fq * 8);
  for (int e = tid; e < 4096; e += 256) PSLC[e] = 0.f;
  f32x4 sacc[4][2], oacc[4][4];
  float m_run[4], l_run[4];
  const int nct = ((4 * i + 2) >> 6) + 1;
  const bf16_t* kcb = a.KC + (size_t)bg * 256 * 64;
  const bf16_t* vcb = a.VCT + (size_t)bg * 64 * 256;
  const int tc = t0 + wid * 16 + fr;
  const float slope0 = exp2f(-(float)(g * 4 + 1)) * 1.4426950408889634f;
#pragma unroll
  for (int mi = 0; mi < 4; ++mi) { m_run[mi] = -1e30f; l_run[mi] = 0.f; }
  __syncthreads();
  nsa_load_tile<false>(kcb, 64u, nullptr, 0u, lds, tid);
  for (int jt = 0; jt < nct; ++jt) {
    asm volatile("s_waitcnt vmcnt(0)" ::: "memory");
    __syncthreads();
    char* tb = (jt & 1) ? (lds + 16384) : lds;
    if (jt + 1 < nct) nsa_load_tile<false>(kcb + (size_t)(jt + 1) * 64 * 64, 64u, nullptr, 0u, (jt & 1) ? lds : (lds + 16384), tid);
#pragma unroll 1
    for (int hf = 0; hf < 2; ++hf) {
      nsa_qk(sacc, qf, tb, hf, fr, fq);
#pragma unroll
      for (int mi = 0; mi < 4; ++mi) {
        const float slope = slope0 * (1.f / (float)(1 << mi)); float mx = -1e30f;
#pragma unroll
        for (int ni = 0; ni < 2; ++ni)
#pragma unroll
          for (int j = 0; j < 4; ++j) {
            const int jj = jt * 64 + hf * 32 + ni * 16 + 4 * fq + j; const bool ok = (16 * jj + 31 <= tc);
            const float v = sacc[mi][ni][j] - slope * ((float)tc - (16.f * jj + 15.5f));
            sacc[mi][ni][j] = ok ? v : -1e30f; mx = fmaxf(mx, sacc[mi][ni][j]);
          }
        mx = max4(mx);
        const float mn = fmaxf(m_run[mi], mx); float ls = 0.f;
#pragma unroll
        for (int ni = 0; ni < 2; ++ni)
#pragma unroll
          for (int j = 0; j < 4; ++j) ls += (sacc[mi][ni][j] > -1e29f) ? __builtin_amdgcn_exp2f(sacc[mi][ni][j] - mn) : 0.f;
        l_run[mi] = l_run[mi] * __builtin_amdgcn_exp2f(m_run[mi] - mn) + ls; m_run[mi] = mn;
      }
    }
  }
  float invl[4];
#pragma unroll
  for (int mi = 0; mi < 4; ++mi) { const float l = red4(l_run[mi]); invl[mi] = l > 0.f ? 1.f / l : 0.f; }
#pragma unroll
  for (int mi = 0; mi < 4; ++mi)
#pragma unroll
    for (int ni = 0; ni < 4; ++ni) oacc[mi][ni] = (f32x4){0.f, 0.f, 0.f, 0.f};
  for (int jt = 0; jt < nct; ++jt) {
    __syncthreads();
    nsa_load_tile<true>(kcb + (size_t)jt * 64 * 64, 64u, vcb + jt * 64, 256u, lds, tid);
    asm volatile("s_waitcnt vmcnt(0)" ::: "memory");
    __syncthreads();
#pragma unroll 1
    for (int hf = 0; hf < 2; ++hf) {
      nsa_qk(sacc, qf, lds, hf, fr, fq);
      float imp[2] = {0.f, 0.f}, car[2] = {0.f, 0.f};
#pragma unroll
      for (int mi = 0; mi < 4; ++mi) {
        const float slope = slope0 * (1.f / (float)(1 << mi));
#pragma unroll
        for (int ni = 0; ni < 2; ++ni) {
#pragma unroll
          for (int j = 0; j < 4; ++j) {
            const int jj = jt * 64 + hf * 32 + ni * 16 + 4 * fq + j; const bool ok = (16 * jj + 31 <= tc);
            const float v = sacc[mi][ni][j] - slope * ((float)tc - (16.f * jj + 15.5f));
            sacc[mi][ni][j] = ok ? __builtin_amdgcn_exp2f(v - m_run[mi]) * invl[mi] : 0.f;
          }
          imp[ni] += (sacc[mi][ni][0] + sacc[mi][ni][1]) + sacc[mi][ni][2] + 0.5f * sacc[mi][ni][3]; car[ni] += 0.5f * sacc[mi][ni][3];
        }
      }
      nsa_pv(oacc, sacc, lds, pw, hf, fr, fq);
#pragma unroll
      for (int ni = 0; ni < 2; ++ni) {
        const int sb = jt * 16 + hf * 8 + ni * 4 + fq; float* pp = PSLC + (wid * 16 + fr) * 64 + sb;
        atomicAdd(pp, imp[ni]);
        if (sb < 63) atomicAdd(pp + 1, car[ni]);
      }
    }
  }
  int frc = fr; asm volatile("" : "+v"(frc));
  {
    const size_t n = nb + t0 + wid * 16 + frc;
#pragma unroll
    for (int mi = 0; mi < 4; ++mi) {
      const int hh = g * 4 + mi; const float gt = sigmoidf_(a.SM[n * 32 + 8 + hh * 3]);
#pragma unroll
      for (int ni = 0; ni < 4; ++ni) {
        bf16_t* dp = a.ANS + n * 512 + hh * 64 + ni * 16 + 4 * fq; const u32x2 pr = *(const u32x2*)dp;
        f32x4 r = oacc[mi][ni] * gt;
        r[0] += __uint_as_float(pr.x << 16); r[1] += __uint_as_float(pr.x & 0xffff0000u); r[2] += __uint_as_float(pr.y << 16); r[3] += __uint_as_float(pr.y & 0xffff0000u);
        st_bf4(dp, r);
      }
    }
  }
  __syncthreads();
  {
    int tsel = tid, isel = i; asm volatile("" : "+v"(tsel), "+v"(isel));
    const int q = tsel >> 2, sub = tsel & 3;
    float mine[16]; int cnt[16];
#pragma unroll
    for (int k = 0; k < 16; ++k) {
      const int sb = sub * 16 + k; const float ps = PSLC[q * 64 + sb];
      mine[k] = (sb == 0 || sb == isel || sb == isel - 1) ? 1e4f : (sb > isel ? -1e4f : ps); cnt[k] = 0;
    }
#pragma unroll
    for (int k = 0; k < 16; ++k) PSLC[q * 64 + sub * 16 + k] = mine[k];
    __syncthreads();
    for (int s2 = 0; s2 <= isel; ++s2) {
      const float o = PSLC[q * 64 + s2];
#pragma unroll
      for (int k = 0; k < 16; ++k) cnt[k] += (o > mine[k] || (o == mine[k] && s2 < sub * 16 + k)) ? 1 : 0;
    }
    unsigned m16 = 0;
#pragma unroll
    for (int k = 0; k < 16; ++k) m16 |= (cnt[k] < 16 ? 1u : 0u) << k;
    unsigned mlo = (sub < 2) ? (m16 << (16 * sub)) : 0u, mhi = (sub >= 2) ? (m16 << (16 * (sub - 2))) : 0u;
    mlo |= __shfl_xor(mlo, 1); mlo |= __shfl_xor(mlo, 2); mhi |= __shfl_xor(mhi, 1); mhi |= __shfl_xor(mhi, 2);
    u64 m64 = ((u64)mhi << 32) | (u64)mlo;
    m64 &= (isel == 63) ? ~0ull : ((2ull << isel) - 1ull);
    if (sub == 0) SELM[q] = m64;
    u64 un = m64;
#pragma unroll
    for (int o = 4; o < 64; o <<= 1) un |= __shfl_xor(un, o);
    if (lane == 0) UNI[wid] = un;
  }
  __syncthreads();
  const u64 uni = UNI[0] | UNI[1] | UNI[2] | UNI[3];
#pragma unroll
  for (int mi = 0; mi < 4; ++mi)
#pragma unroll
    for (int ks = 0; ks < 2; ++ks) qf[mi][ks] = *(const bf16x8*)(a.NQ + (size_t)(nb + t0 + mi * 16 + fr) * 512 + h * 64 + ks * 32 + fq * 8);
#pragma unroll 1
  for (int br = 1; br <= 1; ++br) {
#pragma unroll
    for (int mi = 0; mi < 4; ++mi) { m_run[mi] = -1e30f; l_run[mi] = 0.f;
#pragma unroll
      for (int ni = 0; ni < 4; ++ni) oacc[mi][ni] = (f32x4){0.f, 0.f, 0.f, 0.f}; }
    const bf16_t* Kb = (br == 1 ? a.KS : a.KW) + (size_t)nb * 128 + g * 64;
    const bf16_t* Vb = (br == 1 ? a.VST : a.VWT) + ((size_t)(b * 128 + g * 64) << 12);
    u64 todo;
    if (br == 1) todo = uni;
    else { const int lo = i >= 8 ? i - 8 : 0; todo = ((i == 63) ? ~0ull : ((2ull << i) - 1ull)) & ~((1ull << lo) - 1ull); }
    int cur = __builtin_ctzll(todo), bsel = 0;
    if (tid == 0) xch[half] = __builtin_popcountll(todo);
    __syncthreads();
    const int ntile = max(xch[0], xch[1]);
    nsa_load_tile<true>(Kb + (size_t)cur * 64 * 128, 128u, Vb + cur * 64, 4096u, lds, tid);
    for (int kt = 0; kt < ntile; ++kt) {
      int nxt = -1;
      if (cur >= 0) { todo &= todo - 1ull; nxt = todo ? __builtin_ctzll(todo) : -1; }
      asm volatile("s_waitcnt vmcnt(0)" ::: "memory");
      __syncthreads();
      if (cur < 0) continue;
      char* tb = bsel ? (lds + 49152) : lds;
      if (nxt >= 0) nsa_load_tile<true>(Kb + (size_t)nxt * 64 * 128, 128u, Vb + nxt * 64, 4096u, bsel ? lds : (lds + 49152), tid);
      const int sb = cur;
#pragma unroll 1
      for (int hf = 0; hf < 2; ++hf) {
        nsa_qk(sacc, qf, tb, hf, fr, fq);
        const bool edge = (sb == i) || (br == 2 && sb == i - 8);
#pragma unroll
        for (int mi = 0; mi < 4; ++mi) {
          const int tq = mi * 16 + fr;
          const bool rsel = (br == 2) || ((SELM[tq] >> sb) & 1ull);
          const float rc = rsel ? -slope * (float)(64 * (i - sb) + tq - hf * 32 - 4 * fq) : -1e30f;
          if (!edge) {
#pragma unroll
            for (int ni = 0; ni < 2; ++ni)
#pragma unroll
              for (int j = 0; j < 4; ++j) sacc[mi][ni][j] += fmaf(slope, (float)(ni * 16 + j), rc);
          } else {
            const int tqh = tq - hf * 32;
#pragma unroll
            for (int ni = 0; ni < 2; ++ni)
#pragma unroll
              for (int j = 0; j < 4; ++j) {
                const int c = ni * 16 + 4 * fq + j;
                const bool okv = (sb == i) ? (c <= tqh) : (c > tqh);
                sacc[mi][ni][j] = okv ? sacc[mi][ni][j] + fmaf(slope, (float)(ni * 16 + j), rc) : -1e30f;
              }
          }
        }
        nsa_online(sacc, m_run, l_run, oacc);
        nsa_pv(oacc, sacc, tb, pw, hf, fr, fq);
      }
      cur = nxt; bsel ^= 1;
    }
    int fre = fr; asm volatile("" : "+v"(fre));
#pragma unroll
    for (int mi = 0; mi < 4; ++mi) {
      const size_t n = nb + t0 + mi * 16 + fre;
      const float l = red4(l_run[mi]); const float sc = sigmoidf_(a.SM[n * 32 + 8 + h * 3 + br]) / l;
#pragma unroll
      for (int ni = 0; ni < 4; ++ni) {
        bf16_t* dp = a.ANS + n * 512 + h * 64 + ni * 16 + 4 * fq; const u32x2 pr = *(const u32x2*)dp;
        f32x4 r = oacc[mi][ni] * sc;
        r[0] += __uint_as_float(pr.x << 16); r[1] += __uint_as_float(pr.x & 0xffff0000u); r[2] += __uint_as_float(pr.y << 16); r[3] += __uint_as_float(pr.y & 0xffff0000u);
        st_bf4(dp, r);
      }
    }
  }
  __syncthreads();
}


__device__ __forceinline__ void nsa_win_item(const MegaArgs& a, int item, char* lds, int tid) {
  asm volatile("" : "+v"(tid));
  const int lane = tid & 63, wid = tid >> 6, fr = lane & 15, fq = lane >> 4;
  const int i = item & 63, g = (item >> 6) & 1, b = item >> 7;
  const int h = g * 4 + wid, nb = b * SEQ, t0 = i * 64, bg = b * 2 + g;
  const float slope = exp2f(-(float)(h + 1)) * 1.4426950408889634f;
  char* pw = lds + 16384 + wid * 8192;
  float* PSLC = (float*)(lds + 49152);
  u64* SELM = (u64*)(lds + 65536);
  u64* UNI = (u64*)(lds + 66048);
  bf16x8 qf[4][2];
#pragma unroll
  for (int mi = 0; mi < 4; ++mi)
#pragma unroll
    for (int ks = 0; ks < 2; ++ks) qf[mi][ks] = *(const bf16x8*)(a.NQ + (size_t)(nb + t0 + mi * 16 + fr) * 512 + h * 64 + ks * 32 + fq * 8);
  f32x4 sacc[4][2], oacc[4][4];
  float m_run[4], l_run[4];
  (void)PSLC; (void)UNI; (void)bg;
  const u64 uni = 0ull;
#pragma unroll 1
  for (int br = 2; br <= 2; ++br) {
#pragma unroll
    for (int mi = 0; mi < 4; ++mi) { m_run[mi] = -1e30f; l_run[mi] = 0.f;
#pragma unroll
      for (int ni = 0; ni < 4; ++ni) oacc[mi][ni] = (f32x4){0.f, 0.f, 0.f, 0.f}; }
    const bf16_t* Kb = (br == 1 ? a.KS : a.KW) + (size_t)nb * 128 + g * 64;
    const bf16_t* Vb = (br == 1 ? a.VST : a.VWT) + ((size_t)(b * 128 + g * 64) << 12);
    u64 todo;
    if (br == 1) todo = uni;
    else { const int lo = i >= 8 ? i - 8 : 0; todo = ((i == 63) ? ~0ull : ((2ull << i) - 1ull)) & ~((1ull << lo) - 1ull); }
    int cur = 63 - __builtin_clzll(todo), bsel = 0;
    __syncthreads();
    nsa_load_tile<true>(Kb + (size_t)cur * 64 * 128, 128u, Vb + cur * 64, 4096u, lds, tid);
    while (cur >= 0) {
      todo &= ~(1ull << cur);
      const int nxt = todo ? 63 - __builtin_clzll(todo) : -1;
      asm volatile("s_waitcnt vmcnt(0)" ::: "memory");
      __syncthreads();
      char* tb = bsel ? (lds + 49152) : lds;
      if (nxt >= 0) nsa_load_tile<true>(Kb + (size_t)nxt * 64 * 128, 128u, Vb + nxt * 64, 4096u, bsel ? lds : (lds + 49152), tid);
      const int sb = cur;
#pragma unroll 1
      for (int hf = 0; hf < 2; ++hf) {
        nsa_qk(sacc, qf, tb, hf, fr, fq);
        const bool edge = (sb == i) || (br == 2 && sb == i - 8);
#pragma unroll
        for (int mi = 0; mi < 4; ++mi) {
          const int tq = mi * 16 + fr;
          const bool rsel = (br == 2) || ((SELM[tq] >> sb) & 1ull);
          const float rc = rsel ? -slope * (float)(64 * (i - sb) + tq - hf * 32 - 4 * fq) : -1e30f;
          if (!edge) {
#pragma unroll
            for (int ni = 0; ni < 2; ++ni)
#pragma unroll
              for (int j = 0; j < 4; ++j) sacc[mi][ni][j] += fmaf(slope, (float)(ni * 16 + j), rc);
          } else {
            const int tqh = tq - hf * 32;
#pragma unroll
            for (int ni = 0; ni < 2; ++ni)
#pragma unroll
              for (int j = 0; j < 4; ++j) {
                const int c = ni * 16 + 4 * fq + j;
                const bool okv = (sb == i) ? (c <= tqh) : (c > tqh);
                sacc[mi][ni][j] = okv ? sacc[mi][ni][j] + fmaf(slope, (float)(ni * 16 + j), rc) : -1e30f;
              }
          }
        }
        nsa_online(sacc, m_run, l_run, oacc);
        nsa_pv(oacc, sacc, tb, pw, hf, fr, fq);
      }
      cur = nxt; bsel ^= 1;
    }
#pragma unroll
    for (int mi = 0; mi < 4; ++mi) {
      const size_t n = nb + t0 + mi * 16 + fr;
      const float l = red4(l_run[mi]); const float sc = sigmoidf_(a.SM[n * 32 + 8 + h * 3 + br]) / l;
#pragma unroll
      for (int ni = 0; ni < 4; ++ni) {
        st_bf4(a.ANS + n * 512 + h * 64 + ni * 16 + 4 * fq, oacc[mi][ni] * sc);
      }
    }
  }
  __syncthreads();
}


__device__ __forceinline__ int img_off(int row, int k) { return row * 128 + ((((k >> 3) ^ ((row >> 1) & 7))) << 4) + (k & 7) * 2; }
__device__ __forceinline__ bf16x8 img_frag(const char* img, int r0, int ks, int fr, int fq) { return *(const bf16x8*)(img + (r0 + fr) * 128 + (((ks * 4 + fq) ^ (fr >> 1)) << 4)); }


__device__ __forceinline__ void stage_raw(const bf16_t* __restrict__ QK, int nb, int t0, int chbase, char* raw, int tid) {
  u32x4 v[5];
#pragma unroll
  for (int i = 0; i < 5; ++i) {
    const int c = tid + 256 * i, row = c >> 4, cc = c & 15, t = t0 - 3 + row;
    v[i] = (c < 1072 && t >= 0) ? *(const u32x4*)(QK + (size_t)(nb + t) * 1024 + chbase + cc * 8) : (u32x4){0u, 0u, 0u, 0u};
  }
#pragma unroll
  for (int i = 0; i < 5; ++i) { const int c = tid + 256 * i; if (c < 1072) *(u32x4*)(raw + c * 16) = v[i]; }
}
template <class Put>
__device__ __forceinline__ void conv_col(const char* raw, const float* __restrict__ conv, int j0, int nj, int ch, int d, float scale, Put put) {
  const float w0 = conv[ch], w1 = conv[1024 + ch], w2 = conv[2048 + ch], w3 = conv[3072 + ch];
  const bf16_t* r = (const bf16_t*)raw + d;
  float x0 = bf2f(r[(j0 + 0) * 128]), x1 = bf2f(r[(j0 + 1) * 128]), x2 = bf2f(r[(j0 + 2) * 128]);
  for (int j = j0; j < j0 + nj; ++j) {
    const float x3 = bf2f(r[(j + 3) * 128]);
    put(j, siluf_(w0 * x0 + w1 * x1 + w2 * x2 + w3 * x3) * scale);
    x0 = x1; x1 = x2; x2 = x3;
  }
}

__device__ __forceinline__ void ml_dc_item(const MegaArgs& a, const MlArgs& ml, int item, char* lds, int tid) {
  asm volatile("" : "+v"(tid));
  const int lane = tid & 63, wid = tid >> 6, wr = wid >> 1, wc = wid & 1, fr = lane & 15, fq = lane >> 4;
  const int bh = item >> 6, c = item & 63, b = bh >> 2, h = bh & 3, nb = b * SEQ, t0 = c * 64;
  char* KT = lds; char* VT = lds + 16384; float* sc = (float*)(lds + 32768); float* dnp = (float*)(lds + 33792);
  if (tid < 64) {
    const size_t n = nb + t0 + tid;
    sc[tid] = a.SM[n * 32 + h] + ml.b_i[h];
    sc[64 + tid] = logsigmoidf_(a.SM[n * 32 + 4 + h] + ml.b_f[h]);
  }
  __syncthreads();
  if (tid < 64) {
    float cs = sc[64 + tid];
#pragma unroll
    for (int o = 1; o < 64; o <<= 1) { const float up = __shfl_up(cs, o); if (tid >= o) cs += up; }
    const float bl = __shfl(cs, 63);
    const float lw = bl - cs + sc[tid];
    const float mx = wave_max(lw);
    sc[128 + tid] = cs; sc[192 + tid] = __expf(lw - mx);
    if (tid == 0) { ml.BL[bh * 64 + c] = bl; ml.MX[bh * 64 + c] = mx; }
  }
  __syncthreads();
  if (tid < 64) { ml.BCUM[bh * SEQ + t0 + tid] = sc[128 + tid]; ml.IP[bh * SEQ + t0 + tid] = sc[tid]; }
  char* RAW = lds + 36864;
  stage_raw(a.QK, nb, t0, 512 + h * 128, RAW, tid);
  __syncthreads();
  {
    const int d = tid & 127, jh = tid >> 7;
    float dn = 0.f;
    conv_col(RAW, ml.conv, jh * 32, 32, 512 + h * 128 + d, d, 0.08838834764831845f,
             [&](int j, float v) { *(bf16_t*)(KT + img_off(d, j)) = f2bf(v); dn += sc[192 + j] * v; });
    dnp[jh * 128 + d] = dn;
    {
      bf16_t tv[32];
#pragma unroll
      for (int u = 0; u < 32; ++u) tv[u] = a.V[(size_t)(nb + t0 + jh * 32 + u) * 512 + h * 128 + d];
#pragma unroll
      for (int u = 0; u < 32; ++u) *(bf16_t*)(VT + img_off(d, jh * 32 + u)) = f2bf(sc[192 + jh * 32 + u] * bf2f(tv[u]));
    }
  }
  __syncthreads();
  if (tid < 128) ml.NST[(size_t)(bh * 64 + c) * 128 + tid] = dnp[tid] + dnp[128 + tid];
  f32x4 acc[4][4]; zero_acc(acc);
#pragma unroll
  for (int ks = 0; ks < 2; ++ks) {
    bf16x8 av[4], bk[4];
#pragma unroll
    for (int i = 0; i < 4; ++i) { av[i] = img_frag(VT, wr * 64 + i * 16, ks, fr, fq); bk[i] = img_frag(KT, wc * 64 + i * 16, ks, fr, fq); }
#pragma unroll
    for (int i = 0; i < 4; ++i)
#pragma unroll
      for (int j = 0; j < 4; ++j) acc[i][j] = __builtin_amdgcn_mfma_f32_16x16x32_bf16(bk[j], av[i], acc[i][j], 0, 0, 0);
  }
  bf16_t* cst = ml.CST + (size_t)(bh * 64 + c) * 16384;
#pragma unroll
  for (int mi = 0; mi < 4; ++mi)
#pragma unroll
    for (int ni = 0; ni < 4; ++ni) st_bf4(cst + (wr * 64 + mi * 16 + fr) * 128 + wc * 64 + ni * 16 + 4 * fq, acc[mi][ni]);
  __syncthreads();
}

__device__ __forceinline__ void ml_scan_item(const MlArgs& ml, int item, int tid) {
  const int bh = item / 17, part = item % 17;
  float m = 0.f;
  if (part < 16) {
    float run[4] = {0.f, 0.f, 0.f, 0.f};
#pragma unroll 1
    for (int c0 = 0; c0 < 64; c0 += 8) {
      u32x2 vb[8]; float bl[8], mxv[8];
#pragma unroll
      for (int u = 0; u < 8; ++u) {
        vb[u] = *(const u32x2*)(ml.CST + (size_t)(bh * 64 + c0 + u) * 16384 + part * 1024 + tid * 4);
        bl[u] = ml.BL[bh * 64 + c0 + u]; mxv[u] = ml.MX[bh * 64 + c0 + u];
      }
#pragma unroll
      for (int u = 0; u < 8; ++u) {
        const float mn = fmaxf(bl[u] + m, mxv[u]), decay = __expf(bl[u] + m - mn), scl = __expf(mxv[u] - mn);
        u32x2 o; o.x = pk2bf(run[0], run[1]); o.y = pk2bf(run[2], run[3]);
        *(u32x2*)(ml.CST + (size_t)(bh * 64 + c0 + u) * 16384 + part * 1024 + tid * 4) = o;
        run[0] = decay * run[0] + scl * __uint_as_float(vb[u].x << 16); run[1] = decay * run[1] + scl * __uint_as_float(vb[u].x & 0xffff0000u);
        run[2] = decay * run[2] + scl * __uint_as_float(vb[u].y << 16); run[3] = decay * run[3] + scl * __uint_as_float(vb[u].y & 0xffff0000u);
        if (part == 0 && tid == 0) ml.MST[bh * 64 + c0 + u] = m;
        m = mn;
      }
    }
  } else if (tid < 128) {
    float run = 0.f;
    for (int c = 0; c < 64; ++c) {
      const float bl = ml.BL[bh * 64 + c], mx = ml.MX[bh * 64 + c];
      const float mn = fmaxf(bl + m, mx), decay = __expf(bl + m - mn), scl = __expf(mx - mn);
      float* p = ml.NST + (size_t)(bh * 64 + c) * 128 + tid;
      const float v = *p; *p = run; run = decay * run + scl * v;
      m = mn;
    }
  }
}

__device__ __forceinline__ void ml_out_item(const MegaArgs& a, const MlArgs& ml, int item, char* lds, int tid) {
  asm volatile("" : "+v"(tid));
  const int lane = tid & 63, wid = tid >> 6, wr = wid >> 1, wc = wid & 1, fr = lane & 15, fq = lane >> 4;
  const int bh = item >> 6, c = item & 63, b = bh >> 2, h = bh & 3, nb = b * SEQ, t0 = c * 64;
  char* Qi = lds; char* Ki = lds + 16384; char* VT = lds + 32768; char* SP = lds + 49152;
  float* sc = (float*)(lds + 57344);
  float* H = (float*)lds;
  {
    char* RAW = lds + 49152;
    const int d = tid & 127, jh = tid >> 7;
    stage_raw(a.QK, nb, t0, h * 128, RAW, tid);
    {
      bf16_t tv[32];
#pragma unroll
      for (int u = 0; u < 32; ++u) tv[u] = a.V[(size_t)(nb + t0 + jh * 32 + u) * 512 + h * 128 + d];
#pragma unroll
      for (int u = 0; u < 32; ++u) *(bf16_t*)(VT + img_off(d, jh * 32 + u)) = tv[u];
    }
    __syncthreads();
    conv_col(RAW, ml.conv, jh * 32, 32, h * 128 + d, d, 1.f, [&](int j, float v) { *(bf16_t*)(Qi + (d >> 6) * 8192 + img_off(j, d & 63)) = f2bf(v); });
    __syncthreads();
    stage_raw(a.QK, nb, t0, 512 + h * 128, RAW, tid);
    __syncthreads();
    conv_col(RAW, ml.conv, jh * 32, 32, 512 + h * 128 + d, d, 0.08838834764831845f, [&](int j, float v) { *(bf16_t*)(Ki + (d >> 6) * 8192 + img_off(j, d & 63)) = f2bf(v); });
    __syncthreads();
  }
  if (tid < 64) { sc[tid] = ml.BCUM[bh * SEQ + t0 + tid]; sc[64 + tid] = ml.IP[bh * SEQ + t0 + tid]; }
  if (tid < 128) sc[448 + tid] = ml.NST[(size_t)(bh * 64 + c) * 128 + tid];
  __syncthreads();
  const float m = ml.MST[bh * 64 + c];
  if (tid < 64) {
    const float bj = sc[tid]; float mxi = -INFINITY;
    for (int s2 = 0; s2 <= tid; ++s2) mxi = fmaxf(mxi, bj - sc[s2] + sc[64 + s2]);
    const float inter = bj + m, mt = fmaxf(mxi, inter);
    sc[128 + tid] = mt; sc[192 + tid] = __expf(inter - mt);
  } else if (tid < 128) {
    const int t = tid - 64; float nq = 0.f;
    for (int k = 0; k < 128; ++k) nq += sc[448 + k] * bf2f(*(const bf16_t*)(Qi + (k >> 6) * 8192 + img_off(t, k & 63)));
    sc[384 + t] = nq;
  }
  f32x4 sacc[2][2];
#pragma unroll
  for (int i = 0; i < 2; ++i)
#pragma unroll
    for (int j = 0; j < 2; ++j) sacc[i][j] = (f32x4){0.f, 0.f, 0.f, 0.f};
#pragma unroll
  for (int kt = 0; kt < 2; ++kt)
#pragma unroll
    for (int ks = 0; ks < 2; ++ks) {
      bf16x8 aq[2], bk[2];
#pragma unroll
      for (int i = 0; i < 2; ++i) { aq[i] = img_frag(Qi + kt * 8192, wr * 32 + i * 16, ks, fr, fq); bk[i] = img_frag(Ki + kt * 8192, wc * 32 + i * 16, ks, fr, fq); }
#pragma unroll
      for (int i = 0; i < 2; ++i)
#pragma unroll
        for (int j = 0; j < 2; ++j) sacc[i][j] = __builtin_amdgcn_mfma_f32_16x16x32_bf16(bk[j], aq[i], sacc[i][j], 0, 0, 0);
    }
  __syncthreads();
  const bf16_t* cst = ml.CST + (size_t)(bh * 64 + c) * 16384;
#pragma unroll
  for (int i = 0; i < 4; ++i) { const int idx = tid + 256 * i, row = idx >> 3, lc = (idx & 7) ^ ((row >> 1) & 7); glds16(cst + row * 128 + lc * 8, Ki + idx * 16); }
#pragma unroll
  for (int mi = 0; mi < 2; ++mi) {
    const int t = wr * 32 + mi * 16 + fr; const float bt = sc[t], mt = sc[128 + t]; float rsum = 0.f;
#pragma unroll
    for (int ni = 0; ni < 2; ++ni) {
      const int s0 = wc * 32 + ni * 16 + 4 * fq; f32x4 p;
#pragma unroll
      for (int j = 0; j < 4; ++j) { const int s2 = s0 + j; p[j] = (s2 <= t) ? sacc[mi][ni][j] * __expf(bt - sc[s2] + sc[64 + s2] - mt) : 0.f; rsum += p[j]; }
      u32x2 o; o.x = pk2bf(p[0], p[1]); o.y = pk2bf(p[2], p[3]);
      *(u32x2*)(SP + img_off(t, s0)) = o;
    }
    rsum += __shfl_xor(rsum, 16); rsum += __shfl_xor(rsum, 32);
    if (fq == 0) sc[256 + t * 2 + wc] = rsum;
  }
  asm volatile("s_waitcnt vmcnt(0)" ::: "memory");
  __syncthreads();
  f32x4 acc1[2][4], acc2[2][4];
#pragma unroll
  for (int i = 0; i < 2; ++i)
#pragma unroll
    for (int j = 0; j < 4; ++j) { acc1[i][j] = (f32x4){0.f, 0.f, 0.f, 0.f}; acc2[i][j] = (f32x4){0.f, 0.f, 0.f, 0.f}; }
#pragma unroll
  for (int ks = 0; ks < 2; ++ks) {
    bf16x8 as[2], bv[4];
#pragma unroll
    for (int i = 0; i < 2; ++i) as[i] = img_frag(SP, wr * 32 + i * 16, ks, fr, fq);
#pragma unroll
    for (int j = 0; j < 4; ++j) bv[j] = img_frag(VT, wc * 64 + j * 16, ks, fr, fq);
#pragma unroll
    for (int i = 0; i < 2; ++i)
#pragma unroll
      for (int j = 0; j < 4; ++j) acc1[i][j] = __builtin_amdgcn_mfma_f32_16x16x32_bf16(bv[j], as[i], acc1[i][j], 0, 0, 0);
  }
#pragma unroll 1
  for (int kt = 0; kt < 2; ++kt) {
    if (kt == 1) {
      __syncthreads();
#pragma unroll
      for (int i = 0; i < 4; ++i) { const int idx = tid + 256 * i, row = idx >> 3, lc = (idx & 7) ^ ((row >> 1) & 7); glds16(cst + row * 128 + 64 + lc * 8, Ki + idx * 16); }
      asm volatile("s_waitcnt vmcnt(0)" ::: "memory");
      __syncthreads();
    }
#pragma unroll
    for (int ks = 0; ks < 2; ++ks) {
      bf16x8 aq[2], bc[4];
#pragma unroll
      for (int i = 0; i < 2; ++i) aq[i] = img_frag(Qi + kt * 8192, wr * 32 + i * 16, ks, fr, fq);
#pragma unroll
      for (int j = 0; j < 4; ++j) bc[j] = img_frag(Ki, wc * 64 + j * 16, ks, fr, fq);
#pragma unroll
      for (int i = 0; i < 2; ++i)
#pragma unroll
        for (int j = 0; j < 4; ++j) acc2[i][j] = __builtin_amdgcn_mfma_f32_16x16x32_bf16(bc[j], aq[i], acc2[i][j], 0, 0, 0);
    }
  }
  __syncthreads();
#pragma unroll
  for (int mi = 0; mi < 2; ++mi) {
    const int t = wr * 32 + mi * 16 + fr; const float wi = sc[192 + t];
    const float den = sc[256 + t * 2] + sc[256 + t * 2 + 1] + wi * sc[384 + t];
    const float inv = 1.f / fmaxf(fabsf(den), __expf(-sc[128 + t]));
#pragma unroll
    for (int ni = 0; ni < 4; ++ni) *(f32x4*)(H + t * 132 + wc * 64 + ni * 16 + 4 * fq) = (acc1[mi][ni] + acc2[mi][ni] * wi) * inv;
  }
  __syncthreads();
  {
    bf16_t og0[16], og1[16];
#pragma unroll
    for (int r = 0; r < 16; ++r) { const size_t n = nb + t0 + wid * 16 + r; og0[r] = a.O[n * 512 + h * 128 + lane]; og1[r] = a.O[n * 512 + h * 128 + 64 + lane]; }
    const float g0 = ml.gain[h * 128 + lane], g1 = ml.gain[h * 128 + 64 + lane];
#pragma unroll
    for (int r = 0; r < 16; ++r) {
      const int j = wid * 16 + r;
      const float a0 = H[j * 132 + lane], a1 = H[j * 132 + 64 + lane];
      const float ss = wave_sum(a0 * a0 + a1 * a1);
      const float rs = rsqrtf(ss * (1.f / 128.f) + EPS);
      const size_t n = nb + t0 + j; const int c0 = h * 128 + lane, c1 = c0 + 64;
      a.AML[n * 512 + c0] = f2bf(sigmoidf_(bf2f(og0[r])) * a0 * rs * g0);
      a.AML[n * 512 + c1] = f2bf(sigmoidf_(bf2f(og1[r])) * a1 * rs * g1);
    }
  }
  __syncthreads();
}


struct EpiX1 {
  static constexpr bool PERM = false, AFTER_DRAIN = false;
  const bf16_t* XB; bf16_t* X1B; float* PS2;
  __device__ __forceinline__ void operator()(const f32x4 (&acc)[2][2][4][2], const pg8::Unit& u, int wr, int wc, int fr, int fq) const {
    const int c8 = (fq & 1) * 16 + (fq >> 1) * 8;
    const size_t base = (size_t)(u.pm * 256 + wr * 64 + fr) * 1024 + u.pn * 256 + wc * 32 + c8;
    u32x4 xr[16];
#pragma unroll
    for (int i = 0; i < 16; ++i) xr[i] = *(const u32x4*)(XB + base + (size_t)((i >> 3) * 128 + ((i >> 1) & 3) * 16) * 1024 + (i & 1) * 128);
#pragma unroll
    for (int ai = 0; ai < 2; ++ai)
#pragma unroll
      for (int m = 0; m < 4; ++m) {
        const int row = u.pm * 256 + ai * 128 + wr * 64 + m * 16 + fr;
#pragma unroll
        for (int bj = 0; bj < 2; ++bj) {
          const size_t off = base + (size_t)(ai * 128 + m * 16) * 1024 + bj * 128;
          float v[8], x8[8]; swap8(acc[ai][bj][m][0], acc[ai][bj][m][1], v); bf8_to_f32(xr[ai * 8 + m * 2 + bj], x8);
          float ss = 0.f;
#pragma unroll
          for (int j = 0; j < 8; ++j) { v[j] += x8[j]; ss += v[j] * v[j]; }
          __builtin_nontemporal_store(pk8bf(v), (u32x4*)(X1B + off));
          ss += __shfl_xor(ss, 16); ss += __shfl_xor(ss, 32);
          if (fq == 0) PS2[(size_t)row * 32 + u.pn * 8 + bj * 4 + wc] = ss;
        }
      }
  }
};
struct EpiXQ {
  static constexpr bool PERM = false, AFTER_DRAIN = false;
  bf16_t* XQ; const PG8_LAS float* rsl;
  __device__ __forceinline__ void operator()(const f32x4 (&acc)[2][2][4][2], const pg8::Unit& u, int wr, int wc, int fr, int fq) const {
#pragma unroll
    for (int ai = 0; ai < 2; ++ai)
#pragma unroll
      for (int m = 0; m < 4; ++m) {
        const int rl = ai * 128 + wr * 64 + m * 16 + fr, row = u.pm * 256 + rl;
        const float rs = rsl[rl];
#pragma unroll
        for (int bj = 0; bj < 2; ++bj) st_bf8_pair(XQ + (size_t)row * 1024 + u.pn * 256 + bj * 128 + wc * 32, fq, acc[ai][bj][m][0] * rs, acc[ai][bj][m][1] * rs);
      }
  }
};
struct EpiX2 {
  static constexpr bool PERM = false, AFTER_DRAIN = false;
  bf16_t* X1B;
  __device__ __forceinline__ void operator()(const f32x4 (&acc)[2][2][4][2], const pg8::Unit& u, int wr, int wc, int fr, int fq) const {
    const int c8 = (fq & 1) * 16 + (fq >> 1) * 8;
    bf16_t* const base = X1B + (size_t)(u.pm * 256 + wr * 64 + fr) * 1024 + u.pn * 256 + wc * 32 + c8;
    u32x4 xr[16];
#pragma unroll
    for (int i = 0; i < 16; ++i) xr[i] = *(const u32x4*)(base + (size_t)((i >> 3) * 128 + ((i >> 1) & 3) * 16) * 1024 + (i & 1) * 128);
#pragma unroll
    for (int ai = 0; ai < 2; ++ai)
#pragma unroll
      for (int m = 0; m < 4; ++m)
#pragma unroll
        for (int bj = 0; bj < 2; ++bj) {
          float v[8], x8[8]; swap8(acc[ai][bj][m][0], acc[ai][bj][m][1], v); bf8_to_f32(xr[ai * 8 + m * 2 + bj], x8);
#pragma unroll
          for (int j = 0; j < 8; ++j) v[j] += x8[j];
          __builtin_nontemporal_store(pk8bf(v), (u32x4*)(base + (size_t)(ai * 128 + m * 16) * 1024 + bj * 128));
        }
  }
};
struct MapMN {
  const bf16_t* A; const bf16_t* Bt; int K, xcd;
  __device__ __forceinline__ void avoff(const pg8::Unit&, int, int K, const unsigned (&voffA)[2], unsigned (&v0)[2], unsigned (&v1)[2]) const { v0[0] = voffA[0]; v0[1] = voffA[1]; v1[0] = voffA[0] + 256u * K; v1[1] = voffA[1] + 256u * K; }
  __device__ __forceinline__ void operator()(int idx, pg8::Unit& u) const {
    u.pm = xcd * 8 + (idx & 7); u.pn = idx >> 3;
    u.aptr = (const char*)(A + (size_t)u.pm * 256 * K); u.bptr = (const char*)(Bt + (size_t)u.pn * 256 * K);
  }
};

struct MapInProj {
  const bf16_t* XB; const bf16_t* WinT; int xcd;
  __device__ __forceinline__ void avoff(const pg8::Unit&, int, int K, const unsigned (&voffA)[2], unsigned (&v0)[2], unsigned (&v1)[2]) const { v0[0] = voffA[0]; v0[1] = voffA[1]; v1[0] = voffA[0] + 256u * K; v1[1] = voffA[1] + 256u * K; }
  __device__ __forceinline__ void operator()(int idx, pg8::Unit& u) const {
    u.pm = xcd * 8 + (idx & 7); u.pn = idx >> 3;
    const char* tokp = (const char*)(XB + (size_t)u.pm * 256 * DM); const char* colp = (const char*)(WinT + (size_t)u.pn * 256 * DM);
    if (u.pn == 12) { u.aptr = colp; u.bptr = tokp; } else { u.aptr = tokp; u.bptr = colp; }
  }
};
struct EpiInProj8 {
  static constexpr bool PERM = false, AFTER_DRAIN = false;
  bf16_t *QK, *V, *O, *NQ, *KVC, *KS, *KW, *VST, *VWT; float* SM; const float* RS1;
  __device__ __forceinline__ void operator()(const f32x4 (&acc)[2][2][4][2], const pg8::Unit& u, int wr, int wc, int fr, int fq) const {
    if (u.pn == 12) {
#pragma unroll
      for (int bj = 0; bj < 2; ++bj) {
        const int tok = u.pm * 256 + bj * 128 + wc * 32;
        const f32x4 rs0 = *(const f32x4*)(RS1 + tok + 4 * fq), rs1 = *(const f32x4*)(RS1 + tok + 16 + 4 * fq);
        const int b = tok >> 12, t = tok & 4095;
#pragma unroll
        for (int ai = 0; ai < 2; ++ai)
#pragma unroll
          for (int m = 0; m < 4; ++m) st_bf8_pair((ai ? VWT : VST) + ((size_t)(b * 128 + wr * 64 + m * 16 + fr) << 12) + t, fq, acc[ai][bj][m][0] * rs0, acc[ai][bj][m][1] * rs1);
      }
      return;
    }
    float rsv[8];
#pragma unroll
    for (int i = 0; i < 8; ++i) rsv[i] = RS1[u.pm * 256 + (i >> 2) * 128 + wr * 64 + (i & 3) * 16 + fr];
#pragma unroll
    for (int bj = 0; bj < 2; ++bj) {
      const int nh = u.pn * 256 + bj * 128;
      bf16_t* dst; int ld, cofs; float scale = 1.f;
      if (nh < 1024) { dst = QK; ld = 1024; cofs = nh; }
      else if (nh < 1536) { dst = V; ld = 512; cofs = nh - 1024; }
      else if (nh < 2048) { dst = O; ld = 512; cofs = nh - 1536; }
      else if (nh < 2560) { dst = NQ; ld = 512; cofs = nh - 2048; scale = 0.125f * 1.4426950408889634f; }
      else if (nh < 2816) { dst = KVC; ld = 256; cofs = nh - 2560; }
      else if (nh < 2944) { dst = KS; ld = 128; cofs = 0; }
      else if (nh < 3072) { dst = KW; ld = 128; cofs = 0; }
      else { dst = nullptr; ld = 0; cofs = 0; }
      if (!dst && nh != 3328) continue;
#pragma unroll
      for (int ai = 0; ai < 2; ++ai)
#pragma unroll
        for (int m = 0; m < 4; ++m) {
          const int row = u.pm * 256 + ai * 128 + wr * 64 + m * 16 + fr; const float rs = rsv[ai * 4 + m] * scale;
          if (dst) {
            st_bf8_pair(dst + (size_t)row * ld + cofs + wc * 32, fq, acc[ai][bj][m][0] * rs, acc[ai][bj][m][1] * rs);
          } else if (wc == 0) {
#pragma unroll
            for (int n = 0; n < 2; ++n) *(f32x4*)(SM + (size_t)row * 32 + n * 16 + 4 * fq) = acc[ai][bj][m][n] * rs;
          }
        }
    }
  }
};

struct MapMoe {
  const int* CNT; const int* LIST; const bf16_t* Abase; const bf16_t* W; size_t wstride; int K, xcd, gather;
  __device__ __forceinline__ void operator()(int idx, pg8::Unit& u) const {
    int g = (idx >> 2) * 8 + xcd, e = 0, ce = 0, pre = 0;
    u.pm = g;
    int cn[16];
#pragma unroll
    for (int k = 0; k < 16; ++k) cn[k] = CNT[k];
    bool fnd = false;
#pragma unroll
    for (int k = 0; k < 16; ++k) {
      const int np = (cn[k] + 255) >> 8;
      const bool stop = !fnd && (g < np || k == 15);
      if (stop) { e = k; ce = cn[k]; fnd = true; }
      if (!fnd) { g -= np; pre += cn[k]; }
    }
    u.e = e; u.ce = ce; u.rt = g; u.p0 = pre + g * 256; u.pn = idx & 3;
    u.bptr = (const char*)(W + (size_t)e * wstride + (size_t)u.pn * 256 * K);
    u.aptr = gather ? (const char*)Abase : (const char*)(Abase + (size_t)u.p0 * K);
  }
  __device__ __forceinline__ void avoff(const pg8::Unit& u, int tid, int K_, const unsigned (&voffA)[2], unsigned (&v0)[2], unsigned (&v1)[2]) const {
    if (!gather) { v0[0] = voffA[0]; v0[1] = voffA[1]; v1[0] = voffA[0] + 256u * K_; v1[1] = voffA[1] + 256u * K_; return; }
#pragma unroll
    for (int i = 0; i < 2; ++i) {
      int R, C; pg8::stage_rc(tid * 16 + i * 8192, R, C);
      int m0_ = u.rt * 256 + R, m1_ = m0_ + 128; if (m0_ >= u.ce) m0_ = u.ce - 1; if (m1_ >= u.ce) m1_ = u.ce - 1;
      v0[i] = (unsigned)((LIST[u.e * NTOK + m0_] >> 1) * K_ + C) * 2u; v1[i] = (unsigned)((LIST[u.e * NTOK + m1_] >> 1) * K_ + C) * 2u;
    }
  }
};
struct EpiMoe1 {
  static constexpr bool PERM = false, AFTER_DRAIN = false;
  const int* LIST; const float* RS3; bf16_t* ACT;
  __device__ __forceinline__ void operator()(const f32x4 (&acc)[2][2][4][2], const pg8::Unit& u, int wr, int wc, int fr, int fq) const {
    int tok[8]; float rsv[8];
#pragma unroll
    for (int i = 0; i < 8; ++i) {
      const int ml = u.rt * 256 + (i >> 2) * 128 + wr * 64 + (i & 3) * 16 + fr;
      tok[i] = LIST[u.e * NTOK + min(ml, u.ce - 1)] >> 1;
    }
#pragma unroll
    for (int i = 0; i < 8; ++i) rsv[i] = RS3[tok[i]];
#pragma unroll
    for (int ai = 0; ai < 2; ++ai)
#pragma unroll
      for (int m = 0; m < 4; ++m) {
        const int r = ai * 128 + wr * 64 + m * 16 + fr, ml = u.rt * 256 + r;
        if (ml < u.ce) {
          const float rs = rsv[ai * 4 + m];
#pragma unroll
          for (int bj = 0; bj < 2; ++bj) {
            const f32x4 a1 = acc[ai][bj][m][0] * rs, a3 = acc[ai][bj][m][1] * rs; f32x4 r4;
#pragma unroll
            for (int j = 0; j < 4; ++j) r4[j] = siluf_(a1[j]) * a3[j];
            {
              const unsigned long long pk = (unsigned long long)pk2bf(r4[0], r4[1]) | ((unsigned long long)pk2bf(r4[2], r4[3]) << 32);
              __hip_atomic_store((unsigned long long*)(ACT + (size_t)(u.p0 + r) * 512 + (u.pn * 8 + bj * 4 + wc) * 16 + 4 * fq), pk, __ATOMIC_RELAXED, __HIP_MEMORY_SCOPE_AGENT);
            }
          }
        }
      }
  }
};
struct EpiMoe2 {
  static constexpr bool PERM = false, AFTER_DRAIN = false;
  const int* LIST; const float* RTW; bf16_t* Y;
  __device__ __forceinline__ void operator()(const f32x4 (&acc)[2][2][4][2], const pg8::Unit& u, int wr, int wc, int fr, int fq) const {
    int ent[8]; float wv[8];
#pragma unroll
    for (int i = 0; i < 8; ++i) {
      const int ml = u.rt * 256 + (i >> 2) * 128 + wr * 64 + (i & 3) * 16 + fr;
      ent[i] = LIST[u.e * NTOK + min(ml, u.ce - 1)];
    }
#pragma unroll
    for (int i = 0; i < 8; ++i) wv[i] = RTW[ent[i]];
#pragma unroll
    for (int ai = 0; ai < 2; ++ai)
#pragma unroll
      for (int m = 0; m < 4; ++m) {
        const int r = ai * 128 + wr * 64 + m * 16 + fr, ml = u.rt * 256 + r;
        {
          const int entry = ent[ai * 4 + m]; const float w = wv[ai * 4 + m];
#pragma unroll
          for (int bj = 0; bj < 2; ++bj) {
            const f32x4 v0 = acc[ai][bj][m][0] * w, v1 = acc[ai][bj][m][1] * w;
            const auto sx = __builtin_amdgcn_permlane16_swap(pk2bf(v0[0], v0[1]), pk2bf(v1[0], v1[1]), false, false);
            const auto sy = __builtin_amdgcn_permlane16_swap(pk2bf(v0[2], v0[3]), pk2bf(v1[2], v1[3]), false, false);
            u32x4 o; o.x = sx[0]; o.y = sy[0]; o.z = sx[1]; o.w = sy[1];
            if (ml < u.ce) __builtin_nontemporal_store(o, (u32x4*)(Y + (size_t)entry * 1024 + u.pn * 256 + bj * 128 + wc * 32 + (fq & 1) * 16 + (fq >> 1) * 8));
          }
        }
      }
  }
};

constexpr int DEP_STRIDE = 16;
struct MoeUpSched {
  int first, stride, count; MapMoe map; unsigned* DEP; bool wave0;
  __device__ __forceinline__ bool next(int i, pg8::Unit& u) const { const int idx = first + i * stride; if (idx >= count) return false; map(idx, u); return true; }
  __device__ __forceinline__ void avoff(const pg8::Unit& u, int tid, int K, const unsigned (&voffA)[2], unsigned (&v0)[2], unsigned (&v1)[2]) const { map.avoff(u, tid, K, voffA, v0, v1); }
  __device__ __forceinline__ void a_ready(const pg8::Unit&) const {}
  __device__ __forceinline__ void done(const pg8::Unit& u) const {
    asm volatile("s_waitcnt vmcnt(0)" ::: "memory");
    __builtin_amdgcn_s_barrier();
    if (wave0 && __builtin_amdgcn_mbcnt_hi(~0u, __builtin_amdgcn_mbcnt_lo(~0u, 0u)) == 0u) (void)__hip_atomic_fetch_add(&DEP[u.pm * DEP_STRIDE], 1u, __ATOMIC_RELAXED, __HIP_MEMORY_SCOPE_AGENT);
  }
};
struct MoeDownSched {
  int li, L, n1, r, fp, nfirst; MapMoe map; unsigned* DEP; bool wave0;
  __device__ __forceinline__ bool next(int i, pg8::Unit& u) const {
    const int j = (i < nfirst) ? 2 * (li - r) + i : fp + li + (i - nfirst) * L;
    if (j >= n1) return false; map(j, u); return true;
  }
  __device__ __forceinline__ void avoff(const pg8::Unit& u, int tid, int K, const unsigned (&voffA)[2], unsigned (&v0)[2], unsigned (&v1)[2]) const { map.avoff(u, tid, K, voffA, v0, v1); }
  __device__ __forceinline__ void a_ready(const pg8::Unit& u) const {
    if (!wave0) return;
    unsigned sp = 0;
    while (__hip_atomic_load(&DEP[u.pm * DEP_STRIDE], __ATOMIC_RELAXED, __HIP_MEMORY_SCOPE_AGENT) < 4u) { __builtin_amdgcn_s_sleep(2); if (++sp > (1u << 22)) break; }
    asm volatile("" ::: "memory");
  }
  __device__ __forceinline__ void done(const pg8::Unit&) const {}
};

struct MapP5 {
  const bf16_t *XB, *WgT, *AML, *ANS, *WmlT, *WnsT; int pm, pn;
  __device__ __forceinline__ void avoff(const pg8::Unit&, int, int K, const unsigned (&voffA)[2], unsigned (&v0)[2], unsigned (&v1)[2]) const { v0[0] = voffA[0]; v0[1] = voffA[1]; v1[0] = voffA[0] + 256u * K; v1[1] = voffA[1] + 256u * K; }
  __device__ __forceinline__ void operator()(int idx, pg8::Unit& u) const {
    u.pm = pm; u.pn = pn; u.e = idx;
    if (idx < 2) { u.K = 1024; u.aptr = (const char*)(XB + (size_t)pm * 256 * 1024); u.bptr = (const char*)(WgT + (size_t)(idx * 1024 + pn * 256) * 1024); }
    else { u.K = 512; u.aptr = (const char*)((idx == 2 ? AML : ANS) + (size_t)pm * 256 * 512); u.bptr = (const char*)((idx == 2 ? WmlT : WnsT) + (size_t)pn * 256 * 512); }
  }
};
struct EpiP5 {
  static constexpr bool PERM = false, AFTER_DRAIN = false;
  bf16_t* MRG; bf16_t* G1; const float* RS1;
  __device__ __forceinline__ void operator()(const f32x4 (&acc)[2][2][4][2], const pg8::Unit& u, int wr, int wc, int fr, int fq) const {
    const int c8 = (fq & 1) * 16 + (fq >> 1) * 8;
    if (u.e < 2) {
      bf16_t* G = u.e ? G1 : MRG;
#pragma unroll
      for (int ai = 0; ai < 2; ++ai)
#pragma unroll
        for (int m = 0; m < 4; ++m) {
          const int row = u.pm * 256 + ai * 128 + wr * 64 + m * 16 + fr; const float rs = RS1[row];
#pragma unroll
          for (int bj = 0; bj < 2; ++bj) {
            u32x2 pk[2];
#pragma unroll
            for (int n = 0; n < 2; ++n) {
              const f32x4 g = acc[ai][bj][m][n] * rs;
              pk[n].x = pk2bf(sigmoidf_(g[0]), sigmoidf_(g[1])); pk[n].y = pk2bf(sigmoidf_(g[2]), sigmoidf_(g[3]));
            }
            const auto sx = __builtin_amdgcn_permlane16_swap(pk[0].x, pk[1].x, false, false);
            const auto sy = __builtin_amdgcn_permlane16_swap(pk[0].y, pk[1].y, false, false);
            u32x4 o; o.x = sx[0]; o.y = sy[0]; o.z = sx[1]; o.w = sy[1];
            *(u32x4*)(G + (size_t)row * 1024 + u.pn * 256 + bj * 128 + wc * 32 + c8) = o;
          }
        }
    } else if (u.e == 2) {
      bf16_t* const base = MRG + (size_t)(u.pm * 256 + wr * 64 + fr) * 1024 + u.pn * 256 + wc * 32 + c8;
      u32x4 gr[16];
#pragma unroll
      for (int i = 0; i < 16; ++i) gr[i] = *(const u32x4*)(base + (size_t)((i >> 3) * 128 + ((i >> 1) & 3) * 16) * 1024 + (i & 1) * 128);
#pragma unroll
      for (int ai = 0; ai < 2; ++ai)
#pragma unroll
        for (int m = 0; m < 4; ++m)
#pragma unroll
          for (int bj = 0; bj < 2; ++bj) {
            float v[8], g[8]; swap8(acc[ai][bj][m][0], acc[ai][bj][m][1], v); bf8_to_f32(gr[ai * 8 + m * 2 + bj], g);
#pragma unroll
            for (int j = 0; j < 8; ++j) v[j] *= g[j];
            *(u32x4*)(base + (size_t)(ai * 128 + m * 16) * 1024 + bj * 128) = pk8bf(v);
          }
    } else {
      const size_t boff = (size_t)(u.pm * 256 + wr * 64 + fr) * 1024 + u.pn * 256 + wc * 32 + c8;
#pragma unroll
      for (int ai = 0; ai < 2; ++ai) {
        u32x4 gr[8], tr[8];
#pragma unroll
        for (int i = 0; i < 8; ++i) { const size_t o = boff + (size_t)(ai * 128 + (i >> 1) * 16) * 1024 + (i & 1) * 128; gr[i] = *(const u32x4*)(G1 + o); tr[i] = *(const u32x4*)(MRG + o); }
#pragma unroll
        for (int m = 0; m < 4; ++m)
#pragma unroll
          for (int bj = 0; bj < 2; ++bj) {
            float v[8], g[8], t[8]; swap8(acc[ai][bj][m][0], acc[ai][bj][m][1], v); bf8_to_f32(gr[m * 2 + bj], g); bf8_to_f32(tr[m * 2 + bj], t);
#pragma unroll
            for (int j = 0; j < 8; ++j) v[j] = t[j] + g[j] * v[j];
            __builtin_nontemporal_store(pk8bf(v), (u32x4*)(MRG + boff + (size_t)(ai * 128 + m * 16) * 1024 + bj * 128));
          }
      }
    }
  }
};

#define XB_TMO      128
#define XB_XCNT(j)  (256  + 64 * (j))
#define XB_XSUB(j)  (1280 + 64 * (j))
#define XB_XGEN(j)  (2304 + 64 * (j))
#define XB_TOP      3328
#define XB_TOPGEN   3392
#define XCD_BAR_WORDS 3456
#define XB_SPIN_CAP (1u << 24)
__device__ __forceinline__ unsigned xb_ld(unsigned* p)              { return __hip_atomic_load(p, __ATOMIC_RELAXED, __HIP_MEMORY_SCOPE_AGENT); }
__device__ __forceinline__ unsigned xb_add(unsigned* p, unsigned v) { return __hip_atomic_fetch_add(p, v, __ATOMIC_RELAXED, __HIP_MEMORY_SCOPE_AGENT); }
__device__ __forceinline__ unsigned xb_xcc_id() { return (unsigned)__builtin_amdgcn_s_getreg((3 << 11) | 20) & 0xFu; }
#define XB_SPIN(cond, bar) do { unsigned _sp = 0; while (cond) { __builtin_amdgcn_s_sleep(1); \
    if ((++_sp & 255u) == 0u) { if (xb_ld(&(bar)[XB_TMO])) break; if (_sp > XB_SPIN_CAP) { atomicAdd(&(bar)[XB_TMO], 1u); break; } } } } while (0)
__device__ __forceinline__ void xcd_barrier_complete(unsigned* bar, unsigned x, unsigned G, unsigned& nloc, unsigned& nx) {
  unsigned sum, cnt, mine, sp = 0u;
  for (;;) {
    sum = 0u; cnt = 0u; mine = 0u;
#pragma unroll
    for (unsigned j = 0; j < 16; ++j) { const unsigned c = xb_ld(&bar[XB_XCNT(j)]); sum += c; cnt += (c > 0u) ? 1u : 0u; mine = (j == x) ? c : mine; }
    if (sum == G) break;
    __builtin_amdgcn_s_sleep(1);
    if ((++sp & 255u) == 0u) { if (xb_ld(&bar[XB_TMO])) break; if (sp > XB_SPIN_CAP) { atomicAdd(&bar[XB_TMO], 1u); break; } }
  }
  nloc = mine > 0u ? mine : 1u; nx = cnt > 0u ? cnt : 1u;
}
__device__ __forceinline__ void xcd_barrier(unsigned* bar, unsigned x, volatile unsigned* st, unsigned G, bool leader_thread) {
  asm volatile("s_waitcnt vmcnt(0)" ::: "memory");
  __syncthreads();
  if (leader_thread) {
    __builtin_amdgcn_s_waitcnt(0);
    unsigned nloc = st[0], nx = st[1];
    if (nloc == 0u) { xcd_barrier_complete(bar, x, G, nloc, nx); st[0] = nloc; st[1] = nx; }
    const unsigned old = xb_add(&bar[XB_XSUB(x)], 1u);
    const unsigned gen = old / nloc;
    if (old + 1u == (gen + 1u) * nloc) {
      __builtin_amdgcn_fence(__ATOMIC_RELEASE, "agent");
      asm volatile("s_waitcnt vmcnt(0)" ::: "memory");
      const unsigned og = xb_add(&bar[XB_TOP], 1u);
      const unsigned tg = og / nx;
      if (og + 1u == (tg + 1u) * nx) xb_add(&bar[XB_TOPGEN], 1u);
      else XB_SPIN(xb_ld(&bar[XB_TOPGEN]) == tg, bar);
      __builtin_amdgcn_fence(__ATOMIC_ACQUIRE, "agent");
      xb_add(&bar[XB_XGEN(x)], 1u);
      asm volatile("s_waitcnt vmcnt(0)" ::: "memory");
    } else {
      XB_SPIN(xb_ld(&bar[XB_XGEN(x)]) == gen, bar);
      __builtin_amdgcn_fence(__ATOMIC_ACQUIRE, "agent");
      asm volatile("s_waitcnt vmcnt(0)" ::: "memory");
    }
  }
  __syncthreads();
}

__device__ __forceinline__ void convert_range(const MegaArgs& a, int lo, int hi, int bid, int nblk, char* lds, int tid) {
  for (int it0 = lo; it0 < hi; it0 += nblk) {
    int it = it0 + bid; if (it >= hi) it = hi - 1;
    int r = it, di = 0;
    while (r >= a.td[di].nitems) { r -= a.td[di].nitems; ++di; }
    transpose_item(a.td[di], r, (float*)lds, tid);
  }
}
#define TILE_IDS unsigned tid_z = 0u; asm volatile("" : "+v"(tid_z)); int tid = (wave_s & 3) * 64 + (int)__builtin_amdgcn_mbcnt_hi(~0u, __builtin_amdgcn_mbcnt_lo(~0u, tid_z)); asm volatile("" : "+v"(tid)); const int half = wave_s >> 2; char* const lds = plds + half * HALF_LDS; const int bid = pbid * 2 + half, nblk = pnblk * 2, li = (pbid >> 3) * 2 + half, nloc = (pnblk >> 3) * 2; const int lane = tid & 63, wid = tid >> 6, wr = wid >> 1, wc = wid & 1, fr = lane & 15, fq = lane >> 4; (void)lane; (void)wid; (void)wr; (void)wc; (void)fr; (void)fq; (void)half; (void)lds; (void)bid; (void)nblk; (void)li; (void)nloc

__global__ void __launch_bounds__(512, 2) k_mega(MegaArgs a) {
  extern __shared__ __attribute__((aligned(16))) char lds_raw[];
  char* const plds = lds_raw;
  cg::grid_group grid = cg::this_grid();
  const int pnblk = gridDim.x, pbid = blockIdx.x;
  const int wave_s = __builtin_amdgcn_readfirstlane((int)(threadIdx.x >> 6));
  unsigned* const xbar = a.BAR + a.li * XCD_BAR_WORDS;
  volatile unsigned* const xst = (volatile unsigned*)(plds + CTRL_OFF);
  volatile int* const xch = (volatile int*)(plds + CTRL_OFF + 16);
  unsigned xcc;
  {
    const bool t0 = (wave_s == 0) && ((int)__builtin_amdgcn_mbcnt_hi(~0u, __builtin_amdgcn_mbcnt_lo(~0u, 0u)) == 0);
    if (t0) { xst[0] = 0u; xst[1] = 0u; }
    xcc = xb_xcc_id();
    if (t0) (void)xb_add(&xbar[XB_XCNT(xcc)], 1u);
    grid.sync();
  }
#define PH(k) (a.ph_lo <= (k) && (k) < a.ph_hi)
  const int xcd = pbid & 7;
#define GRID_BAR() do { const int ld_ = (wave_s == 0) && ((int)__builtin_amdgcn_mbcnt_hi(~0u, __builtin_amdgcn_mbcnt_lo(~0u, 0u)) == 0); xcd_barrier(xbar, xcc, xst, (unsigned)pnblk, ld_); } while (0)
#define SYNC_AFTER(k) do { if (PH(k) && PH((k) + 1)) GRID_BAR(); } while (0)
#pragma unroll 1
  for (int rp_ = PH(0) ? a.rep[0] : 0; rp_ > 0; --rp_) {
    TILE_IDS;
    convert_range(a, a.cv_lo[0], a.cv_hi[0], bid, nblk, lds, tid);
    for (int i = bid * 256 + tid; i < (NIN - DIN_A) * 1024 / 8; i += nblk * 256) ((u32x4*)(a.WinT + (size_t)DIN_A * 1024))[i] = (u32x4){0u, 0u, 0u, 0u};
    rows_to_bf16(a.x, a.XB, a.RS1, NTOK, bid * 4 + wid, nblk * 4, lane);
    rows_to_bf16(a.mem, a.MEMB, a.RSM, NB * MEMT, bid * 4 + wid, nblk * 4, lane);
    for (int o = bid * 4 + wid; o < 256; o += nblk * 4) {
      const int which = o >> 7, u = o & 127; const float* pos = which ? a.posv : a.posk; const float* w1 = which ? a.cvw1 : a.ckw1;
      float sacc = 0.f;
      for (int f = lane; f < 2048; f += 64) sacc += pos[f] * w1[(size_t)f * 128 + u];
      sacc = wave_sum(sacc);
      if (lane == 0) a.POSW[o] = sacc;
    }
  }
  SYNC_AFTER(0);
#pragma unroll 1
  for (int rp_ = PH(1) ? a.rep[1] : 0; rp_ > 0; --rp_) {
    TILE_IDS;
    {
      TILE8_IDS;
      ListSched<MapInProj> S8{pbid >> 3, pnblk >> 3, 112, MapInProj{a.XB, a.WinT, xcd}};
      EpiInProj8 E8{a.QK, a.V, a.O, a.NQ, a.KVC, a.KS, a.KW, a.VST, a.VWT, a.SM, a.RS1};
      pg8::gemm_phase<EpiInProj8, ListSched<MapInProj>, true, true>((PG8_LAS unsigned char*)plds, pg8::Gemm{DM}, S8, E8, t512, wave_s);
    }
    if ((pbid >> 3) >= 16) convert_range(a, a.cv_lo[1], a.cv_hi[1], ((xcd * 16 + (pbid >> 3) - 16) * 2 + half), (pnblk >> 1) * 2, lds, tid);
  }
  SYNC_AFTER(1);
#pragma unroll 1
  for (int rp_ = PH(2) ? a.rep[2] : 0; rp_ > 0; --rp_) {
    TILE_IDS;
    for (int it = bid; it < 128; it += nblk) {
      const int which = it >> 6, m0 = ((it >> 2) & 15) * 128, slab = it & 3;
      f32x4 acc[4][4]; zero_acc(acc);
      {
        int tid2 = tid; asm volatile("" : "+v"(tid2));
        unsigned ao[4], bo[4];
#pragma unroll
        for (int i = 0; i < 4; ++i) {
          const int row = st_row(tid2, i), lc = st_lc(tid2, i);
          const int m = m0 + row, bg = m >> 8, j = m & 255;
          ao[i] = (unsigned)((bg >> 1) * SEQ + 16 * j + slab * 8) * 256u + which * 128 + (bg & 1) * 64 + lc * 8;
          bo[i] = (unsigned)row * 2048u + slab * 512 + lc * 8;
        }
        gemm_core(acc, a.KVC, ao, 256u, which ? a.CV1T : a.CK1T, bo, 64u, 8, lds, tid2);
      }
      float* cp = a.CPART + (size_t)((which * 4 + slab) * 2048 + m0) * 128;
#pragma unroll
      for (int mi = 0; mi < 4; ++mi)
#pragma unroll
        for (int ni = 0; ni < 4; ++ni) *(f32x4*)(cp + (wr * 64 + mi * 16 + fr) * 128 + wc * 64 + ni * 16 + 4 * fq) = acc[mi][ni];
    }
    for (int q = nloc - 1 - li; q < 16; q += nloc) {
      f32x4 acc[4][4]; zero_acc(acc);
      const int tile = xcd * 16 + q; constexpr int T1 = 0, T2n = 16;
        const int t2 = tile - T1; const int m0 = (t2 / T2n) * 128, n0 = (t2 % T2n) * 128;
        if (n0 < 1024) {
          gemm_acc(acc, a.MEMB, DM, (const int*)nullptr, 0, 0, a.WkvT, DM, DM, lds, m0, n0, tid);
#pragma unroll
          for (int mi = 0; mi < 4; ++mi) {
            const int m = m0 + wr * 64 + mi * 16 + fr; const float rs = a.RSM[m];
#pragma unroll
            for (int ni = 0; ni < 4; ++ni) st_bf4(a.KVM + (size_t)m * 1024 + n0 + wc * 64 + ni * 16 + 4 * fq, acc[mi][ni] * rs);
          }
        } else {
          gemm_acc(acc, a.WkvT, DM, (const int*)nullptr, 0, 0, a.MEMB, DM, DM, lds, n0, m0, tid);
          bf16_t* vmt = a.KVM + (size_t)1024 * 1024;
#pragma unroll
          for (int ni = 0; ni < 4; ++ni) {
            const int tok = m0 + wc * 64 + ni * 16 + 4 * fq; const f32x4 rs = *(const f32x4*)(a.RSM + tok);
            const int b = tok >> 8, key = tok & 255;
#pragma unroll
            for (int mi = 0; mi < 4; ++mi) {
              const int col = n0 - 1024 + wr * 64 + mi * 16 + fr;
              st_bf4(vmt + ((size_t)(b * 1024 + col) << 8) + key, acc[mi][ni] * rs);
            }
          }
        }
    }
    for (int lp = pbid >> 3; lp < 32; lp += pnblk >> 3) nsa_win_item(a, ((((((xcd >> 1) & 1) * 2 + half) * 2 + (xcd & 1)) << 6)) | (63 - (2 * lp + (xcd >> 2))), lds, tid);
    {
      volatile int* wqw = (volatile int*)(lds + MEGA_LDS - 32);
      (void)wqw;
      for (;;) {
        if (wave_s == 0 && lane == 0) xch[2] = atomicAdd(a.WQ + 1, 2);
        __syncthreads();
        const int it0 = xch[2];
        __syncthreads();
        if (it0 >= 1024) break;
        ml_dc_item(a, a.ml, it0 + half, lds, tid);
      }
    }
  }
  SYNC_AFTER(2);
#pragma unroll 1
  for (int rp_ = PH(3) ? a.rep[3] : 0; rp_ > 0; --rp_) {
    TILE_IDS;
    if (rp_ == 1) for (int it = bid; it < 272; it += nblk) ml_scan_item(a.ml, it, tid);
    for (int it = nblk - 1 - bid; it < 128; it += nblk) {
      const int which = it >> 6, m0 = (it & 63) * 32;
      float* hid = (float*)lds;
      float* w2s = (float*)(lds + 16640);
      {
        const float* w2 = which ? a.cvw2 : a.ckw2;
#pragma unroll
        for (int c = 0; c < 8; ++c) *(f32x4*)(w2s + (tid + 256 * c) * 4) = *(const f32x4*)(w2 + (tid + 256 * c) * 4);
        const int row = tid >> 3, u0 = (tid & 7) * 16;
        const float* cp = a.CPART + (size_t)(which * 4 * 2048 + m0 + row) * 128 + u0;
#pragma unroll
        for (int c4 = 0; c4 < 4; ++c4) {
          f32x4 hv = *(const f32x4*)(cp + c4 * 4) + *(const f32x4*)(cp + 2048 * 128 + c4 * 4) + *(const f32x4*)(cp + 2 * 2048 * 128 + c4 * 4) + *(const f32x4*)(cp + 3 * 2048 * 128 + c4 * 4)
                   + *(const f32x4*)(a.POSW + which * 128 + u0 + c4 * 4);
#pragma unroll
          for (int j = 0; j < 4; ++j) hid[row * 129 + u0 + c4 * 4 + j] = gelu_tanh(hv[j]);
        }
      }
      __syncthreads();
      {
        const int row = tid >> 3, d0 = (tid & 7) * 8;
        float o[8];
#pragma unroll
        for (int d = 0; d < 8; ++d) o[d] = 0.f;
        for (int u = 0; u < 128; ++u) {
          const float hv = hid[row * 129 + u]; const f32x4 w0 = *(const f32x4*)(w2s + u * 64 + d0), w1 = *(const f32x4*)(w2s + u * 64 + d0 + 4);
          o[0] += hv * w0[0]; o[1] += hv * w0[1]; o[2] += hv * w0[2]; o[3] += hv * w0[3]; o[4] += hv * w1[0]; o[5] += hv * w1[1]; o[6] += hv * w1[2]; o[7] += hv * w1[3];
        }
        const int m = m0 + row, bg = m >> 8, j = m & 255;
        if (which == 0) {
#pragma unroll
          for (int d = 0; d < 8; ++d) a.KC[(size_t)m * 64 + d0 + d] = (j == 255) ? (bf16_t)0 : f2bf(o[d]);
        } else {
#pragma unroll
          for (int d = 0; d < 8; ++d) a.VCT[((size_t)(bg * 64 + d0 + d) << 8) + j] = (j == 255) ? (bf16_t)0 : f2bf(o[d]);
        }
      }
      __syncthreads();
    }
  }
  SYNC_AFTER(3);
#pragma unroll 1
  for (int rp_ = PH(4) ? a.rep[4] : 0; rp_ > 0; --rp_) {
    for (int lp = pbid >> 3; lp < 32; lp += pnblk >> 3) { TILE_IDS; nsa_main_item(a, ((((((xcd >> 1) & 1) * 2 + half) * 2 + (xcd & 1)) << 6)) | (63 - (2 * lp + (xcd >> 2))), lds, tid, xch, half); }
    { TILE_IDS;
      volatile int* wqw = (volatile int*)(lds + MEGA_LDS - 32);
      (void)wqw;
      for (;;) {
        if (wave_s == 0 && lane == 0) xch[2] = atomicAdd(a.WQ, 2);
        __syncthreads();
        const int it0 = xch[2];
        __syncthreads();
        if (it0 >= 1024) break;
        ml_out_item(a, a.ml, it0 + half, lds, tid);
      } }
  }
  SYNC_AFTER(4);
#pragma unroll 1
  for (int rp_ = PH(5) ? a.rep[5] : 0; rp_ > 0; --rp_) {
    bf16_t* const G1 = (bf16_t*)((char*)a.out + 32 * MiB);
    const int xcd = pbid & 7;
    for (int lp = pbid >> 3; lp < 32; lp += pnblk >> 3) {
      const int pm = xcd * 8 + (lp & 7), pn = lp >> 3;
      TILE8_IDS;
      ListSched<MapP5> S8{0, 1, 4, MapP5{a.XB, a.WgT, a.AML, a.ANS, a.WmlT, a.WnsT, pm, pn}}; EpiP5 E8{a.MRG, G1, a.RS1};
      pg8::gemm_phase_vk<EpiP5, ListSched<MapP5>, false, true>((PG8_LAS unsigned char*)plds, pg8::Gemm{DM}, S8, E8, t512, wave_s);
    }
    { TILE_IDS; convert_range(a, a.cv_lo[5], a.cv_hi[5], bid, nblk, lds, tid); }
  }
  SYNC_AFTER(5);
#pragma unroll 1
  for (int rp_ = PH(6) ? a.rep[6] : 0; rp_ > 0; --rp_) {
    TILE_IDS;
    {
      TILE8_IDS;
      ListSched<MapMN> S8{pbid >> 3, pnblk >> 3, 32, MapMN{a.MRG, a.WoutT, DM, xcd}};
      EpiX1 E8{a.XB, a.X1B, a.PS2};
      pg8::gemm_phase<decltype(E8), ListSched<MapMN>, false, true>((PG8_LAS unsigned char*)plds, pg8::Gemm{DM}, S8, E8, t512, wave_s);
    }
    convert_range(a, a.cv_lo[6], a.cv_hi[6], bid, nblk, lds, tid);
  }
  SYNC_AFTER(6);
#pragma unroll 1
  for (int rp_ = PH(7) ? a.rep[7] : 0; rp_ > 0; --rp_) {
    TILE_IDS;
    {
      TILE8_IDS;
      for (int idx = pbid >> 3; idx < 32; idx += pnblk >> 3) {
        __syncthreads();
        if (t512 < 256) {
          const f32x4* pp = (const f32x4*)(a.PS2 + (size_t)((xcd * 8 + (idx & 7)) * 256 + t512) * 32);
          float ss = 0.f;
#pragma unroll
          for (int c = 0; c < 8; ++c) { const f32x4 p = pp[c]; ss += (p[0] + p[1]) + (p[2] + p[3]); }
          ((float*)(plds + 131072))[t512] = rsqrtf(ss * (1.f / DM) + EPS);
        }
        __syncthreads();
        ListSched<MapMN> S8{idx, 1 << 20, 32, MapMN{a.X1B, a.WqT, DM, xcd}};
        EpiXQ E8{a.XQ, (const PG8_LAS float*)(plds + 131072)};
        pg8::gemm_phase<decltype(E8), ListSched<MapMN>, false, true>((PG8_LAS unsigned char*)plds, pg8::Gemm{DM}, S8, E8, t512, wave_s);
      }
    }
    convert_range(a, a.cv_lo[7], a.cv_hi[7], bid, nblk, lds, tid);
  }
  SYNC_AFTER(7);
#pragma unroll 1
  for (int rp_ = PH(8) ? a.rep[8] : 0; rp_ > 0; --rp_) {
    TILE_IDS;
    float* RMX = (float*)lds; float* RSUM = (float*)(lds + 1024);
    for (int q = li; q < 64; q += nloc) {
      const int m0 = (xcd * 16 + (q >> 2)) * 128, hh = q & 3, b = m0 >> 12;
      bf16_t* Qh = a.XQ + hh * 256;
      const bf16_t* Kh = a.KVM + (size_t)(b * 256) * 1024 + hh * 256;
      const bf16_t* Vh = a.KVM + (size_t)1024 * 1024 + ((size_t)(b * 1024 + hh * 256) << 8);
      f32x4 acc0[4][4], acc1[4][4]; zero_acc(acc0); zero_acc(acc1);
      gemm_acc(acc0, Qh, 1024, (const int*)nullptr, 0, 0, Kh, 1024, 256, lds, m0, 0, tid);
      gemm_acc(acc1, Qh, 1024, (const int*)nullptr, 0, 0, Kh, 1024, 256, lds, m0, 128, tid);
      float mloc[4];
#pragma unroll
      for (int mi = 0; mi < 4; ++mi) {
        float mx = -INFINITY;
#pragma unroll
        for (int ni = 0; ni < 4; ++ni)
#pragma unroll
          for (int j = 0; j < 4; ++j) mx = fmaxf(mx, fmaxf(acc0[mi][ni][j], acc1[mi][ni][j]));
        mx = max4(mx); mloc[mi] = mx;
        if (fq == 0) RMX[(wr * 64 + mi * 16 + fr) * 2 + wc] = mx;
      }
      __syncthreads();
#pragma unroll
      for (int mi = 0; mi < 4; ++mi) {
        const int r = wr * 64 + mi * 16 + fr;
        const float m = fmaxf(RMX[r * 2], RMX[r * 2 + 1]); float ls = 0.f;
#pragma unroll
        for (int ni = 0; ni < 4; ++ni)
#pragma unroll
          for (int j = 0; j < 4; ++j) {
            acc0[mi][ni][j] = __expf((acc0[mi][ni][j] - m) * 0.0625f); acc1[mi][ni][j] = __expf((acc1[mi][ni][j] - m) * 0.0625f);
            ls += acc0[mi][ni][j] + acc1[mi][ni][j];
          }
        ls = red4(ls);
        if (fq == 0) RSUM[r * 2 + wc] = ls;
      }
      __syncthreads();
#pragma unroll
      for (int mi = 0; mi < 4; ++mi) {
        const int r = wr * 64 + mi * 16 + fr;
        const float inv = 1.f / (RSUM[r * 2] + RSUM[r * 2 + 1]);
        bf16_t* pr = Qh + (size_t)(m0 + r) * 1024 + wc * 64 + 4 * fq;
#pragma unroll
        for (int ni = 0; ni < 4; ++ni) { st_bf4(pr + ni * 16, acc0[mi][ni] * inv); st_bf4(pr + 128 + ni * 16, acc1[mi][ni] * inv); }
      }
      asm volatile("s_waitcnt vmcnt(0)" ::: "memory");
      __threadfence_block();
      __syncthreads();
#pragma unroll 1
      for (int dh = 0; dh < 2; ++dh) {
        zero_acc(acc0);
        gemm_acc(acc0, Qh, 1024, (const int*)nullptr, 0, 0, Vh, 256, 256, lds, m0, dh * 128, tid);
#pragma unroll
        for (int mi = 0; mi < 4; ++mi) {
          const int r = wr * 64 + mi * 16 + fr;
#pragma unroll
          for (int ni = 0; ni < 4; ++ni) st_bf4(a.XO + (size_t)(m0 + r) * 1024 + hh * 256 + dh * 128 + wc * 64 + ni * 16 + 4 * fq, acc0[mi][ni]);
        }
      }
    }
    convert_range(a, a.cv_lo[8], a.cv_hi[8], bid, nblk, lds, tid);
  }
  SYNC_AFTER(8);
#pragma unroll 1
  for (int rp_ = PH(9) ? a.rep[9] : 0; rp_ > 0; --rp_) {
    TILE_IDS;
    {
      TILE8_IDS;
      ListSched<MapMN> S8{pbid >> 3, pnblk >> 3, 32, MapMN{a.XO, a.WoT, DM, xcd}};
      EpiX2 E8{a.X1B};
      pg8::gemm_phase<decltype(E8), ListSched<MapMN>, false, true>((PG8_LAS unsigned char*)plds, pg8::Gemm{DM}, S8, E8, t512, wave_s);
    }
    convert_range(a, a.cv_lo[9], a.cv_hi[9], bid, nblk, lds, tid);
  }
  SYNC_AFTER(9);
#pragma unroll 1
  for (int rp_ = PH(10) ? a.rep[10] : 0; rp_ > 0; --rp_) {
    TILE_IDS;
    const int tpb = NTOK / nblk;
    int* ex_l = (int*)(lds + 65536);
    float* we_l = (float*)lds;
    for (int c = tid; c < 4096; c += 256) { const int k = c >> 2, q = c & 3; *(f32x4*)(we_l + (q * 1024 + k) * 4) = *(const f32x4*)(a.we + k * 16 + q * 4); }
    __syncthreads();
    for (int k = 0; k < tpb / 4; ++k) {
      const int tl = wid * (tpb / 4) + k, n = bid * tpb + tl;
      int lane = tid & 63; asm volatile("" : "+v"(lane));
      const bf16_t* xr = a.H3 + (size_t)n * DM;
      float v[16]; float s = 0.f;
#pragma unroll
      for (int i = 0; i < 16; ++i) { v[i] = bf2f(xr[lane + 64 * i]); s += v[i] * v[i]; }
      s = wave_sum(s);
      const float rs = rsqrtf(s * (1.f / DM) + EPS);
      float lg[20];
#pragma unroll
      for (int e = 0; e < 20; ++e) lg[e] = 0.f;
#pragma unroll
      for (int i = 0; i < 16; ++i) {
        const int k2 = lane + 64 * i; const float hk = v[i] * rs * a.g_ffn[k2];
        const f32x4 wgv = *(const f32x4*)(a.wg + k2 * 4);
#pragma unroll
        for (int e = 0; e < 4; ++e) lg[e] += hk * wgv[e];
#pragma unroll
        for (int q = 0; q < 4; ++q) { const f32x4 wv = *(const f32x4*)(we_l + (q * 1024 + k2) * 4);
#pragma unroll
          for (int e = 0; e < 4; ++e) lg[4 + q * 4 + e] += hk * wv[e]; }
      }
#pragma unroll
      for (int e = 0; e < 20; ++e) lg[e] = wave_sum(lg[e]);
      if (lane == 0) {
        float gl[4]; float gm = -INFINITY; int gi = 0;
#pragma unroll
        for (int e = 0; e < 4; ++e) { gl[e] = lg[e] + a.bg[e]; if (gl[e] > gm) { gm = gl[e]; gi = e; } }
        float gs = 0.f;
#pragma unroll
        for (int e = 0; e < 4; ++e) gs += __expf(gl[e] - gm);
        const float gval = 1.f / gs;
        float el[4] = {0.f, 0.f, 0.f, 0.f};
#pragma unroll
        for (int gg = 0; gg < 4; ++gg) if (gi == gg) {
#pragma unroll
          for (int e = 0; e < 4; ++e) el[e] = lg[4 + gg * 4 + e] + a.be[gg * 4 + e];
        }
        int i0 = 0; float v0 = el[0];
#pragma unroll
        for (int e = 1; e < 4; ++e) if (el[e] > v0) { v0 = el[e]; i0 = e; }
        int i1 = -1; float v1 = -INFINITY;
#pragma unroll
        for (int e = 0; e < 4; ++e) if (e != i0 && el[e] > v1) { v1 = el[e]; i1 = e; }
        const float e1 = __expf(v1 - v0);
        ex_l[tl * 2] = gi * 4 + i0; ex_l[tl * 2 + 1] = gi * 4 + i1;
        a.RTW[n * 2] = gval / (1.f + e1); a.RTW[n * 2 + 1] = gval * e1 / (1.f + e1);
        a.RS3[n] = rs;
      }
    }
    __syncthreads();
    if (tid < 16) {
      int cnt = 0;
      for (int j = 0; j < 2 * tpb; ++j) cnt += (ex_l[j] == tid) ? 1 : 0;
      if (cnt > 0) {
        int pos = atomicAdd(&a.CNT[tid], cnt);
        for (int j = 0; j < 2 * tpb; ++j) if (ex_l[j] == tid) a.LIST[tid * NTOK + pos++] = (bid * tpb) * 2 + j;
      }
    }
    __syncthreads();
  }
  SYNC_AFTER(10);
#pragma unroll 1
  for (int rp_ = PH(11) ? a.rep[11] : 0; rp_ > 0; --rp_) {
    TILE8_IDS;
    int rtot = 0;
    for (int e = 0; e < 16; ++e) rtot += (a.CNT[e] + 255) >> 8;
    const int n1 = ((rtot - xcd + 7) >> 3) * 4;
    const int li8 = pbid >> 3, L8 = pnblk >> 3;
    unsigned* const DEP = (unsigned*)a.CNT + 1024;
    {
      MoeUpSched S8{li8, L8, n1, MapMoe{a.CNT, a.LIST, a.H3, a.W13T, (size_t)1024 * 1024, DM, xcd, 1}, DEP, wave_s == 0};
      EpiMoe1 E8{a.LIST, a.RS3, a.ACT};
      pg8::gemm_phase<EpiMoe1, MoeUpSched, true, true>((PG8_LAS unsigned char*)plds, pg8::Gemm{DM}, S8, E8, t512, wave_s);
    }
    {
      const int r = n1 % L8, fp = r ? min(n1, 2 * (L8 - r)) : 0;
      const int nfirst = (r && li8 >= r) ? max(0, min(2, n1 - 2 * (li8 - r))) : 0;
      MoeDownSched S8{li8, L8, n1, r, fp, nfirst, MapMoe{a.CNT, a.LIST, a.ACT, a.W2T, (size_t)1024 * 512, 512, xcd, 0}, DEP, wave_s == 0};
      EpiMoe2 E8{a.LIST, a.RTW, a.Y};
      { pg8::Unit u0; if (S8.next(0, u0)) S8.a_ready(u0); }
      __syncthreads();
      pg8::gemm_phase<EpiMoe2, MoeDownSched, true, true, true>((PG8_LAS unsigned char*)plds, pg8::Gemm{512}, S8, E8, t512, wave_s);
    }
  }
  if (PH(11) && PH(13)) GRID_BAR();
#pragma unroll 1
  for (int rp_ = PH(13) ? a.rep[13] : 0; rp_ > 0; --rp_) {
    TILE_IDS;
    for (int row = bid * 4 + wid; row < NTOK; row += nblk * 4) {
      f32x4* xr = (f32x4*)(a.out + (size_t)row * DM) + lane;
      const u32x2* x2r = (const u32x2*)(a.H3 + (size_t)row * DM) + lane;
      const u32x2* y0 = (const u32x2*)(a.Y + (size_t)(row * 2) * DM) + lane; const u32x2* y1 = y0 + DM / 4;
      f32x4 v[4]; float s = 0.f;
#pragma unroll
      for (int j = 0; j < 4; ++j) {
        { const u32x2 xx = x2r[64 * j]; v[j][0] = __uint_as_float(xx.x << 16); v[j][1] = __uint_as_float(xx.x & 0xffff0000u); v[j][2] = __uint_as_float(xx.y << 16); v[j][3] = __uint_as_float(xx.y & 0xffff0000u); }
        const u32x2 p = y0[64 * j], q = y1[64 * j];
        v[j][0] += __uint_as_float(p.x << 16) + __uint_as_float(q.x << 16); v[j][1] += __uint_as_float(p.x & 0xffff0000u) + __uint_as_float(q.x & 0xffff0000u);
        v[j][2] += __uint_as_float(p.y << 16) + __uint_as_float(q.y << 16); v[j][3] += __uint_as_float(p.y & 0xffff0000u) + __uint_as_float(q.y & 0xffff0000u);
        s += v[j][0] * v[j][0] + v[j][1] * v[j][1] + v[j][2] * v[j][2] + v[j][3] * v[j][3];
      }
      s = wave_sum(s);
      const float rs = rsqrtf(s * (1.f / DM) + EPS);
#pragma unroll
      for (int j = 0; j < 4; ++j) xr[64 * j] = v[j] * rs * ((const f32x4*)a.g_final)[lane + 64 * j];
    }
  }
}

extern "C" void kernel_launch(void* const* d_in, const int* in_sizes, int n_in, void* d_out, int out_size, void* d_ws, size_t ws_size, hipStream_t stream) {
  const float* x = (const float*)d_in[0];
  const float* mem = (const float*)d_in[1];
  const float* norm_mix = (const float*)d_in[2];
  const float* w_in = (const float*)d_in[3];
  const float* conv_qk = (const float*)d_in[4];
  const float* b_igate = (const float*)d_in[5];
  const float* b_fgate = (const float*)d_in[6];
  const float* mlstm_norm = (const float*)d_in[7];
  const float* cmp_pos_k = (const float*)d_in[8];
  const float* cmp_pos_v = (const float*)d_in[9];
  const float* cmp_k_w1 = (const float*)d_in[10];
  const float* cmp_k_w2 = (const float*)d_in[11];
  const float* cmp_v_w1 = (const float*)d_in[12];
  const float* cmp_v_w2 = (const float*)d_in[13];
  const float* w_br_mlstm = (const float*)d_in[14];
  const float* w_br_nsa = (const float*)d_in[15];
  const float* w_mix_out = (const float*)d_in[16];
  const float* norm_xattn = (const float*)d_in[17];
  const float* norm_mem = (const float*)d_in[18];
  const float* xa_wq = (const float*)d_in[19];
  const float* xa_wkv = (const float*)d_in[20];
  const float* xa_wo = (const float*)d_in[21];
  const float* norm_ffn = (const float*)d_in[22];
  const float* router_group_w = (const float*)d_in[23];
  const float* router_group_b = (const float*)d_in[24];
  const float* router_expert_w = (const float*)d_in[25];
  const float* router_expert_b = (const float*)d_in[26];
  const float* moe_w1 = (const float*)d_in[27];
  const float* moe_w3 = (const float*)d_in[28];
  const float* moe_w2 = (const float*)d_in[29];
  const float* norm_final = (const float*)d_in[30];
  float* out = (float*)d_out;
  char* ws = (char*)d_ws;

  int* CNT = (int*)(ws + WS_CNT); int* LIST = (int*)(ws + WS_LIST); float* RTW = (float*)(ws + WS_RTW);
  float* SM = (float*)(ws + WS_SM); float* BCUM = (float*)(ws + WS_BCUM); float* IP = (float*)(ws + WS_IP);
  float* BL = (float*)(ws + WS_BL); float* MX = (float*)(ws + WS_MX); float* MST = (float*)(ws + WS_MST); float* NST = (float*)(ws + WS_NST);
  bf16_t* KC = (bf16_t*)(ws + WS_KC); bf16_t* VC = (bf16_t*)(ws + WS_VC);
  bf16_t* QK = (bf16_t*)(ws + WS_QK); bf16_t* V = (bf16_t*)(ws + WS_V); bf16_t* O = (bf16_t*)(ws + WS_O);
  bf16_t* NQ = (bf16_t*)(ws + WS_NQ); bf16_t* KV = (bf16_t*)(ws + WS_KV); bf16_t* CST = (bf16_t*)(ws + WS_CST);
  bf16_t* AML = (bf16_t*)(ws + WS_AML); bf16_t* ANS = (bf16_t*)(ws + WS_ANS); bf16_t* MRG = (bf16_t*)(ws + WS_MRG);
  bf16_t* KVM = (bf16_t*)(ws + WS_KVM); bf16_t* MEMN = (bf16_t*)(ws + WS_MEMN);
  bf16_t* H2 = (bf16_t*)(ws + WS_H2); bf16_t* XQ = (bf16_t*)(ws + WS_XQ); bf16_t* XO = (bf16_t*)(ws + WS_XO);
  bf16_t* H3 = H2; bf16_t* ACT = XQ; bf16_t* Y = (bf16_t*)(ws + 136 * MiB);
  bf16_t* H = (bf16_t*)d_out;
  bf16_t* T2 = (bf16_t*)((char*)d_out + 32 * MiB);

  (void)hipMemsetAsync(ws, 0, 131072, stream);
  static int grid_blocks = 0;
  if (!grid_blocks) {
    int dev = 0, cus = 0, per_cu = 0;
    (void)hipGetDevice(&dev);
    (void)hipDeviceGetAttribute(&cus, hipDeviceAttributeMultiprocessorCount, dev);
    (void)hipFuncSetAttribute((const void*)k_mega, hipFuncAttributeMaxDynamicSharedMemorySize, TOTAL_LDS);
    (void)hipOccupancyMaxActiveBlocksPerMultiprocessor(&per_cu, (const void*)k_mega, 512, TOTAL_LDS);
    if (per_cu > 1) per_cu = 1;
    if (per_cu < 1) per_cu = 1;
    grid_blocks = cus * per_cu;
  }
  MegaArgs fa{};
  fa.x = x; fa.mem = mem; fa.out = out; fa.BAR = (unsigned*)(ws + 65536);
  fa.ml.conv = conv_qk; fa.ml.b_i = b_igate; fa.ml.b_f = b_fgate; fa.ml.gain = mlstm_norm;
  fa.ml.BCUM = BCUM; fa.ml.IP = IP; fa.ml.BL = BL; fa.ml.MX = MX; fa.ml.MST = MST; fa.ml.NST = NST; fa.ml.CST = CST;
  fa.XB = (bf16_t*)d_out; fa.MEMB = (bf16_t*)(ws + WS_MEMB); fa.RS1 = (float*)(ws + WS_RS1); fa.RSM = (float*)(ws + WS_RSM); fa.PS2 = (float*)(ws + WS_PS2);
  fa.QK = QK; fa.V = V; fa.O = O; fa.NQ = NQ; fa.SM = SM;
  fa.KVC = (bf16_t*)(ws + WS_KVC); fa.KS = (bf16_t*)(ws + WS_KS); fa.KW = (bf16_t*)(ws + WS_KW); fa.VST = (bf16_t*)(ws + WS_VST); fa.VWT = (bf16_t*)(ws + WS_VWT);
  fa.KC = KC; fa.VCT = VC; fa.CK1T = (bf16_t*)(ws + WS_CK1T); fa.CV1T = (bf16_t*)(ws + WS_CV1T); fa.POSW = (float*)(ws + WS_POSW);
  fa.posk = cmp_pos_k; fa.posv = cmp_pos_v; fa.ckw1 = cmp_k_w1; fa.cvw1 = cmp_v_w1; fa.ckw2 = cmp_k_w2; fa.cvw2 = cmp_v_w2;
  fa.AML = AML; fa.ANS = ANS; fa.MRG = MRG; fa.X1B = H2; fa.XQ = XQ; fa.XO = XO; fa.KVM = KVM;
  fa.WinT = (bf16_t*)(ws + WS_WIN_T); fa.WgT = (bf16_t*)(ws + WS_WG_T); fa.WmlT = (bf16_t*)(ws + WS_WML_T); fa.WnsT = (bf16_t*)(ws + WS_WNS_T);
  fa.H3 = H3; fa.ACT = ACT; fa.Y = Y; fa.W13T = (bf16_t*)(ws + 104 * MiB); fa.W2T = (bf16_t*)(ws + 240 * MiB);
  fa.CPART = (float*)(ws + 176 * MiB); fa.WQ = (int*)(ws + 256);
  fa.RS3 = (float*)(ws + WS_RSM + 8192); fa.RTW = RTW; fa.CNT = CNT; fa.LIST = LIST;
  fa.g_ffn = norm_ffn; fa.wg = router_group_w; fa.bg = router_group_b; fa.we = router_expert_w; fa.be = router_expert_b; fa.g_final = norm_final;
  fa.WoutT = (bf16_t*)(ws + WS_WOUT_T); fa.WqT = (bf16_t*)(ws + WS_WQ_T); fa.WkvT = (bf16_t*)(ws + WS_WKV_T); fa.WoT = (bf16_t*)(ws + WS_WO_T);
  {
    auto mk = [&](const float* src, bf16_t* dst, const float* gain, int ldw, int K, int c0, int ncols, int drow0) {
      TDesc d{}; d.src = src; d.dst = dst; d.gain = gain; d.ldw = ldw; d.K = K; d.c0 = c0; d.ncols = ncols; d.drow0 = drow0; d.per = (K / 64) * ((ncols + 63) / 64); d.nitems = d.per; d.mode = 0; d.rofs = 0; d.sstride = 0; d.dstride = 0; d.pad = 0; return d; };
    int n = 0;
    fa.td[n++] = mk(w_in, fa.WinT, norm_mix, DIN, DM, 0, 2048, 0);
    fa.td[n++] = mk(w_in, fa.WinT, norm_mix, DIN, DM, 2056, 512, 2048);
    fa.td[n++] = mk(w_in, fa.WinT, norm_mix, DIN, DM, 2568, 384, 2560);
    fa.td[n++] = mk(w_in, fa.WinT, norm_mix, DIN, DM, 3080, 128, 2944);
    fa.td[n++] = mk(w_in, fa.WinT, norm_mix, DIN, DM, 2952, 128, 3072);
    fa.td[n++] = mk(w_in, fa.WinT, norm_mix, DIN, DM, 3208, 128, 3200);
    fa.td[n++] = mk(w_in, fa.WinT, norm_mix, DIN, DM, 2048, 8, 3328);
    fa.td[n++] = mk(w_in, fa.WinT, norm_mix, DIN, DM, 3336, 24, 3336);
    fa.td[n++] = mk(w_in, fa.WgT, norm_mix, DIN, DM, 3360, 2048, 0);
    fa.td[n++] = mk(w_br_mlstm, fa.WmlT, nullptr, 1024, 512, 0, 1024, 0);
    fa.td[n++] = mk(w_br_nsa, fa.WnsT, nullptr, 1024, 512, 0, 1024, 0);
    fa.td[n++] = mk(w_mix_out, fa.WoutT, nullptr, 1024, 1024, 0, 1024, 0);
    fa.td[n++] = mk(xa_wq, fa.WqT, norm_xattn, 1024, 1024, 0, 1024, 0);
    fa.td[n++] = mk(xa_wkv, fa.WkvT, norm_mem, 2048, 1024, 0, 2048, 0);
    fa.td[n++] = mk(xa_wo, fa.WoT, nullptr, 1024, 1024, 0, 1024, 0);
    fa.td[n++] = mk(cmp_k_w1, fa.CK1T, nullptr, 128, 2048, 0, 128, 0);
    fa.td[n++] = mk(cmp_v_w1, fa.CV1T, nullptr, 128, 2048, 0, 128, 0);
    fa.ntdA = n;
    { TDesc d = mk(moe_w1, fa.W13T, norm_ffn, 512, 1024, 0, 512, 0); d.mode = 2; d.rofs = 0; d.nitems = 16 * d.per; d.sstride = 1024 * 512; d.dstride = 1024 * 1024; fa.td[n++] = d; }
    { TDesc d = mk(moe_w3, fa.W13T, norm_ffn, 512, 1024, 0, 512, 0); d.mode = 2; d.rofs = 16; d.nitems = 16 * d.per; d.sstride = 1024 * 512; d.dstride = 1024 * 1024; fa.td[n++] = d; }
    { TDesc d = mk(moe_w2, fa.W2T, nullptr, 1024, 512, 0, 1024, 0); d.nitems = 16 * d.per; d.sstride = 512 * 1024; d.dstride = 1024 * 512; fa.td[n++] = d; }
    fa.ntdB = n;
    int cum[25]; cum[0] = 0; for (int i = 0; i < n; ++i) cum[i + 1] = cum[i] + fa.td[i].nitems;
    for (int k = 0; k < 16; ++k) { fa.cv_lo[k] = 0; fa.cv_hi[k] = 0; }
    fa.cv_lo[0] = 0; fa.cv_hi[0] = cum[8];
    fa.cv_lo[1] = cum[8]; fa.cv_hi[1] = cum[fa.ntdA];
    { const int lo = cum[fa.ntdA], tot = cum[n] - lo; const int phs[5] = {5, 6, 7, 8, 9};
      for (int i = 0; i < 5; ++i) { fa.cv_lo[phs[i]] = lo + (int)((long long)tot * i / 5); fa.cv_hi[phs[i]] = lo + (int)((long long)tot * (i + 1) / 5); } }
  }
  int launch_i = 0;
  auto mega = [&](int lo, int hi) {
    fa.ph_lo = lo; fa.ph_hi = hi; fa.li = launch_i++; fa.pad = 0;
    for (int k = 0; k < 16; ++k) fa.rep[k] = 1;

    void* args[] = {&fa};
    (void)hipLaunchCooperativeKernel((const void*)k_mega, dim3(grid_blocks), dim3(512), args, TOTAL_LDS, stream);
  };
  mega(0, 14);
}
```

```cpp
#include <hip/hip_runtime.h>
#include <stdint.h>

typedef unsigned short bf16_t;
__device__ __forceinline__ float bf2f(bf16_t v) { return __uint_as_float(((unsigned)v) << 16); }
typedef float f32x2_cv __attribute__((ext_vector_type(2)));
typedef __bf16 bf16x2_cv __attribute__((ext_vector_type(2)));
__device__ __forceinline__ unsigned pk2bf(float lo, float hi) { f32x2_cv v; v.x = lo; v.y = hi; return __builtin_bit_cast(unsigned, __builtin_convertvector(v, bf16x2_cv)); }
__device__ __forceinline__ bf16_t f2bf(float f) { return (bf16_t)(pk2bf(f, 0.f) & 0xffffu); }

constexpr int NB = 4, SEQ = 4096, NTOK = NB * SEQ, DM = 1024;
constexpr int DIN = 5408, DIN_A = 3360;
constexpr int MEMT = 256;
constexpr float EPS = 1e-6f;
constexpr size_t MiB = 1u << 20;

constexpr size_t WS_CNT = 0;
constexpr size_t WS_LIST = 1 * MiB;
constexpr size_t WS_RTW = 2 * MiB;
constexpr size_t WS_SM = 3 * MiB;
constexpr size_t WS_BCUM = 5 * MiB;
constexpr size_t WS_IP = 5 * MiB + 256 * 1024;
constexpr size_t WS_BL = 5 * MiB + 512 * 1024;
constexpr size_t WS_MX = WS_BL + 4096;
constexpr size_t WS_MST = WS_MX + 4096;
constexpr size_t WS_NST = 6 * MiB;
constexpr size_t WS_KC = 7 * MiB;
constexpr size_t WS_VC = 7 * MiB + 512 * 1024;
constexpr size_t WS_QK = 8 * MiB;
constexpr size_t WS_V = 40 * MiB;
constexpr size_t WS_O = 56 * MiB;
constexpr size_t WS_NQ = 72 * MiB;
constexpr size_t WS_KV = 88 * MiB;
constexpr size_t WS_CST = 112 * MiB;
constexpr size_t WS_AML = 144 * MiB;
constexpr size_t WS_ANS = 160 * MiB;
constexpr size_t WS_MRG = 176 * MiB;
constexpr size_t WS_KVM = 233 * MiB;
constexpr size_t WS_MEMN = 237 * MiB;
constexpr size_t WS_H2 = 8 * MiB;
constexpr size_t WS_XQ = 40 * MiB;
constexpr size_t WS_XO = 72 * MiB;
constexpr size_t WS_Y = 72 * MiB;

__device__ __forceinline__ float wave_sum(float v) {
#pragma unroll
  for (int o = 32; o > 0; o >>= 1) v += __shfl_xor(v, o);
  return v;
}
__device__ __forceinline__ float wave_max(float v) {
#pragma unroll
  for (int o = 32; o > 0; o >>= 1) v = fmaxf(v, __shfl_xor(v, o));
  return v;
}
__device__ __forceinline__ float sigmoidf_(float x) { return 1.f / (1.f + __expf(-x)); }
__device__ __forceinline__ float siluf_(float x) { return x / (1.f + __expf(-x)); }
__device__ __forceinline__ float logsigmoidf_(float x) { return fminf(x, 0.f) - log1pf(__expf(-fabsf(x))); }
__device__ __forceinline__ float gelu_tanh(float x) { float u = 0.7978845608028654f * (x + 0.044715f * x * x * x); return 0.5f * x * (1.f + tanhf(u)); }

#include <hip/hip_cooperative_groups.h>
namespace cg = cooperative_groups;
#define LAS __attribute__((address_space(3)))
typedef short bf16x8 __attribute__((ext_vector_type(8)));
typedef float f32x4 __attribute__((ext_vector_type(4)));
typedef unsigned u32x2 __attribute__((ext_vector_type(2)));
typedef unsigned u32x4 __attribute__((ext_vector_type(4)));

constexpr size_t WS_RS1 = 5 * MiB + 768 * 1024;
constexpr size_t WS_RSM = WS_RS1 + 65536;
constexpr size_t WS_PS2 = 4 * MiB;
constexpr size_t WS_WIN_T = 208 * MiB;
constexpr size_t WS_WG_T = 216 * MiB;
constexpr size_t WS_WML_T = 220 * MiB;
constexpr size_t WS_WNS_T = 221 * MiB;
constexpr size_t WS_WOUT_T = 222 * MiB;
constexpr size_t WS_WQ_T = 224 * MiB;
constexpr size_t WS_WKV_T = 226 * MiB;
constexpr size_t WS_WO_T = 230 * MiB;
constexpr size_t WS_MEMB = 238 * MiB;
constexpr size_t WS_KVC = WS_KV;
constexpr size_t WS_KS = WS_KV + 8 * MiB;
constexpr size_t WS_KW = WS_KV + 12 * MiB;
constexpr size_t WS_VST = WS_KV + 16 * MiB;
constexpr size_t WS_VWT = WS_KV + 20 * MiB;
constexpr size_t WS_CK1T = 232 * MiB;
constexpr size_t WS_CV1T = 232 * MiB + 512 * 1024;
constexpr size_t WS_POSW = WS_RSM + 8192 + 65536;
constexpr int NIN = 3584;

__device__ __forceinline__ void st_bf4(bf16_t* p, f32x4 v) { u32x2 o; o.x = pk2bf(v[0], v[1]); o.y = pk2bf(v[2], v[3]); *(u32x2*)p = o; }
__device__ __forceinline__ void swap8(const f32x4& v0, const f32x4& v1, float (&o)[8]) {
#pragma unroll
  for (int j = 0; j < 4; ++j) { const auto r = __builtin_amdgcn_permlane16_swap(__float_as_uint(v0[j]), __float_as_uint(v1[j]), false, false); o[j] = __uint_as_float(r[0]); o[4 + j] = __uint_as_float(r[1]); }
}
__device__ __forceinline__ void bf8_to_f32(const u32x4 p, float (&o)[8]) {
  o[0] = __uint_as_float(p.x << 16); o[1] = __uint_as_float(p.x & 0xffff0000u); o[2] = __uint_as_float(p.y << 16); o[3] = __uint_as_float(p.y & 0xffff0000u);
  o[4] = __uint_as_float(p.z << 16); o[5] = __uint_as_float(p.z & 0xffff0000u); o[6] = __uint_as_float(p.w << 16); o[7] = __uint_as_float(p.w & 0xffff0000u);
}
__device__ __forceinline__ u32x4 pk8bf(const float (&v)[8]) { u32x4 o; o.x = pk2bf(v[0], v[1]); o.y = pk2bf(v[2], v[3]); o.z = pk2bf(v[4], v[5]); o.w = pk2bf(v[6], v[7]); return o; }
__device__ __forceinline__ void st_bf8_pair(bf16_t* p, int fq, f32x4 v0, f32x4 v1) {
  const auto sx = __builtin_amdgcn_permlane16_swap(pk2bf(v0[0], v0[1]), pk2bf(v1[0], v1[1]), false, false);
  const auto sy = __builtin_amdgcn_permlane16_swap(pk2bf(v0[2], v0[3]), pk2bf(v1[2], v1[3]), false, false);
  u32x4 o; o.x = sx[0]; o.y = sy[0]; o.z = sx[1]; o.w = sy[1];
  __builtin_nontemporal_store(o, (u32x4*)(p + (fq & 1) * 16 + (fq >> 1) * 8));
}
__device__ __forceinline__ void st_bf8_pair_c(bf16_t* p, int fq, f32x4 v0, f32x4 v1) {
  const auto sx = __builtin_amdgcn_permlane16_swap(pk2bf(v0[0], v0[1]), pk2bf(v1[0], v1[1]), false, false);
  const auto sy = __builtin_amdgcn_permlane16_swap(pk2bf(v0[2], v0[3]), pk2bf(v1[2], v1[3]), false, false);
  u32x4 o; o.x = sx[0]; o.y = sy[0]; o.z = sx[1]; o.w = sy[1];
  *(u32x4*)(p + (fq & 1) * 16 + (fq >> 1) * 8) = o;
}

struct TDesc { const float* src; bf16_t* dst; const float* gain; int ldw, K, c0, ncols, drow0, nitems, mode, rofs, per, sstride, dstride, pad; };
__device__ __forceinline__ void transpose_item(const TDesc& d, int item, float* t  , int tid) {
  const int bat = item / d.per; item -= bat * d.per;
  const float* src = d.src + (size_t)bat * d.sstride; bf16_t* dst = d.dst + (size_t)bat * d.dstride;
  const int ncb = (d.ncols + 63) >> 6; const int kb = item / ncb, cb = item % ncb; const int k0 = kb * 64, n0 = cb * 64;
  {
    const int c4 = (tid & 15) * 4, kq = tid >> 4;
    f32x4 v[4];
#pragma unroll
    for (int p = 0; p < 4; ++p) {
      const int kk = p * 16 + kq;
      v[p] = (n0 + c4 < d.ncols) ? *(const f32x4*)(src + (size_t)(k0 + kk) * d.ldw + d.c0 + n0 + c4) : (f32x4){0.f, 0.f, 0.f, 0.f};
    }
#pragma unroll
    for (int p = 0; p < 4; ++p) {
      const int kk = p * 16 + kq; const float g = d.gain ? d.gain[k0 + kk] : 1.f;
      float* tp = t + kk * 65 + c4; tp[0] = v[p][0] * g; tp[1] = v[p][1] * g; tp[2] = v[p][2] * g; tp[3] = v[p][3] * g;
    }
  }
  __syncthreads();
#pragma unroll
  for (int j = 0; j < 2; ++j) {
    int c = tid + j * 256; int n = c >> 3, kc = c & 7;
    if (n0 + n < d.ncols) {
      const float* p = t + (kc * 8) * 65 + n;
      u32x4 o; o.x = pk2bf(p[0], p[65]); o.y = pk2bf(p[130], p[195]); o.z = pk2bf(p[260], p[325]); o.w = pk2bf(p[390], p[455]);
      const int drow = d.mode == 2 ? (d.drow0 + (cb * 4 + (n >> 4)) * 32 + (n & 15) + d.rofs) : d.mode ? (d.drow0 + cb * 128 + (n >> 5) * 64 + (n & 31) + d.rofs) : (d.drow0 + n0 + n);
      *(u32x4*)(dst + (size_t)drow * d.K + k0 + kc * 8) = o;
    }
  }
  __syncthreads();
}

__device__ __forceinline__ void rows_to_bf16(const float* __restrict__ src, bf16_t* __restrict__ dst, float* __restrict__ rs, int nrows, int gw, int ngw, int lane) {
  for (int row = gw; row < nrows; row += ngw) {
    const f32x4* xr = (const f32x4*)(src + (size_t)row * DM) + lane;
    f32x4 v[4]; float s = 0.f;
#pragma unroll
    for (int j = 0; j < 4; ++j) { v[j] = xr[64 * j]; s += v[j][0] * v[j][0] + v[j][1] * v[j][1] + v[j][2] * v[j][2] + v[j][3] * v[j][3]; }
    s = wave_sum(s);
    if (lane == 0) rs[row] = rsqrtf(s * (1.f / DM) + EPS);
#pragma unroll
    for (int j = 0; j < 4; ++j) st_bf4(dst + (size_t)row * DM + (lane + 64 * j) * 4, v[j]);
  }
}

__device__ __forceinline__ void glds16(const void* g, char* l) {
  __builtin_amdgcn_global_load_lds((const unsigned*)g, (LAS unsigned*)l, 16, 0, 0);
}
__device__ __forceinline__ int st_row(int tid, int i) { return (tid >> 3) + 32 * i; }
__device__ __forceinline__ int st_lc(int tid, int i) { return (tid & 7) ^ ((st_row(tid, i) >> 1) & 7); }
__device__ __forceinline__ void gemm_core(f32x4 (&acc)[4][4], const bf16_t* __restrict__ A, const unsigned (&ao)[4], unsigned ksa,
                                          const bf16_t* __restrict__ Bt, const unsigned (&bo)[4], unsigned ksb, int nt, char* lds, int tid) {
  const int lane = tid & 63, wid = tid >> 6, wr = wid >> 1, wc = wid & 1, fr = lane & 15, fq = lane >> 4;
  char* ldst = lds + tid * 16;
#pragma unroll
  for (int i = 0; i < 4; ++i) { glds16(A + ao[i], ldst + i * 4096); glds16(Bt + bo[i], ldst + 16384 + i * 4096); }
  const int sw = fr >> 1;
  const int aoff = (wr * 64 + fr) * 128, boff = (wc * 64 + fr) * 128;
  for (int t = 0; t < nt; ++t) {
    asm volatile("s_waitcnt vmcnt(0)" ::: "memory");
    __syncthreads();
    const int cur = t & 1;
    if (t + 1 < nt) {
      char* nb = ldst + (cur ^ 1) * 32768; const unsigned ka = (t + 1) * ksa, kb = (t + 1) * ksb;
#pragma unroll
      for (int i = 0; i < 4; ++i) { glds16(A + (ao[i] + ka), nb + i * 4096); glds16(Bt + (bo[i] + kb), nb + 16384 + i * 4096); }
    }
    const char* sA = lds + cur * 32768 + aoff; const char* sB = lds + cur * 32768 + 16384 + boff;
#pragma unroll
    for (int ks = 0; ks < 2; ++ks) {
      bf16x8 a[4], b[4];
      const int co = ((ks * 4 + fq) ^ sw) << 4;
#pragma unroll
      for (int i = 0; i < 4; ++i) { a[i] = *(const bf16x8*)(sA + i * 2048 + co); b[i] = *(const bf16x8*)(sB + i * 2048 + co); }
#pragma unroll
      for (int i = 0; i < 4; ++i)
#pragma unroll
        for (int j = 0; j < 4; ++j) acc[i][j] = __builtin_amdgcn_mfma_f32_16x16x32_bf16(b[j], a[i], acc[i][j], 0, 0, 0);
    }
  }
  __syncthreads();
}
__device__ __forceinline__ void gemm_acc(f32x4 (&acc)[4][4], const bf16_t* __restrict__ A, size_t lda, const int* __restrict__ arow, int ashift, int mvalid,
                                         const bf16_t* __restrict__ Bt, size_t ldb, int K, char* lds, int m0, int n0, int tid) {
  asm volatile("" : "+v"(tid));
  unsigned ao[4], bo[4];
#pragma unroll
  for (int i = 0; i < 4; ++i) {
    const int row = st_row(tid, i), lc = st_lc(tid, i);
    int gr;
    if (arow) { int mm = m0 + row; if (mm >= mvalid) mm = mvalid - 1; gr = arow[mm] >> ashift; } else gr = m0 + row;
    ao[i] = (unsigned)gr * (unsigned)lda + lc * 8;
    bo[i] = (unsigned)(n0 + row) * (unsigned)ldb + lc * 8;
  }
  gemm_core(acc, A, ao, 64u, Bt, bo, 64u, K >> 6, lds, tid);
}
__device__ __forceinline__ void zero_acc(f32x4 (&acc)[4][4]) {
#pragma unroll
  for (int i = 0; i < 4; ++i)
#pragma unroll
    for (int j = 0; j < 4; ++j) acc[i][j] = (f32x4){0.f, 0.f, 0.f, 0.f};
}


namespace pg8 {
#define PG8_LAS __attribute__((address_space(3)))
typedef unsigned short bf16_t;
typedef short bf16x8 __attribute__((ext_vector_type(8)));
typedef float f32x4 __attribute__((ext_vector_type(4)));
typedef unsigned u32x4 __attribute__((ext_vector_type(4)));
constexpr int BM = 256, BK = 64, HALF = 128, HTB = HALF * BK * 2  , STAGE_BYTES = 8 * HTB, NXCD = 8, WGM = 8;

__host__ __device__ __forceinline__ int lds_byte(int r, int c) { const int st = (r >> 4) * 2 + (c >> 5), rr = r & 15, cc = c & 31, ob = rr * 64 + cc * 2; return st * 1024 + (ob ^ (((ob >> 9) & 1) << 5)); }
__host__ __device__ __forceinline__ void stage_rc(int b, int& R, int& C) { const int st = b / 1024, sb = b % 1024, swz = sb ^ (((sb >> 9) & 1) << 5); R = (st >> 1) * 16 + swz / 64; C = (st & 1) * 32 + (swz % 64) / 2; }
__host__ __device__ __forceinline__ int perm32(int rho) { const int n = rho >> 4, i = rho & 15; return 8 * (i >> 2) + 4 * n + (i & 3); }

struct Unit { int pm, pn; const char* aptr; const char* bptr; int e, ce, p0, rt, K; };
struct Gemm { int K; };
template <class Epi, class Sched, bool ALIGN_EPI = false, bool SP2 = false, bool ACOH = false  >
__device__ __forceinline__ void gemm_phase(PG8_LAS unsigned char* lds, const Gemm g, const Sched& S, const Epi& E, int tid  , int wid  ) {
    asm volatile("" : "+v"(tid));
    const int lane = tid & 63, wr = wid >> 2, wc = wid & 3, fr = lane & 15, fq = lane >> 4;
    const int K = g.K, nt = K / BK;
    unsigned voffA[2], voffB[2];
#pragma unroll
    for (int i = 0; i < 2; ++i) { int R, C; stage_rc(tid * 16 + i * 8192, R, C); const int Rb = Epi::PERM ? ((R & ~31) + perm32(R & 31)) : R;
        voffA[i] = (unsigned)(R * K + C) * 2u; voffB[i] = (unsigned)(Rb * K + C) * 2u; }
    unsigned cva0[2], cva1[2], nva0[2], nva1[2];
    const size_t kstep = (size_t)(BK * 2);
    const size_t hstep = (size_t)HALF * K * 2;
    const unsigned ldsw = (unsigned)wid * 1024u;
    const int aoff = lds_byte(wr * 64 + fr, fq * 8), boff = lds_byte(wc * 32 + fr, fq * 8);
#define PG8_SA(b, h) (((b) * 2 + (h)) * HTB)
#define PG8_SB(b, h) ((4 + (b) * 2 + (h)) * HTB)
#define PG8_STAGE(bufoff, gbase, voff) do { _Pragma("unroll") for (int _i = 0; _i < 2; ++_i) \
        __builtin_amdgcn_global_load_lds((const unsigned*)((const char*)(gbase) + (voff)[_i]), (PG8_LAS unsigned*)(lds + (bufoff) + ldsw + _i * 8192), 16, 0, 0); } while (0)
#define PG8_STAGEA(bufoff, gbase, voff) do { _Pragma("unroll") for (int _i = 0; _i < 2; ++_i) { \
        if constexpr (ACOH) __builtin_amdgcn_global_load_lds((const unsigned*)((const char*)(gbase) + (voff)[_i]), (PG8_LAS unsigned*)(lds + (bufoff) + ldsw + _i * 8192), 16, 0, 16  ); \
        else __builtin_amdgcn_global_load_lds((const unsigned*)((const char*)(gbase) + (voff)[_i]), (PG8_LAS unsigned*)(lds + (bufoff) + ldsw + _i * 8192), 16, 0, 0); } } while (0)
#define PG8_LDA(dst, b, h) do { _Pragma("unroll") for (int m = 0; m < 4; ++m) _Pragma("unroll") for (int k = 0; k < 2; ++k) dst[m][k] = *(const PG8_LAS bf16x8*)(lds + PG8_SA(b, h) + aoff + m * 2048 + k * 1024); } while (0)
#define PG8_LDB(dst, b, h) do { _Pragma("unroll") for (int n = 0; n < 2; ++n) _Pragma("unroll") for (int k = 0; k < 2; ++k) dst[n][k] = *(const PG8_LAS bf16x8*)(lds + PG8_SB(b, h) + boff + n * 2048 + k * 1024); } while (0)
#define PG8_MMA(ai, bj, At, Bt) do { __builtin_amdgcn_s_setprio(1); _Pragma("unroll") for (int m = 0; m < 4; ++m) _Pragma("unroll") for (int n = 0; n < 2; ++n) _Pragma("unroll") for (int k = 0; k < 2; ++k) \
        acc[ai][bj][m][n] = __builtin_amdgcn_mfma_f32_16x16x32_bf16(Bt[n][k], At[m][k], acc[ai][bj][m][n], 0, 0, 0); __builtin_amdgcn_s_setprio(0); } while (0)
#define PG8_WAIT_V(n) asm volatile("s_waitcnt vmcnt(" #n ")" ::: "memory")
#define PG8_WAIT_L(n) asm volatile("s_waitcnt lgkmcnt(" #n ")" ::: "memory")
#define PG8_BAR __builtin_amdgcn_s_barrier()
#define PG8_SCHED __builtin_amdgcn_sched_barrier(0)
    Unit cur, nxt; int ui = 0;
    if (!S.next(0, cur)) return;
    S.avoff(cur, tid, K, voffA, cva0, cva1);
    f32x4 acc[2][2][4][2];
#pragma unroll
    for (int a = 0; a < 2; ++a)
#pragma unroll
        for (int b = 0; b < 2; ++b)
#pragma unroll
            for (int m = 0; m < 4; ++m)
#pragma unroll
                for (int n = 0; n < 2; ++n) acc[a][b][m][n] = (f32x4){0.f, 0.f, 0.f, 0.f};
    bf16x8 At[4][2], B0[2][2], B1[2][2];
    const char* cA = cur.aptr; const char* cB = cur.bptr;
    S.a_ready(cur);
    if constexpr (SP2) {
        PG8_STAGE(PG8_SB(0, 0), cB, voffB); PG8_STAGE(PG8_SB(0, 1), cB + hstep, voffB); PG8_STAGEA(PG8_SA(0, 0), cA, cva0); PG8_STAGEA(PG8_SA(0, 1), cA, cva1);
        if (wr == 1) PG8_BAR;
        PG8_WAIT_V(2); PG8_BAR;
        PG8_STAGE(PG8_SB(1, 0), cB + kstep, voffB); PG8_STAGEA(PG8_SA(1, 0), cA + kstep, cva0); PG8_STAGE(PG8_SB(1, 1), cB + hstep + kstep, voffB);
        PG8_WAIT_V(6); PG8_BAR;
    } else {
        PG8_STAGE(PG8_SB(0, 0), cB, voffB); PG8_STAGEA(PG8_SA(0, 0), cA, cva0); PG8_STAGE(PG8_SB(0, 1), cB + hstep, voffB); PG8_STAGEA(PG8_SA(0, 1), cA, cva1);
        if (wr == 1) PG8_BAR;
        PG8_WAIT_V(4); PG8_BAR;
        PG8_STAGE(PG8_SB(1, 0), cB + kstep, voffB); PG8_STAGEA(PG8_SA(1, 0), cA + kstep, cva0); PG8_STAGE(PG8_SB(1, 1), cB + hstep + kstep, voffB);
        PG8_WAIT_V(6); PG8_BAR;
    }
    for (;;) {
        const bool has_next = S.next(ui + 1, nxt);
        if (has_next) S.avoff(nxt, tid, K, voffA, nva0, nva1); else { nva0[0] = cva0[0]; nva0[1] = cva0[1]; nva1[0] = cva1[0]; nva1[1] = cva1[1]; }
        const char* nA = has_next ? nxt.aptr : cA; const char* nB = has_next ? nxt.bptr : cB;
        for (int t = 0; t < nt; t += 2) {
            const bool last = (t == nt - 2);
            const char* a1 = cA + (size_t)(t + 1) * kstep;
            const char* a2 = last ? nA : cA + (size_t)(t + 2) * kstep; const char* b2 = last ? nB : cB + (size_t)(t + 2) * kstep;
            const char* a3 = a2 + kstep; const char* b3 = b2 + kstep;
            const unsigned xva0[2] = {last ? nva0[0] : cva0[0], last ? nva0[1] : cva0[1]}, xva1[2] = {last ? nva1[0] : cva1[0], last ? nva1[1] : cva1[1]};
            if (last && has_next) S.a_ready(nxt);
            if constexpr (SP2) {
            PG8_LDB(B0, 0, 0); PG8_LDB(B1, 0, 1); PG8_SCHED; PG8_LDA(At, 0, 0); PG8_STAGEA(PG8_SA(1, 1), a1, cva1);
            PG8_WAIT_V(8); PG8_WAIT_L(0); PG8_BAR; PG8_MMA(0, 0, At, B0); PG8_MMA(0, 1, At, B1); PG8_BAR; PG8_SCHED;
            PG8_LDA(At, 0, 1); PG8_STAGE(PG8_SB(0, 0), b2, voffB); PG8_STAGE(PG8_SB(0, 1), b2 + hstep, voffB); PG8_STAGEA(PG8_SA(0, 0), a2, xva0);
            PG8_WAIT_V(8); PG8_WAIT_L(0); PG8_BAR; PG8_MMA(1, 0, At, B0); PG8_MMA(1, 1, At, B1); PG8_BAR; PG8_SCHED;
            PG8_LDB(B0, 1, 0); PG8_LDB(B1, 1, 1); PG8_SCHED; PG8_LDA(At, 1, 0); PG8_STAGEA(PG8_SA(0, 1), a2, xva1);
            PG8_WAIT_V(8); PG8_WAIT_L(0); PG8_BAR; PG8_MMA(0, 0, At, B0); PG8_MMA(0, 1, At, B1); PG8_BAR; PG8_SCHED;
            PG8_LDA(At, 1, 1); PG8_STAGE(PG8_SB(1, 0), b3, voffB); PG8_STAGE(PG8_SB(1, 1), b3 + hstep, voffB); PG8_STAGEA(PG8_SA(1, 0), a3, xva0);
            PG8_WAIT_V(8); PG8_WAIT_L(0); PG8_BAR; PG8_MMA(1, 0, At, B0); PG8_MMA(1, 1, At, B1); PG8_BAR; PG8_SCHED;
            } else {
            PG8_LDB(B0, 0, 0); PG8_SCHED; PG8_LDA(At, 0, 0); PG8_STAGEA(PG8_SA(1, 1), a1, cva1);
            PG8_WAIT_L(8); PG8_BAR; PG8_WAIT_L(0); PG8_MMA(0, 0, At, B0); PG8_BAR; PG8_SCHED;
            PG8_LDB(B1, 0, 1); PG8_STAGE(PG8_SB(0, 0), b2, voffB);
            PG8_BAR; PG8_WAIT_L(0); PG8_MMA(0, 1, At, B1); PG8_BAR;
            PG8_LDA(At, 0, 1); PG8_STAGEA(PG8_SA(0, 0), a2, xva0);
            PG8_BAR; PG8_WAIT_L(0); PG8_MMA(1, 0, At, B0); PG8_BAR; PG8_SCHED;
            PG8_STAGE(PG8_SB(0, 1), b2 + hstep, voffB);
            PG8_WAIT_V(6); PG8_BAR; PG8_MMA(1, 1, At, B1); PG8_BAR;
            PG8_LDB(B0, 1, 0); PG8_SCHED; PG8_LDA(At, 1, 0); PG8_STAGEA(PG8_SA(0, 1), a2, xva1);
            PG8_WAIT_L(8); PG8_BAR; PG8_WAIT_L(0); PG8_MMA(0, 0, At, B0); PG8_BAR; PG8_SCHED;
            PG8_LDB(B1, 1, 1); PG8_STAGE(PG8_SB(1, 0), b3, voffB);
            PG8_BAR; PG8_WAIT_L(0); PG8_MMA(0, 1, At, B1); PG8_BAR;
            PG8_LDA(At, 1, 1); PG8_STAGEA(PG8_SA(1, 0), a3, xva0);
            PG8_BAR; PG8_WAIT_L(0); PG8_MMA(1, 0, At, B0); PG8_BAR; PG8_SCHED;
            PG8_STAGE(PG8_SB(1, 1), b3 + hstep, voffB);
            PG8_WAIT_V(6); PG8_BAR; PG8_MMA(1, 1, At, B1); PG8_BAR;
            }
        }
        if constexpr (ALIGN_EPI) { if (wr == 0) PG8_BAR; }
        if constexpr (!Epi::AFTER_DRAIN) { E(acc, cur, wr, wc, fr, fq); S.done(cur); }
        if (!has_next) break;
#pragma unroll
        for (int a = 0; a < 2; ++a)
#pragma unroll
            for (int b = 0; b < 2; ++b)
#pragma unroll
                for (int m = 0; m < 4; ++m)
#pragma unroll
                    for (int n = 0; n < 2; ++n) acc[a][b][m][n] = (f32x4){0.f, 0.f, 0.f, 0.f};
        cur = nxt; cA = nA; cB = nB; ++ui; cva0[0] = nva0[0]; cva0[1] = nva0[1]; cva1[0] = nva1[0]; cva1[1] = nva1[1];
        if constexpr (ALIGN_EPI) { if (wr == 1) PG8_BAR; }
    }
    PG8_WAIT_V(0);
    if constexpr (!ALIGN_EPI) { if (wr == 0) PG8_BAR; }
    PG8_BAR;
    if constexpr (Epi::AFTER_DRAIN) { E.fused(acc, cur, wr, wc, fr, fq, lds, wid, lane); S.done(cur); }
#undef PG8_SA
#undef PG8_SB
#undef PG8_STAGE
#undef PG8_STAGEA
#undef PG8_LDA
#undef PG8_LDB
#undef PG8_MMA
#undef PG8_WAIT_V
#undef PG8_WAIT_L
#undef PG8_BAR
#undef PG8_SCHED
}
template <class Epi, class Sched, bool ALIGN_EPI = false, bool SP2 = true, bool ACOH = false>
__device__ __forceinline__ void gemm_phase_vk(PG8_LAS unsigned char* lds, const Gemm g, const Sched& S, const Epi& E, int tid  , int wid  ) {
    static_assert(!Epi::PERM, "no row permutation in the per-unit-K body");
    asm volatile("" : "+v"(tid));
    const int lane = tid & 63, wr = wid >> 2, wc = wid & 3, fr = lane & 15, fq = lane >> 4;
    (void)g;
    unsigned vR2[2], vC2[2];
#pragma unroll
    for (int i = 0; i < 2; ++i) { int R, C; stage_rc(tid * 16 + i * 8192, R, C); vR2[i] = (unsigned)R * 2u; vC2[i] = (unsigned)C * 2u; }
    unsigned cvb[2], nvb[2];
    unsigned cva0[2], cva1[2], nva0[2], nva1[2];
    const size_t kstep = (size_t)(BK * 2);
    const unsigned ldsw = (unsigned)wid * 1024u;
    const int aoff = lds_byte(wr * 64 + fr, fq * 8), boff = lds_byte(wc * 32 + fr, fq * 8);
#define PG8_SA(b, h) (((b) * 2 + (h)) * HTB)
#define PG8_SB(b, h) ((4 + (b) * 2 + (h)) * HTB)
#define PG8_STAGE(bufoff, gbase, voff) do { _Pragma("unroll") for (int _i = 0; _i < 2; ++_i) \
        __builtin_amdgcn_global_load_lds((const unsigned*)((const char*)(gbase) + (voff)[_i]), (PG8_LAS unsigned*)(lds + (bufoff) + ldsw + _i * 8192), 16, 0, 0); } while (0)
#define PG8_STAGEA(bufoff, gbase, voff) do { _Pragma("unroll") for (int _i = 0; _i < 2; ++_i) { \
        if constexpr (ACOH) __builtin_amdgcn_global_load_lds((const unsigned*)((const char*)(gbase) + (voff)[_i]), (PG8_LAS unsigned*)(lds + (bufoff) + ldsw + _i * 8192), 16, 0, 16  ); \
        else __builtin_amdgcn_global_load_lds((const unsigned*)((const char*)(gbase) + (voff)[_i]), (PG8_LAS unsigned*)(lds + (bufoff) + ldsw + _i * 8192), 16, 0, 0); } } while (0)
#define PG8_LDA(dst, b, h) do { _Pragma("unroll") for (int m = 0; m < 4; ++m) _Pragma("unroll") for (int k = 0; k < 2; ++k) dst[m][k] = *(const PG8_LAS bf16x8*)(lds + PG8_SA(b, h) + aoff + m * 2048 + k * 1024); } while (0)
#define PG8_LDB(dst, b, h) do { _Pragma("unroll") for (int n = 0; n < 2; ++n) _Pragma("unroll") for (int k = 0; k < 2; ++k) dst[n][k] = *(const PG8_LAS bf16x8*)(lds + PG8_SB(b, h) + boff + n * 2048 + k * 1024); } while (0)
#define PG8_MMA(ai, bj, At, Bt) do { __builtin_amdgcn_s_setprio(1); _Pragma("unroll") for (int m = 0; m < 4; ++m) _Pragma("unroll") for (int n = 0; n < 2; ++n) _Pragma("unroll") for (int k = 0; k < 2; ++k) \
        acc[ai][bj][m][n] = __builtin_amdgcn_mfma_f32_16x16x32_bf16(Bt[n][k], At[m][k], acc[ai][bj][m][n], 0, 0, 0); __builtin_amdgcn_s_setprio(0); } while (0)
#define PG8_WAIT_V(n) asm volatile("s_waitcnt vmcnt(" #n ")" ::: "memory")
#define PG8_WAIT_L(n) asm volatile("s_waitcnt lgkmcnt(" #n ")" ::: "memory")
#define PG8_BAR __builtin_amdgcn_s_barrier()
#define PG8_SCHED __builtin_amdgcn_sched_barrier(0)
    Unit cur, nxt; int ui = 0;
    if (!S.next(0, cur)) return;
    int cK = cur.K, nK = cur.K;
    size_t chs = (size_t)HALF * cK * 2, nhs = chs;
    { const unsigned va[2] = {vR2[0] * (unsigned)cK + vC2[0], vR2[1] * (unsigned)cK + vC2[1]}; cvb[0] = va[0]; cvb[1] = va[1]; S.avoff(cur, tid, cK, va, cva0, cva1); }
    f32x4 acc[2][2][4][2];
#pragma unroll
    for (int a = 0; a < 2; ++a)
#pragma unroll
        for (int b = 0; b < 2; ++b)
#pragma unroll
            for (int m = 0; m < 4; ++m)
#pragma unroll
                for (int n = 0; n < 2; ++n) acc[a][b][m][n] = (f32x4){0.f, 0.f, 0.f, 0.f};
    bf16x8 At[4][2], B0[2][2], B1[2][2];
    const char* cA = cur.aptr; const char* cB = cur.bptr;
    S.a_ready(cur);
    if constexpr (SP2) {
        PG8_STAGE(PG8_SB(0, 0), cB, cvb); PG8_STAGE(PG8_SB(0, 1), cB + chs, cvb); PG8_STAGEA(PG8_SA(0, 0), cA, cva0); PG8_STAGEA(PG8_SA(0, 1), cA, cva1);
        if (wr == 1) PG8_BAR;
        PG8_WAIT_V(2); PG8_BAR;
        PG8_STAGE(PG8_SB(1, 0), cB + kstep, cvb); PG8_STAGEA(PG8_SA(1, 0), cA + kstep, cva0); PG8_STAGE(PG8_SB(1, 1), cB + chs + kstep, cvb);
        PG8_WAIT_V(6); PG8_BAR;
    } else {
        PG8_STAGE(PG8_SB(0, 0), cB, cvb); PG8_STAGEA(PG8_SA(0, 0), cA, cva0); PG8_STAGE(PG8_SB(0, 1), cB + chs, cvb); PG8_STAGEA(PG8_SA(0, 1), cA, cva1);
        if (wr == 1) PG8_BAR;
        PG8_WAIT_V(4); PG8_BAR;
        PG8_STAGE(PG8_SB(1, 0), cB + kstep, cvb); PG8_STAGEA(PG8_SA(1, 0), cA + kstep, cva0); PG8_STAGE(PG8_SB(1, 1), cB + chs + kstep, cvb);
        PG8_WAIT_V(6); PG8_BAR;
    }
    for (;;) {
        const bool has_next = S.next(ui + 1, nxt);
        if (has_next) { nK = nxt.K; nhs = (size_t)HALF * nK * 2; const unsigned va[2] = {vR2[0] * (unsigned)nK + vC2[0], vR2[1] * (unsigned)nK + vC2[1]}; nvb[0] = va[0]; nvb[1] = va[1]; S.avoff(nxt, tid, nK, va, nva0, nva1); }
        else { nK = cK; nhs = chs; nvb[0] = cvb[0]; nvb[1] = cvb[1]; nva0[0] = cva0[0]; nva0[1] = cva0[1]; nva1[0] = cva1[0]; nva1[1] = cva1[1]; }
        const int nt = cK / BK;
        const char* nA = has_next ? nxt.aptr : cA; const char* nB = has_next ? nxt.bptr : cB;
        for (int t = 0; t < nt; t += 2) {
            const bool last = (t == nt - 2);
            const char* a1 = cA + (size_t)(t + 1) * kstep;
            const char* a2 = last ? nA : cA + (size_t)(t + 2) * kstep; const char* b2 = last ? nB : cB + (size_t)(t + 2) * kstep;
            const char* a3 = a2 + kstep; const char* b3 = b2 + kstep;
            const unsigned xva0[2] = {last ? nva0[0] : cva0[0], last ? nva0[1] : cva0[1]}, xva1[2] = {last ? nva1[0] : cva1[0], last ? nva1[1] : cva1[1]};
            const unsigned xvb[2] = {last ? nvb[0] : cvb[0], last ? nvb[1] : cvb[1]}; const size_t xhs = last ? nhs : chs;
            if (last && has_next) S.a_ready(nxt);
            if constexpr (SP2) {
            PG8_LDB(B0, 0, 0); PG8_LDB(B1, 0, 1); PG8_SCHED; PG8_LDA(At, 0, 0); PG8_STAGEA(PG8_SA(1, 1), a1, cva1);
            PG8_WAIT_V(8); PG8_WAIT_L(0); PG8_BAR; PG8_MMA(0, 0, At, B0); PG8_MMA(0, 1, At, B1); PG8_BAR; PG8_SCHED;
            PG8_LDA(At, 0, 1); PG8_STAGE(PG8_SB(0, 0), b2, xvb); PG8_STAGE(PG8_SB(0, 1), b2 + xhs, xvb); PG8_STAGEA(PG8_SA(0, 0), a2, xva0);
            PG8_WAIT_V(8); PG8_WAIT_L(0); PG8_BAR; PG8_MMA(1, 0, At, B0); PG8_MMA(1, 1, At, B1); PG8_BAR; PG8_SCHED;
            PG8_LDB(B0, 1, 0); PG8_LDB(B1, 1, 1); PG8_SCHED; PG8_LDA(At, 1, 0); PG8_STAGEA(PG8_SA(0, 1), a2, xva1);
            PG8_WAIT_V(8); PG8_WAIT_L(0); PG8_BAR; PG8_MMA(0, 0, At, B0); PG8_MMA(0, 1, At, B1); PG8_BAR; PG8_SCHED;
            PG8_LDA(At, 1, 1); PG8_STAGE(PG8_SB(1, 0), b3, xvb); PG8_STAGE(PG8_SB(1, 1), b3 + xhs, xvb); PG8_STAGEA(PG8_SA(1, 0), a3, xva0);
            PG8_WAIT_V(8); PG8_WAIT_L(0); PG8_BAR; PG8_MMA(1, 0, At, B0); PG8_MMA(1, 1, At, B1); PG8_BAR; PG8_SCHED;
            } else {
            PG8_LDB(B0, 0, 0); PG8_SCHED; PG8_LDA(At, 0, 0); PG8_STAGEA(PG8_SA(1, 1), a1, cva1);
            PG8_WAIT_L(8); PG8_BAR; PG8_WAIT_L(0); PG8_MMA(0, 0, At, B0); PG8_BAR; PG8_SCHED;
            PG8_LDB(B1, 0, 1); PG8_STAGE(PG8_SB(0, 0), b2, xvb);
            PG8_BAR; PG8_WAIT_L(0); PG8_MMA(0, 1, At, B1); PG8_BAR;
            PG8_LDA(At, 0, 1); PG8_STAGEA(PG8_SA(0, 0), a2, xva0);
            PG8_BAR; PG8_WAIT_L(0); PG8_MMA(1, 0, At, B0); PG8_BAR; PG8_SCHED;
            PG8_STAGE(PG8_SB(0, 1), b2 + xhs, xvb);
            PG8_WAIT_V(6); PG8_BAR; PG8_MMA(1, 1, At, B1); PG8_BAR;
            PG8_LDB(B0, 1, 0); PG8_SCHED; PG8_LDA(At, 1, 0); PG8_STAGEA(PG8_SA(0, 1), a2, xva1);
            PG8_WAIT_L(8); PG8_BAR; PG8_WAIT_L(0); PG8_MMA(0, 0, At, B0); PG8_BAR; PG8_SCHED;
            PG8_LDB(B1, 1, 1); PG8_STAGE(PG8_SB(1, 0), b3, xvb);
            PG8_BAR; PG8_WAIT_L(0); PG8_MMA(0, 1, At, B1); PG8_BAR;
            PG8_LDA(At, 1, 1); PG8_STAGEA(PG8_SA(1, 0), a3, xva0);
            PG8_BAR; PG8_WAIT_L(0); PG8_MMA(1, 0, At, B0); PG8_BAR; PG8_SCHED;
            PG8_STAGE(PG8_SB(1, 1), b3 + xhs, xvb);
            PG8_WAIT_V(6); PG8_BAR; PG8_MMA(1, 1, At, B1); PG8_BAR;
            }
        }
        if constexpr (ALIGN_EPI) { if (wr == 0) PG8_BAR; }
        if constexpr (!Epi::AFTER_DRAIN) { E(acc, cur, wr, wc, fr, fq); S.done(cur); }
        if (!has_next) break;
#pragma unroll
        for (int a = 0; a < 2; ++a)
#pragma unroll
            for (int b = 0; b < 2; ++b)
#pragma unroll
                for (int m = 0; m < 4; ++m)
#pragma unroll
                    for (int n = 0; n < 2; ++n) acc[a][b][m][n] = (f32x4){0.f, 0.f, 0.f, 0.f};
        cur = nxt; cA = nA; cB = nB; ++ui; cva0[0] = nva0[0]; cva0[1] = nva0[1]; cva1[0] = nva1[0]; cva1[1] = nva1[1]; cvb[0] = nvb[0]; cvb[1] = nvb[1]; cK = nK; chs = nhs;
        if constexpr (ALIGN_EPI) { if (wr == 1) PG8_BAR; }
    }
    PG8_WAIT_V(0);
    if constexpr (!ALIGN_EPI) { if (wr == 0) PG8_BAR; }
    PG8_BAR;
    if constexpr (Epi::AFTER_DRAIN) { E.fused(acc, cur, wr, wc, fr, fq, lds, wid, lane); S.done(cur); }
#undef PG8_SA
#undef PG8_SB
#undef PG8_STAGE
#undef PG8_STAGEA
#undef PG8_LDA
#undef PG8_LDB
#undef PG8_MMA
#undef PG8_WAIT_V
#undef PG8_WAIT_L
#undef PG8_BAR
#undef PG8_SCHED
}
}

#define TILE8_IDS unsigned t8_z = 0u; asm volatile("" : "+v"(t8_z)); int t512 = wave_s * 64 + (int)__builtin_amdgcn_mbcnt_hi(~0u, __builtin_amdgcn_mbcnt_lo(~0u, t8_z)); asm volatile("" : "+v"(t512))
template <class Map> struct ListSched {
  int first, stride, count; Map map;
  __device__ __forceinline__ bool next(int i, pg8::Unit& u) const { const int idx = first + i * stride; if (idx >= count) return false; map(idx, u); return true; }
  __device__ __forceinline__ void avoff(const pg8::Unit& u, int tid, int K, const unsigned (&voffA)[2], unsigned (&v0)[2], unsigned (&v1)[2]) const { map.avoff(u, tid, K, voffA, v0, v1); }
  __device__ __forceinline__ void a_ready(const pg8::Unit&) const {}
  __device__ __forceinline__ void done(const pg8::Unit&) const {}
};
struct MlArgs { const float *conv, *b_i, *b_f, *gain; float *BCUM, *IP, *BL, *MX, *MST, *NST; bf16_t* CST; };
struct MegaArgs {
  const float* x; const float* mem; float* out;
  bf16_t *XB, *MEMB; float *RS1, *RSM, *PS2;
  bf16_t *QK, *V, *O, *NQ, *KVC, *KS, *KW, *VST, *VWT, *KC, *VCT, *CK1T, *CV1T; float *SM, *POSW;
  const float *posk, *posv, *ckw1, *cvw1, *ckw2, *cvw2;
  bf16_t *AML, *ANS, *MRG, *X1B, *XQ, *XO, *KVM;
  bf16_t *WinT, *WgT, *WmlT, *WnsT, *WoutT, *WqT, *WkvT, *WoT;
  bf16_t *H3, *ACT, *Y, *W13T, *W2T; float *RS3, *RTW; int *CNT, *LIST;
  const float *g_ffn, *wg, *bg, *we, *be, *g_final;
  unsigned* BAR;
  MlArgs ml;
  float* CPART; int* WQ;
  TDesc td[24]; int ntdA, ntdB; int ph_lo, ph_hi, li, pad; int rep[16]; int cv_lo[16], cv_hi[16];
};


constexpr int NSA_LDS = 66112;
constexpr int MEGA_LDS = 73728;
constexpr int HALF_LDS = 73728, CTRL_OFF = 2 * HALF_LDS, TOTAL_LDS = CTRL_OFF + 64;
typedef unsigned long long u64;

template <bool WITH_V>
__device__ __forceinline__ void nsa_load_tile(const bf16_t* __restrict__ Ksrc, unsigned kstride, const bf16_t* __restrict__ Vsrc, unsigned vstride, char* lds, int tid) {
#pragma unroll
  for (int i = 0; i < 2; ++i) {
    const int idx = tid + 256 * i, row = idx >> 3, lc = (idx & 7) ^ ((row >> 1) & 7);
    glds16(Ksrc + (size_t)row * kstride + lc * 8, lds + idx * 16);
    if (WITH_V) glds16(Vsrc + (size_t)row * vstride + lc * 8, lds + 8192 + idx * 16);
  }
}

__device__ __forceinline__ void nsa_qk(f32x4 (&sacc)[4][2], const bf16x8 (&qf)[4][2], const char* lds, int hf, int fr, int fq) {
#pragma unroll
  for (int mi = 0; mi < 4; ++mi)
#pragma unroll
    for (int ni = 0; ni < 2; ++ni) sacc[mi][ni] = (f32x4){0.f, 0.f, 0.f, 0.f};
#pragma unroll
  for (int ks = 0; ks < 2; ++ks) {
    bf16x8 kf[2];
    const int co = ((ks * 4 + fq) ^ (fr >> 1)) << 4;
#pragma unroll
    for (int ni = 0; ni < 2; ++ni) kf[ni] = *(const bf16x8*)(lds + ((hf * 2 + ni) * 16 + fr) * 128 + co);
#pragma unroll
    for (int mi = 0; mi < 4; ++mi)
#pragma unroll
      for (int ni = 0; ni < 2; ++ni) sacc[mi][ni] = __builtin_amdgcn_mfma_f32_16x16x32_bf16(kf[ni], qf[mi][ks], sacc[mi][ni], 0, 0, 0);
  }
}
__device__ __forceinline__ void nsa_pv(f32x4 (&oacc)[4][4], const f32x4 (&p)[4][2], char* lds, char* pw, int hf, int fr, int fq) {
#pragma unroll
  for (int mi = 0; mi < 4; ++mi)
#pragma unroll
    for (int ni = 0; ni < 2; ++ni) {
      u32x2 o; o.x = pk2bf(p[mi][ni][0], p[mi][ni][1]); o.y = pk2bf(p[mi][ni][2], p[mi][ni][3]);
      *(u32x2*)(pw + (mi * 16 + fr) * 128 + ((((hf * 2 + ni) * 2 + (fq >> 1)) ^ (fr >> 1)) << 4) + (fq & 1) * 8) = o;
    }
  bf16x8 pf[4], vf[4];
  const int co = ((hf * 4 + fq) ^ (fr >> 1)) << 4;
#pragma unroll
  for (int i = 0; i < 4; ++i) { pf[i] = *(const bf16x8*)(pw + (i * 16 + fr) * 128 + co); vf[i] = *(const bf16x8*)(lds + 8192 + (i * 16 + fr) * 128 + co); }
#pragma unroll
  for (int mi = 0; mi < 4; ++mi)
#pragma unroll
    for (int ni = 0; ni < 4; ++ni) oacc[mi][ni] = __builtin_amdgcn_mfma_f32_16x16x32_bf16(vf[ni], pf[mi], oacc[mi][ni], 0, 0, 0);
}
__device__ __forceinline__ float red4(float v) {
  const auto r = __builtin_amdgcn_permlane16_swap(__float_as_uint(v), __float_as_uint(v), false, false); v = __uint_as_float(r[0]) + __uint_as_float(r[1]);
  const auto q = __builtin_amdgcn_permlane32_swap(__float_as_uint(v), __float_as_uint(v), false, false); return __uint_as_float(q[0]) + __uint_as_float(q[1]);
}
__device__ __forceinline__ float max4(float v) {
  const auto r = __builtin_amdgcn_permlane16_swap(__float_as_uint(v), __float_as_uint(v), false, false); v = fmaxf(__uint_as_float(r[0]), __uint_as_float(r[1]));
  const auto q = __builtin_amdgcn_permlane32_swap(__float_as_uint(v), __float_as_uint(v), false, false); return fmaxf(__uint_as_float(q[0]), __uint_as_float(q[1]));
}

__device__ __forceinline__ void nsa_online(f32x4 (&sv)[4][2], float (&m_run)[4], float (&l_run)[4], f32x4 (&oacc)[4][4]) {
  float mxa[4];
#pragma unroll
  for (int mi = 0; mi < 4; ++mi)
    mxa[mi] = max4(fmaxf(fmaxf(fmaxf(sv[mi][0][0], sv[mi][0][1]), fmaxf(sv[mi][0][2], sv[mi][0][3])), fmaxf(fmaxf(sv[mi][1][0], sv[mi][1][1]), fmaxf(sv[mi][1][2], sv[mi][1][3]))));
#pragma unroll
  for (int mi = 0; mi < 4; ++mi) {
    const float mx = mxa[mi];
    if (__any(mx > m_run[mi] + 8.f)) {
      const float mn = fmaxf(fmaxf(m_run[mi], mx), -1e20f);
      const float alpha = __builtin_amdgcn_exp2f(m_run[mi] - mn);
      m_run[mi] = mn; l_run[mi] *= alpha;
#pragma unroll
      for (int ni = 0; ni < 4; ++ni) oacc[mi][ni] *= alpha;
    }
    float ls = 0.f;
#pragma unroll
    for (int ni = 0; ni < 2; ++ni)
#pragma unroll
      for (int j = 0; j < 4; ++j) { const float pv = __builtin_amdgcn_exp2f(sv[mi][ni][j] - m_run[mi]); sv[mi][ni][j] = pv; ls += pv; }
    l_run[mi] += ls;
  }
}

__device__ __forceinline__ void nsa_main_item(const MegaArgs& a, int item, char* lds, int tid, volatile int* xch, int half) {
  asm volatile("" : "+v"(tid));
  const int lane = tid & 63, wid = tid >> 6, fr = lane & 15, fq = lane >> 4;
  const int i = item & 63, g = (item >> 6) & 1, b = item >> 7;
  const int h = g * 4 + wid, nb = b * SEQ, t0 = i * 64, bg = b * 2 + g;
  const float slope = exp2f(-(float)(h + 1)) * 1.4426950408889634f;
  char* pw = lds + 16384 + wid * 8192;
  float* PSLC = (float*)(lds + 49152);
  u64* SELM = (u64*)(lds + 65536);
  u64* UNI = (u64*)(lds + 66048);
  bf16x8 qf[4][2];
#pragma unroll
  for (int mi = 0; mi < 4; ++mi)
#pragma unroll
    for (int ks = 0; ks < 2; ++ks) qf[mi][ks] = *(const bf16x8*)(a.NQ + (size_t)(nb + t0 + wid * 16 + fr) * 512 + (g * 4 + mi) * 64 + ks * 32 + fq * 8);
  for (int e = tid; e < 4096; e += 256) PSLC[e] = 0.f;
  f32x4 sacc[4][2], oacc[4][4];
  float m_run[4], l_run[4];
  const int nct = ((4 * i + 2) >> 6) + 1;
  const bf16_t* kcb = a.KC + (size_t)bg * 256 * 64;
  const bf16_t* vcb = a.VCT + (size_t)bg * 64 * 256;
  const int tc = t0 + wid * 16 + fr;
  const float slope0 = exp2f(-(float)(g * 4 + 1)) * 1.4426950408889634f;
#pragma unroll
  for (int mi = 0; mi < 4; ++mi) { m_run[mi] = -1e30f; l_run[mi] = 0.f; }
  __syncthreads();
  nsa_load_tile<false>(kcb, 64u, nullptr, 0u, lds, tid);
  for (int jt = 0; jt < nct; ++jt) {
    asm volatile("s_waitcnt vmcnt(0)" ::: "memory");
    __syncthreads();
    char* tb = (jt & 1) ? (lds + 16384) : lds;
    if (jt + 1 < nct) nsa_load_tile<false>(kcb + (size_t)(jt + 1) * 64 * 64, 64u, nullptr, 0u, (jt & 1) ? lds : (lds + 16384), tid);
#pragma unroll 1
    for (int hf = 0; hf < 2; ++hf) {
      nsa_qk(sacc, qf, tb, hf, fr, fq);
#pragma unroll
      for (int mi = 0; mi < 4; ++mi) {
        const float slope = slope0 * (1.f / (float)(1 << mi)); float mx = -1e30f;
#pragma unroll
        for (int ni = 0; ni < 2; ++ni)
#pragma unroll
          for (int j = 0; j < 4; ++j) {
            const int jj = jt * 64 + hf * 32 + ni * 16 + 4 * fq + j; const bool ok = (16 * jj + 31 <= tc);
            const float v = sacc[mi][ni][j] - slope * ((float)tc - (16.f * jj + 15.5f));
            sacc[mi][ni][j] = ok ? v : -1e30f; mx = fmaxf(mx, sacc[mi][ni][j]);
          }
        mx = max4(mx);
        const float mn = fmaxf(m_run[mi], mx); float ls = 0.f;
#pragma unroll
        for (int ni = 0; ni < 2; ++ni)
#pragma unroll
          for (int j = 0; j < 4; ++j) ls += (sacc[mi][ni][j] > -1e29f) ? __builtin_amdgcn_exp2f(sacc[mi][ni][j] - mn) : 0.f;
        l_run[mi] = l_run[mi] * __builtin_amdgcn_exp2f(m_run[mi] - mn) + ls; m_run[mi] = mn;
      }
    }
  }
  float invl[4];
#pragma unroll
  for (int mi = 0; mi < 4; ++mi) { const float l = red4(l_run[mi]); invl[mi] = l > 0.f ? 1.f / l : 0.f; }
#pragma unroll
  for (int mi = 0; mi < 4; ++mi)
#pragma unroll
    for (int ni = 0; ni < 4; ++ni) oacc[mi][ni] = (f32x4){0.f, 0.f, 0.f, 0.f};
  for (int jt = 0; jt < nct; ++jt) {
    __syncthreads();
    nsa_load_tile<true>(kcb + (size_t)jt * 64 * 64, 64u, vcb + jt * 64, 256u, lds, tid);
    asm volatile("s_waitcnt vmcnt(0)" ::: "memory");
    __syncthreads();
#pragma unroll 1
    for (int hf = 0; hf < 2; ++hf) {
      nsa_qk(sacc, qf, lds, hf, fr, fq);
      float imp[2] = {0.f, 0.f}, car[2] = {0.f, 0.f};
#pragma unroll
      for (int mi = 0; mi < 4; ++mi) {
        const float slope = slope0 * (1.f / (float)(1 << mi));
#pragma unroll
        for (int ni = 0; ni < 2; ++ni) {
#pragma unroll
          for (int j = 0; j < 4; ++j) {
            const int jj = jt * 64 + hf * 32 + ni * 16 + 4 * fq + j; const bool ok = (16 * jj + 31 <= tc);
            const float v = sacc[mi][ni][j] - slope * ((float)tc - (16.f * jj + 15.5f));
            sacc[mi][ni][j] = ok ? __builtin_amdgcn_exp2f(v - m_run[mi]) * invl[mi] : 0.f;
          }
          imp[ni] += (sacc[mi][ni][0] + sacc[mi][ni][1]) + sacc[mi][ni][2] + 0.5f * sacc[mi][ni][3]; car[ni] += 0.5f * sacc[mi][ni][3];
        }
      }
      nsa_pv(oacc, sacc, lds, pw, hf, fr, fq);
#pragma unroll
      for (int ni = 0; ni < 2; ++ni) {
        const int sb = jt * 16 + hf * 8 + ni * 4 + fq; float* pp = PSLC + (wid * 16 + fr) * 64 + sb;
        atomicAdd(pp, imp[ni]);
        if (sb < 63) atomicAdd(pp + 1, car[ni]);
      }
    }
  }
  int frc = fr; asm volatile("" : "+v"(frc));
  {
    const size_t n = nb + t0 + wid * 16 + frc;
#pragma unroll
    for (int mi = 0; mi < 4; ++mi) {
      const int hh = g * 4 + mi; const float gt = sigmoidf_(a.SM[n * 32 + 8 + hh * 3]);
#pragma unroll
      for (int ni = 0; ni < 4; ++ni) {
        bf16_t* dp = a.ANS + n * 512 + hh * 64 + ni * 16 + 4 * fq; const u32x2 pr = *(const u32x2*)dp;
        f32x4 r = oacc[mi][ni] * gt;
        r[0] += __uint_as_float(pr.x << 16); r[1] += __uint_as_float(pr.x & 0xffff0000u); r[2] += __uint_as_float(pr.y << 16); r[3] += __uint_as_float(pr.y & 0xffff0000u);
        st_bf4(dp, r);
      }
    }
  }
  __syncthreads();
  {
    int tsel = tid, isel = i; asm volatile("" : "+v"(tsel), "+v"(isel));
    const int q = tsel >> 2, sub = tsel & 3;
    float mine[16]; int cnt[16];
#pragma unroll
    for (int k = 0; k < 16; ++k) {
      const int sb = sub * 16 + k; const float ps = PSLC[q * 64 + sb];
      mine[k] = (sb == 0 || sb == isel || sb == isel - 1) ? 1e4f : (sb > isel ? -1e4f : ps); cnt[k] = 0;
    }
#pragma unroll
    for (int k = 0; k < 16; ++k) PSLC[q * 64 + sub * 16 + k] = mine[k];
    __syncthreads();
    for (int s2 = 0; s2 <= isel; ++s2) {
      const float o = PSLC[q * 64 + s2];
#pragma unroll
      for (int k = 0; k < 16; ++k) cnt[k] += (o > mine[k] || (o == mine[k] && s2 < sub * 16 + k)) ? 1 : 0;
    }
    unsigned m16 = 0;
#pragma unroll
    for (int k = 0; k < 16; ++k) m16 |= (cnt[k] < 16 ? 1u : 0u) << k;
    unsigned mlo = (sub < 2) ? (m16 << (16 * sub)) : 0u, mhi = (sub >= 2) ? (m16 << (16 * (sub - 2))) : 0u;
    mlo |= __shfl_xor(mlo, 1); mlo |= __shfl_xor(mlo, 2); mhi |= __shfl_xor(mhi, 1); mhi |= __shfl_xor(mhi, 2);
    u64 m64 = ((u64)mhi << 32) | (u64)mlo;
    m64 &= (isel == 63) ? ~0ull : ((2ull << isel) - 1ull);
    if (sub == 0) SELM[q] = m64;
    u64 un = m64;
#pragma unroll
    for (int o = 4; o < 64; o <<= 1) un |= __shfl_xor(un, o);
    if (lane == 0) UNI[wid] = un;
  }
  __syncthreads();
  const u64 uni = UNI[0] | UNI[1] | UNI[2] | UNI[3];
#pragma unroll
  for (int mi = 0; mi < 4; ++mi)
#pragma unroll
    for (int ks = 0; ks < 2; ++ks) qf[mi][ks] = *(const bf16x8*)(a.NQ + (size_t)(nb + t0 + mi * 16 + fr) * 512 + h * 64 + ks * 32 + fq * 8);
#pragma unroll 1
  for (int br = 1; br <= 1; ++br) {
#pragma unroll
    for (int mi = 0; mi < 4; ++mi) { m_run[mi] = -1e30f; l_run[mi] = 0.f;
#pragma unroll
      for (int ni = 0; ni < 4; ++ni) oacc[mi][ni] = (f32x4){0.f, 0.f, 0.f, 0.f}; }
    const bf16_t* Kb = (br == 1 ? a.KS : a.KW) + (size_t)nb * 128 + g * 64;
    const bf16_t* Vb = (br == 1 ? a.VST : a.VWT) + ((size_t)(b * 128 + g * 64) << 12);
    u64 todo;
    if (br == 1) todo = uni;
    else { const int lo = i >= 8 ? i - 8 : 0; todo = ((i == 63) ? ~0ull : ((2ull << i) - 1ull)) & ~((1ull << lo) - 1ull); }
    int cur = __builtin_ctzll(todo), bsel = 0;
    if (tid == 0) xch[half] = __builtin_popcountll(todo);
    __syncthreads();
    const int ntile = max(xch[0], xch[1]);
    nsa_load_tile<true>(Kb + (size_t)cur * 64 * 128, 128u, Vb + cur * 64, 4096u, lds, tid);
    for (int kt = 0; kt < ntile; ++kt) {
      int nxt = -1;
      if (cur >= 0) { todo &= todo - 1ull; nxt = todo ? __builtin_ctzll(todo) : -1; }
      asm volatile("s_waitcnt vmcnt(0)" ::: "memory");
      __syncthreads();
      if (cur < 0) continue;
      char* tb = bsel ? (lds + 49152) : lds;
      if (nxt >= 0) nsa_load_tile<true>(Kb + (size_t)nxt * 64 * 128, 128u, Vb + nxt * 64, 4096u, bsel ? lds : (lds + 49152), tid);
      const int sb = cur;
#pragma unroll 1
      for (int hf = 0; hf < 2; ++hf) {
        nsa_qk(sacc, qf, tb, hf, fr, fq);
        const bool edge = (sb == i) || (br == 2 && sb == i - 8);
#pragma unroll
        for (int mi = 0; mi < 4; ++mi) {
          const int tq = mi * 16 + fr;
          const bool rsel = (br == 2) || ((SELM[tq] >> sb) & 1ull);
          const float rc = rsel ? -slope * (float)(64 * (i - sb) + tq - hf * 32 - 4 * fq) : -1e30f;
          if (!edge) {
#pragma unroll
            for (int ni = 0; ni < 2; ++ni)
#pragma unroll
              for (int j = 0; j < 4; ++j) sacc[mi][ni][j] += fmaf(slope, (float)(ni * 16 + j), rc);
          } else {
            const int tqh = tq - hf * 32;
#pragma unroll
            for (int ni = 0; ni < 2; ++ni)
#pragma unroll
              for (int j = 0; j < 4; ++j) {
                const int c = ni * 16 + 4 * fq + j;
                const bool okv = (sb == i) ? (c <= tqh) : (c > tqh);
                sacc[mi][ni][j] = okv ? sacc[mi][ni][j] + fmaf(slope, (float)(ni * 16 + j), rc) : -1e30f;
              }
          }
        }
        nsa_online(sacc, m_run, l_run, oacc);
        nsa_pv(oacc, sacc, tb, pw, hf, fr, fq);
      }
      cur = nxt; bsel ^= 1;
    }
    int fre = fr; asm volatile("" : "+v"(fre));
#pragma unroll
    for (int mi = 0; mi < 4; ++mi) {
      const size_t n = nb + t0 + mi * 16 + fre;
      const float l = red4(l_run[mi]); const float sc = sigmoidf_(a.SM[n * 32 + 8 + h * 3 + br]) / l;
#pragma unroll
      for (int ni = 0; ni < 4; ++ni) {
        bf16_t* dp = a.ANS + n * 512 + h * 64 + ni * 16 + 4 * fq; const u32x2 pr = *(const u32x2*)dp;
        f32x4 r = oacc[mi][ni] * sc;
        r[0] += __uint_as_float(pr.x << 16); r[1] += __uint_as_float(pr.x & 0xffff0000u); r[2] += __uint_as_float(pr.y << 16); r[3] += __uint_as_float(pr.y & 0xffff0000u);
        st_bf4(dp, r);
      }
    }
  }
  __syncthreads();
}


__device__ __forceinline__ void nsa_win_item(const MegaArgs& a, int item, char* lds, int tid) {
  asm volatile("" : "+v"(tid));
  const int lane = tid & 63, wid = tid >> 6, fr = lane & 15, fq = lane >> 4;
  const int i = item & 63, g = (item >> 6) & 1, b = item >> 7;
  const int h = g * 4 + wid, nb = b * SEQ, t0 = i * 64, bg = b * 2 + g;
  const float slope = exp2f(-(float)(h + 1)) * 1.4426950408889634f;
  char* pw = lds + 16384 + wid * 8192;
  float* PSLC = (float*)(lds + 49152);
  u64* SELM = (u64*)(lds + 65536);
  u64* UNI = (u64*)(lds + 66048);
  bf16x8 qf[4][2];
#pragma unroll
  for (int mi = 0; mi < 4; ++mi)
#pragma unroll
    for (int ks = 0; ks < 2; ++ks) qf[mi][ks] = *(const bf16x8*)(a.NQ + (size_t)(nb + t0 + mi * 16 + fr) * 512 + h * 64 + ks * 32 + fq * 8);
  f32x4 sacc[4][2], oacc[4][4];
  float m_run[4], l_run[4];
  (void)PSLC; (void)UNI; (void)bg;
  const u64 uni = 0ull;
#pragma unroll 1
  for (int br = 2; br <= 2; ++br) {
#pragma unroll
    for (int mi = 0; mi < 4; ++mi) { m_run[mi] = -1e30f; l_run[mi] = 0.f;
#pragma unroll
      for (int ni = 0; ni < 4; ++ni) oacc[mi][ni] = (f32x4){0.f, 0.f, 0.f, 0.f}; }
    const bf16_t* Kb = (br == 1 ? a.KS : a.KW) + (size_t)nb * 128 + g * 64;
    const bf16_t* Vb = (br == 1 ? a.VST : a.VWT) + ((size_t)(b * 128 + g * 64) << 12);
    u64 todo;
    if (br == 1) todo = uni;
    else { const int lo = i >= 8 ? i - 8 : 0; todo = ((i == 63) ? ~0ull : ((2ull << i) - 1ull)) & ~((1ull << lo) - 1ull); }
    int cur = 63 - __builtin_clzll(todo), bsel = 0;
    __syncthreads();
    nsa_load_tile<true>(Kb + (size_t)cur * 64 * 128, 128u, Vb + cur * 64, 4096u, lds, tid);
    while (cur >= 0) {
      todo &= ~(1ull << cur);
      const int nxt = todo ? 63 - __builtin_clzll(todo) : -1;
      asm volatile("s_waitcnt vmcnt(0)" ::: "memory");
      __syncthreads();
      char* tb = bsel ? (lds + 49152) : lds;
      if (nxt >= 0) nsa_load_tile<true>(Kb + (size_t)nxt * 64 * 128, 128u, Vb + nxt * 64, 4096u, bsel ? lds : (lds + 49152), tid);
      const int sb = cur;
#pragma unroll 1
      for (int hf = 0; hf < 2; ++hf) {
        nsa_qk(sacc, qf, tb, hf, fr, fq);
        const bool edge = (sb == i) || (br == 2 && sb == i - 8);
#pragma unroll
        for (int mi = 0; mi < 4; ++mi) {
          const int tq = mi * 16 + fr;
          const bool rsel = (br == 2) || ((SELM[tq] >> sb) & 1ull);
          const float rc = rsel ? -slope * (float)(64 * (i - sb) + tq - hf * 32 - 4 * fq) : -1e30f;
          if (!edge) {
#pragma unroll
            for (int ni = 0; ni < 2; ++ni)
#pragma unroll
              for (int j = 0; j < 4; ++j) sacc[mi][ni][j] += fmaf(slope, (float)(ni * 16 + j), rc);
          } else {
            const int tqh = tq - hf * 32;
#pragma unroll
            for (int ni = 0; ni < 2; ++ni)
#pragma unroll
              for (int j = 0; j < 4; ++j) {
                const int c = ni * 16 + 4 * fq + j;
                const bool okv = (sb == i) ? (c <= tqh) : (c > tqh);
                sacc[mi][ni][j] = okv ? sacc[mi][ni][j] + fmaf(slope, (float)(ni * 16 + j), rc) : -1e30f;
              }
          }
        }
        nsa_online(sacc, m_run, l_run, oacc);
        nsa_pv(oacc, sacc, tb, pw, hf, fr, fq);
      }
      cur = nxt; bsel ^= 1;
    }
#pragma unroll
    for (int mi = 0; mi < 4; ++mi) {
      const size_t n = nb + t0 + mi * 16 + fr;
      const float l = red4(l_run[mi]); const float sc = sigmoidf_(a.SM[n * 32 + 8 + h * 3 + br]) / l;
#pragma unroll
      for (int ni = 0; ni < 4; ++ni) {
        st_bf4(a.ANS + n * 512 + h * 64 + ni * 16 + 4 * fq, oacc[mi][ni] * sc);
      }
    }
  }
  __syncthreads();
}


__device__ __forceinline__ int img_off(int row, int k) { return row * 128 + ((((k >> 3) ^ ((row >> 1) & 7))) << 4) + (k & 7) * 2; }
__device__ __forceinline__ bf16x8 img_frag(const char* img, int r0, int ks, int fr, int fq) { return *(const bf16x8*)(img + (r0 + fr) * 128 + (((ks * 4 + fq) ^ (fr >> 1)) << 4)); }


__device__ __forceinline__ void stage_raw(const bf16_t* __restrict__ QK, int nb, int t0, int chbase, char* raw, int tid) {
  u32x4 v[5];
#pragma unroll
  for (int i = 0; i < 5; ++i) {
    const int c = tid + 256 * i, row = c >> 4, cc = c & 15, t = t0 - 3 + row;
    v[i] = (c < 1072 && t >= 0) ? *(const u32x4*)(QK + (size_t)(nb + t) * 1024 + chbase + cc * 8) : (u32x4){0u, 0u, 0u, 0u};
  }
#pragma unroll
  for (int i = 0; i < 5; ++i) { const int c = tid + 256 * i; if (c < 1072) *(u32x4*)(raw + c * 16) = v[i]; }
}
template <class Put>
__device__ __forceinline__ void conv_col(const char* raw, const float* __restrict__ conv, int j0, int nj, int ch, int d, float scale, Put put) {
  const float w0 = conv[ch], w1 = conv[1024 + ch], w2 = conv[2048 + ch], w3 = conv[3072 + ch];
  const bf16_t* r = (const bf16_t*)raw + d;
  float x0 = bf2f(r[(j0 + 0) * 128]), x1 = bf2f(r[(j0 + 1) * 128]), x2 = bf2f(r[(j0 + 2) * 128]);
  for (int j = j0; j < j0 + nj; ++j) {
    const float x3 = bf2f(r[(j + 3) * 128]);
    put(j, siluf_(w0 * x0 + w1 * x1 + w2 * x2 + w3 * x3) * scale);
    x0 = x1; x1 = x2; x2 = x3;
  }
}

__device__ __forceinline__ void ml_dc_item(const MegaArgs& a, const MlArgs& ml, int item, char* lds, int tid) {
  asm volatile("" : "+v"(tid));
  const int lane = tid & 63, wid = tid >> 6, wr = wid >> 1, wc = wid & 1, fr = lane & 15, fq = lane >> 4;
  const int bh = item >> 6, c = item & 63, b = bh >> 2, h = bh & 3, nb = b * SEQ, t0 = c * 64;
  char* KT = lds; char* VT = lds + 16384; float* sc = (float*)(lds + 32768); float* dnp = (float*)(lds + 33792);
  if (tid < 64) {
    const size_t n = nb + t0 + tid;
    sc[tid] = a.SM[n * 32 + h] + ml.b_i[h];
    sc[64 + tid] = logsigmoidf_(a.SM[n * 32 + 4 + h] + ml.b_f[h]);
  }
  __syncthreads();
  if (tid < 64) {
    float cs = sc[64 + tid];
#pragma unroll
    for (int o = 1; o < 64; o <<= 1) { const float up = __shfl_up(cs, o); if (tid >= o) cs += up; }
    const float bl = __shfl(cs, 63);
    const float lw = bl - cs + sc[tid];
    const float mx = wave_max(lw);
    sc[128 + tid] = cs; sc[192 + tid] = __expf(lw - mx);
    if (tid == 0) { ml.BL[bh * 64 + c] = bl; ml.MX[bh * 64 + c] = mx; }
  }
  __syncthreads();
  if (tid < 64) { ml.BCUM[bh * SEQ + t0 + tid] = sc[128 + tid]; ml.IP[bh * SEQ + t0 + tid] = sc[tid]; }
  char* RAW = lds + 36864;
  stage_raw(a.QK, nb, t0, 512 + h * 128, RAW, tid);
  __syncthreads();
  {
    const int d = tid & 127, jh = tid >> 7;
    float dn = 0.f;
    conv_col(RAW, ml.conv, jh * 32, 32, 512 + h * 128 + d, d, 0.08838834764831845f,
             [&](int j, float v) { *(bf16_t*)(KT + img_off(d, j)) = f2bf(v); dn += sc[192 + j] * v; });
    dnp[jh * 128 + d] = dn;
    {
      bf16_t tv[32];
#pragma unroll
      for (int u = 0; u < 32; ++u) tv[u] = a.V[(size_t)(nb + t0 + jh * 32 + u) * 512 + h * 128 + d];
#pragma unroll
      for (int u = 0; u < 32; ++u) *(bf16_t*)(VT + img_off(d, jh * 32 + u)) = f2bf(sc[192 + jh * 32 + u] * bf2f(tv[u]));
    }
  }
  __syncthreads();
  if (tid < 128) ml.NST[(size_t)(bh * 64 + c) * 128 + tid] = dnp[tid] + dnp[128 + tid];
  f32x4 acc[4][4]; zero_acc(acc);
#pragma unroll
  for (int ks = 0; ks < 2; ++ks) {
    bf16x8 av[4], bk[4];
#pragma unroll
    for (int i = 0; i < 4; ++i) { av[i] = img_frag(VT, wr * 64 + i * 16, ks, fr, fq); bk[i] = img_frag(KT, wc * 64 + i * 16, ks, fr, fq); }
#pragma unroll
    for (int i = 0; i < 4; ++i)
#pragma unroll
      for (int j = 0; j < 4; ++j) acc[i][j] = __builtin_amdgcn_mfma_f32_16x16x32_bf16(bk[j], av[i], acc[i][j], 0, 0, 0);
  }
  bf16_t* cst = ml.CST + (size_t)(bh * 64 + c) * 16384;
#pragma unroll
  for (int mi = 0; mi < 4; ++mi)
#pragma unroll
    for (int ni = 0; ni < 4; ++ni) st_bf4(cst + (wr * 64 + mi * 16 + fr) * 128 + wc * 64 + ni * 16 + 4 * fq, acc[mi][ni]);
  __syncthreads();
}

__device__ __forceinline__ void ml_scan_item(const MlArgs& ml, int item, int tid) {
  const int bh = item / 17, part = item % 17;
  float m = 0.f;
  if (part < 16) {
    float run[4] = {0.f, 0.f, 0.f, 0.f};
#pragma unroll 1
    for (int c0 = 0; c0 < 64; c0 += 8) {
      u32x2 vb[8]; float bl[8], mxv[8];
#pragma unroll
      for (int u = 0; u < 8; ++u) {
        vb[u] = *(const u32x2*)(ml.CST + (size_t)(bh * 64 + c0 + u) * 16384 + part * 1024 + tid * 4);
        bl[u] = ml.BL[bh * 64 + c0 + u]; mxv[u] = ml.MX[bh * 64 + c0 + u];
      }
#pragma unroll
      for (int u = 0; u < 8; ++u) {
        const float mn = fmaxf(bl[u] + m, mxv[u]), decay = __expf(bl[u] + m - mn), scl = __expf(mxv[u] - mn);
        u32x2 o; o.x = pk2bf(run[0], run[1]); o.y = pk2bf(run[2], run[3]);
        *(u32x2*)(ml.CST + (size_t)(bh * 64 + c0 + u) * 16384 + part * 1024 + tid * 4) = o;
        run[0] = decay * run[0] + scl * __uint_as_float(vb[u].x << 16); run[1] = decay * run[1] + scl * __uint_as_float(vb[u].x & 0xffff0000u);
        run[2] = decay * run[2] + scl * __uint_as_float(vb[u].y << 16); run[3] = decay * run[3] + scl * __uint_as_float(vb[u].y & 0xffff0000u);
        if (part == 0 && tid == 0) ml.MST[bh * 64 + c0 + u] = m;
        m = mn;
      }
    }
  } else if (tid < 128) {
    float run = 0.f;
    for (int c = 0; c < 64; ++c) {
      const float bl = ml.BL[bh * 64 + c], mx = ml.MX[bh * 64 + c];
      const float mn = fmaxf(bl + m, mx), decay = __expf(bl + m - mn), scl = __expf(mx - mn);
      float* p = ml.NST + (size_t)(bh * 64 + c) * 128 + tid;
      const float v = *p; *p = run; run = decay * run + scl * v;
      m = mn;
    }
  }
}

__device__ __forceinline__ void ml_out_item(const MegaArgs& a, const MlArgs& ml, int item, char* lds, int tid) {
  asm volatile("" : "+v"(tid));
  const int lane = tid & 63, wid = tid >> 6, wr = wid >> 1, wc = wid & 1, fr = lane & 15, fq = lane >> 4;
  const int bh = item >> 6, c = item & 63, b = bh >> 2, h = bh & 3, nb = b * SEQ, t0 = c * 64;
  char* Qi = lds; char* Ki = lds + 16384; char* VT = lds + 32768; char* SP = lds + 49152;
  float* sc = (float*)(lds + 57344);
  float* H = (float*)lds;
  {
    char* RAW = lds + 49152;
    const int d = tid & 127, jh = tid >> 7;
    stage_raw(a.QK, nb, t0, h * 128, RAW, tid);
    {
      bf16_t tv[32];
#pragma unroll
      for (int u = 0; u < 32; ++u) tv[u] = a.V[(size_t)(nb + t0 + jh * 32 + u) * 512 + h * 128 + d];
#pragma unroll
      for (int u = 0; u < 32; ++u) *(bf16_t*)(VT + img_off(d, jh * 32 + u)) = tv[u];
    }
    __syncthreads();
    conv_col(RAW, ml.conv, jh * 32, 32, h * 128 + d, d, 1.f, [&](int j, float v) { *(bf16_t*)(Qi + (d >> 6) * 8192 + img_off(j, d & 63)) = f2bf(v); });
    __syncthreads();
    stage_raw(a.QK, nb, t0, 512 + h * 128, RAW, tid);
    __syncthreads();
    conv_col(RAW, ml.conv, jh * 32, 32, 512 + h * 128 + d, d, 0.08838834764831845f, [&](int j, float v) { *(bf16_t*)(Ki + (d >> 6) * 8192 + img_off(j, d & 63)) = f2bf(v); });
    __syncthreads();
  }
  if (tid < 64) { sc[tid] = ml.BCUM[bh * SEQ + t0 + tid]; sc[64 + tid] = ml.IP[bh * SEQ + t0 + tid]; }
  if (tid < 128) sc[448 + tid] = ml.NST[(size_t)(bh * 64 + c) * 128 + tid];
  __syncthreads();
  const float m = ml.MST[bh * 64 + c];
  if (tid < 64) {
    const float bj = sc[tid]; float mxi = -INFINITY;
    for (int s2 = 0; s2 <= tid; ++s2) mxi = fmaxf(mxi, bj - sc[s2] + sc[64 + s2]);
    const float inter = bj + m, mt = fmaxf(mxi, inter);
    sc[128 + tid] = mt; sc[192 + tid] = __expf(inter - mt);
  } else if (tid < 128) {
    const int t = tid - 64; float nq = 0.f;
    for (int k = 0; k < 128; ++k) nq += sc[448 + k] * bf2f(*(const bf16_t*)(Qi + (k >> 6) * 8192 + img_off(t, k & 63)));
    sc[384 + t] = nq;
  }
  f32x4 sacc[2][2];
#pragma unroll
  for (int i = 0; i < 2; ++i)
#pragma unroll
    for (int j = 0; j < 2; ++j) sacc[i][j] = (f32x4){0.f, 0.f, 0.f, 0.f};
#pragma unroll
  for (int kt = 0; kt < 2; ++kt)
#pragma unroll
    for (int ks = 0; ks < 2; ++ks) {
      bf16x8 aq[2], bk[2];
#pragma unroll
      for (int i = 0; i < 2; ++i) { aq[i] = img_frag(Qi + kt * 8192, wr * 32 + i * 16, ks, fr, fq); bk[i] = img_frag(Ki + kt * 8192, wc * 32 + i * 16, ks, fr, fq); }
#pragma unroll
      for (int i = 0; i < 2; ++i)
#pragma unroll
        for (int j = 0; j < 2; ++j) sacc[i][j] = __builtin_amdgcn_mfma_f32_16x16x32_bf16(bk[j], aq[i], sacc[i][j], 0, 0, 0);
    }
  __syncthreads();
  const bf16_t* cst = ml.CST + (size_t)(bh * 64 + c) * 16384;
#pragma unroll
  for (int i = 0; i < 4; ++i) { const int idx = tid + 256 * i, row = idx >> 3, lc = (idx & 7) ^ ((row >> 1) & 7); glds16(cst + row * 128 + lc * 8, Ki + idx * 16); }
#pragma unroll
  for (int mi = 0; mi < 2; ++mi) {
    const int t = wr * 32 + mi * 16 + fr; const float bt = sc[t], mt = sc[128 + t]; float rsum = 0.f;
#pragma unroll
    for (int ni = 0; ni < 2; ++ni) {
      const int s0 = wc * 32 + ni * 16 + 4 * fq; f32x4 p;
#pragma unroll
      for (int j = 0; j < 4; ++j) { const int s2 = s0 + j; p[j] = (s2 <= t) ? sacc[mi][ni][j] * __expf(bt - sc[s2] + sc[64 + s2] - mt) : 0.f; rsum += p[j]; }
      u32x2 o; o.x = pk2bf(p[0], p[1]); o.y = pk2bf(p[2], p[3]);
      *(u32x2*)(SP + img_off(t, s0)) = o;
    }
    rsum += __shfl_xor(rsum, 16); rsum += __shfl_xor(rsum, 32);
    if (fq == 0) sc[256 + t * 2 + wc] = rsum;
  }
  asm volatile("s_waitcnt vmcnt(0)" ::: "memory");
  __syncthreads();
  f32x4 acc1[2][4], acc2[2][4];
#pragma unroll
  for (int i = 0; i < 2; ++i)
#pragma unroll
    for (int j = 0; j < 4; ++j) { acc1[i][j] = (f32x4){0.f, 0.f, 0.f, 0.f}; acc2[i][j] = (f32x4){0.f, 0.f, 0.f, 0.f}; }
#pragma unroll
  for (int ks = 0; ks < 2; ++ks) {
    bf16x8 as[2], bv[4];
#pragma unroll
    for (int i = 0; i < 2; ++i) as[i] = img_frag(SP, wr * 32 + i * 16, ks, fr, fq);
#pragma unroll
    for (int j = 0; j < 4; ++j) bv[j] = img_frag(VT, wc * 64 + j * 16, ks, fr, fq);
#pragma unroll
    for (int i = 0; i < 2; ++i)
#pragma unroll
      for (int j = 0; j < 4; ++j) acc1[i][j] = __builtin_amdgcn_mfma_f32_16x16x32_bf16(bv[j], as[i], acc1[i][j], 0, 0, 0);
  }
#pragma unroll 1
  for (int kt = 0; kt < 2; ++kt) {
    if (kt == 1) {
      __syncthreads();
#pragma unroll
      for (int i = 0; i < 4; ++i) { const int idx = tid + 256 * i, row = idx >> 3, lc = (idx & 7) ^ ((row >> 1) & 7); glds16(cst + row * 128 + 64 + lc * 8, Ki + idx * 16); }
      asm volatile("s_waitcnt vmcnt(0)" ::: "memory");
      __syncthreads();
    }
#pragma unroll
    for (int ks = 0; ks < 2; ++ks) {
      bf16x8 aq[2], bc[4];
#pragma unroll
      for (int i = 0; i < 2; ++i) aq[i] = img_frag(Qi + kt * 8192, wr * 32 + i * 16, ks, fr, fq);
#pragma unroll
      for (int j = 0; j < 4; ++j) bc[j] = img_frag(Ki, wc * 64 + j * 16, ks, fr, fq);
#pragma unroll
      for (int i = 0; i < 2; ++i)
#pragma unroll
        for (int j = 0; j < 4; ++j) acc2[i][j] = __builtin_amdgcn_mfma_f32_16x16x32_bf16(bc[j], aq[i], acc2[i][j], 0, 0, 0);
    }
  }
  __syncthreads();
#pragma unroll
  for (int mi = 0; mi < 2; ++mi) {
    const int t = wr * 32 + mi * 16 + fr; const float wi = sc[192 + t];
    const float den = sc[256 + t * 2] + sc[256 + t * 2 + 1] + wi * sc[384 + t];
    const float inv = 1.f / fmaxf(fabsf(den), __expf(-sc[128 + t]));
#pragma unroll
    for (int ni = 0; ni < 4; ++ni) *(f32x4*)(H + t * 132 + wc * 64 + ni * 16 + 4 * fq) = (acc1[mi][ni] + acc2[mi][ni] * wi) * inv;
  }
  __syncthreads();
  {
    bf16_t og0[16], og1[16];
#pragma unroll
    for (int r = 0; r < 16; ++r) { const size_t n = nb + t0 + wid * 16 + r; og0[r] = a.O[n * 512 + h * 128 + lane]; og1[r] = a.O[n * 512 + h * 128 + 64 + lane]; }
    const float g0 = ml.gain[h * 128 + lane], g1 = ml.gain[h * 128 + 64 + lane];
#pragma unroll
    for (int r = 0; r < 16; ++r) {
      const int j = wid * 16 + r;
      const float a0 = H[j * 132 + lane], a1 = H[j * 132 + 64 + lane];
      const float ss = wave_sum(a0 * a0 + a1 * a1);
      const float rs = rsqrtf(ss * (1.f / 128.f) + EPS);
      const size_t n = nb + t0 + j; const int c0 = h * 128 + lane, c1 = c0 + 64;
      a.AML[n * 512 + c0] = f2bf(sigmoidf_(bf2f(og0[r])) * a0 * rs * g0);
      a.AML[n * 512 + c1] = f2bf(sigmoidf_(bf2f(og1[r])) * a1 * rs * g1);
    }
  }
  __syncthreads();
}


struct EpiX1 {
  static constexpr bool PERM = false, AFTER_DRAIN = false;
  const bf16_t* XB; bf16_t* X1B; float* PS2;
  __device__ __forceinline__ void operator()(const f32x4 (&acc)[2][2][4][2], const pg8::Unit& u, int wr, int wc, int fr, int fq) const {
    const int c8 = (fq & 1) * 16 + (fq >> 1) * 8;
    const size_t base = (size_t)(u.pm * 256 + wr * 64 + fr) * 1024 + u.pn * 256 + wc * 32 + c8;
    u32x4 xr[16];
#pragma unroll
    for (int i = 0; i < 16; ++i) xr[i] = *(const u32x4*)(XB + base + (size_t)((i >> 3) * 128 + ((i >> 1) & 3) * 16) * 1024 + (i & 1) * 128);
#pragma unroll
    for (int ai = 0; ai < 2; ++ai)
#pragma unroll
      for (int m = 0; m < 4; ++m) {
        const int row = u.pm * 256 + ai * 128 + wr * 64 + m * 16 + fr;
#pragma unroll
        for (int bj = 0; bj < 2; ++bj) {
          const size_t off = base + (size_t)(ai * 128 + m * 16) * 1024 + bj * 128;
          float v[8], x8[8]; swap8(acc[ai][bj][m][0], acc[ai][bj][m][1], v); bf8_to_f32(xr[ai * 8 + m * 2 + bj], x8);
          float ss = 0.f;
#pragma unroll
          for (int j = 0; j < 8; ++j) { v[j] += x8[j]; ss += v[j] * v[j]; }
          __builtin_nontemporal_store(pk8bf(v), (u32x4*)(X1B + off));
          ss += __shfl_xor(ss, 16); ss += __shfl_xor(ss, 32);
          if (fq == 0) PS2[(size_t)row * 32 + u.pn * 8 + bj * 4 + wc] = ss;
        }
      }
  }
};
struct EpiXQ {
  static constexpr bool PERM = false, AFTER_DRAIN = false;
  bf16_t* XQ; const PG8_LAS float* rsl;
  __device__ __forceinline__ void operator()(const f32x4 (&acc)[2][2][4][2], const pg8::Unit& u, int wr, int wc, int fr, int fq) const {
#pragma unroll
    for (int ai = 0; ai < 2; ++ai)
#pragma unroll
      for (int m = 0; m < 4; ++m) {
        const int rl = ai * 128 + wr * 64 + m * 16 + fr, row = u.pm * 256 + rl;
        const float rs = rsl[rl];
#pragma unroll
        for (int bj = 0; bj < 2; ++bj) st_bf8_pair(XQ + (size_t)row * 1024 + u.pn * 256 + bj * 128 + wc * 32, fq, acc[ai][bj][m][0] * rs, acc[ai][bj][m][1] * rs);
      }
  }
};
struct EpiX2 {
  static constexpr bool PERM = false, AFTER_DRAIN = false;
  bf16_t* X1B;
  __device__ __forceinline__ void operator()(const f32x4 (&acc)[2][2][4][2], const pg8::Unit& u, int wr, int wc, int fr, int fq) const {
    const int c8 = (fq & 1) * 16 + (fq >> 1) * 8;
    bf16_t* const base = X1B + (size_t)(u.pm * 256 + wr * 64 + fr) * 1024 + u.pn * 256 + wc * 32 + c8;
    u32x4 xr[16];
#pragma unroll
    for (int i = 0; i < 16; ++i) xr[i] = *(const u32x4*)(base + (size_t)((i >> 3) * 128 + ((i >> 1) & 3) * 16) * 1024 + (i & 1) * 128);
#pragma unroll
    for (int ai = 0; ai < 2; ++ai)
#pragma unroll
      for (int m = 0; m < 4; ++m)
#pragma unroll
        for (int bj = 0; bj < 2; ++bj) {
          float v[8], x8[8]; swap8(acc[ai][bj][m][0], acc[ai][bj][m][1], v); bf8_to_f32(xr[ai * 8 + m * 2 + bj], x8);
#pragma unroll
          for (int j = 0; j < 8; ++j) v[j] += x8[j];
          __builtin_nontemporal_store(pk8bf(v), (u32x4*)(base + (size_t)(ai * 128 + m * 16) * 1024 + bj * 128));
        }
  }
};
struct MapMN {
  const bf16_t* A; const bf16_t* Bt; int K, xcd;
  __device__ __forceinline__ void avoff(const pg8::Unit&, int, int K, const unsigned (&voffA)[2], unsigned (&v0)[2], unsigned (&v1)[2]) const { v0[0] = voffA[0]; v0[1] = voffA[1]; v1[0] = voffA[0] + 256u * K; v1[1] = voffA[1] + 256u * K; }
  __device__ __forceinline__ void operator()(int idx, pg8::Unit& u) const {
    u.pm = xcd * 8 + (idx & 7); u.pn = idx >> 3;
    u.aptr = (const char*)(A + (size_t)u.pm * 256 * K); u.bptr = (const char*)(Bt + (size_t)u.pn * 256 * K);
  }
};

struct MapInProj {
  const bf16_t* XB; const bf16_t* WinT; int xcd;
  __device__ __forceinline__ void avoff(const pg8::Unit&, int, int K, const unsigned (&voffA)[2], unsigned (&v0)[2], unsigned (&v1)[2]) const { v0[0] = voffA[0]; v0[1] = voffA[1]; v1[0] = voffA[0] + 256u * K; v1[1] = voffA[1] + 256u * K; }
  __device__ __forceinline__ void operator()(int idx, pg8::Unit& u) const {
    u.pm = xcd * 8 + (idx & 7); u.pn = idx >> 3;
    const char* tokp = (const char*)(XB + (size_t)u.pm * 256 * DM); const char* colp = (const char*)(WinT + (size_t)u.pn * 256 * DM);
    if (u.pn == 12) { u.aptr = colp; u.bptr = tokp; } else { u.aptr = tokp; u.bptr = colp; }
  }
};
struct EpiInProj8 {
  static constexpr bool PERM = false, AFTER_DRAIN = false;
  bf16_t *QK, *V, *O, *NQ, *KVC, *KS, *KW, *VST, *VWT; float* SM; const float* RS1;
  __device__ __forceinline__ void operator()(const f32x4 (&acc)[2][2][4][2], const pg8::Unit& u, int wr, int wc, int fr, int fq) const {
    if (u.pn == 12) {
#pragma unroll
      for (int bj = 0; bj < 2; ++bj) {
        const int tok = u.pm * 256 + bj * 128 + wc * 32;
        const f32x4 rs0 = *(const f32x4*)(RS1 + tok + 4 * fq), rs1 = *(const f32x4*)(RS1 + tok + 16 + 4 * fq);
        const int b = tok >> 12, t = tok & 4095;
#pragma unroll
        for (int ai = 0; ai < 2; ++ai)
#pragma unroll
          for (int m = 0; m < 4; ++m) st_bf8_pair((ai ? VWT : VST) + ((size_t)(b * 128 + wr * 64 + m * 16 + fr) << 12) + t, fq, acc[ai][bj][m][0] * rs0, acc[ai][bj][m][1] * rs1);
      }
      return;
    }
    float rsv[8];
#pragma unroll
    for (int i = 0; i < 8; ++i) rsv[i] = RS1[u.pm * 256 + (i >> 2) * 128 + wr * 64 + (i & 3) * 16 + fr];
#pragma unroll
    for (int bj = 0; bj < 2; ++bj) {
      const int nh = u.pn * 256 + bj * 128;
      bf16_t* dst; int ld, cofs; float scale = 1.f;
      if (nh < 1024) { dst = QK; ld = 1024; cofs = nh; }
      else if (nh < 1536) { dst = V; ld = 512; cofs = nh - 1024; }
      else if (nh < 2048) { dst = O; ld = 512; cofs = nh - 1536; }
      else if (nh < 2560) { dst = NQ; ld = 512; cofs = nh - 2048; scale = 0.125f * 1.4426950408889634f; }
      else if (nh < 2816) { dst = KVC; ld = 256; cofs = nh - 2560; }
      else if (nh < 2944) { dst = KS; ld = 128; cofs = 0; }
      else if (nh < 3072) { dst = KW; ld = 128; cofs = 0; }
      else { dst = nullptr; ld = 0; cofs = 0; }
      if (!dst && nh != 3328) continue;
#pragma unroll
      for (int ai = 0; ai < 2; ++ai)
#pragma unroll
        for (int m = 0; m < 4; ++m) {
          const int row = u.pm * 256 + ai * 128 + wr * 64 + m * 16 + fr; const float rs = rsv[ai * 4 + m] * scale;
          if (dst) {
            st_bf8_pair(dst + (size_t)row * ld + cofs + wc * 32, fq, acc[ai][bj][m][0] * rs, acc[ai][bj][m][1] * rs);
          } else if (wc == 0) {
#pragma unroll
            for (int n = 0; n < 2; ++n) *(f32x4*)(SM + (size_t)row * 32 + n * 16 + 4 * fq) = acc[ai][bj][m][n] * rs;
          }
        }
    }
  }
};

struct MapMoe {
  const int* CNT; const int* LIST; const bf16_t* Abase; const bf16_t* W; size_t wstride; int K, xcd, gather;
  __device__ __forceinline__ void operator()(int idx, pg8::Unit& u) const {
    int g = (idx >> 2) * 8 + xcd, e = 0, ce = 0, pre = 0;
    u.pm = g;
    int cn[16];
#pragma unroll
    for (int k = 0; k < 16; ++k) cn[k] = CNT[k];
    bool fnd = false;
#pragma unroll
    for (int k = 0; k < 16; ++k) {
      const int np = (cn[k] + 255) >> 8;
      const bool stop = !fnd && (g < np || k == 15);
      if (stop) { e = k; ce = cn[k]; fnd = true; }
      if (!fnd) { g -= np; pre += cn[k]; }
    }
    u.e = e; u.ce = ce; u.rt = g; u.p0 = pre + g * 256; u.pn = idx & 3;
    u.bptr = (const char*)(W + (size_t)e * wstride + (size_t)u.pn * 256 * K);
    u.aptr = gather ? (const char*)Abase : (const char*)(Abase + (size_t)u.p0 * K);
  }
  __device__ __forceinline__ void avoff(const pg8::Unit& u, int tid, int K_, const unsigned (&voffA)[2], unsigned (&v0)[2], unsigned (&v1)[2]) const {
    if (!gather) { v0[0] = voffA[0]; v0[1] = voffA[1]; v1[0] = voffA[0] + 256u * K_; v1[1] = voffA[1] + 256u * K_; return; }
#pragma unroll
    for (int i = 0; i < 2; ++i) {
      int R, C; pg8::stage_rc(tid * 16 + i * 8192, R, C);
      int m0_ = u.rt * 256 + R, m1_ = m0_ + 128; if (m0_ >= u.ce) m0_ = u.ce - 1; if (m1_ >= u.ce) m1_ = u.ce - 1;
      v0[i] = (unsigned)((LIST[u.e * NTOK + m0_] >> 1) * K_ + C) * 2u; v1[i] = (unsigned)((LIST[u.e * NTOK + m1_] >> 1) * K_ + C) * 2u;
    }
  }
};
struct EpiMoe1 {
  static constexpr bool PERM = false, AFTER_DRAIN = false;
  const int* LIST; const float* RS3; bf16_t* ACT;
  __device__ __forceinline__ void operator()(const f32x4 (&acc)[2][2][4][2], const pg8::Unit& u, int wr, int wc, int fr, int fq) const {
    int tok[8]; float rsv[8];
#pragma unroll
    for (int i = 0; i < 8; ++i) {
      const int ml = u.rt * 256 + (i >> 2) * 128 + wr * 64 + (i & 3) * 16 + fr;
      tok[i] = LIST[u.e * NTOK + min(ml, u.ce - 1)] >> 1;
    }
#pragma unroll
    for (int i = 0; i < 8; ++i) rsv[i] = RS3[tok[i]];
#pragma unroll
    for (int ai = 0; ai < 2; ++ai)
#pragma unroll
      for (int m = 0; m < 4; ++m) {
        const int r = ai * 128 + wr * 64 + m * 16 + fr, ml = u.rt * 256 + r;
        if (ml < u.ce) {
          const float rs = rsv[ai * 4 + m];
#pragma unroll
          for (int bj = 0; bj < 2; ++bj) {
            const f32x4 a1 = acc[ai][bj][m][0] * rs, a3 = acc[ai][bj][m][1] * rs; f32x4 r4;
#pragma unroll
            for (int j = 0; j < 4; ++j) r4[j] = siluf_(a1[j]) * a3[j];
            {
              const unsigned long long pk = (unsigned long long)pk2bf(r4[0], r4[1]) | ((unsigned long long)pk2bf(r4[2], r4[3]) << 32);
              __hip_atomic_store((unsigned long long*)(ACT + (size_t)(u.p0 + r) * 512 + (u.pn * 8 + bj * 4 + wc) * 16 + 4 * fq), pk, __ATOMIC_RELAXED, __HIP_MEMORY_SCOPE_AGENT);
            }
          }
        }
      }
  }
};
struct EpiMoe2 {
  static constexpr bool PERM = false, AFTER_DRAIN = false;
  const int* LIST; const float* RTW; bf16_t* Y;
  __device__ __forceinline__ void operator()(const f32x4 (&acc)[2][2][4][2], const pg8::Unit& u, int wr, int wc, int fr, int fq) const {
    int ent[8]; float wv[8];
#pragma unroll
    for (int i = 0; i < 8; ++i) {
      const int ml = u.rt * 256 + (i >> 2) * 128 + wr * 64 + (i & 3) * 16 + fr;
      ent[i] = LIST[u.e * NTOK + min(ml, u.ce - 1)];
    }
#pragma unroll
    for (int i = 0; i < 8; ++i) wv[i] = RTW[ent[i]];
#pragma unroll
    for (int ai = 0; ai < 2; ++ai)
#pragma unroll
      for (int m = 0; m < 4; ++m) {
        const int r = ai * 128 + wr * 64 + m * 16 + fr, ml = u.rt * 256 + r;
        {
          const int entry = ent[ai * 4 + m]; const float w = wv[ai * 4 + m];
#pragma unroll
          for (int bj = 0; bj < 2; ++bj) {
            const f32x4 v0 = acc[ai][bj][m][0] * w, v1 = acc[ai][bj][m][1] * w;
            const auto sx = __builtin_amdgcn_permlane16_swap(pk2bf(v0[0], v0[1]), pk2bf(v1[0], v1[1]), false, false);
            const auto sy = __builtin_amdgcn_permlane16_swap(pk2bf(v0[2], v0[3]), pk2bf(v1[2], v1[3]), false, false);
            u32x4 o; o.x = sx[0]; o.y = sy[0]; o.z = sx[1]; o.w = sy[1];
            if (ml < u.ce) __builtin_nontemporal_store(o, (u32x4*)(Y + (size_t)entry * 1024 + u.pn * 256 + bj * 128 + wc * 32 + (fq & 1) * 16 + (fq >> 1) * 8));
          }
        }
      }
  }
};

constexpr int DEP_STRIDE = 16;
struct MoeUpSched {
  int first, stride, count; MapMoe map; unsigned* DEP; bool wave0;
  __device__ __forceinline__ bool next(int i, pg8::Unit& u) const { const int idx = first + i * stride; if (idx >= count) return false; map(idx, u); return true; }
  __device__ __forceinline__ void avoff(const pg8::Unit& u, int tid, int K, const unsigned (&voffA)[2], unsigned (&v0)[2], unsigned (&v1)[2]) const { map.avoff(u, tid, K, voffA, v0, v1); }
  __device__ __forceinline__ void a_ready(const pg8::Unit&) const {}
  __device__ __forceinline__ void done(const pg8::Unit& u) const {
    asm volatile("s_waitcnt vmcnt(0)" ::: "memory");
    __builtin_amdgcn_s_barrier();
    if (wave0 && __builtin_amdgcn_mbcnt_hi(~0u, __builtin_amdgcn_mbcnt_lo(~0u, 0u)) == 0u) (void)__hip_atomic_fetch_add(&DEP[u.pm * DEP_STRIDE], 1u, __ATOMIC_RELAXED, __HIP_MEMORY_SCOPE_AGENT);
  }
};
struct MoeDownSched {
  int li, L, n1, r, fp, nfirst; MapMoe map; unsigned* DEP; bool wave0;
  __device__ __forceinline__ bool next(int i, pg8::Unit& u) const {
    const int j = (i < nfirst) ? 2 * (li - r) + i : fp + li + (i - nfirst) * L;
    if (j >= n1) return false; map(j, u); return true;
  }
  __device__ __forceinline__ void avoff(const pg8::Unit& u, int tid, int K, const unsigned (&voffA)[2], unsigned (&v0)[2], unsigned (&v1)[2]) const { map.avoff(u, tid, K, voffA, v0, v1); }
  __device__ __forceinline__ void a_ready(const pg8::Unit& u) const {
    if (!wave0) return;
    unsigned sp = 0;
    while (__hip_atomic_load(&DEP[u.pm * DEP_STRIDE], __ATOMIC_RELAXED, __HIP_MEMORY_SCOPE_AGENT) < 4u) { __builtin_amdgcn_s_sleep(2); if (++sp > (1u << 22)) break; }
    asm volatile("" ::: "memory");
  }
  __device__ __forceinline__ void done(const pg8::Unit&) const {}
};

struct MapP5 {
  const bf16_t *XB, *WgT, *AML, *ANS, *WmlT, *WnsT; int pm, pn;
  __device__ __forceinline__ void avoff(const pg8::Unit&, int, int K, const unsigned (&voffA)[2], unsigned (&v0)[2], unsigned (&v1)[2]) const { v0[0] = voffA[0]; v0[1] = voffA[1]; v1[0] = voffA[0] + 256u * K; v1[1] = voffA[1] + 256u * K; }
  __device__ __forceinline__ void operator()(int idx, pg8::Unit& u) const {
    u.pm = pm; u.pn = pn; u.e = idx;
    if (idx < 2) { u.K = 1024; u.aptr = (const char*)(XB + (size_t)pm * 256 * 1024); u.bptr = (const char*)(WgT + (size_t)(idx * 1024 + pn * 256) * 1024); }
    else { u.K = 512; u.aptr = (const char*)((idx == 2 ? AML : ANS) + (size_t)pm * 256 * 512); u.bptr = (const char*)((idx == 2 ? WmlT : WnsT) + (size_t)pn * 256 * 512); }
  }
};
struct EpiP5 {
  static constexpr bool PERM = false, AFTER_DRAIN = false;
  bf16_t* MRG; bf16_t* G1; const float* RS1;
  __device__ __forceinline__ void operator()(const f32x4 (&acc)[2][2][4][2], const pg8::Unit& u, int wr, int wc, int fr, int fq) const {
    const int c8 = (fq & 1) * 16 + (fq >> 1) * 8;
    if (u.e < 2) {
      bf16_t* G = u.e ? G1 : MRG;
#pragma unroll
      for (int ai = 0; ai < 2; ++ai)
#pragma unroll
        for (int m = 0; m < 4; ++m) {
          const int row = u.pm * 256 + ai * 128 + wr * 64 + m * 16 + fr; const float rs = RS1[row];
#pragma unroll
          for (int bj = 0; bj < 2; ++bj) {
            u32x2 pk[2];
#pragma unroll
            for (int n = 0; n < 2; ++n) {
              const f32x4 g = acc[ai][bj][m][n] * rs;
              pk[n].x = pk2bf(sigmoidf_(g[0]), sigmoidf_(g[1])); pk[n].y = pk2bf(sigmoidf_(g[2]), sigmoidf_(g[3]));
            }
            const auto sx = __builtin_amdgcn_permlane16_swap(pk[0].x, pk[1].x, false, false);
            const auto sy = __builtin_amdgcn_permlane16_swap(pk[0].y, pk[1].y, false, false);
            u32x4 o; o.x = sx[0]; o.y = sy[0]; o.z = sx[1]; o.w = sy[1];
            *(u32x4*)(G + (size_t)row * 1024 + u.pn * 256 + bj * 128 + wc * 32 + c8) = o;
          }
        }
    } else if (u.e == 2) {
      bf16_t* const base = MRG + (size_t)(u.pm * 256 + wr * 64 + fr) * 1024 + u.pn * 256 + wc * 32 + c8;
      u32x4 gr[16];
#pragma unroll
      for (int i = 0; i < 16; ++i) gr[i] = *(const u32x4*)(base + (size_t)((i >> 3) * 128 + ((i >> 1) & 3) * 16) * 1024 + (i & 1) * 128);
#pragma unroll
      for (int ai = 0; ai < 2; ++ai)
#pragma unroll
        for (int m = 0; m < 4; ++m)
#pragma unroll
          for (int bj = 0; bj < 2; ++bj) {
            float v[8], g[8]; swap8(acc[ai][bj][m][0], acc[ai][bj][m][1], v); bf8_to_f32(gr[ai * 8 + m * 2 + bj], g);
#pragma unroll
            for (int j = 0; j < 8; ++j) v[j] *= g[j];
            *(u32x4*)(base + (size_t)(ai * 128 + m * 16) * 1024 + bj * 128) = pk8bf(v);
          }
    } else {
      const size_t boff = (size_t)(u.pm * 256 + wr * 64 + fr) * 1024 + u.pn * 256 + wc * 32 + c8;
#pragma unroll
      for (int ai = 0; ai < 2; ++ai) {
        u32x4 gr[8], tr[8];
#pragma unroll
        for (int i = 0; i < 8; ++i) { const size_t o = boff + (size_t)(ai * 128 + (i >> 1) * 16) * 1024 + (i & 1) * 128; gr[i] = *(const u32x4*)(G1 + o); tr[i] = *(const u32x4*)(MRG + o); }
#pragma unroll
        for (int m = 0; m < 4; ++m)
#pragma unroll
          for (int bj = 0; bj < 2; ++bj) {
            float v[8], g[8], t[8]; swap8(acc[ai][bj][m][0], acc[ai][bj][m][1], v); bf8_to_f32(gr[m * 2 + bj], g); bf8_to_f32(tr[m * 2 + bj], t);
#pragma unroll
            for (int j = 0; j < 8; ++j) v[j] = t[j] + g[j] * v[j];
            __builtin_nontemporal_store(pk8bf(v), (u32x4*)(MRG + boff + (size_t)(ai * 128 + m * 16) * 1024 + bj * 128));
          }
      }
    }
  }
};

#define XB_TMO      128
#define XB_XCNT(j)  (256  + 64 * (j))
#define XB_XSUB(j)  (1280 + 64 * (j))
#define XB_XGEN(j)  (2304 + 64 * (j))
#define XB_TOP      3328
#define XB_TOPGEN   3392
#define XCD_BAR_WORDS 3456
#define XB_SPIN_CAP (1u << 24)
__device__ __forceinline__ unsigned xb_ld(unsigned* p)              { return __hip_atomic_load(p, __ATOMIC_RELAXED, __HIP_MEMORY_SCOPE_AGENT); }
__device__ __forceinline__ unsigned xb_add(unsigned* p, unsigned v) { return __hip_atomic_fetch_add(p, v, __ATOMIC_RELAXED, __HIP_MEMORY_SCOPE_AGENT); }
__device__ __forceinline__ unsigned xb_xcc_id() { return (unsigned)__builtin_amdgcn_s_getreg((3 << 11) | 20) & 0xFu; }
#define XB_SPIN(cond, bar) do { unsigned _sp = 0; while (cond) { __builtin_amdgcn_s_sleep(1); \
    if ((++_sp & 255u) == 0u) { if (xb_ld(&(bar)[XB_TMO])) break; if (_sp > XB_SPIN_CAP) { atomicAdd(&(bar)[XB_TMO], 1u); break; } } } } while (0)
__device__ __forceinline__ void xcd_barrier_complete(unsigned* bar, unsigned x, unsigned G, unsigned& nloc, unsigned& nx) {
  unsigned sum, cnt, mine, sp = 0u;
  for (;;) {
    sum = 0u; cnt = 0u; mine = 0u;
#pragma unroll
    for (unsigned j = 0; j < 16; ++j) { const unsigned c = xb_ld(&bar[XB_XCNT(j)]); sum += c; cnt += (c > 0u) ? 1u : 0u; mine = (j == x) ? c : mine; }
    if (sum == G) break;
    __builtin_amdgcn_s_sleep(1);
    if ((++sp & 255u) == 0u) { if (xb_ld(&bar[XB_TMO])) break; if (sp > XB_SPIN_CAP) { atomicAdd(&bar[XB_TMO], 1u); break; } }
  }
  nloc = mine > 0u ? mine : 1u; nx = cnt > 0u ? cnt : 1u;
}
__device__ __forceinline__ void xcd_barrier(unsigned* bar, unsigned x, volatile unsigned* st, unsigned G, bool leader_thread) {
  asm volatile("s_waitcnt vmcnt(0)" ::: "memory");
  __syncthreads();
  if (leader_thread) {
    __builtin_amdgcn_s_waitcnt(0);
    unsigned nloc = st[0], nx = st[1];
    if (nloc == 0u) { xcd_barrier_complete(bar, x, G, nloc, nx); st[0] = nloc; st[1] = nx; }
    const unsigned old = xb_add(&bar[XB_XSUB(x)], 1u);
    const unsigned gen = old / nloc;
    if (old + 1u == (gen + 1u) * nloc) {
      __builtin_amdgcn_fence(__ATOMIC_RELEASE, "agent");
      asm volatile("s_waitcnt vmcnt(0)" ::: "memory");
      const unsigned og = xb_add(&bar[XB_TOP], 1u);
      const unsigned tg = og / nx;
      if (og + 1u == (tg + 1u) * nx) xb_add(&bar[XB_TOPGEN], 1u);
      else XB_SPIN(xb_ld(&bar[XB_TOPGEN]) == tg, bar);
      __builtin_amdgcn_fence(__ATOMIC_ACQUIRE, "agent");
      xb_add(&bar[XB_XGEN(x)], 1u);
      asm volatile("s_waitcnt vmcnt(0)" ::: "memory");
    } else {
      XB_SPIN(xb_ld(&bar[XB_XGEN(x)]) == gen, bar);
      __builtin_amdgcn_fence(__ATOMIC_ACQUIRE, "agent");
      asm volatile("s_waitcnt vmcnt(0)" ::: "memory");
    }
  }
  __syncthreads();
}

__device__ __forceinline__ void convert_range(const MegaArgs& a, int lo, int hi, int bid, int nblk, char* lds, int tid) {
  for (int it0 = lo; it0 < hi; it0 += nblk) {
    int it = it0 + bid; if (it >= hi) it = hi - 1;
    int r = it, di = 0;
    while (r >= a.td[di].nitems) { r -= a.td[di].nitems; ++di; }
    transpose_item(a.td[di], r, (float*)lds, tid);
  }
}
#define TILE_IDS unsigned tid_z = 0u; asm volatile("" : "+v"(tid_z)); int tid = (wave_s & 3) * 64 + (int)__builtin_amdgcn_mbcnt_hi(~0u, __builtin_amdgcn_mbcnt_lo(~0u, tid_z)); asm volatile("" : "+v"(tid)); const int half = wave_s >> 2; char* const lds = plds + half * HALF_LDS; const int bid = pbid * 2 + half, nblk = pnblk * 2, li = (pbid >> 3) * 2 + half, nloc = (pnblk >> 3) * 2; const int lane = tid & 63, wid = tid >> 6, wr = wid >> 1, wc = wid & 1, fr = lane & 15, fq = lane >> 4; (void)lane; (void)wid; (void)wr; (void)wc; (void)fr; (void)fq; (void)half; (void)lds; (void)bid; (void)nblk; (void)li; (void)nloc

__global__ void __launch_bounds__(512, 2) k_mega(MegaArgs a) {
  extern __shared__ __attribute__((aligned(16))) char lds_raw[];
  char* const plds = lds_raw;
  cg::grid_group grid = cg::this_grid();
  const int pnblk = gridDim.x, pbid = blockIdx.x;
  const int wave_s = __builtin_amdgcn_readfirstlane((int)(threadIdx.x >> 6));
  unsigned* const xbar = a.BAR + a.li * XCD_BAR_WORDS;
  volatile unsigned* const xst = (volatile unsigned*)(plds + CTRL_OFF);
  volatile int* const xch = (volatile int*)(plds + CTRL_OFF + 16);
  unsigned xcc;
  {
    const bool t0 = (wave_s == 0) && ((int)__builtin_amdgcn_mbcnt_hi(~0u, __builtin_amdgcn_mbcnt_lo(~0u, 0u)) == 0);
    if (t0) { xst[0] = 0u; xst[1] = 0u; }
    xcc = xb_xcc_id();
    if (t0) (void)xb_add(&xbar[XB_XCNT(xcc)], 1u);
    grid.sync();
  }
#define PH(k) (a.ph_lo <= (k) && (k) < a.ph_hi)
  const int xcd = pbid & 7;
#define GRID_BAR() do { const int ld_ = (wave_s == 0) && ((int)__builtin_amdgcn_mbcnt_hi(~0u, __builtin_amdgcn_mbcnt_lo(~0u, 0u)) == 0); xcd_barrier(xbar, xcc, xst, (unsigned)pnblk, ld_); } while (0)
#define SYNC_AFTER(k) do { if (PH(k) && PH((k) + 1)) GRID_BAR(); } while (0)
#pragma unroll 1
  for (int rp_ = PH(0) ? a.rep[0] : 0; rp_ > 0; --rp_) {
    TILE_IDS;
    convert_range(a, a.cv_lo[0], a.cv_hi[0], bid, nblk, lds, tid);
    for (int i = bid * 256 + tid; i < (NIN - DIN_A) * 1024 / 8; i += nblk * 256) ((u32x4*)(a.WinT + (size_t)DIN_A * 1024))[i] = (u32x4){0u, 0u, 0u, 0u};
    rows_to_bf16(a.x, a.XB, a.RS1, NTOK, bid * 4 + wid, nblk * 4, lane);
    rows_to_bf16(a.mem, a.MEMB, a.RSM, NB * MEMT, bid * 4 + wid, nblk * 4, lane);
    for (int o = bid * 4 + wid; o < 256; o += nblk * 4) {
      const int which = o >> 7, u = o & 127; const float* pos = which ? a.posv : a.posk; const float* w1 = which ? a.cvw1 : a.ckw1;
      float sacc = 0.f;
      for (int f = lane; f < 2048; f += 64) sacc += pos[f] * w1[(size_t)f * 128 + u];
      sacc = wave_sum(sacc);
      if (lane == 0) a.POSW[o] = sacc;
    }
  }
  SYNC_AFTER(0);
#pragma unroll 1
  for (int rp_ = PH(1) ? a.rep[1] : 0; rp_ > 0; --rp_) {
    TILE_IDS;
    {
      TILE8_IDS;
      ListSched<MapInProj> S8{pbid >> 3, pnblk >> 3, 112, MapInProj{a.XB, a.WinT, xcd}};
      EpiInProj8 E8{a.QK, a.V, a.O, a.NQ, a.KVC, a.KS, a.KW, a.VST, a.VWT, a.SM, a.RS1};
      pg8::gemm_phase<EpiInProj8, ListSched<MapInProj>, true, true>((PG8_LAS unsigned char*)plds, pg8::Gemm{DM}, S8, E8, t512, wave_s);
    }
    if ((pbid >> 3) >= 16) convert_range(a, a.cv_lo[1], a.cv_hi[1], ((xcd * 16 + (pbid >> 3) - 16) * 2 + half), (pnblk >> 1) * 2, lds, tid);
  }
  SYNC_AFTER(1);
#pragma unroll 1
  for (int rp_ = PH(2) ? a.rep[2] : 0; rp_ > 0; --rp_) {
    TILE_IDS;
    for (int it = bid; it < 128; it += nblk) {
      const int which = it >> 6, m0 = ((it >> 2) & 15) * 128, slab = it & 3;
      f32x4 acc[4][4]; zero_acc(acc);
      {
        int tid2 = tid; asm volatile("" : "+v"(tid2));
        unsigned ao[4], bo[4];
#pragma unroll
        for (int i = 0; i < 4; ++i) {
          const int row = st_row(tid2, i), lc = st_lc(tid2, i);
          const int m = m0 + row, bg = m >> 8, j = m & 255;
          ao[i] = (unsigned)((bg >> 1) * SEQ + 16 * j + slab * 8) * 256u + which * 128 + (bg & 1) * 64 + lc * 8;
          bo[i] = (unsigned)row * 2048u + slab * 512 + lc * 8;
        }
        gemm_core(acc, a.KVC, ao, 256u, which ? a.CV1T : a.CK1T, bo, 64u, 8, lds, tid2);
      }
      float* cp = a.CPART + (size_t)((which * 4 + slab) * 2048 + m0) * 128;
#pragma unroll
      for (int mi = 0; mi < 4; ++mi)
#pragma unroll
        for (int ni = 0; ni < 4; ++ni) *(f32x4*)(cp + (wr * 64 + mi * 16 + fr) * 128 + wc * 64 + ni * 16 + 4 * fq) = acc[mi][ni];
    }
    for (int q = nloc - 1 - li; q < 16; q += nloc) {
      f32x4 acc[4][4]; zero_acc(acc);
      const int tile = xcd * 16 + q; constexpr int T1 = 0, T2n = 16;
        const int t2 = tile - T1; const int m0 = (t2 / T2n) * 128, n0 = (t2 % T2n) * 128;
        if (n0 < 1024) {
          gemm_acc(acc, a.MEMB, DM, (const int*)nullptr, 0, 0, a.WkvT, DM, DM, lds, m0, n0, tid);
#pragma unroll
          for (int mi = 0; mi < 4; ++mi) {
            const int m = m0 + wr * 64 + mi * 16 + fr; const float rs = a.RSM[m];
#pragma unroll
            for (int ni = 0; ni < 4; ++ni) st_bf4(a.KVM + (size_t)m * 1024 + n0 + wc * 64 + ni * 16 + 4 * fq, acc[mi][ni] * rs);
          }
        } else {
          gemm_acc(acc, a.WkvT, DM, (const int*)nullptr, 0, 0, a.MEMB, DM, DM, lds, n0, m0, tid);
          bf16_t* vmt = a.KVM + (size_t)1024 * 1024;
#pragma unroll
          for (int ni = 0; ni < 4; ++ni) {
            const int tok = m0 + wc * 64 + ni * 16 + 4 * fq; const f32x4 rs = *(const f32x4*)(a.RSM + tok);
            const int b = tok >> 8, key = tok & 255;
#pragma unroll
            for (int mi = 0; mi < 4; ++mi) {
              const int col = n0 - 1024 + wr * 64 + mi * 16 + fr;
              st_bf4(vmt + ((size_t)(b * 1024 + col) << 8) + key, acc[mi][ni] * rs);
            }
          }
        }
    }
    for (int lp = pbid >> 3; lp < 32; lp += pnblk >> 3) nsa_win_item(a, ((((((xcd >> 1) & 1) * 2 + half) * 2 + (xcd & 1)) << 6)) | (63 - (2 * lp + (xcd >> 2))), lds, tid);
    {
      volatile int* wqw = (volatile int*)(lds + MEGA_LDS - 32);
      (void)wqw;
      for (;;) {
        if (wave_s == 0 && lane == 0) xch[2] = atomicAdd(a.WQ + 1, 2);
        __syncthreads();
        const int it0 = xch[2];
        __syncthreads();
        if (it0 >= 1024) break;
        ml_dc_item(a, a.ml, it0 + half, lds, tid);
      }
    }
  }
  SYNC_AFTER(2);
#pragma unroll 1
  for (int rp_ = PH(3) ? a.rep[3] : 0; rp_ > 0; --rp_) {
    TILE_IDS;
    if (rp_ == 1) for (int it = bid; it < 272; it += nblk) ml_scan_item(a.ml, it, tid);
    for (int it = nblk - 1 - bid; it < 128; it += nblk) {
      const int which = it >> 6, m0 = (it & 63) * 32;
      float* hid = (float*)lds;
      float* w2s = (float*)(lds + 16640);
      {
        const float* w2 = which ? a.cvw2 : a.ckw2;
#pragma unroll
        for (int c = 0; c < 8; ++c) *(f32x4*)(w2s + (tid + 256 * c) * 4) = *(const f32x4*)(w2 + (tid + 256 * c) * 4);
        const int row = tid >> 3, u0 = (tid & 7) * 16;
        const float* cp = a.CPART + (size_t)(which * 4 * 2048 + m0 + row) * 128 + u0;
#pragma unroll
        for (int c4 = 0; c4 < 4; ++c4) {
          f32x4 hv = *(const f32x4*)(cp + c4 * 4) + *(const f32x4*)(cp + 2048 * 128 + c4 * 4) + *(const f32x4*)(cp + 2 * 2048 * 128 + c4 * 4) + *(const f32x4*)(cp + 3 * 2048 * 128 + c4 * 4)
                   + *(const f32x4*)(a.POSW + which * 128 + u0 + c4 * 4);
#pragma unroll
          for (int j = 0; j < 4; ++j) hid[row * 129 + u0 + c4 * 4 + j] = gelu_tanh(hv[j]);
        }
      }
      __syncthreads();
      {
        const int row = tid >> 3, d0 = (tid & 7) * 8;
        float o[8];
#pragma unroll
        for (int d = 0; d < 8; ++d) o[d] = 0.f;
        for (int u = 0; u < 128; ++u) {
          const float hv = hid[row * 129 + u]; const f32x4 w0 = *(const f32x4*)(w2s + u * 64 + d0), w1 = *(const f32x4*)(w2s + u * 64 + d0 + 4);
          o[0] += hv * w0[0]; o[1] += hv * w0[1]; o[2] += hv * w0[2]; o[3] += hv * w0[3]; o[4] += hv * w1[0]; o[5] += hv * w1[1]; o[6] += hv * w1[2]; o[7] += hv * w1[3];
        }
        const int m = m0 + row, bg = m >> 8, j = m & 255;
        if (which == 0) {
#pragma unroll
          for (int d = 0; d < 8; ++d) a.KC[(size_t)m * 64 + d0 + d] = (j == 255) ? (bf16_t)0 : f2bf(o[d]);
        } else {
#pragma unroll
          for (int d = 0; d < 8; ++d) a.VCT[((size_t)(bg * 64 + d0 + d) << 8) + j] = (j == 255) ? (bf16_t)0 : f2bf(o[d]);
        }
      }
      __syncthreads();
    }
  }
  SYNC_AFTER(3);
#pragma unroll 1
  for (int rp_ = PH(4) ? a.rep[4] : 0; rp_ > 0; --rp_) {
    for (int lp = pbid >> 3; lp < 32; lp += pnblk >> 3) { TILE_IDS; nsa_main_item(a, ((((((xcd >> 1) & 1) * 2 + half) * 2 + (xcd & 1)) << 6)) | (63 - (2 * lp + (xcd >> 2))), lds, tid, xch, half); }
    { TILE_IDS;
      volatile int* wqw = (volatile int*)(lds + MEGA_LDS - 32);
      (void)wqw;
      for (;;) {
        if (wave_s == 0 && lane == 0) xch[2] = atomicAdd(a.WQ, 2);
        __syncthreads();
        const int it0 = xch[2];
        __syncthreads();
        if (it0 >= 1024) break;
        ml_out_item(a, a.ml, it0 + half, lds, tid);
      } }
  }
  SYNC_AFTER(4);
#pragma unroll 1
  for (int rp_ = PH(5) ? a.rep[5] : 0; rp_ > 0; --rp_) {
    bf16_t* const G1 = (bf16_t*)((char*)a.out + 32 * MiB);
    const int xcd = pbid & 7;
    for (int lp = pbid >> 3; lp < 32; lp += pnblk >> 3) {
      const int pm = xcd * 8 + (lp & 7), pn = lp >> 3;
      TILE8_IDS;
      ListSched<MapP5> S8{0, 1, 4, MapP5{a.XB, a.WgT, a.AML, a.ANS, a.WmlT, a.WnsT, pm, pn}}; EpiP5 E8{a.MRG, G1, a.RS1};
      pg8::gemm_phase_vk<EpiP5, ListSched<MapP5>, false, true>((PG8_LAS unsigned char*)plds, pg8::Gemm{DM}, S8, E8, t512, wave_s);
    }
    { TILE_IDS; convert_range(a, a.cv_lo[5], a.cv_hi[5], bid, nblk, lds, tid); }
  }
  SYNC_AFTER(5);
#pragma unroll 1
  for (int rp_ = PH(6) ? a.rep[6] : 0; rp_ > 0; --rp_) {
    TILE_IDS;
    {
      TILE8_IDS;
      ListSched<MapMN> S8{pbid >> 3, pnblk >> 3, 32, MapMN{a.MRG, a.WoutT, DM, xcd}};
      EpiX1 E8{a.XB, a.X1B, a.PS2};
      pg8::gemm_phase<decltype(E8), ListSched<MapMN>, false, true>((PG8_LAS unsigned char*)plds, pg8::Gemm{DM}, S8, E8, t512, wave_s);
    }
    convert_range(a, a.cv_lo[6], a.cv_hi[6], bid, nblk, lds, tid);
  }
  SYNC_AFTER(6);
#pragma unroll 1
  for (int rp_ = PH(7) ? a.rep[7] : 0; rp_ > 0; --rp_) {
    TILE_IDS;
    {
      TILE8_IDS;
      for (int idx = pbid >> 3; idx < 32; idx += pnblk >> 3) {
        __syncthreads();
        if (t512 < 256) {
          const f32x4* pp = (const f32x4*)(a.PS2 + (size_t)((xcd * 8 + (idx & 7)) * 256 + t512) * 32);
          float ss = 0.f;
#pragma unroll
          for (int c = 0; c < 8; ++c) { const f32x4 p = pp[c]; ss += (p[0] + p[1]) + (p[2] + p[3]); }
          ((float*)(plds + 131072))[t512] = rsqrtf(ss * (1.f / DM) + EPS);
        }
        __syncthreads();
        ListSched<MapMN> S8{idx, 1 << 20, 32, MapMN{a.X1B, a.WqT, DM, xcd}};
        EpiXQ E8{a.XQ, (const PG8_LAS float*)(plds + 131072)};
        pg8::gemm_phase<decltype(E8), ListSched<MapMN>, false, true>((PG8_LAS unsigned char*)plds, pg8::Gemm{DM}, S8, E8, t512, wave_s);
      }
    }
    convert_range(a, a.cv_lo[7], a.cv_hi[7], bid, nblk, lds, tid);
  }
  SYNC_AFTER(7);
#pragma unroll 1
  for (int rp_ = PH(8) ? a.rep[8] : 0; rp_ > 0; --rp_) {
    TILE_IDS;
    float* RMX = (float*)lds; float* RSUM = (float*)(lds + 1024);
    for (int q = li; q < 64; q += nloc) {
      const int m0 = (xcd * 16 + (q >> 2)) * 128, hh = q & 3, b = m0 >> 12;
      bf16_t* Qh = a.XQ + hh * 256;
      const bf16_t* Kh = a.KVM + (size_t)(b * 256) * 1024 + hh * 256;
      const bf16_t* Vh = a.KVM + (size_t)1024 * 1024 + ((size_t)(b * 1024 + hh * 256) << 8);
      f32x4 acc0[4][4], acc1[4][4]; zero_acc(acc0); zero_acc(acc1);
      gemm_acc(acc0, Qh, 1024, (const int*)nullptr, 0, 0, Kh, 1024, 256, lds, m0, 0, tid);
      gemm_acc(acc1, Qh, 1024, (const int*)nullptr, 0, 0, Kh, 1024, 256, lds, m0, 128, tid);
      float mloc[4];
#pragma unroll
      for (int mi = 0; mi < 4; ++mi) {
        float mx = -INFINITY;
#pragma unroll
        for (int ni = 0; ni < 4; ++ni)
#pragma unroll
          for (int j = 0; j < 4; ++j) mx = fmaxf(mx, fmaxf(acc0[mi][ni][j], acc1[mi][ni][j]));
        mx = max4(mx); mloc[mi] = mx;
        if (fq == 0) RMX[(wr * 64 + mi * 16 + fr) * 2 + wc] = mx;
      }
      __syncthreads();
#pragma unroll
      for (int mi = 0; mi < 4; ++mi) {
        const int r = wr * 64 + mi * 16 + fr;
        const float m = fmaxf(RMX[r * 2], RMX[r * 2 + 1]); float ls = 0.f;
#pragma unroll
        for (int ni = 0; ni < 4; ++ni)
#pragma unroll
          for (int j = 0; j < 4; ++j) {
            acc0[mi][ni][j] = __expf((acc0[mi][ni][j] - m) * 0.0625f); acc1[mi][ni][j] = __expf((acc1[mi][ni][j] - m) * 0.0625f);
            ls += acc0[mi][ni][j] + acc1[mi][ni][j];
          }
        ls = red4(ls);
        if (fq == 0) RSUM[r * 2 + wc] = ls;
      }
      __syncthreads();
#pragma unroll
      for (int mi = 0; mi < 4; ++mi) {
        const int r = wr * 64 + mi * 16 + fr;
        const float inv = 1.f / (RSUM[r * 2] + RSUM[r * 2 + 1]);
        bf16_t* pr = Qh + (size_t)(m0 + r) * 1024 + wc * 64 + 4 * fq;
#pragma unroll
        for (int ni = 0; ni < 4; ++ni) { st_bf4(pr + ni * 16, acc0[mi][ni] * inv); st_bf4(pr + 128 + ni * 16, acc1[mi][ni] * inv); }
      }
      asm volatile("s_waitcnt vmcnt(0)" ::: "memory");
      __threadfence_block();
      __syncthreads();
#pragma unroll 1
      for (int dh = 0; dh < 2; ++dh) {
        zero_acc(acc0);
        gemm_acc(acc0, Qh, 1024, (const int*)nullptr, 0, 0, Vh, 256, 256, lds, m0, dh * 128, tid);
#pragma unroll
        for (int mi = 0; mi < 4; ++mi) {
          const int r = wr * 64 + mi * 16 + fr;
#pragma unroll
          for (int ni = 0; ni < 4; ++ni) st_bf4(a.XO + (size_t)(m0 + r) * 1024 + hh * 256 + dh * 128 + wc * 64 + ni * 16 + 4 * fq, acc0[mi][ni]);
        }
      }
    }
    convert_range(a, a.cv_lo[8], a.cv_hi[8], bid, nblk, lds, tid);
  }
  SYNC_AFTER(8);
#pragma unroll 1
  for (int rp_ = PH(9) ? a.rep[9] : 0; rp_ > 0; --rp_) {
    TILE_IDS;
    {
      TILE8_IDS;
      ListSched<MapMN> S8{pbid >> 3, pnblk >> 3, 32, MapMN{a.XO, a.WoT, DM, xcd}};
      EpiX2 E8{a.X1B};
      pg8::gemm_phase<decltype(E8), ListSched<MapMN>, false, true>((PG8_LAS unsigned char*)plds, pg8::Gemm{DM}, S8, E8, t512, wave_s);
    }
    convert_range(a, a.cv_lo[9], a.cv_hi[9], bid, nblk, lds, tid);
  }
  SYNC_AFTER(9);
#pragma unroll 1
  for (int rp_ = PH(10) ? a.rep[10] : 0; rp_ > 0; --rp_) {
    TILE_IDS;
    const int tpb = NTOK / nblk;
    int* ex_l = (int*)(lds + 65536);
    float* we_l = (float*)lds;
    for (int c = tid; c < 4096; c += 256) { const int k = c >> 2, q = c & 3; *(f32x4*)(we_l + (q * 1024 + k) * 4) = *(const f32x4*)(a.we + k * 16 + q * 4); }
    __syncthreads();
    for (int k = 0; k < tpb / 4; ++k) {
      const int tl = wid * (tpb / 4) + k, n = bid * tpb + tl;
      int lane = tid & 63; asm volatile("" : "+v"(lane));
      const bf16_t* xr = a.H3 + (size_t)n * DM;
      float v[16]; float s = 0.f;
#pragma unroll
      for (int i = 0; i < 16; ++i) { v[i] = bf2f(xr[lane + 64 * i]); s += v[i] * v[i]; }
      s = wave_sum(s);
      const float rs = rsqrtf(s * (1.f / DM) + EPS);
      float lg[20];
#pragma unroll
      for (int e = 0; e < 20; ++e) lg[e] = 0.f;
#pragma unroll
      for (int i = 0; i < 16; ++i) {
        const int k2 = lane + 64 * i; const float hk = v[i] * rs * a.g_ffn[k2];
        const f32x4 wgv = *(const f32x4*)(a.wg + k2 * 4);
#pragma unroll
        for (int e = 0; e < 4; ++e) lg[e] += hk * wgv[e];
#pragma unroll
        for (int q = 0; q < 4; ++q) { const f32x4 wv = *(const f32x4*)(we_l + (q * 1024 + k2) * 4);
#pragma unroll
          for (int e = 0; e < 4; ++e) lg[4 + q * 4 + e] += hk * wv[e]; }
      }
#pragma unroll
      for (int e = 0; e < 20; ++e) lg[e] = wave_sum(lg[e]);
      if (lane == 0) {
        float gl[4]; float gm = -INFINITY; int gi = 0;
#pragma unroll
        for (int e = 0; e < 4; ++e) { gl[e] = lg[e] + a.bg[e]; if (gl[e] > gm) { gm = gl[e]; gi = e; } }
        float gs = 0.f;
#pragma unroll
        for (int e = 0; e < 4; ++e) gs += __expf(gl[e] - gm);
        const float gval = 1.f / gs;
        float el[4] = {0.f, 0.f, 0.f, 0.f};
#pragma unroll
        for (int gg = 0; gg < 4; ++gg) if (gi == gg) {
#pragma unroll
          for (int e = 0; e < 4; ++e) el[e] = lg[4 + gg * 4 + e] + a.be[gg * 4 + e];
        }
        int i0 = 0; float v0 = el[0];
#pragma unroll
        for (int e = 1; e < 4; ++e) if (el[e] > v0) { v0 = el[e]; i0 = e; }
        int i1 = -1; float v1 = -INFINITY;
#pragma unroll
        for (int e = 0; e < 4; ++e) if (e != i0 && el[e] > v1) { v1 = el[e]; i1 = e; }
        const float e1 = __expf(v1 - v0);
        ex_l[tl * 2] = gi * 4 + i0; ex_l[tl * 2 + 1] = gi * 4 + i1;
        a.RTW[n * 2] = gval / (1.f + e1); a.RTW[n * 2 + 1] = gval * e1 / (1.f + e1);
        a.RS3[n] = rs;
      }
    }
    __syncthreads();
    if (tid < 16) {
      int cnt = 0;
      for (int j = 0; j < 2 * tpb; ++j) cnt += (ex_l[j] == tid) ? 1 : 0;
      if (cnt > 0) {
        int pos = atomicAdd(&a.CNT[tid], cnt);
        for (int j = 0; j < 2 * tpb; ++j) if (ex_l[j] == tid) a.LIST[tid * NTOK + pos++] = (bid * tpb) * 2 + j;
      }
    }
    __syncthreads();
  }
  SYNC_AFTER(10);
#pragma unroll 1
  for (int rp_ = PH(11) ? a.rep[11] : 0; rp_ > 0; --rp_) {
    TILE8_IDS;
    int rtot = 0;
    for (int e = 0; e < 16; ++e) rtot += (a.CNT[e] + 255) >> 8;
    const int n1 = ((rtot - xcd + 7) >> 3) * 4;
    const int li8 = pbid >> 3, L8 = pnblk >> 3;
    unsigned* const DEP = (unsigned*)a.CNT + 1024;
    {
      MoeUpSched S8{li8, L8, n1, MapMoe{a.CNT, a.LIST, a.H3, a.W13T, (size_t)1024 * 1024, DM, xcd, 1}, DEP, wave_s == 0};
      EpiMoe1 E8{a.LIST, a.RS3, a.ACT};
      pg8::gemm_phase<EpiMoe1, MoeUpSched, true, true>((PG8_LAS unsigned char*)plds, pg8::Gemm{DM}, S8, E8, t512, wave_s);
    }
    {
      const int r = n1 % L8, fp = r ? min(n1, 2 * (L8 - r)) : 0;
      const int nfirst = (r && li8 >= r) ? max(0, min(2, n1 - 2 * (li8 - r))) : 0;
      MoeDownSched S8{li8, L8, n1, r, fp, nfirst, MapMoe{a.CNT, a.LIST, a.ACT, a.W2T, (size_t)1024 * 512, 512, xcd, 0}, DEP, wave_s == 0};
      EpiMoe2 E8{a.LIST, a.RTW, a.Y};
      { pg8::Unit u0; if (S8.next(0, u0)) S8.a_ready(u0); }
      __syncthreads();
      pg8::gemm_phase<EpiMoe2, MoeDownSched, true, true, true>((PG8_LAS unsigned char*)plds, pg8::Gemm{512}, S8, E8, t512, wave_s);
    }
  }
  if (PH(11) && PH(13)) GRID_BAR();
#pragma unroll 1
  for (int rp_ = PH(13) ? a.rep[13] : 0; rp_ > 0; --rp_) {
    TILE_IDS;
    for (int row = bid * 4 + wid; row < NTOK; row += nblk * 4) {
      f32x4* xr = (f32x4*)(a.out + (size_t)row * DM) + lane;
      const u32x2* x2r = (const u32x2*)(a.H3 + (size_t)row * DM) + lane;
      const u32x2* y0 = (const u32x2*)(a.Y + (size_t)(row * 2) * DM) + lane; const u32x2* y1 = y0 + DM / 4;
      f32x4 v[4]; float s = 0.f;
#pragma unroll
      for (int j = 0; j < 4; ++j) {
        { const u32x2 xx = x2r[64 * j]; v[j][0] = __uint_as_float(xx.x << 16); v[j][1] = __uint_as_float(xx.x & 0xffff0000u); v[j][2] = __uint_as_float(xx.y << 16); v[j][3] = __uint_as_float(xx.y & 0xffff0000u); }
        const u32x2 p = y0[64 * j], q = y1[64 * j];
        v[j][0] += __uint_as_float(p.x << 16) + __uint_as_float(q.x << 16); v[j][1] += __uint_as_float(p.x & 0xffff0000u) + __uint_as_float(q.x & 0xffff0000u);
        v[j][2] += __uint_as_float(p.y << 16) + __uint_as_float(q.y << 16); v[j][3] += __uint_as_float(p.y & 0xffff0000u) + __uint_as_float(q.y & 0xffff0000u);
        s += v[j][0] * v[j][0] + v[j][1] * v[j][1] + v[j][2] * v[j][2] + v[j][3] * v[j][3];
      }
      s = wave_sum(s);
      const float rs = rsqrtf(s * (1.f / DM) + EPS);
#pragma unroll
      for (int j = 0; j < 4; ++j) xr[64 * j] = v[j] * rs * ((const f32x4*)a.g_final)[lane + 64 * j];
    }
  }
}

extern "C" void kernel_launch(void* const* d_in, const int* in_sizes, int n_in, void* d_out, int out_size, void* d_ws, size_t ws_size, hipStream_t stream) {
  const float* x = (const float*)d_in[0];
  const float* mem = (const float*)d_in[1];
  const float* norm_mix = (const float*)d_in[2];
  const float* w_in = (const float*)d_in[3];
  const float* conv_qk = (const float*)d_in[4];
  const float* b_igate = (const float*)d_in[5];
  const float* b_fgate = (const float*)d_in[6];
  const float* mlstm_norm = (const float*)d_in[7];
  const float* cmp_pos_k = (const float*)d_in[8];
  const float* cmp_pos_v = (const float*)d_in[9];
  const float* cmp_k_w1 = (const float*)d_in[10];
  const float* cmp_k_w2 = (const float*)d_in[11];
  const float* cmp_v_w1 = (const float*)d_in[12];
  const float* cmp_v_w2 = (const float*)d_in[13];
  const float* w_br_mlstm = (const float*)d_in[14];
  const float* w_br_nsa = (const float*)d_in[15];
  const float* w_mix_out = (const float*)d_in[16];
  const float* norm_xattn = (const float*)d_in[17];
  const float* norm_mem = (const float*)d_in[18];
  const float* xa_wq = (const float*)d_in[19];
  const float* xa_wkv = (const float*)d_in[20];
  const float* xa_wo = (const float*)d_in[21];
  const float* norm_ffn = (const float*)d_in[22];
  const float* router_group_w = (const float*)d_in[23];
  const float* router_group_b = (const float*)d_in[24];
  const float* router_expert_w = (const float*)d_in[25];
  const float* router_expert_b = (const float*)d_in[26];
  const float* moe_w1 = (const float*)d_in[27];
  const float* moe_w3 = (const float*)d_in[28];
  const float* moe_w2 = (const float*)d_in[29];
  const float* norm_final = (const float*)d_in[30];
  float* out = (float*)d_out;
  char* ws = (char*)d_ws;

  int* CNT = (int*)(ws + WS_CNT); int* LIST = (int*)(ws + WS_LIST); float* RTW = (float*)(ws + WS_RTW);
  float* SM = (float*)(ws + WS_SM); float* BCUM = (float*)(ws + WS_BCUM); float* IP = (float*)(ws + WS_IP);
  float* BL = (float*)(ws + WS_BL); float* MX = (float*)(ws + WS_MX); float* MST = (float*)(ws + WS_MST); float* NST = (float*)(ws + WS_NST);
  bf16_t* KC = (bf16_t*)(ws + WS_KC); bf16_t* VC = (bf16_t*)(ws + WS_VC);
  bf16_t* QK = (bf16_t*)(ws + WS_QK); bf16_t* V = (bf16_t*)(ws + WS_V); bf16_t* O = (bf16_t*)(ws + WS_O);
  bf16_t* NQ = (bf16_t*)(ws + WS_NQ); bf16_t* KV = (bf16_t*)(ws + WS_KV); bf16_t* CST = (bf16_t*)(ws + WS_CST);
  bf16_t* AML = (bf16_t*)(ws + WS_AML); bf16_t* ANS = (bf16_t*)(ws + WS_ANS); bf16_t* MRG = (bf16_t*)(ws + WS_MRG);
  bf16_t* KVM = (bf16_t*)(ws + WS_KVM); bf16_t* MEMN = (bf16_t*)(ws + WS_MEMN);
  bf16_t* H2 = (bf16_t*)(ws + WS_H2); bf16_t* XQ = (bf16_t*)(ws + WS_XQ); bf16_t* XO = (bf16_t*)(ws + WS_XO);
  bf16_t* H3 = H2; bf16_t* ACT = XQ; bf16_t* Y = (bf16_t*)(ws + 136 * MiB);
  bf16_t* H = (bf16_t*)d_out;
  bf16_t* T2 = (bf16_t*)((char*)d_out + 32 * MiB);

  (void)hipMemsetAsync(ws, 0, 131072, stream);
  static int grid_blocks = 0;
  if (!grid_blocks) {
    int dev = 0, cus = 0, per_cu = 0;
    (void)hipGetDevice(&dev);
    (void)hipDeviceGetAttribute(&cus, hipDeviceAttributeMultiprocessorCount, dev);
    (void)hipFuncSetAttribute((const void*)k_mega, hipFuncAttributeMaxDynamicSharedMemorySize, TOTAL_LDS);
    (void)hipOccupancyMaxActiveBlocksPerMultiprocessor(&per_cu, (const void*)k_mega, 512, TOTAL_LDS);
    if (per_cu > 1) per_cu = 1;
    if (per_cu < 1) per_cu = 1;
    grid_blocks = cus * per_cu;
  }
  MegaArgs fa{};
  fa.x = x; fa.mem = mem; fa.out = out; fa.BAR = (unsigned*)(ws + 65536);
  fa.ml.conv = conv_qk; fa.ml.b_i = b_igate; fa.ml.b_f = b_fgate; fa.ml.gain = mlstm_norm;
  fa.ml.BCUM = BCUM; fa.ml.IP = IP; fa.ml.BL = BL; fa.ml.MX = MX; fa.ml.MST = MST; fa.ml.NST = NST; fa.ml.CST = CST;
  fa.XB = (bf16_t*)d_out; fa.MEMB = (bf16_t*)(ws + WS_MEMB); fa.RS1 = (float*)(ws + WS_RS1); fa.RSM = (float*)(ws + WS_RSM); fa.PS2 = (float*)(ws + WS_PS2);
  fa.QK = QK; fa.V = V; fa.O = O; fa.NQ = NQ; fa.SM = SM;
  fa.KVC = (bf16_t*)(ws + WS_KVC); fa.KS = (bf16_t*)(ws + WS_KS); fa.KW = (bf16_t*)(ws + WS_KW); fa.VST = (bf16_t*)(ws + WS_VST); fa.VWT = (bf16_t*)(ws + WS_VWT);
  fa.KC = KC; fa.VCT = VC; fa.CK1T = (bf16_t*)(ws + WS_CK1T); fa.CV1T = (bf16_t*)(ws + WS_CV1T); fa.POSW = (float*)(ws + WS_POSW);
  fa.posk = cmp_pos_k; fa.posv = cmp_pos_v; fa.ckw1 = cmp_k_w1; fa.cvw1 = cmp_v_w1; fa.ckw2 = cmp_k_w2; fa.cvw2 = cmp_v_w2;
  fa.AML = AML; fa.ANS = ANS; fa.MRG = MRG; fa.X1B = H2; fa.XQ = XQ; fa.XO = XO; fa.KVM = KVM;
  fa.WinT = (bf16_t*)(ws + WS_WIN_T); fa.WgT = (bf16_t*)(ws + WS_WG_T); fa.WmlT = (bf16_t*)(ws + WS_WML_T); fa.WnsT = (bf16_t*)(ws + WS_WNS_T);
  fa.H3 = H3; fa.ACT = ACT; fa.Y = Y; fa.W13T = (bf16_t*)(ws + 104 * MiB); fa.W2T = (bf16_t*)(ws + 240 * MiB);
  fa.CPART = (float*)(ws + 176 * MiB); fa.WQ = (int*)(ws + 256);
  fa.RS3 = (float*)(ws + WS_RSM + 8192); fa.RTW = RTW; fa.CNT = CNT; fa.LIST = LIST;
  fa.g_ffn = norm_ffn; fa.wg = router_group_w; fa.bg = router_group_b; fa.we = router_expert_w; fa.be = router_expert_b; fa.g_final = norm_final;
  fa.WoutT = (bf16_t*)(ws + WS_WOUT_T); fa.WqT = (bf16_t*)(ws + WS_WQ_T); fa.WkvT = (bf16_t*)(ws + WS_WKV_T); fa.WoT = (bf16_t*)(ws + WS_WO_T);
  {
    auto mk = [&](const float* src, bf16_t* dst, const float* gain, int ldw, int K, int c0, int ncols, int drow0) {
      TDesc d{}; d.src = src; d.dst = dst; d.gain = gain; d.ldw = ldw; d.K = K; d.c0 = c0; d.ncols = ncols; d.drow0 = drow0; d.per = (K / 64) * ((ncols + 63) / 64); d.nitems = d.per; d.mode = 0; d.rofs = 0; d.sstride = 0; d.dstride = 0; d.pad = 0; return d; };
    int n = 0;
    fa.td[n++] = mk(w_in, fa.WinT, norm_mix, DIN, DM, 0, 2048, 0);
    fa.td[n++] = mk(w_in, fa.WinT, norm_mix, DIN, DM, 2056, 512, 2048);
    fa.td[n++] = mk(w_in, fa.WinT, norm_mix, DIN, DM, 2568, 384, 2560);
    fa.td[n++] = mk(w_in, fa.WinT, norm_mix, DIN, DM, 3080, 128, 2944);
    fa.td[n++] = mk(w_in, fa.WinT, norm_mix, DIN, DM, 2952, 128, 3072);
    fa.td[n++] = mk(w_in, fa.WinT, norm_mix, DIN, DM, 3208, 128, 3200);
    fa.td[n++] = mk(w_in, fa.WinT, norm_mix, DIN, DM, 2048, 8, 3328);
    fa.td[n++] = mk(w_in, fa.WinT, norm_mix, DIN, DM, 3336, 24, 3336);
    fa.td[n++] = mk(w_in, fa.WgT, norm_mix, DIN, DM, 3360, 2048, 0);
    fa.td[n++] = mk(w_br_mlstm, fa.WmlT, nullptr, 1024, 512, 0, 1024, 0);
    fa.td[n++] = mk(w_br_nsa, fa.WnsT, nullptr, 1024, 512, 0, 1024, 0);
    fa.td[n++] = mk(w_mix_out, fa.WoutT, nullptr, 1024, 1024, 0, 1024, 0);
    fa.td[n++] = mk(xa_wq, fa.WqT, norm_xattn, 1024, 1024, 0, 1024, 0);
    fa.td[n++] = mk(xa_wkv, fa.WkvT, norm_mem, 2048, 1024, 0, 2048, 0);
    fa.td[n++] = mk(xa_wo, fa.WoT, nullptr, 1024, 1024, 0, 1024, 0);
    fa.td[n++] = mk(cmp_k_w1, fa.CK1T, nullptr, 128, 2048, 0, 128, 0);
    fa.td[n++] = mk(cmp_v_w1, fa.CV1T, nullptr, 128, 2048, 0, 128, 0);
    fa.ntdA = n;
    { TDesc d = mk(moe_w1, fa.W13T, norm_ffn, 512, 1024, 0, 512, 0); d.mode = 2; d.rofs = 0; d.nitems = 16 * d.per; d.sstride = 1024 * 512; d.dstride = 1024 * 1024; fa.td[n++] = d; }
    { TDesc d = mk(moe_w3, fa.W13T, norm_ffn, 512, 1024, 0, 512, 0); d.mode = 2; d.rofs = 16; d.nitems = 16 * d.per; d.sstride = 1024 * 512; d.dstride = 1024 * 1024; fa.td[n++] = d; }
    { TDesc d = mk(moe_w2, fa.W2T, nullptr, 1024, 512, 0, 1024, 0); d.nitems = 16 * d.per; d.sstride = 512 * 1024; d.dstride = 1024 * 512; fa.td[n++] = d; }
    fa.ntdB = n;
    int cum[25]; cum[0] = 0; for (int i = 0; i < n; ++i) cum[i + 1] = cum[i] + fa.td[i].nitems;
    for (int k = 0; k < 16; ++k) { fa.cv_lo[k] = 0; fa.cv_hi[k] = 0; }
    fa.cv_lo[0] = 0; fa.cv_hi[0] = cum[8];
    fa.cv_lo[1] = cum[8]; fa.cv_hi[1] = cum[fa.ntdA];
    { const int lo = cum[fa.ntdA], tot = cum[n] - lo; const int phs[5] = {5, 6, 7, 8, 9};
      for (int i = 0; i < 5; ++i) { fa.cv_lo[phs[i]] = lo + (int)((long long)tot * i / 5); fa.cv_hi[phs[i]] = lo + (int)((long long)tot * (i + 1) / 5); } }
  }
  int launch_i = 0;
  auto mega = [&](int lo, int hi) {
    fa.ph_lo = lo; fa.ph_hi = hi; fa.li = launch_i++; fa.pad = 0;
    for (int k = 0; k < 16; ++k) fa.rep[k] = 1;

    void* args[] = {&fa};
    (void)hipLaunchCooperativeKernel((const void*)k_mega, dim3(grid_blocks), dim3(512), args, TOTAL_LDS, stream);
  };
  mega(0, 14);
}
```

```cpp
#include <hip/hip_runtime.h>
#include <stdint.h>

typedef unsigned short bf16_t;
__device__ __forceinline__ float bf2f(bf16_t v) { return __uint_as_float(((unsigned)v) << 16); }
typedef float f32x2_cv __attribute__((ext_vector_type(2)));
typedef __bf16 bf16x2_cv __attribute__((ext_vector_type(2)));
__device__ __forceinline__ unsigned pk2bf(float lo, float hi) { f32x2_cv v; v.x = lo; v.y = hi; return __builtin_bit_cast(unsigned, __builtin_convertvector(v, bf16x2_cv)); }
__device__ __forceinline__ bf16_t f2bf(float f) { return (bf16_t)(pk2bf(f, 0.f) & 0xffffu); }

constexpr int NB = 4, SEQ = 4096, NTOK = NB * SEQ, DM = 1024;
constexpr int DIN = 5408, DIN_A = 3360;
constexpr int MEMT = 256;
constexpr float EPS = 1e-6f;
constexpr size_t MiB = 1u << 20;

constexpr size_t WS_CNT = 0;
constexpr size_t WS_LIST = 1 * MiB;
constexpr size_t WS_RTW = 2 * MiB;
constexpr size_t WS_SM = 3 * MiB;
constexpr size_t WS_BCUM = 5 * MiB;
constexpr size_t WS_IP = 5 * MiB + 256 * 1024;
constexpr size_t WS_BL = 5 * MiB + 512 * 1024;
constexpr size_t WS_MX = WS_BL + 4096;
constexpr size_t WS_MST = WS_MX + 4096;
constexpr size_t WS_NST = 6 * MiB;
constexpr size_t WS_KC = 7 * MiB;
constexpr size_t WS_VC = 7 * MiB + 512 * 1024;
constexpr size_t WS_QK = 8 * MiB;
constexpr size_t WS_V = 40 * MiB;
constexpr size_t WS_O = 56 * MiB;
constexpr size_t WS_NQ = 72 * MiB;
constexpr size_t WS_KV = 88 * MiB;
constexpr size_t WS_CST = 112 * MiB;
constexpr size_t WS_AML = 144 * MiB;
constexpr size_t WS_ANS = 160 * MiB;
constexpr size_t WS_MRG = 176 * MiB;
constexpr size_t WS_KVM = 233 * MiB;
constexpr size_t WS_MEMN = 237 * MiB;
constexpr size_t WS_H2 = 8 * MiB;
constexpr size_t WS_XQ = 40 * MiB;
constexpr size_t WS_XO = 72 * MiB;
constexpr size_t WS_Y = 72 * MiB;

__device__ __forceinline__ float wave_sum(float v) {
#pragma unroll
  for (int o = 32; o > 0; o >>= 1) v += __shfl_xor(v, o);
  return v;
}
__device__ __forceinline__ float wave_max(float v) {
#pragma unroll
  for (int o = 32; o > 0; o >>= 1) v = fmaxf(v, __shfl_xor(v, o));
  return v;
}
__device__ __forceinline__ float sigmoidf_(float x) { return __builtin_amdgcn_rcpf(1.f + __expf(-x)); }
__device__ __forceinline__ float siluf_(float x) { return x * __builtin_amdgcn_rcpf(1.f + __expf(-x)); }
__device__ __forceinline__ float logsigmoidf_(float x) { return fminf(x, 0.f) - log1pf(__expf(-fabsf(x))); }
__device__ __forceinline__ float gelu_tanh(float x) { float u = 0.7978845608028654f * (x + 0.044715f * x * x * x); return 0.5f * x * (1.f + tanhf(u)); }

#include <hip/hip_cooperative_groups.h>
namespace cg = cooperative_groups;
#define LAS __attribute__((address_space(3)))
typedef short bf16x8 __attribute__((ext_vector_type(8)));
typedef float f32x4 __attribute__((ext_vector_type(4)));
typedef unsigned u32x2 __attribute__((ext_vector_type(2)));
typedef unsigned u32x4 __attribute__((ext_vector_type(4)));

constexpr size_t WS_RS1 = 5 * MiB + 768 * 1024;
constexpr size_t WS_RSM = WS_RS1 + 65536;
constexpr size_t WS_PS2 = 4 * MiB;
constexpr size_t WS_WIN_T = 208 * MiB;
constexpr size_t WS_WG_T = 216 * MiB;
constexpr size_t WS_WML_T = 220 * MiB;
constexpr size_t WS_WNS_T = 221 * MiB;
constexpr size_t WS_WOUT_T = 222 * MiB;
constexpr size_t WS_WQ_T = 224 * MiB;
constexpr size_t WS_WKV_T = 226 * MiB;
constexpr size_t WS_WO_T = 230 * MiB;
constexpr size_t WS_MEMB = 238 * MiB;
constexpr size_t WS_KVC = WS_KV;
constexpr size_t WS_KS = WS_KV + 8 * MiB;
constexpr size_t WS_KW = WS_KV + 12 * MiB;
constexpr size_t WS_VST = WS_KV + 16 * MiB;
constexpr size_t WS_VWT = WS_KV + 20 * MiB;
constexpr size_t WS_CK1T = 232 * MiB;
constexpr size_t WS_CV1T = 232 * MiB + 512 * 1024;
constexpr size_t WS_POSW = WS_RSM + 8192 + 65536;
constexpr int NIN = 3584;

__device__ __forceinline__ void st_bf4(bf16_t* p, f32x4 v) { u32x2 o; o.x = pk2bf(v[0], v[1]); o.y = pk2bf(v[2], v[3]); *(u32x2*)p = o; }
__device__ __forceinline__ void swap8(const f32x4& v0, const f32x4& v1, float (&o)[8]) {
#pragma unroll
  for (int j = 0; j < 4; ++j) { const auto r = __builtin_amdgcn_permlane16_swap(__float_as_uint(v0[j]), __float_as_uint(v1[j]), false, false); o[j] = __uint_as_float(r[0]); o[4 + j] = __uint_as_float(r[1]); }
}
__device__ __forceinline__ void bf8_to_f32(const u32x4 p, float (&o)[8]) {
  o[0] = __uint_as_float(p.x << 16); o[1] = __uint_as_float(p.x & 0xffff0000u); o[2] = __uint_as_float(p.y << 16); o[3] = __uint_as_float(p.y & 0xffff0000u);
  o[4] = __uint_as_float(p.z << 16); o[5] = __uint_as_float(p.z & 0xffff0000u); o[6] = __uint_as_float(p.w << 16); o[7] = __uint_as_float(p.w & 0xffff0000u);
}
__device__ __forceinline__ u32x4 pk8bf(const float (&v)[8]) { u32x4 o; o.x = pk2bf(v[0], v[1]); o.y = pk2bf(v[2], v[3]); o.z = pk2bf(v[4], v[5]); o.w = pk2bf(v[6], v[7]); return o; }
__device__ __forceinline__ void st_bf8_pair(bf16_t* p, int fq, f32x4 v0, f32x4 v1) {
  const auto sx = __builtin_amdgcn_permlane16_swap(pk2bf(v0[0], v0[1]), pk2bf(v1[0], v1[1]), false, false);
  const auto sy = __builtin_amdgcn_permlane16_swap(pk2bf(v0[2], v0[3]), pk2bf(v1[2], v1[3]), false, false);
  u32x4 o; o.x = sx[0]; o.y = sy[0]; o.z = sx[1]; o.w = sy[1];
  __builtin_nontemporal_store(o, (u32x4*)(p + (fq & 1) * 16 + (fq >> 1) * 8));
}
__device__ __forceinline__ void st_bf8_pair_c(bf16_t* p, int fq, f32x4 v0, f32x4 v1) {
  const auto sx = __builtin_amdgcn_permlane16_swap(pk2bf(v0[0], v0[1]), pk2bf(v1[0], v1[1]), false, false);
  const auto sy = __builtin_amdgcn_permlane16_swap(pk2bf(v0[2], v0[3]), pk2bf(v1[2], v1[3]), false, false);
  u32x4 o; o.x = sx[0]; o.y = sy[0]; o.z = sx[1]; o.w = sy[1];
  *(u32x4*)(p + (fq & 1) * 16 + (fq >> 1) * 8) = o;
}

struct TDesc { const float* src; bf16_t* dst; const float* gain; int ldw, K, c0, ncols, drow0, nitems, mode, rofs, per, sstride, dstride, pad; };
__device__ __forceinline__ void transpose_item(const TDesc& d, int item, float* t  , int tid) {
  const int bat = item / d.per; item -= bat * d.per;
  const float* src = d.src + (size_t)bat * d.sstride; bf16_t* dst = d.dst + (size_t)bat * d.dstride;
  const int ncb = (d.ncols + 63) >> 6; const int kb = item / ncb, cb = item % ncb; const int k0 = kb * 64, n0 = cb * 64;
  {
    const int c4 = (tid & 15) * 4, kq = tid >> 4;
    f32x4 v[4];
#pragma unroll
    for (int p = 0; p < 4; ++p) {
      const int kk = p * 16 + kq;
      v[p] = (n0 + c4 < d.ncols) ? __builtin_nontemporal_load((const f32x4*)(src + (size_t)(k0 + kk) * d.ldw + d.c0 + n0 + c4)) : (f32x4){0.f, 0.f, 0.f, 0.f};
    }
#pragma unroll
    for (int p = 0; p < 4; ++p) {
      const int kk = p * 16 + kq; const float g = d.gain ? d.gain[k0 + kk] : 1.f;
      float* tp = t + kk * 65 + c4; tp[0] = v[p][0] * g; tp[1] = v[p][1] * g; tp[2] = v[p][2] * g; tp[3] = v[p][3] * g;
    }
  }
  __syncthreads();
#pragma unroll
  for (int j = 0; j < 2; ++j) {
    int c = tid + j * 256; int n = c >> 3, kc = c & 7;
    if (n0 + n < d.ncols) {
      const float* p = t + (kc * 8) * 65 + n;
      u32x4 o; o.x = pk2bf(p[0], p[65]); o.y = pk2bf(p[130], p[195]); o.z = pk2bf(p[260], p[325]); o.w = pk2bf(p[390], p[455]);
      const int drow = d.mode == 2 ? (d.drow0 + (cb * 4 + (n >> 4)) * 32 + (n & 15) + d.rofs) : d.mode ? (d.drow0 + cb * 128 + (n >> 5) * 64 + (n & 31) + d.rofs) : (d.drow0 + n0 + n);
      *(u32x4*)(dst + (size_t)drow * d.K + k0 + kc * 8) = o;
    }
  }
  __syncthreads();
}

__device__ __forceinline__ void rows_to_bf16(const float* __restrict__ src, bf16_t* __restrict__ dst, float* __restrict__ rs, int nrows, int gw, int ngw, int lane) {
  for (int row = gw; row < nrows; row += ngw) {
    const f32x4* xr = (const f32x4*)(src + (size_t)row * DM) + lane;
    f32x4 v[4]; float s = 0.f;
#pragma unroll
    for (int j = 0; j < 4; ++j) { v[j] = __builtin_nontemporal_load(xr + 64 * j); s += v[j][0] * v[j][0] + v[j][1] * v[j][1] + v[j][2] * v[j][2] + v[j][3] * v[j][3]; }
    s = wave_sum(s);
    if (lane == 0) rs[row] = rsqrtf(s * (1.f / DM) + EPS);
#pragma unroll
    for (int j = 0; j < 4; ++j) st_bf4(dst + (size_t)row * DM + (lane + 64 * j) * 4, v[j]);
  }
}

__device__ __forceinline__ void glds16(const void* g, char* l) {
  __builtin_amdgcn_global_load_lds((const unsigned*)g, (LAS unsigned*)l, 16, 0, 0);
}
__device__ __forceinline__ void glds16_nt(const void* g, char* l) {
  __builtin_amdgcn_global_load_lds((const unsigned*)g, (LAS unsigned*)l, 16, 0, 2);
}
__device__ __forceinline__ int st_row(int tid, int i) { return (tid >> 3) + 32 * i; }
__device__ __forceinline__ int st_lc(int tid, int i) { return (tid & 7) ^ ((st_row(tid, i) >> 1) & 7); }
__device__ __forceinline__ void gemm_core(f32x4 (&acc)[4][4], const bf16_t* __restrict__ A, const unsigned (&ao)[4], unsigned ksa,
                                          const bf16_t* __restrict__ Bt, const unsigned (&bo)[4], unsigned ksb, int nt, char* lds, int tid) {
  const int lane = tid & 63, wid = tid >> 6, wr = wid >> 1, wc = wid & 1, fr = lane & 15, fq = lane >> 4;
  char* ldst = lds + tid * 16;
#pragma unroll
  for (int i = 0; i < 4; ++i) { glds16(A + ao[i], ldst + i * 4096); glds16(Bt + bo[i], ldst + 16384 + i * 4096); }
  const int sw = fr >> 1;
  const int aoff = (wr * 64 + fr) * 128, boff = (wc * 64 + fr) * 128;
  for (int t = 0; t < nt; ++t) {
    asm volatile("s_waitcnt vmcnt(0)" ::: "memory");
    __syncthreads();
    const int cur = t & 1;
    if (t + 1 < nt) {
      char* nb = ldst + (cur ^ 1) * 32768; const unsigned ka = (t + 1) * ksa, kb = (t + 1) * ksb;
#pragma unroll
      for (int i = 0; i < 4; ++i) { glds16(A + (ao[i] + ka), nb + i * 4096); glds16(Bt + (bo[i] + kb), nb + 16384 + i * 4096); }
    }
    const char* sA = lds + cur * 32768 + aoff; const char* sB = lds + cur * 32768 + 16384 + boff;
#pragma unroll
    for (int ks = 0; ks < 2; ++ks) {
      bf16x8 a[4], b[4];
      const int co = ((ks * 4 + fq) ^ sw) << 4;
#pragma unroll
      for (int i = 0; i < 4; ++i) { a[i] = *(const bf16x8*)(sA + i * 2048 + co); b[i] = *(const bf16x8*)(sB + i * 2048 + co); }
#pragma unroll
      for (int i = 0; i < 4; ++i)
#pragma unroll
        for (int j = 0; j < 4; ++j) acc[i][j] = __builtin_amdgcn_mfma_f32_16x16x32_bf16(b[j], a[i], acc[i][j], 0, 0, 0);
    }
  }
  __syncthreads();
}
__device__ __forceinline__ void gemm_acc(f32x4 (&acc)[4][4], const bf16_t* __restrict__ A, size_t lda, const int* __restrict__ arow, int ashift, int mvalid,
                                         const bf16_t* __restrict__ Bt, size_t ldb, int K, char* lds, int m0, int n0, int tid) {
  asm volatile("" : "+v"(tid));
  unsigned ao[4], bo[4];
#pragma unroll
  for (int i = 0; i < 4; ++i) {
    const int row = st_row(tid, i), lc = st_lc(tid, i);
    int gr;
    if (arow) { int mm = m0 + row; if (mm >= mvalid) mm = mvalid - 1; gr = arow[mm] >> ashift; } else gr = m0 + row;
    ao[i] = (unsigned)gr * (unsigned)lda + lc * 8;
    bo[i] = (unsigned)(n0 + row) * (unsigned)ldb + lc * 8;
  }
  gemm_core(acc, A, ao, 64u, Bt, bo, 64u, K >> 6, lds, tid);
}
__device__ __forceinline__ void zero_acc(f32x4 (&acc)[4][4]) {
#pragma unroll
  for (int i = 0; i < 4; ++i)
#pragma unroll
    for (int j = 0; j < 4; ++j) acc[i][j] = (f32x4){0.f, 0.f, 0.f, 0.f};
}


namespace pg8 {
#define PG8_LAS __attribute__((address_space(3)))
typedef unsigned short bf16_t;
typedef short bf16x8 __attribute__((ext_vector_type(8)));
typedef float f32x4 __attribute__((ext_vector_type(4)));
typedef unsigned u32x4 __attribute__((ext_vector_type(4)));
constexpr int BM = 256, BK = 64, HALF = 128, HTB = HALF * BK * 2  , STAGE_BYTES = 8 * HTB, NXCD = 8, WGM = 8;

__host__ __device__ __forceinline__ int lds_byte(int r, int c) { const int st = (r >> 4) * 2 + (c >> 5), rr = r & 15, cc = c & 31, ob = rr * 64 + cc * 2; return st * 1024 + (ob ^ (((ob >> 9) & 1) << 5)); }
__host__ __device__ __forceinline__ void stage_rc(int b, int& R, int& C) { const int st = b / 1024, sb = b % 1024, swz = sb ^ (((sb >> 9) & 1) << 5); R = (st >> 1) * 16 + swz / 64; C = (st & 1) * 32 + (swz % 64) / 2; }
__host__ __device__ __forceinline__ int perm32(int rho) { const int n = rho >> 4, i = rho & 15; return 8 * (i >> 2) + 4 * n + (i & 3); }

struct Unit { int pm, pn; const char* aptr; const char* bptr; int e, ce, p0, rt, K; };
struct Gemm { int K; };
template <class Epi, class Sched, bool ALIGN_EPI = false, bool SP2 = false, bool ACOH = false  >
__device__ __forceinline__ void gemm_phase(PG8_LAS unsigned char* lds, const Gemm g, const Sched& S, const Epi& E, int tid  , int wid  ) {
    asm volatile("" : "+v"(tid));
    const int lane = tid & 63, wr = wid >> 2, wc = wid & 3, fr = lane & 15, fq = lane >> 4;
    const int K = g.K, nt = K / BK;
    unsigned voffA[2], voffB[2];
#pragma unroll
    for (int i = 0; i < 2; ++i) { int R, C; stage_rc(tid * 16 + i * 8192, R, C); const int Rb = Epi::PERM ? ((R & ~31) + perm32(R & 31)) : R;
        voffA[i] = (unsigned)(R * K + C) * 2u; voffB[i] = (unsigned)(Rb * K + C) * 2u; }
    unsigned cva0[2], cva1[2], nva0[2], nva1[2];
    const size_t kstep = (size_t)(BK * 2);
    const size_t hstep = (size_t)HALF * K * 2;
    const unsigned ldsw = (unsigned)wid * 1024u;
    const int aoff = lds_byte(wr * 64 + fr, fq * 8), boff = lds_byte(wc * 32 + fr, fq * 8);
#define PG8_SA(b, h) (((b) * 2 + (h)) * HTB)
#define PG8_SB(b, h) ((4 + (b) * 2 + (h)) * HTB)
#define PG8_STAGE(bufoff, gbase, voff) do { _Pragma("unroll") for (int _i = 0; _i < 2; ++_i) \
        __builtin_amdgcn_global_load_lds((const unsigned*)((const char*)(gbase) + (voff)[_i]), (PG8_LAS unsigned*)(lds + (bufoff) + ldsw + _i * 8192), 16, 0, 0); } while (0)
#define PG8_STAGEA(bufoff, gbase, voff) do { _Pragma("unroll") for (int _i = 0; _i < 2; ++_i) { \
        if constexpr (ACOH) __builtin_amdgcn_global_load_lds((const unsigned*)((const char*)(gbase) + (voff)[_i]), (PG8_LAS unsigned*)(lds + (bufoff) + ldsw + _i * 8192), 16, 0, 16  ); \
        else __builtin_amdgcn_global_load_lds((const unsigned*)((const char*)(gbase) + (voff)[_i]), (PG8_LAS unsigned*)(lds + (bufoff) + ldsw + _i * 8192), 16, 0, 0); } } while (0)
#define PG8_LDA(dst, b, h) do { _Pragma("unroll") for (int m = 0; m < 4; ++m) _Pragma("unroll") for (int k = 0; k < 2; ++k) dst[m][k] = *(const PG8_LAS bf16x8*)(lds + PG8_SA(b, h) + aoff + m * 2048 + k * 1024); } while (0)
#define PG8_LDB(dst, b, h) do { _Pragma("unroll") for (int n = 0; n < 2; ++n) _Pragma("unroll") for (int k = 0; k < 2; ++k) dst[n][k] = *(const PG8_LAS bf16x8*)(lds + PG8_SB(b, h) + boff + n * 2048 + k * 1024); } while (0)
#define PG8_MMA(ai, bj, At, Bt) do { __builtin_amdgcn_s_setprio(1); _Pragma("unroll") for (int m = 0; m < 4; ++m) _Pragma("unroll") for (int n = 0; n < 2; ++n) _Pragma("unroll") for (int k = 0; k < 2; ++k) \
        acc[ai][bj][m][n] = __builtin_amdgcn_mfma_f32_16x16x32_bf16(Bt[n][k], At[m][k], acc[ai][bj][m][n], 0, 0, 0); __builtin_amdgcn_s_setprio(0); } while (0)
#define PG8_WAIT_V(n) asm volatile("s_waitcnt vmcnt(" #n ")" ::: "memory")
#define PG8_WAIT_L(n) asm volatile("s_waitcnt lgkmcnt(" #n ")" ::: "memory")
#define PG8_BAR __builtin_amdgcn_s_barrier()
#define PG8_SCHED __builtin_amdgcn_sched_barrier(0)
    Unit cur, nxt; int ui = 0;
    if (!S.next(0, cur)) return;
    S.avoff(cur, tid, K, voffA, cva0, cva1);
    f32x4 acc[2][2][4][2];
#pragma unroll
    for (int a = 0; a < 2; ++a)
#pragma unroll
        for (int b = 0; b < 2; ++b)
#pragma unroll
            for (int m = 0; m < 4; ++m)
#pragma unroll
                for (int n = 0; n < 2; ++n) acc[a][b][m][n] = (f32x4){0.f, 0.f, 0.f, 0.f};
    bf16x8 At[4][2], B0[2][2], B1[2][2];
    const char* cA = cur.aptr; const char* cB = cur.bptr;
    S.a_ready(cur);
    if constexpr (SP2) {
        PG8_STAGE(PG8_SB(0, 0), cB, voffB); PG8_STAGE(PG8_SB(0, 1), cB + hstep, voffB); PG8_STAGEA(PG8_SA(0, 0), cA, cva0); PG8_STAGEA(PG8_SA(0, 1), cA, cva1);
        if (wr == 1) PG8_BAR;
        PG8_WAIT_V(2); PG8_BAR;
        PG8_STAGE(PG8_SB(1, 0), cB + kstep, voffB); PG8_STAGEA(PG8_SA(1, 0), cA + kstep, cva0); PG8_STAGE(PG8_SB(1, 1), cB + hstep + kstep, voffB);
        PG8_WAIT_V(6); PG8_BAR;
    } else {
        PG8_STAGE(PG8_SB(0, 0), cB, voffB); PG8_STAGEA(PG8_SA(0, 0), cA, cva0); PG8_STAGE(PG8_SB(0, 1), cB + hstep, voffB); PG8_STAGEA(PG8_SA(0, 1), cA, cva1);
        if (wr == 1) PG8_BAR;
        PG8_WAIT_V(4); PG8_BAR;
        PG8_STAGE(PG8_SB(1, 0), cB + kstep, voffB); PG8_STAGEA(PG8_SA(1, 0), cA + kstep, cva0); PG8_STAGE(PG8_SB(1, 1), cB + hstep + kstep, voffB);
        PG8_WAIT_V(6); PG8_BAR;
    }
    for (;;) {
        const bool has_next = S.next(ui + 1, nxt);
        if (has_next) S.avoff(nxt, tid, K, voffA, nva0, nva1); else { nva0[0] = cva0[0]; nva0[1] = cva0[1]; nva1[0] = cva1[0]; nva1[1] = cva1[1]; }
        const char* nA = has_next ? nxt.aptr : cA; const char* nB = has_next ? nxt.bptr : cB;
        for (int t = 0; t < nt; t += 2) {
            const bool last = (t == nt - 2);
            const char* a1 = cA + (size_t)(t + 1) * kstep;
            const char* a2 = last ? nA : cA + (size_t)(t + 2) * kstep; const char* b2 = last ? nB : cB + (size_t)(t + 2) * kstep;
            const char* a3 = a2 + kstep; const char* b3 = b2 + kstep;
            const unsigned xva0[2] = {last ? nva0[0] : cva0[0], last ? nva0[1] : cva0[1]}, xva1[2] = {last ? nva1[0] : cva1[0], last ? nva1[1] : cva1[1]};
            if (last && has_next) S.a_ready(nxt);
            if constexpr (SP2) {
            PG8_LDB(B0, 0, 0); PG8_LDB(B1, 0, 1); PG8_SCHED; PG8_LDA(At, 0, 0); PG8_STAGEA(PG8_SA(1, 1), a1, cva1);
            PG8_WAIT_V(8); PG8_WAIT_L(0); PG8_BAR; PG8_MMA(0, 0, At, B0); PG8_MMA(0, 1, At, B1); PG8_BAR; PG8_SCHED;
            PG8_LDA(At, 0, 1); PG8_STAGE(PG8_SB(0, 0), b2, voffB); PG8_STAGE(PG8_SB(0, 1), b2 + hstep, voffB); PG8_STAGEA(PG8_SA(0, 0), a2, xva0);
            PG8_WAIT_V(8); PG8_WAIT_L(0); PG8_BAR; PG8_MMA(1, 0, At, B0); PG8_MMA(1, 1, At, B1); PG8_BAR; PG8_SCHED;
            PG8_LDB(B0, 1, 0); PG8_LDB(B1, 1, 1); PG8_SCHED; PG8_LDA(At, 1, 0); PG8_STAGEA(PG8_SA(0, 1), a2, xva1);
            PG8_WAIT_V(8); PG8_WAIT_L(0); PG8_BAR; PG8_MMA(0, 0, At, B0); PG8_MMA(0, 1, At, B1); PG8_BAR; PG8_SCHED;
            PG8_LDA(At, 1, 1); PG8_STAGE(PG8_SB(1, 0), b3, voffB); PG8_STAGE(PG8_SB(1, 1), b3 + hstep, voffB); PG8_STAGEA(PG8_SA(1, 0), a3, xva0);
            PG8_WAIT_V(8); PG8_WAIT_L(0); PG8_BAR; PG8_MMA(1, 0, At, B0); PG8_MMA(1, 1, At, B1); PG8_BAR; PG8_SCHED;
            } else {
            PG8_LDB(B0, 0, 0); PG8_SCHED; PG8_LDA(At, 0, 0); PG8_STAGEA(PG8_SA(1, 1), a1, cva1);
            PG8_WAIT_L(8); PG8_BAR; PG8_WAIT_L(0); PG8_MMA(0, 0, At, B0); PG8_BAR; PG8_SCHED;
            PG8_LDB(B1, 0, 1); PG8_STAGE(PG8_SB(0, 0), b2, voffB);
            PG8_BAR; PG8_WAIT_L(0); PG8_MMA(0, 1, At, B1); PG8_BAR;
            PG8_LDA(At, 0, 1); PG8_STAGEA(PG8_SA(0, 0), a2, xva0);
            PG8_BAR; PG8_WAIT_L(0); PG8_MMA(1, 0, At, B0); PG8_BAR; PG8_SCHED;
            PG8_STAGE(PG8_SB(0, 1), b2 + hstep, voffB);
            PG8_WAIT_V(6); PG8_BAR; PG8_MMA(1, 1, At, B1); PG8_BAR;
            PG8_LDB(B0, 1, 0); PG8_SCHED; PG8_LDA(At, 1, 0); PG8_STAGEA(PG8_SA(0, 1), a2, xva1);
            PG8_WAIT_L(8); PG8_BAR; PG8_WAIT_L(0); PG8_MMA(0, 0, At, B0); PG8_BAR; PG8_SCHED;
            PG8_LDB(B1, 1, 1); PG8_STAGE(PG8_SB(1, 0), b3, voffB);
            PG8_BAR; PG8_WAIT_L(0); PG8_MMA(0, 1, At, B1); PG8_BAR;
            PG8_LDA(At, 1, 1); PG8_STAGEA(PG8_SA(1, 0), a3, xva0);
            PG8_BAR; PG8_WAIT_L(0); PG8_MMA(1, 0, At, B0); PG8_BAR; PG8_SCHED;
            PG8_STAGE(PG8_SB(1, 1), b3 + hstep, voffB);
            PG8_WAIT_V(6); PG8_BAR; PG8_MMA(1, 1, At, B1); PG8_BAR;
            }
        }
        if constexpr (ALIGN_EPI) { if (wr == 0) PG8_BAR; }
        if constexpr (!Epi::AFTER_DRAIN) { E(acc, cur, wr, wc, fr, fq); S.done(cur); }
        if (!has_next) break;
#pragma unroll
        for (int a = 0; a < 2; ++a)
#pragma unroll
            for (int b = 0; b < 2; ++b)
#pragma unroll
                for (int m = 0; m < 4; ++m)
#pragma unroll
                    for (int n = 0; n < 2; ++n) acc[a][b][m][n] = (f32x4){0.f, 0.f, 0.f, 0.f};
        cur = nxt; cA = nA; cB = nB; ++ui; cva0[0] = nva0[0]; cva0[1] = nva0[1]; cva1[0] = nva1[0]; cva1[1] = nva1[1];
        if constexpr (ALIGN_EPI) { if (wr == 1) PG8_BAR; }
    }
    PG8_WAIT_V(0);
    if constexpr (!ALIGN_EPI) { if (wr == 0) PG8_BAR; }
    PG8_BAR;
    if constexpr (Epi::AFTER_DRAIN) { E.fused(acc, cur, wr, wc, fr, fq, lds, wid, lane); S.done(cur); }
#undef PG8_SA
#undef PG8_SB
#undef PG8_STAGE
#undef PG8_STAGEA
#undef PG8_LDA
#undef PG8_LDB
#undef PG8_MMA
#undef PG8_WAIT_V
#undef PG8_WAIT_L
#undef PG8_BAR
#undef PG8_SCHED
}
template <class Epi, class Sched, bool ALIGN_EPI = false, bool SP2 = true, bool ACOH = false>
__device__ __forceinline__ void gemm_phase_vk(PG8_LAS unsigned char* lds, const Gemm g, const Sched& S, const Epi& E, int tid  , int wid  ) {
    static_assert(!Epi::PERM, "no row permutation in the per-unit-K body");
    asm volatile("" : "+v"(tid));
    const int lane = tid & 63, wr = wid >> 2, wc = wid & 3, fr = lane & 15, fq = lane >> 4;
    (void)g;
    unsigned vR2[2], vC2[2];
#pragma unroll
    for (int i = 0; i < 2; ++i) { int R, C; stage_rc(tid * 16 + i * 8192, R, C); vR2[i] = (unsigned)R * 2u; vC2[i] = (unsigned)C * 2u; }
    unsigned cvb[2], nvb[2];
    unsigned cva0[2], cva1[2], nva0[2], nva1[2];
    const size_t kstep = (size_t)(BK * 2);
    const unsigned ldsw = (unsigned)wid * 1024u;
    const int aoff = lds_byte(wr * 64 + fr, fq * 8), boff = lds_byte(wc * 32 + fr, fq * 8);
#define PG8_SA(b, h) (((b) * 2 + (h)) * HTB)
#define PG8_SB(b, h) ((4 + (b) * 2 + (h)) * HTB)
#define PG8_STAGE(bufoff, gbase, voff) do { _Pragma("unroll") for (int _i = 0; _i < 2; ++_i) \
        __builtin_amdgcn_global_load_lds((const unsigned*)((const char*)(gbase) + (voff)[_i]), (PG8_LAS unsigned*)(lds + (bufoff) + ldsw + _i * 8192), 16, 0, 0); } while (0)
#define PG8_STAGEA(bufoff, gbase, voff) do { _Pragma("unroll") for (int _i = 0; _i < 2; ++_i) { \
        if constexpr (ACOH) __builtin_amdgcn_global_load_lds((const unsigned*)((const char*)(gbase) + (voff)[_i]), (PG8_LAS unsigned*)(lds + (bufoff) + ldsw + _i * 8192), 16, 0, 16  ); \
        else __builtin_amdgcn_global_load_lds((const unsigned*)((const char*)(gbase) + (voff)[_i]), (PG8_LAS unsigned*)(lds + (bufoff) + ldsw + _i * 8192), 16, 0, 0); } } while (0)
#define PG8_LDA(dst, b, h) do { _Pragma("unroll") for (int m = 0; m < 4; ++m) _Pragma("unroll") for (int k = 0; k < 2; ++k) dst[m][k] = *(const PG8_LAS bf16x8*)(lds + PG8_SA(b, h) + aoff + m * 2048 + k * 1024); } while (0)
#define PG8_LDB(dst, b, h) do { _Pragma("unroll") for (int n = 0; n < 2; ++n) _Pragma("unroll") for (int k = 0; k < 2; ++k) dst[n][k] = *(const PG8_LAS bf16x8*)(lds + PG8_SB(b, h) + boff + n * 2048 + k * 1024); } while (0)
#define PG8_MMA(ai, bj, At, Bt) do { __builtin_amdgcn_s_setprio(1); _Pragma("unroll") for (int m = 0; m < 4; ++m) _Pragma("unroll") for (int n = 0; n < 2; ++n) _Pragma("unroll") for (int k = 0; k < 2; ++k) \
        acc[ai][bj][m][n] = __builtin_amdgcn_mfma_f32_16x16x32_bf16(Bt[n][k], At[m][k], acc[ai][bj][m][n], 0, 0, 0); __builtin_amdgcn_s_setprio(0); } while (0)
#define PG8_WAIT_V(n) asm volatile("s_waitcnt vmcnt(" #n ")" ::: "memory")
#define PG8_WAIT_L(n) asm volatile("s_waitcnt lgkmcnt(" #n ")" ::: "memory")
#define PG8_BAR __builtin_amdgcn_s_barrier()
#define PG8_SCHED __builtin_amdgcn_sched_barrier(0)
    Unit cur, nxt; int ui = 0;
    if (!S.next(0, cur)) return;
    int cK = cur.K, nK = cur.K;
    size_t chs = (size_t)HALF * cK * 2, nhs = chs;
    { const unsigned va[2] = {vR2[0] * (unsigned)cK + vC2[0], vR2[1] * (unsigned)cK + vC2[1]}; cvb[0] = va[0]; cvb[1] = va[1]; S.avoff(cur, tid, cK, va, cva0, cva1); }
    f32x4 acc[2][2][4][2];
#pragma unroll
    for (int a = 0; a < 2; ++a)
#pragma unroll
        for (int b = 0; b < 2; ++b)
#pragma unroll
            for (int m = 0; m < 4; ++m)
#pragma unroll
                for (int n = 0; n < 2; ++n) acc[a][b][m][n] = (f32x4){0.f, 0.f, 0.f, 0.f};
    bf16x8 At[4][2], B0[2][2], B1[2][2];
    const char* cA = cur.aptr; const char* cB = cur.bptr;
    S.a_ready(cur);
    if constexpr (SP2) {
        PG8_STAGE(PG8_SB(0, 0), cB, cvb); PG8_STAGE(PG8_SB(0, 1), cB + chs, cvb); PG8_STAGEA(PG8_SA(0, 0), cA, cva0); PG8_STAGEA(PG8_SA(0, 1), cA, cva1);
        if (wr == 1) PG8_BAR;
        PG8_WAIT_V(2); PG8_BAR;
        PG8_STAGE(PG8_SB(1, 0), cB + kstep, cvb); PG8_STAGEA(PG8_SA(1, 0), cA + kstep, cva0); PG8_STAGE(PG8_SB(1, 1), cB + chs + kstep, cvb);
        PG8_WAIT_V(6); PG8_BAR;
    } else {
        PG8_STAGE(PG8_SB(0, 0), cB, cvb); PG8_STAGEA(PG8_SA(0, 0), cA, cva0); PG8_STAGE(PG8_SB(0, 1), cB + chs, cvb); PG8_STAGEA(PG8_SA(0, 1), cA, cva1);
        if (wr == 1) PG8_BAR;
        PG8_WAIT_V(4); PG8_BAR;
        PG8_STAGE(PG8_SB(1, 0), cB + kstep, cvb); PG8_STAGEA(PG8_SA(1, 0), cA + kstep, cva0); PG8_STAGE(PG8_SB(1, 1), cB + chs + kstep, cvb);
        PG8_WAIT_V(6); PG8_BAR;
    }
    for (;;) {
        const bool has_next = S.next(ui + 1, nxt);
        if (has_next) { nK = nxt.K; nhs = (size_t)HALF * nK * 2; const unsigned va[2] = {vR2[0] * (unsigned)nK + vC2[0], vR2[1] * (unsigned)nK + vC2[1]}; nvb[0] = va[0]; nvb[1] = va[1]; S.avoff(nxt, tid, nK, va, nva0, nva1); }
        else { nK = cK; nhs = chs; nvb[0] = cvb[0]; nvb[1] = cvb[1]; nva0[0] = cva0[0]; nva0[1] = cva0[1]; nva1[0] = cva1[0]; nva1[1] = cva1[1]; }
        const int nt = cK / BK;
        const char* nA = has_next ? nxt.aptr : cA; const char* nB = has_next ? nxt.bptr : cB;
        for (int t = 0; t < nt; t += 2) {
            const bool last = (t == nt - 2);
            const char* a1 = cA + (size_t)(t + 1) * kstep;
            const char* a2 = last ? nA : cA + (size_t)(t + 2) * kstep; const char* b2 = last ? nB : cB + (size_t)(t + 2) * kstep;
            const char* a3 = a2 + kstep; const char* b3 = b2 + kstep;
            const unsigned xva0[2] = {last ? nva0[0] : cva0[0], last ? nva0[1] : cva0[1]}, xva1[2] = {last ? nva1[0] : cva1[0], last ? nva1[1] : cva1[1]};
            const unsigned xvb[2] = {last ? nvb[0] : cvb[0], last ? nvb[1] : cvb[1]}; const size_t xhs = last ? nhs : chs;
            if (last && has_next) S.a_ready(nxt);
            if constexpr (SP2) {
            PG8_LDB(B0, 0, 0); PG8_LDB(B1, 0, 1); PG8_SCHED; PG8_LDA(At, 0, 0); PG8_STAGEA(PG8_SA(1, 1), a1, cva1);
            PG8_WAIT_V(8); PG8_WAIT_L(0); PG8_BAR; PG8_MMA(0, 0, At, B0); PG8_MMA(0, 1, At, B1); PG8_BAR; PG8_SCHED;
            PG8_LDA(At, 0, 1); PG8_STAGE(PG8_SB(0, 0), b2, xvb); PG8_STAGE(PG8_SB(0, 1), b2 + xhs, xvb); PG8_STAGEA(PG8_SA(0, 0), a2, xva0);
            PG8_WAIT_V(8); PG8_WAIT_L(0); PG8_BAR; PG8_MMA(1, 0, At, B0); PG8_MMA(1, 1, At, B1); PG8_BAR; PG8_SCHED;
            PG8_LDB(B0, 1, 0); PG8_LDB(B1, 1, 1); PG8_SCHED; PG8_LDA(At, 1, 0); PG8_STAGEA(PG8_SA(0, 1), a2, xva1);
            PG8_WAIT_V(8); PG8_WAIT_L(0); PG8_BAR; PG8_MMA(0, 0, At, B0); PG8_MMA(0, 1, At, B1); PG8_BAR; PG8_SCHED;
            PG8_LDA(At, 1, 1); PG8_STAGE(PG8_SB(1, 0), b3, xvb); PG8_STAGE(PG8_SB(1, 1), b3 + xhs, xvb); PG8_STAGEA(PG8_SA(1, 0), a3, xva0);
            PG8_WAIT_V(8); PG8_WAIT_L(0); PG8_BAR; PG8_MMA(1, 0, At, B0); PG8_MMA(1, 1, At, B1); PG8_BAR; PG8_SCHED;
            } else {
            PG8_LDB(B0, 0, 0); PG8_SCHED; PG8_LDA(At, 0, 0); PG8_STAGEA(PG8_SA(1, 1), a1, cva1);
            PG8_WAIT_L(8); PG8_BAR; PG8_WAIT_L(0); PG8_MMA(0, 0, At, B0); PG8_BAR; PG8_SCHED;
            PG8_LDB(B1, 0, 1); PG8_STAGE(PG8_SB(0, 0), b2, xvb);
            PG8_BAR; PG8_WAIT_L(0); PG8_MMA(0, 1, At, B1); PG8_BAR;
            PG8_LDA(At, 0, 1); PG8_STAGEA(PG8_SA(0, 0), a2, xva0);
            PG8_BAR; PG8_WAIT_L(0); PG8_MMA(1, 0, At, B0); PG8_BAR; PG8_SCHED;
            PG8_STAGE(PG8_SB(0, 1), b2 + xhs, xvb);
            PG8_WAIT_V(6); PG8_BAR; PG8_MMA(1, 1, At, B1); PG8_BAR;
            PG8_LDB(B0, 1, 0); PG8_SCHED; PG8_LDA(At, 1, 0); PG8_STAGEA(PG8_SA(0, 1), a2, xva1);
            PG8_WAIT_L(8); PG8_BAR; PG8_WAIT_L(0); PG8_MMA(0, 0, At, B0); PG8_BAR; PG8_SCHED;
            PG8_LDB(B1, 1, 1); PG8_STAGE(PG8_SB(1, 0), b3, xvb);
            PG8_BAR; PG8_WAIT_L(0); PG8_MMA(0, 1, At, B1); PG8_BAR;
            PG8_LDA(At, 1, 1); PG8_STAGEA(PG8_SA(1, 0), a3, xva0);
            PG8_BAR; PG8_WAIT_L(0); PG8_MMA(1, 0, At, B0); PG8_BAR; PG8_SCHED;
            PG8_STAGE(PG8_SB(1, 1), b3 + xhs, xvb);
            PG8_WAIT_V(6); PG8_BAR; PG8_MMA(1, 1, At, B1); PG8_BAR;
            }
        }
        if constexpr (ALIGN_EPI) { if (wr == 0) PG8_BAR; }
        if constexpr (!Epi::AFTER_DRAIN) { E(acc, cur, wr, wc, fr, fq); S.done(cur); }
        if (!has_next) break;
#pragma unroll
        for (int a = 0; a < 2; ++a)
#pragma unroll
            for (int b = 0; b < 2; ++b)
#pragma unroll
                for (int m = 0; m < 4; ++m)
#pragma unroll
                    for (int n = 0; n < 2; ++n) acc[a][b][m][n] = (f32x4){0.f, 0.f, 0.f, 0.f};
        cur = nxt; cA = nA; cB = nB; ++ui; cva0[0] = nva0[0]; cva0[1] = nva0[1]; cva1[0] = nva1[0]; cva1[1] = nva1[1]; cvb[0] = nvb[0]; cvb[1] = nvb[1]; cK = nK; chs = nhs;
        if constexpr (ALIGN_EPI) { if (wr == 1) PG8_BAR; }
    }
    PG8_WAIT_V(0);
    if constexpr (!ALIGN_EPI) { if (wr == 0) PG8_BAR; }
    PG8_BAR;
    if constexpr (Epi::AFTER_DRAIN) { E.fused(acc, cur, wr, wc, fr, fq, lds, wid, lane); S.done(cur); }
#undef PG8_SA
#undef PG8_SB
#undef PG8_STAGE
#undef PG8_STAGEA
#undef PG8_LDA
#undef PG8_LDB
#undef PG8_MMA
#undef PG8_WAIT_V
#undef PG8_WAIT_L
#undef PG8_BAR
#undef PG8_SCHED
}
}

#define TILE8_IDS unsigned t8_z = 0u; asm volatile("" : "+v"(t8_z)); int t512 = wave_s * 64 + (int)__builtin_amdgcn_mbcnt_hi(~0u, __builtin_amdgcn_mbcnt_lo(~0u, t8_z)); asm volatile("" : "+v"(t512))
template <class Map> struct ListSched {
  int first, stride, count; Map map;
  __device__ __forceinline__ bool next(int i, pg8::Unit& u) const { const int idx = first + i * stride; if (idx >= count) return false; map(idx, u); return true; }
  __device__ __forceinline__ void avoff(const pg8::Unit& u, int tid, int K, const unsigned (&voffA)[2], unsigned (&v0)[2], unsigned (&v1)[2]) const { map.avoff(u, tid, K, voffA, v0, v1); }
  __device__ __forceinline__ void a_ready(const pg8::Unit&) const {}
  __device__ __forceinline__ void done(const pg8::Unit&) const {}
};
struct MlArgs { const float *conv, *b_i, *b_f, *gain; float *BCUM, *IP, *BL, *MX, *MST, *NST; bf16_t* CST; };
struct MegaArgs {
  const float* x; const float* mem; float* out;
  bf16_t *XB, *MEMB; float *RS1, *RSM, *PS2;
  bf16_t *QK, *V, *O, *NQ, *KVC, *KS, *KW, *VST, *VWT, *KC, *VCT, *CK1T, *CV1T; float *SM, *POSW;
  const float *posk, *posv, *ckw1, *cvw1, *ckw2, *cvw2;
  bf16_t *AML, *ANS, *MRG, *X1B, *XQ, *XO, *KVM;
  bf16_t *WinT, *WgT, *WmlT, *WnsT, *WoutT, *WqT, *WkvT, *WoT;
  bf16_t *H3, *ACT, *Y, *W13T, *W2T; float *RS3, *RTW; int *CNT, *LIST;
  const float *g_ffn, *wg, *bg, *we, *be, *g_final;
  unsigned* BAR;
  MlArgs ml;
  float* CPART; int* WQ;
  TDesc td[24]; int ntdA, ntdB; int ph_lo, ph_hi, li, pad; int rep[16]; int cv_lo[16], cv_hi[16];
};


constexpr int NSA_LDS = 66112;
constexpr int MEGA_LDS = 73728;
constexpr int HALF_LDS = 73728, CTRL_OFF = 2 * HALF_LDS, TOTAL_LDS = CTRL_OFF + 64;
typedef unsigned long long u64;

template <bool WITH_V>
__device__ __forceinline__ void nsa_load_tile(const bf16_t* __restrict__ Ksrc, unsigned kstride, const bf16_t* __restrict__ Vsrc, unsigned vstride, char* lds, int tid) {
#pragma unroll
  for (int i = 0; i < 2; ++i) {
    const int idx = tid + 256 * i, row = idx >> 3, lc = (idx & 7) ^ ((row >> 1) & 7);
    glds16(Ksrc + (size_t)row * kstride + lc * 8, lds + idx * 16);
    if (WITH_V) glds16(Vsrc + (size_t)row * vstride + lc * 8, lds + 8192 + idx * 16);
  }
}

__device__ __forceinline__ void nsa_qk(f32x4 (&sacc)[4][2], const bf16x8 (&qf)[4][2], const char* lds, int hf, int fr, int fq) {
#pragma unroll
  for (int mi = 0; mi < 4; ++mi)
#pragma unroll
    for (int ni = 0; ni < 2; ++ni) sacc[mi][ni] = (f32x4){0.f, 0.f, 0.f, 0.f};
#pragma unroll
  for (int ks = 0; ks < 2; ++ks) {
    bf16x8 kf[2];
    const int co = ((ks * 4 + fq) ^ (fr >> 1)) << 4;
#pragma unroll
    for (int ni = 0; ni < 2; ++ni) kf[ni] = *(const bf16x8*)(lds + ((hf * 2 + ni) * 16 + fr) * 128 + co);
#pragma unroll
    for (int mi = 0; mi < 4; ++mi)
#pragma unroll
      for (int ni = 0; ni < 2; ++ni) sacc[mi][ni] = __builtin_amdgcn_mfma_f32_16x16x32_bf16(kf[ni], qf[mi][ks], sacc[mi][ni], 0, 0, 0);
  }
}
__device__ __forceinline__ void nsa_qk_seed(f32x4 (&sacc)[4][2], const bf16x8 (&qf)[4][2], const char* lds, int hf, int fr, int fq, const f32x4 (&cinit)[2]) {
  const int kr0 = hf * 32 + 8 * (fr >> 2) + (fr & 3);
#pragma unroll
  for (int ks = 0; ks < 2; ++ks) {
    bf16x8 kf[2];
#pragma unroll
    for (int ni = 0; ni < 2; ++ni) { const int kr = kr0 + 4 * ni; kf[ni] = *(const bf16x8*)(lds + kr * 128 + (((ks * 4 + fq) ^ ((kr >> 1) & 7)) << 4)); }
#pragma unroll
    for (int mi = 0; mi < 4; ++mi)
#pragma unroll
      for (int ni = 0; ni < 2; ++ni) sacc[mi][ni] = __builtin_amdgcn_mfma_f32_16x16x32_bf16(kf[ni], qf[mi][ks], ks ? sacc[mi][ni] : cinit[ni], 0, 0, 0);
  }
}
__device__ __forceinline__ void nsa_pv_perm_l(f32x4 (&oacc)[4][4], f32x4 (&lacc)[4], const f32x4 (&p)[4][2], const char* lds, int hf, int fr, int fq) {
  bf16x8 vf[4];
  const int co = ((hf * 4 + fq) ^ (fr >> 1)) << 4;
#pragma unroll
  for (int i = 0; i < 4; ++i) vf[i] = *(const bf16x8*)(lds + 8192 + (i * 16 + fr) * 128 + co);
  const unsigned one2 = (fr == 0) ? 0x3F803F80u : 0u;
  u32x4 o4; o4.x = one2; o4.y = one2; o4.z = one2; o4.w = one2;
  const bf16x8 ones = __builtin_bit_cast(bf16x8, o4);
#pragma unroll
  for (int mi = 0; mi < 4; ++mi) {
    u32x4 t; t.x = pk2bf(p[mi][0][0], p[mi][0][1]); t.y = pk2bf(p[mi][0][2], p[mi][0][3]); t.z = pk2bf(p[mi][1][0], p[mi][1][1]); t.w = pk2bf(p[mi][1][2], p[mi][1][3]);
    const bf16x8 pf = __builtin_bit_cast(bf16x8, t);
#pragma unroll
    for (int ni = 0; ni < 4; ++ni) oacc[mi][ni] = __builtin_amdgcn_mfma_f32_16x16x32_bf16(vf[ni], pf, oacc[mi][ni], 0, 0, 0);
    lacc[mi] = __builtin_amdgcn_mfma_f32_16x16x32_bf16(ones, pf, lacc[mi], 0, 0, 0);
  }
}
__device__ __forceinline__ void nsa_qk_seed4(f32x4 (&sacc)[4][2], const bf16x8 (&qf)[4][2], const char* lds, int hf, int fr, int fq, const f32x4 (&cinit)[4][2]) {
  const int kr0 = hf * 32 + 8 * (fr >> 2) + (fr & 3);
#pragma unroll
  for (int ks = 0; ks < 2; ++ks) {
    bf16x8 kf[2];
#pragma unroll
    for (int ni = 0; ni < 2; ++ni) { const int kr = kr0 + 4 * ni; kf[ni] = *(const bf16x8*)(lds + kr * 128 + (((ks * 4 + fq) ^ ((kr >> 1) & 7)) << 4)); }
#pragma unroll
    for (int mi = 0; mi < 4; ++mi)
#pragma unroll
      for (int ni = 0; ni < 2; ++ni) sacc[mi][ni] = __builtin_amdgcn_mfma_f32_16x16x32_bf16(kf[ni], qf[mi][ks], ks ? sacc[mi][ni] : cinit[mi][ni], 0, 0, 0);
  }
}
__device__ __forceinline__ void nsa_pv_perm(f32x4 (&oacc)[4][4], const f32x4 (&p)[4][2], const char* lds, int hf, int fr, int fq) {
  bf16x8 vf[4];
  const int co = ((hf * 4 + fq) ^ (fr >> 1)) << 4;
#pragma unroll
  for (int i = 0; i < 4; ++i) vf[i] = *(const bf16x8*)(lds + 8192 + (i * 16 + fr) * 128 + co);
#pragma unroll
  for (int mi = 0; mi < 4; ++mi) {
    u32x4 t; t.x = pk2bf(p[mi][0][0], p[mi][0][1]); t.y = pk2bf(p[mi][0][2], p[mi][0][3]); t.z = pk2bf(p[mi][1][0], p[mi][1][1]); t.w = pk2bf(p[mi][1][2], p[mi][1][3]);
    const bf16x8 pf = __builtin_bit_cast(bf16x8, t);
#pragma unroll
    for (int ni = 0; ni < 4; ++ni) oacc[mi][ni] = __builtin_amdgcn_mfma_f32_16x16x32_bf16(vf[ni], pf, oacc[mi][ni], 0, 0, 0);
  }
}
__device__ __forceinline__ void nsa_pv(f32x4 (&oacc)[4][4], const f32x4 (&p)[4][2], char* lds, char* pw, int hf, int fr, int fq) {
  (void)pw;
  bf16x8 vf[4];
  const int sw = (fr >> 1) & 7, c0 = ((hf * 4 + (fq >> 1)) ^ sw) << 4, c1 = ((hf * 4 + 2 + (fq >> 1)) ^ sw) << 4;
#pragma unroll
  for (int i = 0; i < 4; ++i) {
    const char* rp = lds + 8192 + (i * 16 + fr) * 128 + (fq & 1) * 8;
    const u32x2 lo = *(const u32x2*)(rp + c0), hi = *(const u32x2*)(rp + c1);
    u32x4 t; t.x = lo.x; t.y = lo.y; t.z = hi.x; t.w = hi.y;
    vf[i] = __builtin_bit_cast(bf16x8, t);
  }
#pragma unroll
  for (int mi = 0; mi < 4; ++mi) {
    u32x4 t; t.x = pk2bf(p[mi][0][0], p[mi][0][1]); t.y = pk2bf(p[mi][0][2], p[mi][0][3]); t.z = pk2bf(p[mi][1][0], p[mi][1][1]); t.w = pk2bf(p[mi][1][2], p[mi][1][3]);
    const bf16x8 pf = __builtin_bit_cast(bf16x8, t);
#pragma unroll
    for (int ni = 0; ni < 4; ++ni) oacc[mi][ni] = __builtin_amdgcn_mfma_f32_16x16x32_bf16(vf[ni], pf, oacc[mi][ni], 0, 0, 0);
  }
}
__device__ __forceinline__ float vmax2(float a, float b) { float r; asm("v_max_f32 %0, %1, %2" : "=v"(r) : "v"(a), "v"(b)); return r; }
__device__ __forceinline__ float vmax3(float a, float b, float c) { float r; asm("v_max3_f32 %0, %1, %2, %3" : "=v"(r) : "v"(a), "v"(b), "v"(c)); return r; }
__device__ __forceinline__ float vmax8(const f32x4& a, const f32x4& b) { return vmax2(vmax3(vmax3(a[0], a[1], a[2]), a[3], b[0]), vmax3(b[1], b[2], b[3])); }
__device__ __forceinline__ float red4(float v) {
  const auto r = __builtin_amdgcn_permlane16_swap(__float_as_uint(v), __float_as_uint(v), false, false); v = __uint_as_float(r[0]) + __uint_as_float(r[1]);
  const auto q = __builtin_amdgcn_permlane32_swap(__float_as_uint(v), __float_as_uint(v), false, false); return __uint_as_float(q[0]) + __uint_as_float(q[1]);
}
__device__ __forceinline__ float max4(float v) {
  const auto r = __builtin_amdgcn_permlane16_swap(__float_as_uint(v), __float_as_uint(v), false, false); v = vmax2(__uint_as_float(r[0]), __uint_as_float(r[1]));
  const auto q = __builtin_amdgcn_permlane32_swap(__float_as_uint(v), __float_as_uint(v), false, false); return vmax2(__uint_as_float(q[0]), __uint_as_float(q[1]));
}

__device__ __forceinline__ void nsa_online(f32x4 (&sv)[4][2], float (&m_run)[4], float (&l_run)[4], f32x4 (&oacc)[4][4]) {
  float mxa[4];
#pragma unroll
  for (int mi = 0; mi < 4; ++mi)
    mxa[mi] = max4(vmax8(sv[mi][0], sv[mi][1]));
  const bool need = (mxa[0] > m_run[0] + 8.f) | (mxa[1] > m_run[1] + 8.f) | (mxa[2] > m_run[2] + 8.f) | (mxa[3] > m_run[3] + 8.f);
  if (__any(need)) {
#pragma unroll
    for (int mi = 0; mi < 4; ++mi) {
      const float mn = fmaxf(fmaxf(m_run[mi], mxa[mi]), -1e20f);
      const float alpha = __builtin_amdgcn_exp2f(m_run[mi] - mn);
      m_run[mi] = mn; l_run[mi] *= alpha;
#pragma unroll
      for (int ni = 0; ni < 4; ++ni) oacc[mi][ni] *= alpha;
    }
  }
#pragma unroll
  for (int mi = 0; mi < 4; ++mi) {
    float ls = 0.f;
#pragma unroll
    for (int ni = 0; ni < 2; ++ni)
#pragma unroll
      for (int j = 0; j < 4; ++j) { const float pv = __builtin_amdgcn_exp2f(sv[mi][ni][j] - m_run[mi]); sv[mi][ni][j] = pv; ls += pv; }
    l_run[mi] += ls;
  }
}

__device__ __forceinline__ void nsa_online_rc(f32x4 (&sv)[4][2], const float (&rcv)[4], float (&m_run)[4], f32x4 (&lacc)[4], f32x4 (&oacc)[4][4]) {
  float mxa[4];
#pragma unroll
  for (int mi = 0; mi < 4; ++mi)
    mxa[mi] = vmax8(sv[mi][0], sv[mi][1]) + rcv[mi];
  const bool need = (mxa[0] > m_run[0] + 8.f) | (mxa[1] > m_run[1] + 8.f) | (mxa[2] > m_run[2] + 8.f) | (mxa[3] > m_run[3] + 8.f);
  if (__any(need)) {
#pragma unroll
    for (int mi = 0; mi < 4; ++mi) mxa[mi] = max4(mxa[mi]);
#pragma unroll
    for (int mi = 0; mi < 4; ++mi) {
      const float mn = fmaxf(fmaxf(m_run[mi], mxa[mi]), -1e20f);
      const float alpha = __builtin_amdgcn_exp2f(m_run[mi] - mn);
      m_run[mi] = mn; lacc[mi] *= alpha;
#pragma unroll
      for (int ni = 0; ni < 4; ++ni) oacc[mi][ni] *= alpha;
    }
  }
#pragma unroll
  for (int mi = 0; mi < 4; ++mi) {
    const float rowc = rcv[mi] - m_run[mi];
    typedef float f32x2_ __attribute__((ext_vector_type(2)));
    f32x2_ r2; r2.x = rowc; r2.y = rowc;
    asm volatile("" : "+v"(r2));
    const f32x2_ a0 = __builtin_shufflevector(sv[mi][0], sv[mi][0], 0, 1) + r2, a1 = __builtin_shufflevector(sv[mi][0], sv[mi][0], 2, 3) + r2;
    const f32x2_ b0 = __builtin_shufflevector(sv[mi][1], sv[mi][1], 0, 1) + r2, b1 = __builtin_shufflevector(sv[mi][1], sv[mi][1], 2, 3) + r2;
    f32x4 p0, p1;
    p0[0] = __builtin_amdgcn_exp2f(a0.x); p0[1] = __builtin_amdgcn_exp2f(a0.y); p0[2] = __builtin_amdgcn_exp2f(a1.x); p0[3] = __builtin_amdgcn_exp2f(a1.y);
    p1[0] = __builtin_amdgcn_exp2f(b0.x); p1[1] = __builtin_amdgcn_exp2f(b0.y); p1[2] = __builtin_amdgcn_exp2f(b1.x); p1[3] = __builtin_amdgcn_exp2f(b1.y);
    sv[mi][0] = p0; sv[mi][1] = p1;
  }
}

__device__ __forceinline__ void nsa_cmp_rows(f32x4 (&sacc)[4][2], float (&rcv)[4], float slope0, int jb, int tc, int trow0, int fq) {
  const int jj0 = jb + 8 * fq;
  const float base = 16.f * (float)jj0 + 15.5f - (float)tc;
#pragma unroll
  for (int mi = 0; mi < 4; ++mi) rcv[mi] = slope0 * (1.f / (float)(1 << mi)) * base;
  if (!(16 * (jb + 31) + 31 <= trow0)) {
    const int jrel = ((tc - 31) >> 4) - jj0;
#pragma unroll
    for (int mi = 0; mi < 4; ++mi)
#pragma unroll
      for (int ni = 0; ni < 2; ++ni)
#pragma unroll
        for (int j = 0; j < 4; ++j) sacc[mi][ni][j] = (ni * 4 + j <= jrel) ? sacc[mi][ni][j] : -1e30f;
  }
}

__device__ __forceinline__ void nsa_main_item(const MegaArgs& a, int item, char* lds, int tid, volatile int* xch, int half) {
  asm volatile("" : "+v"(tid));
  const int lane = tid & 63, wid = tid >> 6, fr = lane & 15, fq = lane >> 4;
  const int i = item & 63, g = (item >> 6) & 1, b = item >> 7;
  const int h = g * 4 + wid, nb = b * SEQ, t0 = i * 64, bg = b * 2 + g;
  const float slope = exp2f(-(float)(h + 1)) * 1.4426950408889634f;
  char* pw = lds + 16384 + wid * 8192;
  float* PSLC = (float*)(lds + 49152);
  u64* SELM = (u64*)(lds + 65536);
  u64* UNI = (u64*)(lds + 66048);
  bf16x8 qf[4][2];
#pragma unroll
  for (int mi = 0; mi < 4; ++mi)
#pragma unroll
    for (int ks = 0; ks < 2; ++ks) qf[mi][ks] = *(const bf16x8*)(a.NQ + (size_t)(nb + t0 + wid * 16 + fr) * 512 + (g * 4 + mi) * 64 + ks * 32 + fq * 8);
  for (int e = tid; e < 4096; e += 256) PSLC[e] = 0.f;
  f32x4 sacc[4][2], oacc[4][4];
  float m_run[4], l_run[4]; f32x4 lacc[4];
  const int nct = ((4 * i + 2) >> 6) + 1;
  const bf16_t* kcb = a.KC + (size_t)bg * 256 * 64;
  const bf16_t* vcb = a.VCT + (size_t)bg * 64 * 256;
  const int tc = t0 + wid * 16 + fr;
  const float slope0 = exp2f(-(float)(g * 4 + 1)) * 1.4426950408889634f;
  f32x4 cs4[4][2];
#pragma unroll
  for (int mi = 0; mi < 4; ++mi)
#pragma unroll
    for (int ni = 0; ni < 2; ++ni)
#pragma unroll
      for (int j = 0; j < 4; ++j) cs4[mi][ni][j] = slope0 * (1.f / (float)(1 << mi)) * 16.f * (float)(ni * 4 + j);
#pragma unroll
  for (int mi = 0; mi < 4; ++mi) { m_run[mi] = -1e30f; l_run[mi] = 0.f; }
  __syncthreads();
  nsa_load_tile<false>(kcb, 64u, nullptr, 0u, lds, tid);
  for (int jt = 0; jt < nct; ++jt) {
    asm volatile("s_waitcnt vmcnt(0)" ::: "memory");
    __syncthreads();
    char* tb = (jt & 1) ? (lds + 16384) : lds;
    if (jt + 1 < nct) nsa_load_tile<false>(kcb + (size_t)(jt + 1) * 64 * 64, 64u, nullptr, 0u, (jt & 1) ? lds : (lds + 16384), tid);
#pragma unroll 1
    for (int hf = 0; hf < 2; ++hf) {
      nsa_qk_seed4(sacc, qf, tb, hf, fr, fq, cs4);
      float rcv[4];
      nsa_cmp_rows(sacc, rcv, slope0, jt * 64 + hf * 32, tc, t0 + wid * 16, fq);
      float mxa[4];
#pragma unroll
      for (int mi = 0; mi < 4; ++mi) mxa[mi] = max4(vmax8(sacc[mi][0], sacc[mi][1]) + rcv[mi]);
#pragma unroll
      for (int mi = 0; mi < 4; ++mi) {
        const float mn = fmaxf(fmaxf(m_run[mi], mxa[mi]), -1e20f);
        typedef float f32x2_ __attribute__((ext_vector_type(2)));
        f32x2_ r2; r2.x = rcv[mi] - mn; r2.y = r2.x; asm volatile("" : "+v"(r2));
        const f32x2_ a0 = __builtin_shufflevector(sacc[mi][0], sacc[mi][0], 0, 1) + r2, a1 = __builtin_shufflevector(sacc[mi][0], sacc[mi][0], 2, 3) + r2;
        const f32x2_ b0 = __builtin_shufflevector(sacc[mi][1], sacc[mi][1], 0, 1) + r2, b1 = __builtin_shufflevector(sacc[mi][1], sacc[mi][1], 2, 3) + r2;
        const float ls = ((__builtin_amdgcn_exp2f(a0.x) + __builtin_amdgcn_exp2f(a0.y)) + (__builtin_amdgcn_exp2f(a1.x) + __builtin_amdgcn_exp2f(a1.y)))
                       + ((__builtin_amdgcn_exp2f(b0.x) + __builtin_amdgcn_exp2f(b0.y)) + (__builtin_amdgcn_exp2f(b1.x) + __builtin_amdgcn_exp2f(b1.y)));
        l_run[mi] = l_run[mi] * __builtin_amdgcn_exp2f(m_run[mi] - mn) + ls; m_run[mi] = mn;
      }
    }
  }
  float invl[4];
#pragma unroll
  for (int mi = 0; mi < 4; ++mi) { const float l = red4(l_run[mi]); invl[mi] = l > 0.f ? -__log2f(l) - m_run[mi] : -1e30f; }
#pragma unroll
  for (int mi = 0; mi < 4; ++mi)
#pragma unroll
    for (int ni = 0; ni < 4; ++ni) oacc[mi][ni] = (f32x4){0.f, 0.f, 0.f, 0.f};
  __syncthreads();
  nsa_load_tile<true>(kcb, 64u, vcb, 256u, lds, tid);
  for (int jt = 0; jt < nct; ++jt) {
    asm volatile("s_waitcnt vmcnt(0)" ::: "memory");
    __syncthreads();
    char* tb = (jt & 1) ? (lds + 16384) : lds;
    if (jt + 1 < nct) nsa_load_tile<true>(kcb + (size_t)(jt + 1) * 64 * 64, 64u, vcb + (jt + 1) * 64, 256u, (jt & 1) ? lds : (lds + 16384), tid);
#pragma unroll 1
    for (int hf = 0; hf < 2; ++hf) {
      nsa_qk_seed4(sacc, qf, tb, hf, fr, fq, cs4);
      float rcv[4];
      nsa_cmp_rows(sacc, rcv, slope0, jt * 64 + hf * 32, tc, t0 + wid * 16, fq);
      float imp[2] = {0.f, 0.f}, car[2] = {0.f, 0.f};
#pragma unroll
      for (int mi = 0; mi < 4; ++mi) {
        typedef float f32x2_ __attribute__((ext_vector_type(2)));
        f32x2_ r2; r2.x = rcv[mi] + invl[mi]; r2.y = r2.x; asm volatile("" : "+v"(r2));
#pragma unroll
        for (int ni = 0; ni < 2; ++ni) {
          const f32x2_ a0 = __builtin_shufflevector(sacc[mi][ni], sacc[mi][ni], 0, 1) + r2, a1 = __builtin_shufflevector(sacc[mi][ni], sacc[mi][ni], 2, 3) + r2;
          sacc[mi][ni][0] = __builtin_amdgcn_exp2f(a0.x); sacc[mi][ni][1] = __builtin_amdgcn_exp2f(a0.y); sacc[mi][ni][2] = __builtin_amdgcn_exp2f(a1.x); sacc[mi][ni][3] = __builtin_amdgcn_exp2f(a1.y);
          imp[ni] += (sacc[mi][ni][0] + sacc[mi][ni][1]) + sacc[mi][ni][2] + 0.5f * sacc[mi][ni][3]; car[ni] += 0.5f * sacc[mi][ni][3];
        }
      }
      nsa_pv_perm(oacc, sacc, tb, hf, fr, fq);
#pragma unroll
      for (int ni = 0; ni < 2; ++ni) {
        const int sb = jt * 16 + hf * 8 + 2 * fq + ni; float* pp = PSLC + (wid * 16 + fr) * 64 + sb;
        atomicAdd(pp, imp[ni]);
        if (sb < 63) atomicAdd(pp + 1, car[ni]);
      }
    }
  }
  int frc = fr; asm volatile("" : "+v"(frc));
  {
    const size_t n = nb + t0 + wid * 16 + frc;
#pragma unroll
    for (int mi = 0; mi < 4; ++mi) {
      const int hh = g * 4 + mi; const float gt = sigmoidf_(a.SM[n * 32 + 8 + hh * 3]);
#pragma unroll
      for (int ni = 0; ni < 4; ++ni) {
        bf16_t* dp = a.ANS + n * 512 + hh * 64 + ni * 16 + 4 * fq; const u32x2 pr = *(const u32x2*)dp;
        f32x4 r = oacc[mi][ni] * gt;
        r[0] += __uint_as_float(pr.x << 16); r[1] += __uint_as_float(pr.x & 0xffff0000u); r[2] += __uint_as_float(pr.y << 16); r[3] += __uint_as_float(pr.y & 0xffff0000u);
        st_bf4(dp, r);
      }
    }
  }
  __syncthreads();
  {
    int tsel = tid, isel = i; asm volatile("" : "+v"(tsel), "+v"(isel));
    const int q = tsel >> 2, sub = tsel & 3;
    float mine[16]; int cnt[16];
#pragma unroll
    for (int k = 0; k < 16; ++k) {
      const int sb = sub * 16 + k; const float ps = PSLC[q * 64 + sb];
      mine[k] = (sb == 0 || sb == isel || sb == isel - 1) ? 1e4f : (sb > isel ? -1e4f : ps); cnt[k] = 0;
    }
#pragma unroll
    for (int k = 0; k < 16; ++k) PSLC[q * 64 + sub * 16 + k] = mine[k];
    __syncthreads();
    for (int s2 = 0; s2 <= isel; ++s2) {
      const float o = PSLC[q * 64 + s2];
#pragma unroll
      for (int k = 0; k < 16; ++k) cnt[k] += (int)((o > mine[k]) | ((o == mine[k]) & (s2 < sub * 16 + k)));
    }
    unsigned m16 = 0;
#pragma unroll
    for (int k = 0; k < 16; ++k) m16 |= (cnt[k] < 16 ? 1u : 0u) << k;
    unsigned mlo = (sub < 2) ? (m16 << (16 * sub)) : 0u, mhi = (sub >= 2) ? (m16 << (16 * (sub - 2))) : 0u;
    mlo |= __shfl_xor(mlo, 1); mlo |= __shfl_xor(mlo, 2); mhi |= __shfl_xor(mhi, 1); mhi |= __shfl_xor(mhi, 2);
    u64 m64 = ((u64)mhi << 32) | (u64)mlo;
    m64 &= (isel == 63) ? ~0ull : ((2ull << isel) - 1ull);
    if (sub == 0) SELM[q] = m64;
    u64 un = m64;
#pragma unroll
    for (int o = 4; o < 64; o <<= 1) un |= __shfl_xor(un, o);
    if (lane == 0) UNI[wid] = un;
  }
  __syncthreads();
  const u64 uni = UNI[0] | UNI[1] | UNI[2] | UNI[3];
#pragma unroll
  for (int mi = 0; mi < 4; ++mi)
#pragma unroll
    for (int ks = 0; ks < 2; ++ks) qf[mi][ks] = *(const bf16x8*)(a.NQ + (size_t)(nb + t0 + mi * 16 + fr) * 512 + h * 64 + ks * 32 + fq * 8);
#pragma unroll 1
  for (int br = 1; br <= 1; ++br) {
#pragma unroll
    for (int mi = 0; mi < 4; ++mi) { m_run[mi] = -1e30f; l_run[mi] = 0.f; lacc[mi] = (f32x4){0.f, 0.f, 0.f, 0.f};
#pragma unroll
      for (int ni = 0; ni < 4; ++ni) oacc[mi][ni] = (f32x4){0.f, 0.f, 0.f, 0.f}; }
    f32x4 cseed[2];
#pragma unroll
    for (int ni = 0; ni < 2; ++ni)
#pragma unroll
      for (int j = 0; j < 4; ++j) cseed[ni][j] = slope * (float)(ni * 4 + j);
    const bf16_t* Kb = (br == 1 ? a.KS : a.KW) + (size_t)nb * 128 + g * 64;
    const bf16_t* Vb = (br == 1 ? a.VST : a.VWT) + ((size_t)(b * 128 + g * 64) << 12);
    u64 todo;
    if (br == 1) todo = uni;
    else { const int lo = i >= 8 ? i - 8 : 0; todo = ((i == 63) ? ~0ull : ((2ull << i) - 1ull)) & ~((1ull << lo) - 1ull); }
    int cur = __builtin_ctzll(todo), bsel = 0;
    if (tid == 0) xch[half] = __builtin_popcountll(todo);
    __syncthreads();
    const int ntile = max(xch[0], xch[1]);
    nsa_load_tile<true>(Kb + (size_t)cur * 64 * 128, 128u, Vb + cur * 64, 4096u, lds, tid);
    for (int kt = 0; kt < ntile; ++kt) {
      int nxt = -1;
      if (cur >= 0) { todo &= todo - 1ull; nxt = todo ? __builtin_ctzll(todo) : -1; }
      asm volatile("s_waitcnt vmcnt(0)" ::: "memory");
      __syncthreads();
      if (cur < 0) continue;
      char* tb = bsel ? (lds + 49152) : lds;
      if (nxt >= 0) nsa_load_tile<true>(Kb + (size_t)nxt * 64 * 128, 128u, Vb + nxt * 64, 4096u, bsel ? lds : (lds + 49152), tid);
      const int sb = cur;
      const bool edge = (sb == i) || (br == 2 && sb == i - 8);
      float rc0[4];
#pragma unroll
      for (int mi = 0; mi < 4; ++mi) {
        const int tq = mi * 16 + fr;
        const bool rsel = (br == 2) || ((SELM[tq] >> sb) & 1ull);
        rc0[mi] = rsel ? -slope * (float)(64 * (i - sb) + tq - 8 * fq) : -1e30f;
      }
#pragma unroll
      for (int hf = 0; hf < 2; ++hf) {
        nsa_qk_seed(sacc, qf, tb, hf, fr, fq, cseed);
        const float hoff = hf ? slope * 32.f : 0.f;
        float rcv[4];
#pragma unroll
        for (int mi = 0; mi < 4; ++mi) rcv[mi] = rc0[mi] + hoff;
        if (edge) {
#pragma unroll
          for (int mi = 0; mi < 4; ++mi) {
            const int tqh = mi * 16 + fr - hf * 32;
#pragma unroll
            for (int ni = 0; ni < 2; ++ni)
#pragma unroll
              for (int j = 0; j < 4; ++j) {
                const int c = 8 * fq + ni * 4 + j;
                const bool okv = (sb == i) ? (c <= tqh) : (c > tqh);
                sacc[mi][ni][j] = okv ? sacc[mi][ni][j] : -1e30f;
              }
          }
        }
        nsa_online_rc(sacc, rcv, m_run, lacc, oacc);
        nsa_pv_perm_l(oacc, lacc, sacc, tb, hf, fr, fq);
      }
      cur = nxt; bsel ^= 1;
    }
    int fre = fr; asm volatile("" : "+v"(fre));
#pragma unroll
    for (int mi = 0; mi < 4; ++mi) {
      const size_t n = nb + t0 + mi * 16 + fre;
      const float l = red4(lacc[mi][0]); const float sc = sigmoidf_(a.SM[n * 32 + 8 + h * 3 + br]) * __builtin_amdgcn_rcpf(l);
#pragma unroll
      for (int ni = 0; ni < 4; ++ni) {
        bf16_t* dp = a.ANS + n * 512 + h * 64 + ni * 16 + 4 * fq; const u32x2 pr = *(const u32x2*)dp;
        f32x4 r = oacc[mi][ni] * sc;
        r[0] += __uint_as_float(pr.x << 16); r[1] += __uint_as_float(pr.x & 0xffff0000u); r[2] += __uint_as_float(pr.y << 16); r[3] += __uint_as_float(pr.y & 0xffff0000u);
        st_bf4(dp, r);
      }
    }
  }
  __syncthreads();
}


__device__ __forceinline__ void nsa_win_item(const MegaArgs& a, int item, char* lds, int tid) {
  asm volatile("" : "+v"(tid));
  const int lane = tid & 63, wid = tid >> 6, fr = lane & 15, fq = lane >> 4;
  const int i = item & 63, g = (item >> 6) & 1, b = item >> 7;
  const int h = g * 4 + wid, nb = b * SEQ, t0 = i * 64, bg = b * 2 + g;
  const float slope = exp2f(-(float)(h + 1)) * 1.4426950408889634f;
  char* pw = lds + 16384 + wid * 8192;
  float* PSLC = (float*)(lds + 49152);
  u64* SELM = (u64*)(lds + 65536);
  u64* UNI = (u64*)(lds + 66048);
  bf16x8 qf[4][2];
#pragma unroll
  for (int mi = 0; mi < 4; ++mi)
#pragma unroll
    for (int ks = 0; ks < 2; ++ks) qf[mi][ks] = *(const bf16x8*)(a.NQ + (size_t)(nb + t0 + mi * 16 + fr) * 512 + h * 64 + ks * 32 + fq * 8);
  f32x4 sacc[4][2], oacc[4][4];
  float m_run[4], l_run[4]; f32x4 lacc[4];
  (void)PSLC; (void)UNI; (void)bg;
  const u64 uni = 0ull;
#pragma unroll 1
  for (int br = 2; br <= 2; ++br) {
#pragma unroll
    for (int mi = 0; mi < 4; ++mi) { m_run[mi] = -1e30f; l_run[mi] = 0.f; lacc[mi] = (f32x4){0.f, 0.f, 0.f, 0.f};
#pragma unroll
      for (int ni = 0; ni < 4; ++ni) oacc[mi][ni] = (f32x4){0.f, 0.f, 0.f, 0.f}; }
    f32x4 cseed[2];
#pragma unroll
    for (int ni = 0; ni < 2; ++ni)
#pragma unroll
      for (int j = 0; j < 4; ++j) cseed[ni][j] = slope * (float)(ni * 4 + j);
    const bf16_t* Kb = (br == 1 ? a.KS : a.KW) + (size_t)nb * 128 + g * 64;
    const bf16_t* Vb = (br == 1 ? a.VST : a.VWT) + ((size_t)(b * 128 + g * 64) << 12);
    u64 todo;
    if (br == 1) todo = uni;
    else { const int lo = i >= 8 ? i - 8 : 0; todo = ((i == 63) ? ~0ull : ((2ull << i) - 1ull)) & ~((1ull << lo) - 1ull); }
    int cur = 63 - __builtin_clzll(todo), bsel = 0;
    __syncthreads();
    nsa_load_tile<true>(Kb + (size_t)cur * 64 * 128, 128u, Vb + cur * 64, 4096u, lds, tid);
    while (cur >= 0) {
      todo &= ~(1ull << cur);
      const int nxt = todo ? 63 - __builtin_clzll(todo) : -1;
      asm volatile("s_waitcnt vmcnt(0)" ::: "memory");
      __syncthreads();
      char* tb = bsel ? (lds + 49152) : lds;
      if (nxt >= 0) nsa_load_tile<true>(Kb + (size_t)nxt * 64 * 128, 128u, Vb + nxt * 64, 4096u, bsel ? lds : (lds + 49152), tid);
      const int sb = cur;
      const bool edge = (sb == i) || (br == 2 && sb == i - 8);
      float rc0[4];
#pragma unroll
      for (int mi = 0; mi < 4; ++mi) {
        const int tq = mi * 16 + fr;
        const bool rsel = (br == 2) || ((SELM[tq] >> sb) & 1ull);
        rc0[mi] = rsel ? -slope * (float)(64 * (i - sb) + tq - 8 * fq) : -1e30f;
      }
#pragma unroll
      for (int hf = 0; hf < 2; ++hf) {
        nsa_qk_seed(sacc, qf, tb, hf, fr, fq, cseed);
        const float hoff = hf ? slope * 32.f : 0.f;
        float rcv[4];
#pragma unroll
        for (int mi = 0; mi < 4; ++mi) rcv[mi] = rc0[mi] + hoff;
        if (edge) {
#pragma unroll
          for (int mi = 0; mi < 4; ++mi) {
            const int tqh = mi * 16 + fr - hf * 32;
#pragma unroll
            for (int ni = 0; ni < 2; ++ni)
#pragma unroll
              for (int j = 0; j < 4; ++j) {
                const int c = 8 * fq + ni * 4 + j;
                const bool okv = (sb == i) ? (c <= tqh) : (c > tqh);
                sacc[mi][ni][j] = okv ? sacc[mi][ni][j] : -1e30f;
              }
          }
        }
        nsa_online_rc(sacc, rcv, m_run, lacc, oacc);
        nsa_pv_perm_l(oacc, lacc, sacc, tb, hf, fr, fq);
      }
      cur = nxt; bsel ^= 1;
    }
#pragma unroll
    for (int mi = 0; mi < 4; ++mi) {
      const size_t n = nb + t0 + mi * 16 + fr;
      const float l = red4(lacc[mi][0]); const float sc = sigmoidf_(a.SM[n * 32 + 8 + h * 3 + br]) * __builtin_amdgcn_rcpf(l);
#pragma unroll
      for (int ni = 0; ni < 4; ++ni) {
        st_bf4(a.ANS + n * 512 + h * 64 + ni * 16 + 4 * fq, oacc[mi][ni] * sc);
      }
    }
  }
  __syncthreads();
}


__device__ __forceinline__ int img_off(int row, int k) { return row * 128 + ((((k >> 3) ^ ((row >> 1) & 7))) << 4) + (k & 7) * 2; }
__device__ __forceinline__ bf16x8 img_frag(const char* img, int r0, int ks, int fr, int fq) { return *(const bf16x8*)(img + (r0 + fr) * 128 + (((ks * 4 + fq) ^ (fr >> 1)) << 4)); }


__device__ __forceinline__ void stage_raw(const bf16_t* __restrict__ QK, int nb, int t0, int chbase, char* raw, int tid) {
  u32x4 v[5];
#pragma unroll
  for (int i = 0; i < 5; ++i) {
    const int c = tid + 256 * i, row = c >> 4, cc = c & 15, t = t0 - 3 + row;
    v[i] = (c < 1072 && t >= 0) ? __builtin_nontemporal_load((const u32x4*)(QK + (size_t)(nb + t) * 1024 + chbase + cc * 8)) : (u32x4){0u, 0u, 0u, 0u};
  }
#pragma unroll
  for (int i = 0; i < 5; ++i) { const int c = tid + 256 * i; if (c < 1072) *(u32x4*)(raw + c * 16) = v[i]; }
}
template <class Put>
__device__ __forceinline__ void conv_col(const char* raw, const float* __restrict__ conv, int j0, int nj, int ch, int d, float scale, Put put) {
  const float w0 = conv[ch], w1 = conv[1024 + ch], w2 = conv[2048 + ch], w3 = conv[3072 + ch];
  const bf16_t* r = (const bf16_t*)raw + d;
  float x0 = bf2f(r[(j0 + 0) * 128]), x1 = bf2f(r[(j0 + 1) * 128]), x2 = bf2f(r[(j0 + 2) * 128]);
#pragma unroll 8
  for (int j = j0; j < j0 + nj; ++j) {
    const float x3 = bf2f(r[(j + 3) * 128]);
    put(j, siluf_(w0 * x0 + w1 * x1 + w2 * x2 + w3 * x3) * scale);
    x0 = x1; x1 = x2; x2 = x3;
  }
}

__device__ __forceinline__ void ml_dc_item(const MegaArgs& a, const MlArgs& ml, int item, char* lds, int tid) {
  asm volatile("" : "+v"(tid));
  const int lane = tid & 63, wid = tid >> 6, wr = wid >> 1, wc = wid & 1, fr = lane & 15, fq = lane >> 4;
  const int bh = item >> 6, c = item & 63, b = bh >> 2, h = bh & 3, nb = b * SEQ, t0 = c * 64;
  char* KT = lds; char* VT = lds + 16384; float* sc = (float*)(lds + 32768); float* dnp = (float*)(lds + 33792);
  if (tid < 64) {
    const size_t n = nb + t0 + tid;
    sc[tid] = a.SM[n * 32 + h] + ml.b_i[h];
    sc[64 + tid] = logsigmoidf_(a.SM[n * 32 + 4 + h] + ml.b_f[h]);
  }
  __syncthreads();
  if (tid < 64) {
    float cs = sc[64 + tid];
#pragma unroll
    for (int o = 1; o < 64; o <<= 1) { const float up = __shfl_up(cs, o); if (tid >= o) cs += up; }
    const float bl = __shfl(cs, 63);
    const float lw = bl - cs + sc[tid];
    const float mx = wave_max(lw);
    sc[128 + tid] = cs; sc[192 + tid] = __expf(lw - mx);
    if (tid == 0) { ml.BL[bh * 64 + c] = bl; ml.MX[bh * 64 + c] = mx; }
  }
  __syncthreads();
  if (tid < 64) { ml.BCUM[bh * SEQ + t0 + tid] = sc[128 + tid]; ml.IP[bh * SEQ + t0 + tid] = sc[tid]; }
  char* RAW = lds + 36864;
  stage_raw(a.QK, nb, t0, 512 + h * 128, RAW, tid);
  __syncthreads();
  {
    const int d = tid & 127, jh = tid >> 7;
    float dn = 0.f;
    conv_col(RAW, ml.conv, jh * 32, 32, 512 + h * 128 + d, d, 0.08838834764831845f,
             [&](int j, float v) { *(bf16_t*)(KT + img_off(d, j)) = f2bf(v); dn += sc[192 + j] * v; });
    dnp[jh * 128 + d] = dn;
    {
      bf16_t tv[32];
#pragma unroll
      for (int u = 0; u < 32; ++u) tv[u] = __builtin_nontemporal_load(a.V + (size_t)(nb + t0 + jh * 32 + u) * 512 + h * 128 + d);
#pragma unroll
      for (int u = 0; u < 32; ++u) *(bf16_t*)(VT + img_off(d, jh * 32 + u)) = f2bf(sc[192 + jh * 32 + u] * bf2f(tv[u]));
    }
  }
  __syncthreads();
  if (tid < 128) ml.NST[(size_t)(bh * 64 + c) * 128 + tid] = dnp[tid] + dnp[128 + tid];
  f32x4 acc[4][4]; zero_acc(acc);
#pragma unroll
  for (int ks = 0; ks < 2; ++ks) {
    bf16x8 av[4], bk[4];
#pragma unroll
    for (int i = 0; i < 4; ++i) { av[i] = img_frag(VT, wr * 64 + i * 16, ks, fr, fq); bk[i] = img_frag(KT, wc * 64 + i * 16, ks, fr, fq); }
#pragma unroll
    for (int i = 0; i < 4; ++i)
#pragma unroll
      for (int j = 0; j < 4; ++j) acc[i][j] = __builtin_amdgcn_mfma_f32_16x16x32_bf16(bk[j], av[i], acc[i][j], 0, 0, 0);
  }
  bf16_t* cst = ml.CST + (size_t)(bh * 64 + c) * 16384;
#pragma unroll
  for (int mi = 0; mi < 4; ++mi)
#pragma unroll
    for (int ni = 0; ni < 4; ++ni) st_bf4(cst + (wr * 64 + mi * 16 + fr) * 128 + wc * 64 + ni * 16 + 4 * fq, acc[mi][ni]);
  __syncthreads();
}

__device__ __forceinline__ void ml_scan_item(const MlArgs& ml, int item, int tid) {
  const int bh = item / 17, part = item % 17;
  float m = 0.f;
  if (part < 16) {
    float run[4] = {0.f, 0.f, 0.f, 0.f};
#pragma unroll 1
    for (int c0 = 0; c0 < 64; c0 += 8) {
      u32x2 vb[8]; float bl[8], mxv[8];
#pragma unroll
      for (int u = 0; u < 8; ++u) {
        vb[u] = *(const u32x2*)(ml.CST + (size_t)(bh * 64 + c0 + u) * 16384 + part * 1024 + tid * 4);
        bl[u] = ml.BL[bh * 64 + c0 + u]; mxv[u] = ml.MX[bh * 64 + c0 + u];
      }
#pragma unroll
      for (int u = 0; u < 8; ++u) {
        const float mn = fmaxf(bl[u] + m, mxv[u]), decay = __expf(bl[u] + m - mn), scl = __expf(mxv[u] - mn);
        u32x2 o; o.x = pk2bf(run[0], run[1]); o.y = pk2bf(run[2], run[3]);
        *(u32x2*)(ml.CST + (size_t)(bh * 64 + c0 + u) * 16384 + part * 1024 + tid * 4) = o;
        run[0] = decay * run[0] + scl * __uint_as_float(vb[u].x << 16); run[1] = decay * run[1] + scl * __uint_as_float(vb[u].x & 0xffff0000u);
        run[2] = decay * run[2] + scl * __uint_as_float(vb[u].y << 16); run[3] = decay * run[3] + scl * __uint_as_float(vb[u].y & 0xffff0000u);
        if (part == 0 && tid == 0) ml.MST[bh * 64 + c0 + u] = m;
        m = mn;
      }
    }
  } else if (tid < 128) {
    float run = 0.f;
    for (int c = 0; c < 64; ++c) {
      const float bl = ml.BL[bh * 64 + c], mx = ml.MX[bh * 64 + c];
      const float mn = fmaxf(bl + m, mx), decay = __expf(bl + m - mn), scl = __expf(mx - mn);
      float* p = ml.NST + (size_t)(bh * 64 + c) * 128 + tid;
      const float v = *p; *p = run; run = decay * run + scl * v;
      m = mn;
    }
  }
}

__device__ __forceinline__ void ml_out_item(const MegaArgs& a, const MlArgs& ml, int item, char* lds, int tid) {
  asm volatile("" : "+v"(tid));
  const int lane = tid & 63, wid = tid >> 6, wr = wid >> 1, wc = wid & 1, fr = lane & 15, fq = lane >> 4;
  const int bh = item >> 6, c = item & 63, b = bh >> 2, h = bh & 3, nb = b * SEQ, t0 = c * 64;
  char* Qi = lds; char* Ki = lds + 16384; char* VT = lds + 32768; char* SP = lds + 49152;
  float* sc = (float*)(lds + 57344);
  float* H = (float*)lds;
  {
    char* RAW = lds + 49152;
    const int d = tid & 127, jh = tid >> 7;
    stage_raw(a.QK, nb, t0, h * 128, RAW, tid);
    {
      bf16_t tv[32];
#pragma unroll
      for (int u = 0; u < 32; ++u) tv[u] = __builtin_nontemporal_load(a.V + (size_t)(nb + t0 + jh * 32 + u) * 512 + h * 128 + d);
#pragma unroll
      for (int u = 0; u < 32; ++u) *(bf16_t*)(VT + img_off(d, jh * 32 + u)) = tv[u];
    }
    __syncthreads();
    conv_col(RAW, ml.conv, jh * 32, 32, h * 128 + d, d, 1.f, [&](int j, float v) { *(bf16_t*)(Qi + (d >> 6) * 8192 + img_off(j, d & 63)) = f2bf(v); });
    __syncthreads();
    stage_raw(a.QK, nb, t0, 512 + h * 128, RAW, tid);
    __syncthreads();
    conv_col(RAW, ml.conv, jh * 32, 32, 512 + h * 128 + d, d, 0.08838834764831845f, [&](int j, float v) { *(bf16_t*)(Ki + (d >> 6) * 8192 + img_off(j, d & 63)) = f2bf(v); });
    __syncthreads();
  }
  if (tid < 64) { sc[tid] = ml.BCUM[bh * SEQ + t0 + tid]; sc[64 + tid] = ml.IP[bh * SEQ + t0 + tid]; }
  if (tid < 128) sc[448 + tid] = ml.NST[(size_t)(bh * 64 + c) * 128 + tid];
  __syncthreads();
  const float m = ml.MST[bh * 64 + c];
  if (tid < 64) {
    const float bj = sc[tid], a0 = sc[0]; float dv = sc[64 + tid] - (bj - a0);
#pragma unroll
    for (int off = 1; off < 64; off <<= 1) { const float o = __shfl_up(dv, off, 64); if (tid >= off) dv = fmaxf(dv, o); }
    const float mxi = (bj - a0) + dv;
    const float inter = bj + m, mt = fmaxf(mxi, inter);
    sc[128 + tid] = mt; sc[192 + tid] = __expf(inter - mt);
  } else if (tid < 128) {
    const int t = tid - 64; float nq = 0.f;
#pragma unroll 8
    for (int k = 0; k < 128; ++k) nq += sc[448 + k] * bf2f(*(const bf16_t*)(Qi + (k >> 6) * 8192 + img_off(t, k & 63)));
    sc[384 + t] = nq;
  }
  f32x4 sacc[2][2];
#pragma unroll
  for (int i = 0; i < 2; ++i)
#pragma unroll
    for (int j = 0; j < 2; ++j) sacc[i][j] = (f32x4){0.f, 0.f, 0.f, 0.f};
#pragma unroll
  for (int kt = 0; kt < 2; ++kt)
#pragma unroll
    for (int ks = 0; ks < 2; ++ks) {
      bf16x8 aq[2], bk[2];
#pragma unroll
      for (int i = 0; i < 2; ++i) { aq[i] = img_frag(Qi + kt * 8192, wr * 32 + i * 16, ks, fr, fq); bk[i] = img_frag(Ki + kt * 8192, wc * 32 + i * 16, ks, fr, fq); }
#pragma unroll
      for (int i = 0; i < 2; ++i)
#pragma unroll
        for (int j = 0; j < 2; ++j) sacc[i][j] = __builtin_amdgcn_mfma_f32_16x16x32_bf16(bk[j], aq[i], sacc[i][j], 0, 0, 0);
    }
  __syncthreads();
  const bf16_t* cst = ml.CST + (size_t)(bh * 64 + c) * 16384;
#pragma unroll
  for (int i = 0; i < 4; ++i) { const int idx = tid + 256 * i, row = idx >> 3, lc = (idx & 7) ^ ((row >> 1) & 7); glds16_nt(cst + row * 128 + lc * 8, Ki + idx * 16); }
#pragma unroll
  for (int mi = 0; mi < 2; ++mi) {
    const int t = wr * 32 + mi * 16 + fr; const float bt = sc[t], mt = sc[128 + t]; float rsum = 0.f;
#pragma unroll
    for (int ni = 0; ni < 2; ++ni) {
      const int s0 = wc * 32 + ni * 16 + 4 * fq; f32x4 p;
#pragma unroll
      for (int j = 0; j < 4; ++j) { const int s2 = s0 + j; p[j] = (s2 <= t) ? sacc[mi][ni][j] * __expf(bt - sc[s2] + sc[64 + s2] - mt) : 0.f; rsum += p[j]; }
      u32x2 o; o.x = pk2bf(p[0], p[1]); o.y = pk2bf(p[2], p[3]);
      *(u32x2*)(SP + img_off(t, s0)) = o;
    }
    rsum += __shfl_xor(rsum, 16); rsum += __shfl_xor(rsum, 32);
    if (fq == 0) sc[256 + t * 2 + wc] = rsum;
  }
  asm volatile("s_waitcnt vmcnt(0)" ::: "memory");
  __syncthreads();
  f32x4 acc1[2][4], acc2[2][4];
#pragma unroll
  for (int i = 0; i < 2; ++i)
#pragma unroll
    for (int j = 0; j < 4; ++j) { acc1[i][j] = (f32x4){0.f, 0.f, 0.f, 0.f}; acc2[i][j] = (f32x4){0.f, 0.f, 0.f, 0.f}; }
#pragma unroll
  for (int ks = 0; ks < 2; ++ks) {
    bf16x8 as[2], bv[4];
#pragma unroll
    for (int i = 0; i < 2; ++i) as[i] = img_frag(SP, wr * 32 + i * 16, ks, fr, fq);
#pragma unroll
    for (int j = 0; j < 4; ++j) bv[j] = img_frag(VT, wc * 64 + j * 16, ks, fr, fq);
#pragma unroll
    for (int i = 0; i < 2; ++i)
#pragma unroll
      for (int j = 0; j < 4; ++j) acc1[i][j] = __builtin_amdgcn_mfma_f32_16x16x32_bf16(bv[j], as[i], acc1[i][j], 0, 0, 0);
  }
#pragma unroll 1
  for (int kt = 0; kt < 2; ++kt) {
    if (kt == 1) {
      __syncthreads();
#pragma unroll
      for (int i = 0; i < 4; ++i) { const int idx = tid + 256 * i, row = idx >> 3, lc = (idx & 7) ^ ((row >> 1) & 7); glds16_nt(cst + row * 128 + 64 + lc * 8, Ki + idx * 16); }
      asm volatile("s_waitcnt vmcnt(0)" ::: "memory");
      __syncthreads();
    }
#pragma unroll
    for (int ks = 0; ks < 2; ++ks) {
      bf16x8 aq[2], bc[4];
#pragma unroll
      for (int i = 0; i < 2; ++i) aq[i] = img_frag(Qi + kt * 8192, wr * 32 + i * 16, ks, fr, fq);
#pragma unroll
      for (int j = 0; j < 4; ++j) bc[j] = img_frag(Ki, wc * 64 + j * 16, ks, fr, fq);
#pragma unroll
      for (int i = 0; i < 2; ++i)
#pragma unroll
        for (int j = 0; j < 4; ++j) acc2[i][j] = __builtin_amdgcn_mfma_f32_16x16x32_bf16(bc[j], aq[i], acc2[i][j], 0, 0, 0);
    }
  }
  __syncthreads();
#pragma unroll
  for (int mi = 0; mi < 2; ++mi) {
    const int t = wr * 32 + mi * 16 + fr; const float wi = sc[192 + t];
    const float den = sc[256 + t * 2] + sc[256 + t * 2 + 1] + wi * sc[384 + t];
    const float inv = __builtin_amdgcn_rcpf(fmaxf(fabsf(den), __expf(-sc[128 + t])));
#pragma unroll
    for (int ni = 0; ni < 4; ++ni) *(f32x4*)(H + t * 132 + wc * 64 + ni * 16 + 4 * fq) = (acc1[mi][ni] + acc2[mi][ni] * wi) * inv;
  }
  __syncthreads();
  {
    bf16_t og0[16], og1[16];
#pragma unroll
    for (int r = 0; r < 16; ++r) { const size_t n = nb + t0 + wid * 16 + r; og0[r] = __builtin_nontemporal_load(a.O + n * 512 + h * 128 + lane); og1[r] = __builtin_nontemporal_load(a.O + n * 512 + h * 128 + 64 + lane); }
    const float g0 = ml.gain[h * 128 + lane], g1 = ml.gain[h * 128 + 64 + lane];
#pragma unroll
    for (int r = 0; r < 16; ++r) {
      const int j = wid * 16 + r;
      const float a0 = H[j * 132 + lane], a1 = H[j * 132 + 64 + lane];
      const float ss = wave_sum(a0 * a0 + a1 * a1);
      const float rs = rsqrtf(ss * (1.f / 128.f) + EPS);
      const size_t n = nb + t0 + j; const int c0 = h * 128 + lane, c1 = c0 + 64;
      a.AML[n * 512 + c0] = f2bf(sigmoidf_(bf2f(og0[r])) * a0 * rs * g0);
      a.AML[n * 512 + c1] = f2bf(sigmoidf_(bf2f(og1[r])) * a1 * rs * g1);
    }
  }
  __syncthreads();
}


struct EpiX1 {
  static constexpr bool PERM = false, AFTER_DRAIN = false;
  const bf16_t* XB; bf16_t* X1B; float* PS2;
  __device__ __forceinline__ void operator()(const f32x4 (&acc)[2][2][4][2], const pg8::Unit& u, int wr, int wc, int fr, int fq) const {
    const int c8 = (fq & 1) * 16 + (fq >> 1) * 8;
    const size_t base = (size_t)(u.pm * 256 + wr * 64 + fr) * 1024 + u.pn * 256 + wc * 32 + c8;
    u32x4 xr[16];
#pragma unroll
    for (int i = 0; i < 16; ++i) xr[i] = *(const u32x4*)(XB + base + (size_t)((i >> 3) * 128 + ((i >> 1) & 3) * 16) * 1024 + (i & 1) * 128);
#pragma unroll
    for (int ai = 0; ai < 2; ++ai)
#pragma unroll
      for (int m = 0; m < 4; ++m) {
        const int row = u.pm * 256 + ai * 128 + wr * 64 + m * 16 + fr;
#pragma unroll
        for (int bj = 0; bj < 2; ++bj) {
          const size_t off = base + (size_t)(ai * 128 + m * 16) * 1024 + bj * 128;
          float v[8], x8[8]; swap8(acc[ai][bj][m][0], acc[ai][bj][m][1], v); bf8_to_f32(xr[ai * 8 + m * 2 + bj], x8);
          float ss = 0.f;
#pragma unroll
          for (int j = 0; j < 8; ++j) { v[j] += x8[j]; ss += v[j] * v[j]; }
          __builtin_nontemporal_store(pk8bf(v), (u32x4*)(X1B + off));
          ss += __shfl_xor(ss, 16); ss += __shfl_xor(ss, 32);
          if (fq == 0) PS2[(size_t)row * 32 + u.pn * 8 + bj * 4 + wc] = ss;
        }
      }
  }
};
struct EpiXQ {
  static constexpr bool PERM = false, AFTER_DRAIN = false;
  bf16_t* XQ; const PG8_LAS float* rsl;
  __device__ __forceinline__ void operator()(const f32x4 (&acc)[2][2][4][2], const pg8::Unit& u, int wr, int wc, int fr, int fq) const {
#pragma unroll
    for (int ai = 0; ai < 2; ++ai)
#pragma unroll
      for (int m = 0; m < 4; ++m) {
        const int rl = ai * 128 + wr * 64 + m * 16 + fr, row = u.pm * 256 + rl;
        const float rs = rsl[rl];
#pragma unroll
        for (int bj = 0; bj < 2; ++bj) st_bf8_pair(XQ + (size_t)row * 1024 + u.pn * 256 + bj * 128 + wc * 32, fq, acc[ai][bj][m][0] * rs, acc[ai][bj][m][1] * rs);
      }
  }
};
struct EpiX2 {
  static constexpr bool PERM = false, AFTER_DRAIN = false;
  bf16_t* X1B;
  __device__ __forceinline__ void operator()(const f32x4 (&acc)[2][2][4][2], const pg8::Unit& u, int wr, int wc, int fr, int fq) const {
    const int c8 = (fq & 1) * 16 + (fq >> 1) * 8;
    bf16_t* const base = X1B + (size_t)(u.pm * 256 + wr * 64 + fr) * 1024 + u.pn * 256 + wc * 32 + c8;
    u32x4 xr[16];
#pragma unroll
    for (int i = 0; i < 16; ++i) xr[i] = *(const u32x4*)(base + (size_t)((i >> 3) * 128 + ((i >> 1) & 3) * 16) * 1024 + (i & 1) * 128);
#pragma unroll
    for (int ai = 0; ai < 2; ++ai)
#pragma unroll
      for (int m = 0; m < 4; ++m)
#pragma unroll
        for (int bj = 0; bj < 2; ++bj) {
          float v[8], x8[8]; swap8(acc[ai][bj][m][0], acc[ai][bj][m][1], v); bf8_to_f32(xr[ai * 8 + m * 2 + bj], x8);
#pragma unroll
          for (int j = 0; j < 8; ++j) v[j] += x8[j];
          __builtin_nontemporal_store(pk8bf(v), (u32x4*)(base + (size_t)(ai * 128 + m * 16) * 1024 + bj * 128));
        }
  }
};
struct MapMN {
  const bf16_t* A; const bf16_t* Bt; int K, xcd;
  __device__ __forceinline__ void avoff(const pg8::Unit&, int, int K, const unsigned (&voffA)[2], unsigned (&v0)[2], unsigned (&v1)[2]) const { v0[0] = voffA[0]; v0[1] = voffA[1]; v1[0] = voffA[0] + 256u * K; v1[1] = voffA[1] + 256u * K; }
  __device__ __forceinline__ void operator()(int idx, pg8::Unit& u) const {
    u.pm = xcd * 8 + (idx & 7); u.pn = idx >> 3;
    u.aptr = (const char*)(A + (size_t)u.pm * 256 * K); u.bptr = (const char*)(Bt + (size_t)u.pn * 256 * K);
  }
};

struct MapInProj {
  const bf16_t* XB; const bf16_t* WinT; int xcd;
  __device__ __forceinline__ void avoff(const pg8::Unit&, int, int K, const unsigned (&voffA)[2], unsigned (&v0)[2], unsigned (&v1)[2]) const { v0[0] = voffA[0]; v0[1] = voffA[1]; v1[0] = voffA[0] + 256u * K; v1[1] = voffA[1] + 256u * K; }
  __device__ __forceinline__ void operator()(int idx, pg8::Unit& u) const {
    u.pm = xcd * 8 + (idx & 7); u.pn = idx >> 3;
    const char* tokp = (const char*)(XB + (size_t)u.pm * 256 * DM); const char* colp = (const char*)(WinT + (size_t)u.pn * 256 * DM);
    if (u.pn == 12) { u.aptr = colp; u.bptr = tokp; } else { u.aptr = tokp; u.bptr = colp; }
  }
};
struct EpiInProj8 {
  static constexpr bool PERM = false, AFTER_DRAIN = false;
  bf16_t *QK, *V, *O, *NQ, *KVC, *KS, *KW, *VST, *VWT; float* SM; const float* RS1;
  __device__ __forceinline__ void operator()(const f32x4 (&acc)[2][2][4][2], const pg8::Unit& u, int wr, int wc, int fr, int fq) const {
    if (u.pn == 12) {
#pragma unroll
      for (int bj = 0; bj < 2; ++bj) {
        const int tok = u.pm * 256 + bj * 128 + wc * 32;
        const f32x4 rs0 = *(const f32x4*)(RS1 + tok + 4 * fq), rs1 = *(const f32x4*)(RS1 + tok + 16 + 4 * fq);
        const int b = tok >> 12, t = tok & 4095;
#pragma unroll
        for (int ai = 0; ai < 2; ++ai)
#pragma unroll
          for (int m = 0; m < 4; ++m) st_bf8_pair((ai ? VWT : VST) + ((size_t)(b * 128 + wr * 64 + m * 16 + fr) << 12) + t, fq, acc[ai][bj][m][0] * rs0, acc[ai][bj][m][1] * rs1);
      }
      return;
    }
    float rsv[8];
#pragma unroll
    for (int i = 0; i < 8; ++i) rsv[i] = RS1[u.pm * 256 + (i >> 2) * 128 + wr * 64 + (i & 3) * 16 + fr];
#pragma unroll
    for (int bj = 0; bj < 2; ++bj) {
      const int nh = u.pn * 256 + bj * 128;
      bf16_t* dst; int ld, cofs; float scale = 1.f;
      if (nh < 1024) { dst = QK; ld = 1024; cofs = nh; }
      else if (nh < 1536) { dst = V; ld = 512; cofs = nh - 1024; }
      else if (nh < 2048) { dst = O; ld = 512; cofs = nh - 1536; }
      else if (nh < 2560) { dst = NQ; ld = 512; cofs = nh - 2048; scale = 0.125f * 1.4426950408889634f; }
      else if (nh < 2816) { dst = KVC; ld = 256; cofs = nh - 2560; }
      else if (nh < 2944) { dst = KS; ld = 128; cofs = 0; }
      else if (nh < 3072) { dst = KW; ld = 128; cofs = 0; }
      else { dst = nullptr; ld = 0; cofs = 0; }
      if (!dst && nh != 3328) continue;
#pragma unroll
      for (int ai = 0; ai < 2; ++ai)
#pragma unroll
        for (int m = 0; m < 4; ++m) {
          const int row = u.pm * 256 + ai * 128 + wr * 64 + m * 16 + fr; const float rs = rsv[ai * 4 + m] * scale;
          if (dst) {
            st_bf8_pair(dst + (size_t)row * ld + cofs + wc * 32, fq, acc[ai][bj][m][0] * rs, acc[ai][bj][m][1] * rs);
          } else if (wc == 0) {
#pragma unroll
            for (int n = 0; n < 2; ++n) *(f32x4*)(SM + (size_t)row * 32 + n * 16 + 4 * fq) = acc[ai][bj][m][n] * rs;
          }
        }
    }
  }
};

struct MapMoe {
  const int* CNT; const int* LIST; const bf16_t* Abase; const bf16_t* W; size_t wstride; int K, xcd, gather;
  __device__ __forceinline__ void operator()(int idx, pg8::Unit& u) const {
    int g = (idx >> 2) * 8 + xcd, e = 0, ce = 0, pre = 0;
    u.pm = g;
    int cn[16];
#pragma unroll
    for (int k = 0; k < 16; ++k) cn[k] = CNT[k];
    bool fnd = false;
#pragma unroll
    for (int k = 0; k < 16; ++k) {
      const int np = (cn[k] + 255) >> 8;
      const bool stop = !fnd && (g < np || k == 15);
      if (stop) { e = k; ce = cn[k]; fnd = true; }
      if (!fnd) { g -= np; pre += cn[k]; }
    }
    u.e = e; u.ce = ce; u.rt = g; u.p0 = pre + g * 256; u.pn = idx & 3;
    u.bptr = (const char*)(W + (size_t)e * wstride + (size_t)u.pn * 256 * K);
    u.aptr = gather ? (const char*)Abase : (const char*)(Abase + (size_t)u.p0 * K);
  }
  __device__ __forceinline__ void avoff(const pg8::Unit& u, int tid, int K_, const unsigned (&voffA)[2], unsigned (&v0)[2], unsigned (&v1)[2]) const {
    if (!gather) { v0[0] = voffA[0]; v0[1] = voffA[1]; v1[0] = voffA[0] + 256u * K_; v1[1] = voffA[1] + 256u * K_; return; }
#pragma unroll
    for (int i = 0; i < 2; ++i) {
      int R, C; pg8::stage_rc(tid * 16 + i * 8192, R, C);
      int m0_ = u.rt * 256 + R, m1_ = m0_ + 128; if (m0_ >= u.ce) m0_ = u.ce - 1; if (m1_ >= u.ce) m1_ = u.ce - 1;
      v0[i] = (unsigned)((LIST[u.e * NTOK + m0_] >> 1) * K_ + C) * 2u; v1[i] = (unsigned)((LIST[u.e * NTOK + m1_] >> 1) * K_ + C) * 2u;
    }
  }
};
struct EpiMoe1 {
  static constexpr bool PERM = false, AFTER_DRAIN = false;
  const int* LIST; const float* RS3; bf16_t* ACT;
  __device__ __forceinline__ void operator()(const f32x4 (&acc)[2][2][4][2], const pg8::Unit& u, int wr, int wc, int fr, int fq) const {
    int tok[8]; float rsv[8];
#pragma unroll
    for (int i = 0; i < 8; ++i) {
      const int ml = u.rt * 256 + (i >> 2) * 128 + wr * 64 + (i & 3) * 16 + fr;
      tok[i] = LIST[u.e * NTOK + min(ml, u.ce - 1)] >> 1;
    }
#pragma unroll
    for (int i = 0; i < 8; ++i) rsv[i] = RS3[tok[i]];
#pragma unroll
    for (int ai = 0; ai < 2; ++ai)
#pragma unroll
      for (int m = 0; m < 4; ++m) {
        const int r = ai * 128 + wr * 64 + m * 16 + fr, ml = u.rt * 256 + r;
        if (ml < u.ce) {
          const float rs = rsv[ai * 4 + m];
#pragma unroll
          for (int bj = 0; bj < 2; ++bj) {
            const f32x4 a1 = acc[ai][bj][m][0] * rs, a3 = acc[ai][bj][m][1] * rs; f32x4 r4;
#pragma unroll
            for (int j = 0; j < 4; ++j) r4[j] = siluf_(a1[j]) * a3[j];
            {
              const unsigned long long pk = (unsigned long long)pk2bf(r4[0], r4[1]) | ((unsigned long long)pk2bf(r4[2], r4[3]) << 32);
              __hip_atomic_store((unsigned long long*)(ACT + (size_t)(u.p0 + r) * 512 + (u.pn * 8 + bj * 4 + wc) * 16 + 4 * fq), pk, __ATOMIC_RELAXED, __HIP_MEMORY_SCOPE_AGENT);
            }
          }
        }
      }
  }
};
struct EpiMoe2 {
  static constexpr bool PERM = false, AFTER_DRAIN = false;
  const int* LIST; const float* RTW; bf16_t* Y;
  __device__ __forceinline__ void operator()(const f32x4 (&acc)[2][2][4][2], const pg8::Unit& u, int wr, int wc, int fr, int fq) const {
    int ent[8]; float wv[8];
#pragma unroll
    for (int i = 0; i < 8; ++i) {
      const int ml = u.rt * 256 + (i >> 2) * 128 + wr * 64 + (i & 3) * 16 + fr;
      ent[i] = LIST[u.e * NTOK + min(ml, u.ce - 1)];
    }
#pragma unroll
    for (int i = 0; i < 8; ++i) wv[i] = RTW[ent[i]];
#pragma unroll
    for (int ai = 0; ai < 2; ++ai)
#pragma unroll
      for (int m = 0; m < 4; ++m) {
        const int r = ai * 128 + wr * 64 + m * 16 + fr, ml = u.rt * 256 + r;
        {
          const int entry = ent[ai * 4 + m]; const float w = wv[ai * 4 + m];
#pragma unroll
          for (int bj = 0; bj < 2; ++bj) {
            const f32x4 v0 = acc[ai][bj][m][0] * w, v1 = acc[ai][bj][m][1] * w;
            const auto sx = __builtin_amdgcn_permlane16_swap(pk2bf(v0[0], v0[1]), pk2bf(v1[0], v1[1]), false, false);
            const auto sy = __builtin_amdgcn_permlane16_swap(pk2bf(v0[2], v0[3]), pk2bf(v1[2], v1[3]), false, false);
            u32x4 o; o.x = sx[0]; o.y = sy[0]; o.z = sx[1]; o.w = sy[1];
            if (ml < u.ce) __builtin_nontemporal_store(o, (u32x4*)(Y + (size_t)entry * 1024 + u.pn * 256 + bj * 128 + wc * 32 + (fq & 1) * 16 + (fq >> 1) * 8));
          }
        }
      }
  }
};

constexpr int DEP_STRIDE = 16;
struct MoeUpSched {
  int first, stride, count; MapMoe map; unsigned* DEP; bool wave0;
  __device__ __forceinline__ bool next(int i, pg8::Unit& u) const { const int idx = first + i * stride; if (idx >= count) return false; map(idx, u); return true; }
  __device__ __forceinline__ void avoff(const pg8::Unit& u, int tid, int K, const unsigned (&voffA)[2], unsigned (&v0)[2], unsigned (&v1)[2]) const { map.avoff(u, tid, K, voffA, v0, v1); }
  __device__ __forceinline__ void a_ready(const pg8::Unit&) const {}
  __device__ __forceinline__ void done(const pg8::Unit& u) const {
    asm volatile("s_waitcnt vmcnt(0)" ::: "memory");
    __builtin_amdgcn_s_barrier();
    if (wave0 && __builtin_amdgcn_mbcnt_hi(~0u, __builtin_amdgcn_mbcnt_lo(~0u, 0u)) == 0u) (void)__hip_atomic_fetch_add(&DEP[u.pm * DEP_STRIDE], 1u, __ATOMIC_RELAXED, __HIP_MEMORY_SCOPE_AGENT);
  }
};
struct MoeDownSched {
  int li, L, n1, r, fp, nfirst; MapMoe map; unsigned* DEP; bool wave0;
  __device__ __forceinline__ bool next(int i, pg8::Unit& u) const {
    const int j = (i < nfirst) ? 2 * (li - r) + i : fp + li + (i - nfirst) * L;
    if (j >= n1) return false; map(j, u); return true;
  }
  __device__ __forceinline__ void avoff(const pg8::Unit& u, int tid, int K, const unsigned (&voffA)[2], unsigned (&v0)[2], unsigned (&v1)[2]) const { map.avoff(u, tid, K, voffA, v0, v1); }
  __device__ __forceinline__ void a_ready(const pg8::Unit& u) const {
    if (!wave0) return;
    unsigned sp = 0;
    while (__hip_atomic_load(&DEP[u.pm * DEP_STRIDE], __ATOMIC_RELAXED, __HIP_MEMORY_SCOPE_AGENT) < 4u) { __builtin_amdgcn_s_sleep(2); if (++sp > (1u << 22)) break; }
    asm volatile("" ::: "memory");
  }
  __device__ __forceinline__ void done(const pg8::Unit&) const {}
};

struct MapP5 {
  const bf16_t *XB, *WgT, *AML, *ANS, *WmlT, *WnsT; int pm, pn;
  __device__ __forceinline__ void avoff(const pg8::Unit&, int, int K, const unsigned (&voffA)[2], unsigned (&v0)[2], unsigned (&v1)[2]) const { v0[0] = voffA[0]; v0[1] = voffA[1]; v1[0] = voffA[0] + 256u * K; v1[1] = voffA[1] + 256u * K; }
  __device__ __forceinline__ void operator()(int idx, pg8::Unit& u) const {
    u.pm = pm; u.pn = pn; u.e = idx;
    if (idx < 2) { u.K = 1024; u.aptr = (const char*)(XB + (size_t)pm * 256 * 1024); u.bptr = (const char*)(WgT + (size_t)(idx * 1024 + pn * 256) * 1024); }
    else { u.K = 512; u.aptr = (const char*)((idx == 2 ? AML : ANS) + (size_t)pm * 256 * 512); u.bptr = (const char*)((idx == 2 ? WmlT : WnsT) + (size_t)pn * 256 * 512); }
  }
};
struct EpiP5 {
  static constexpr bool PERM = false, AFTER_DRAIN = false;
  bf16_t* MRG; bf16_t* G1; const float* RS1;
  __device__ __forceinline__ void operator()(const f32x4 (&acc)[2][2][4][2], const pg8::Unit& u, int wr, int wc, int fr, int fq) const {
    const int c8 = (fq & 1) * 16 + (fq >> 1) * 8;
    if (u.e < 2) {
      bf16_t* G = u.e ? G1 : MRG;
#pragma unroll
      for (int ai = 0; ai < 2; ++ai)
#pragma unroll
        for (int m = 0; m < 4; ++m) {
          const int row = u.pm * 256 + ai * 128 + wr * 64 + m * 16 + fr; const float rs = RS1[row];
#pragma unroll
          for (int bj = 0; bj < 2; ++bj) {
            u32x2 pk[2];
#pragma unroll
            for (int n = 0; n < 2; ++n) {
              const f32x4 g = acc[ai][bj][m][n] * rs;
              pk[n].x = pk2bf(sigmoidf_(g[0]), sigmoidf_(g[1])); pk[n].y = pk2bf(sigmoidf_(g[2]), sigmoidf_(g[3]));
            }
            const auto sx = __builtin_amdgcn_permlane16_swap(pk[0].x, pk[1].x, false, false);
            const auto sy = __builtin_amdgcn_permlane16_swap(pk[0].y, pk[1].y, false, false);
            u32x4 o; o.x = sx[0]; o.y = sy[0]; o.z = sx[1]; o.w = sy[1];
            *(u32x4*)(G + (size_t)row * 1024 + u.pn * 256 + bj * 128 + wc * 32 + c8) = o;
          }
        }
    } else if (u.e == 2) {
      bf16_t* const base = MRG + (size_t)(u.pm * 256 + wr * 64 + fr) * 1024 + u.pn * 256 + wc * 32 + c8;
      u32x4 gr[16];
#pragma unroll
      for (int i = 0; i < 16; ++i) gr[i] = *(const u32x4*)(base + (size_t)((i >> 3) * 128 + ((i >> 1) & 3) * 16) * 1024 + (i & 1) * 128);
#pragma unroll
      for (int ai = 0; ai < 2; ++ai)
#pragma unroll
        for (int m = 0; m < 4; ++m)
#pragma unroll
          for (int bj = 0; bj < 2; ++bj) {
            float v[8], g[8]; swap8(acc[ai][bj][m][0], acc[ai][bj][m][1], v); bf8_to_f32(gr[ai * 8 + m * 2 + bj], g);
#pragma unroll
            for (int j = 0; j < 8; ++j) v[j] *= g[j];
            *(u32x4*)(base + (size_t)(ai * 128 + m * 16) * 1024 + bj * 128) = pk8bf(v);
          }
    } else {
      const size_t boff = (size_t)(u.pm * 256 + wr * 64 + fr) * 1024 + u.pn * 256 + wc * 32 + c8;
#pragma unroll
      for (int ai = 0; ai < 2; ++ai) {
        u32x4 gr[8], tr[8];
#pragma unroll
        for (int i = 0; i < 8; ++i) { const size_t o = boff + (size_t)(ai * 128 + (i >> 1) * 16) * 1024 + (i & 1) * 128; gr[i] = *(const u32x4*)(G1 + o); tr[i] = *(const u32x4*)(MRG + o); }
#pragma unroll
        for (int m = 0; m < 4; ++m)
#pragma unroll
          for (int bj = 0; bj < 2; ++bj) {
            float v[8], g[8], t[8]; swap8(acc[ai][bj][m][0], acc[ai][bj][m][1], v); bf8_to_f32(gr[m * 2 + bj], g); bf8_to_f32(tr[m * 2 + bj], t);
#pragma unroll
            for (int j = 0; j < 8; ++j) v[j] = t[j] + g[j] * v[j];
            __builtin_nontemporal_store(pk8bf(v), (u32x4*)(MRG + boff + (size_t)(ai * 128 + m * 16) * 1024 + bj * 128));
          }
      }
    }
  }
};

#define XB_TMO      128
#define XB_XCNT(j)  (256  + 64 * (j))
#define XB_XSUB(j)  (1280 + 64 * (j))
#define XB_XGEN(j)  (2304 + 64 * (j))
#define XB_TOP      3328
#define XB_TOPGEN   3392
#define XCD_BAR_WORDS 3456
#define XB_SPIN_CAP (1u << 24)
__device__ __forceinline__ unsigned xb_ld(unsigned* p)              { return __hip_atomic_load(p, __ATOMIC_RELAXED, __HIP_MEMORY_SCOPE_AGENT); }
__device__ __forceinline__ unsigned xb_add(unsigned* p, unsigned v) { return __hip_atomic_fetch_add(p, v, __ATOMIC_RELAXED, __HIP_MEMORY_SCOPE_AGENT); }
__device__ __forceinline__ unsigned xb_xcc_id() { return (unsigned)__builtin_amdgcn_s_getreg((3 << 11) | 20) & 0xFu; }
#define XB_SPIN(cond, bar) do { unsigned _sp = 0; while (cond) { __builtin_amdgcn_s_sleep(1); \
    if ((++_sp & 255u) == 0u) { if (xb_ld(&(bar)[XB_TMO])) break; if (_sp > XB_SPIN_CAP) { atomicAdd(&(bar)[XB_TMO], 1u); break; } } } } while (0)
__device__ __forceinline__ void xcd_barrier_complete(unsigned* bar, unsigned x, unsigned G, unsigned& nloc, unsigned& nx) {
  unsigned sum, cnt, mine, sp = 0u;
  for (;;) {
    sum = 0u; cnt = 0u; mine = 0u;
#pragma unroll
    for (unsigned j = 0; j < 16; ++j) { const unsigned c = xb_ld(&bar[XB_XCNT(j)]); sum += c; cnt += (c > 0u) ? 1u : 0u; mine = (j == x) ? c : mine; }
    if (sum == G) break;
    __builtin_amdgcn_s_sleep(1);
    if ((++sp & 255u) == 0u) { if (xb_ld(&bar[XB_TMO])) break; if (sp > XB_SPIN_CAP) { atomicAdd(&bar[XB_TMO], 1u); break; } }
  }
  nloc = mine > 0u ? mine : 1u; nx = cnt > 0u ? cnt : 1u;
}
__device__ __forceinline__ void xcd_barrier(unsigned* bar, unsigned x, volatile unsigned* st, unsigned G, bool leader_thread) {
  asm volatile("s_waitcnt vmcnt(0)" ::: "memory");
  __syncthreads();
  if (leader_thread) {
    __builtin_amdgcn_s_waitcnt(0);
    unsigned nloc = st[0], nx = st[1];
    if (nloc == 0u) { xcd_barrier_complete(bar, x, G, nloc, nx); st[0] = nloc; st[1] = nx; }
    const unsigned old = xb_add(&bar[XB_XSUB(x)], 1u);
    const unsigned gen = old / nloc;
    if (old + 1u == (gen + 1u) * nloc) {
      __builtin_amdgcn_fence(__ATOMIC_RELEASE, "agent");
      asm volatile("s_waitcnt vmcnt(0)" ::: "memory");
      const unsigned og = xb_add(&bar[XB_TOP], 1u);
      const unsigned tg = og / nx;
      if (og + 1u == (tg + 1u) * nx) xb_add(&bar[XB_TOPGEN], 1u);
      else XB_SPIN(xb_ld(&bar[XB_TOPGEN]) == tg, bar);
      __builtin_amdgcn_fence(__ATOMIC_ACQUIRE, "agent");
      xb_add(&bar[XB_XGEN(x)], 1u);
      asm volatile("s_waitcnt vmcnt(0)" ::: "memory");
    } else {
      XB_SPIN(xb_ld(&bar[XB_XGEN(x)]) == gen, bar);
      asm volatile("buffer_inv sc0\n\ts_waitcnt vmcnt(0)" ::: "memory");
    }
  }
  __syncthreads();
}

__device__ __forceinline__ void convert_range(const MegaArgs& a, int lo, int hi, int bid, int nblk, char* lds, int tid) {
  for (int it0 = lo; it0 < hi; it0 += nblk) {
    int it = it0 + bid; if (it >= hi) it = hi - 1;
    int r = it, di = 0;
    while (r >= a.td[di].nitems) { r -= a.td[di].nitems; ++di; }
    transpose_item(a.td[di], r, (float*)lds, tid);
  }
}
#define TILE_IDS unsigned tid_z = 0u; asm volatile("" : "+v"(tid_z)); int tid = (wave_s & 3) * 64 + (int)__builtin_amdgcn_mbcnt_hi(~0u, __builtin_amdgcn_mbcnt_lo(~0u, tid_z)); asm volatile("" : "+v"(tid)); const int half = wave_s >> 2; char* const lds = plds + half * HALF_LDS; const int bid = pbid * 2 + half, nblk = pnblk * 2, li = (pbid >> 3) * 2 + half, nloc = (pnblk >> 3) * 2; const int lane = tid & 63, wid = tid >> 6, wr = wid >> 1, wc = wid & 1, fr = lane & 15, fq = lane >> 4; (void)lane; (void)wid; (void)wr; (void)wc; (void)fr; (void)fq; (void)half; (void)lds; (void)bid; (void)nblk; (void)li; (void)nloc

__global__ void __launch_bounds__(512, 2) k_mega(MegaArgs a) {
  extern __shared__ __attribute__((aligned(16))) char lds_raw[];
  char* const plds = lds_raw;
  cg::grid_group grid = cg::this_grid();
  const int pnblk = gridDim.x, pbid = blockIdx.x;
  const int wave_s = __builtin_amdgcn_readfirstlane((int)(threadIdx.x >> 6));
  unsigned* const xbar = a.BAR + a.li * XCD_BAR_WORDS;
  volatile unsigned* const xst = (volatile unsigned*)(plds + CTRL_OFF);
  volatile int* const xch = (volatile int*)(plds + CTRL_OFF + 16);
  unsigned xcc;
  {
    const bool t0 = (wave_s == 0) && ((int)__builtin_amdgcn_mbcnt_hi(~0u, __builtin_amdgcn_mbcnt_lo(~0u, 0u)) == 0);
    if (t0) { xst[0] = 0u; xst[1] = 0u; }
    xcc = xb_xcc_id();
    if (t0) (void)xb_add(&xbar[XB_XCNT(xcc)], 1u);
    grid.sync();
  }
#define PH(k) (a.ph_lo <= (k) && (k) < a.ph_hi)
  const int xcd = pbid & 7;
#define GRID_BAR() do { const int ld_ = (wave_s == 0) && ((int)__builtin_amdgcn_mbcnt_hi(~0u, __builtin_amdgcn_mbcnt_lo(~0u, 0u)) == 0); xcd_barrier(xbar, xcc, xst, (unsigned)pnblk, ld_); } while (0)
#define SYNC_AFTER(k) do { if (PH(k) && PH((k) + 1)) GRID_BAR(); } while (0)
#pragma unroll 1
  for (int rp_ = PH(0) ? a.rep[0] : 0; rp_ > 0; --rp_) {
    TILE_IDS;
    convert_range(a, a.cv_lo[0], a.cv_hi[0], bid, nblk, lds, tid);
    for (int i = bid * 256 + tid; i < (NIN - DIN_A) * 1024 / 8; i += nblk * 256) ((u32x4*)(a.WinT + (size_t)DIN_A * 1024))[i] = (u32x4){0u, 0u, 0u, 0u};
    rows_to_bf16(a.x, a.XB, a.RS1, NTOK, bid * 4 + wid, nblk * 4, lane);
    rows_to_bf16(a.mem, a.MEMB, a.RSM, NB * MEMT, bid * 4 + wid, nblk * 4, lane);
    for (int o = bid * 4 + wid; o < 256; o += nblk * 4) {
      const int which = o >> 7, u = o & 127; const float* pos = which ? a.posv : a.posk; const float* w1 = which ? a.cvw1 : a.ckw1;
      float sacc = 0.f;
      for (int f = lane; f < 2048; f += 64) sacc += pos[f] * w1[(size_t)f * 128 + u];
      sacc = wave_sum(sacc);
      if (lane == 0) a.POSW[o] = sacc;
    }
  }
  SYNC_AFTER(0);
#pragma unroll 1
  for (int rp_ = PH(1) ? a.rep[1] : 0; rp_ > 0; --rp_) {
    TILE_IDS;
    {
      TILE8_IDS;
      ListSched<MapInProj> S8{pbid >> 3, pnblk >> 3, 112, MapInProj{a.XB, a.WinT, xcd}};
      EpiInProj8 E8{a.QK, a.V, a.O, a.NQ, a.KVC, a.KS, a.KW, a.VST, a.VWT, a.SM, a.RS1};
      pg8::gemm_phase<EpiInProj8, ListSched<MapInProj>, true, true>((PG8_LAS unsigned char*)plds, pg8::Gemm{DM}, S8, E8, t512, wave_s);
    }
    if ((pbid >> 3) >= 16) convert_range(a, a.cv_lo[1], a.cv_hi[1], ((xcd * 16 + (pbid >> 3) - 16) * 2 + half), (pnblk >> 1) * 2, lds, tid);
  }
  SYNC_AFTER(1);
#pragma unroll 1
  for (int rp_ = PH(2) ? a.rep[2] : 0; rp_ > 0; --rp_) {
    TILE_IDS;
    for (int it = bid; it < 128; it += nblk) {
      const int which = it >> 6, m0 = ((it >> 2) & 15) * 128, slab = it & 3;
      f32x4 acc[4][4]; zero_acc(acc);
      {
        int tid2 = tid; asm volatile("" : "+v"(tid2));
        unsigned ao[4], bo[4];
#pragma unroll
        for (int i = 0; i < 4; ++i) {
          const int row = st_row(tid2, i), lc = st_lc(tid2, i);
          const int m = m0 + row, bg = m >> 8, j = m & 255;
          ao[i] = (unsigned)((bg >> 1) * SEQ + 16 * j + slab * 8) * 256u + which * 128 + (bg & 1) * 64 + lc * 8;
          bo[i] = (unsigned)row * 2048u + slab * 512 + lc * 8;
        }
        gemm_core(acc, a.KVC, ao, 256u, which ? a.CV1T : a.CK1T, bo, 64u, 8, lds, tid2);
      }
      float* cp = a.CPART + (size_t)((which * 4 + slab) * 2048 + m0) * 128;
#pragma unroll
      for (int mi = 0; mi < 4; ++mi)
#pragma unroll
        for (int ni = 0; ni < 4; ++ni) *(f32x4*)(cp + (wr * 64 + mi * 16 + fr) * 128 + wc * 64 + ni * 16 + 4 * fq) = acc[mi][ni];
    }
    for (int q = nloc - 1 - li; q < 16; q += nloc) {
      f32x4 acc[4][4]; zero_acc(acc);
      const int tile = xcd * 16 + q; constexpr int T1 = 0, T2n = 16;
        const int t2 = tile - T1; const int m0 = (t2 / T2n) * 128, n0 = (t2 % T2n) * 128;
        if (n0 < 1024) {
          gemm_acc(acc, a.MEMB, DM, (const int*)nullptr, 0, 0, a.WkvT, DM, DM, lds, m0, n0, tid);
#pragma unroll
          for (int mi = 0; mi < 4; ++mi) {
            const int m = m0 + wr * 64 + mi * 16 + fr; const float rs = a.RSM[m];
#pragma unroll
            for (int ni = 0; ni < 4; ++ni) st_bf4(a.KVM + (size_t)m * 1024 + n0 + wc * 64 + ni * 16 + 4 * fq, acc[mi][ni] * rs);
          }
        } else {
          gemm_acc(acc, a.WkvT, DM, (const int*)nullptr, 0, 0, a.MEMB, DM, DM, lds, n0, m0, tid);
          bf16_t* vmt = a.KVM + (size_t)1024 * 1024;
#pragma unroll
          for (int ni = 0; ni < 4; ++ni) {
            const int tok = m0 + wc * 64 + ni * 16 + 4 * fq; const f32x4 rs = *(const f32x4*)(a.RSM + tok);
            const int b = tok >> 8, key = tok & 255;
#pragma unroll
            for (int mi = 0; mi < 4; ++mi) {
              const int col = n0 - 1024 + wr * 64 + mi * 16 + fr;
              st_bf4(vmt + ((size_t)(b * 1024 + col) << 8) + key, acc[mi][ni] * rs);
            }
          }
        }
    }
    for (int lp = pbid >> 3; lp < 32; lp += pnblk >> 3) nsa_win_item(a, ((((((xcd >> 1) & 1) * 2 + half) * 2 + (xcd & 1)) << 6)) | (63 - (2 * lp + (xcd >> 2))), lds, tid);
    {
      volatile int* wqw = (volatile int*)(lds + MEGA_LDS - 32);
      (void)wqw;
      int it0 = pbid * 2;
      while (it0 < 1024) {
        ml_dc_item(a, a.ml, it0 + half, lds, tid);
        if (wave_s == 0 && lane == 0) xch[2] = 2 * pnblk + atomicAdd(a.WQ + 1, 2);
        __syncthreads();
        it0 = xch[2];
        __syncthreads();
      }
    }
  }
  SYNC_AFTER(2);
#pragma unroll 1
  for (int rp_ = PH(3) ? a.rep[3] : 0; rp_ > 0; --rp_) {
    TILE_IDS;
    if (rp_ == 1) for (int it = bid; it < 272; it += nblk) ml_scan_item(a.ml, it, tid);
    for (int it = nblk - 1 - bid; it < 128; it += nblk) {
      const int which = it >> 6, m0 = (it & 63) * 32;
      float* hid = (float*)lds;
      float* w2s = (float*)(lds + 16640);
      {
        const float* w2 = which ? a.cvw2 : a.ckw2;
#pragma unroll
        for (int c = 0; c < 8; ++c) *(f32x4*)(w2s + (tid + 256 * c) * 4) = *(const f32x4*)(w2 + (tid + 256 * c) * 4);
        const int row = tid >> 3, u0 = (tid & 7) * 16;
        const float* cp = a.CPART + (size_t)(which * 4 * 2048 + m0 + row) * 128 + u0;
#pragma unroll
        for (int c4 = 0; c4 < 4; ++c4) {
          f32x4 hv = *(const f32x4*)(cp + c4 * 4) + *(const f32x4*)(cp + 2048 * 128 + c4 * 4) + *(const f32x4*)(cp + 2 * 2048 * 128 + c4 * 4) + *(const f32x4*)(cp + 3 * 2048 * 128 + c4 * 4)
                   + *(const f32x4*)(a.POSW + which * 128 + u0 + c4 * 4);
#pragma unroll
          for (int j = 0; j < 4; ++j) hid[row * 129 + u0 + c4 * 4 + j] = gelu_tanh(hv[j]);
        }
      }
      __syncthreads();
      {
        const int row = tid >> 3, d0 = (tid & 7) * 8;
        float o[8];
#pragma unroll
        for (int d = 0; d < 8; ++d) o[d] = 0.f;
        for (int u = 0; u < 128; ++u) {
          const float hv = hid[row * 129 + u]; const f32x4 w0 = *(const f32x4*)(w2s + u * 64 + d0), w1 = *(const f32x4*)(w2s + u * 64 + d0 + 4);
          o[0] += hv * w0[0]; o[1] += hv * w0[1]; o[2] += hv * w0[2]; o[3] += hv * w0[3]; o[4] += hv * w1[0]; o[5] += hv * w1[1]; o[6] += hv * w1[2]; o[7] += hv * w1[3];
        }
        const int m = m0 + row, bg = m >> 8, j = m & 255;
        if (which == 0) {
#pragma unroll
          for (int d = 0; d < 8; ++d) a.KC[(size_t)m * 64 + d0 + d] = (j == 255) ? (bf16_t)0 : f2bf(o[d]);
        } else {
#pragma unroll
          for (int d = 0; d < 8; ++d) a.VCT[((size_t)(bg * 64 + d0 + d) << 8) + j] = (j == 255) ? (bf16_t)0 : f2bf(o[d]);
        }
      }
      __syncthreads();
    }
  }
  SYNC_AFTER(3);
#pragma unroll 1
  for (int rp_ = PH(4) ? a.rep[4] : 0; rp_ > 0; --rp_) {
    for (int lp = pbid >> 3; lp < 32; lp += pnblk >> 3) { TILE_IDS; nsa_main_item(a, ((((((xcd >> 1) & 1) * 2 + half) * 2 + (xcd & 1)) << 6)) | (63 - (2 * lp + (xcd >> 2))), lds, tid, xch, half); }
    { TILE_IDS;
      volatile int* wqw = (volatile int*)(lds + MEGA_LDS - 32);
      (void)wqw;
      int it0 = pbid * 2;
      while (it0 < 1024) {
        ml_out_item(a, a.ml, it0 + half, lds, tid);
        if (wave_s == 0 && lane == 0) xch[2] = 2 * pnblk + atomicAdd(a.WQ, 2);
        __syncthreads();
        it0 = xch[2];
        __syncthreads();
      } }
  }
  SYNC_AFTER(4);
#pragma unroll 1
  for (int rp_ = PH(5) ? a.rep[5] : 0; rp_ > 0; --rp_) {
    bf16_t* const G1 = (bf16_t*)((char*)a.out + 32 * MiB);
    const int xcd = pbid & 7;
    for (int lp = pbid >> 3; lp < 32; lp += pnblk >> 3) {
      const int pm = xcd * 8 + (lp & 7), pn = lp >> 3;
      TILE8_IDS;
      ListSched<MapP5> S8{0, 1, 4, MapP5{a.XB, a.WgT, a.AML, a.ANS, a.WmlT, a.WnsT, pm, pn}}; EpiP5 E8{a.MRG, G1, a.RS1};
      pg8::gemm_phase_vk<EpiP5, ListSched<MapP5>, true, true>((PG8_LAS unsigned char*)plds, pg8::Gemm{DM}, S8, E8, t512, wave_s);
    }
    { TILE_IDS; convert_range(a, a.cv_lo[5], a.cv_hi[5], bid, nblk, lds, tid); }
  }
  SYNC_AFTER(5);
#pragma unroll 1
  for (int rp_ = PH(6) ? a.rep[6] : 0; rp_ > 0; --rp_) {
    TILE_IDS;
    {
      TILE8_IDS;
      ListSched<MapMN> S8{pbid >> 3, pnblk >> 3, 32, MapMN{a.MRG, a.WoutT, DM, xcd}};
      EpiX1 E8{a.XB, a.X1B, a.PS2};
      pg8::gemm_phase<decltype(E8), ListSched<MapMN>, false, true>((PG8_LAS unsigned char*)plds, pg8::Gemm{DM}, S8, E8, t512, wave_s);
    }
    convert_range(a, a.cv_lo[6], a.cv_hi[6], bid, nblk, lds, tid);
  }
  SYNC_AFTER(6);
#pragma unroll 1
  for (int rp_ = PH(7) ? a.rep[7] : 0; rp_ > 0; --rp_) {
    TILE_IDS;
    {
      TILE8_IDS;
      for (int idx = pbid >> 3; idx < 32; idx += pnblk >> 3) {
        __syncthreads();
        if (t512 < 256) {
          const f32x4* pp = (const f32x4*)(a.PS2 + (size_t)((xcd * 8 + (idx & 7)) * 256 + t512) * 32);
          float ss = 0.f;
#pragma unroll
          for (int c = 0; c < 8; ++c) { const f32x4 p = pp[c]; ss += (p[0] + p[1]) + (p[2] + p[3]); }
          ((float*)(plds + 131072))[t512] = rsqrtf(ss * (1.f / DM) + EPS);
        }
        __syncthreads();
        ListSched<MapMN> S8{idx, 1 << 20, 32, MapMN{a.X1B, a.WqT, DM, xcd}};
        EpiXQ E8{a.XQ, (const PG8_LAS float*)(plds + 131072)};
        pg8::gemm_phase<decltype(E8), ListSched<MapMN>, false, true>((PG8_LAS unsigned char*)plds, pg8::Gemm{DM}, S8, E8, t512, wave_s);
      }
    }
    convert_range(a, a.cv_lo[7], a.cv_hi[7], bid, nblk, lds, tid);
  }
  SYNC_AFTER(7);
#pragma unroll 1
  for (int rp_ = PH(8) ? a.rep[8] : 0; rp_ > 0; --rp_) {
    TILE_IDS;
    float* RMX = (float*)lds; float* RSUM = (float*)(lds + 1024);
    for (int q = li; q < 64; q += nloc) {
      const int m0 = (xcd * 16 + (q >> 2)) * 128, hh = q & 3, b = m0 >> 12;
      bf16_t* Qh = a.XQ + hh * 256;
      const bf16_t* Kh = a.KVM + (size_t)(b * 256) * 1024 + hh * 256;
      const bf16_t* Vh = a.KVM + (size_t)1024 * 1024 + ((size_t)(b * 1024 + hh * 256) << 8);
      f32x4 acc0[4][4], acc1[4][4]; zero_acc(acc0); zero_acc(acc1);
      gemm_acc(acc0, Qh, 1024, (const int*)nullptr, 0, 0, Kh, 1024, 256, lds, m0, 0, tid);
      gemm_acc(acc1, Qh, 1024, (const int*)nullptr, 0, 0, Kh, 1024, 256, lds, m0, 128, tid);
      float mloc[4];
#pragma unroll
      for (int mi = 0; mi < 4; ++mi) {
        float mx = -INFINITY;
#pragma unroll
        for (int ni = 0; ni < 4; ++ni)
#pragma unroll
          for (int j = 0; j < 4; ++j) mx = fmaxf(mx, fmaxf(acc0[mi][ni][j], acc1[mi][ni][j]));
        mx = max4(mx); mloc[mi] = mx;
        if (fq == 0) RMX[(wr * 64 + mi * 16 + fr) * 2 + wc] = mx;
      }
      __syncthreads();
#pragma unroll
      for (int mi = 0; mi < 4; ++mi) {
        const int r = wr * 64 + mi * 16 + fr;
        const float m = fmaxf(RMX[r * 2], RMX[r * 2 + 1]); float ls = 0.f;
#pragma unroll
        for (int ni = 0; ni < 4; ++ni)
#pragma unroll
          for (int j = 0; j < 4; ++j) {
            acc0[mi][ni][j] = __expf((acc0[mi][ni][j] - m) * 0.0625f); acc1[mi][ni][j] = __expf((acc1[mi][ni][j] - m) * 0.0625f);
            ls += acc0[mi][ni][j] + acc1[mi][ni][j];
          }
        ls = red4(ls);
        if (fq == 0) RSUM[r * 2 + wc] = ls;
      }
      __syncthreads();
#pragma unroll
      for (int mi = 0; mi < 4; ++mi) {
        const int r = wr * 64 + mi * 16 + fr;
        const float inv = 1.f / (RSUM[r * 2] + RSUM[r * 2 + 1]);
        bf16_t* pr = Qh + (size_t)(m0 + r) * 1024 + wc * 64 + 4 * fq;
#pragma unroll
        for (int ni = 0; ni < 4; ++ni) { st_bf4(pr + ni * 16, acc0[mi][ni] * inv); st_bf4(pr + 128 + ni * 16, acc1[mi][ni] * inv); }
      }
      asm volatile("s_waitcnt vmcnt(0)" ::: "memory");
      __threadfence_block();
      __syncthreads();
#pragma unroll 1
      for (int dh = 0; dh < 2; ++dh) {
        zero_acc(acc0);
        gemm_acc(acc0, Qh, 1024, (const int*)nullptr, 0, 0, Vh, 256, 256, lds, m0, dh * 128, tid);
#pragma unroll
        for (int mi = 0; mi < 4; ++mi) {
          const int r = wr * 64 + mi * 16 + fr;
#pragma unroll
          for (int ni = 0; ni < 4; ++ni) st_bf4(a.XO + (size_t)(m0 + r) * 1024 + hh * 256 + dh * 128 + wc * 64 + ni * 16 + 4 * fq, acc0[mi][ni]);
        }
      }
    }
    convert_range(a, a.cv_lo[8], a.cv_hi[8], bid, nblk, lds, tid);
  }
  SYNC_AFTER(8);
#pragma unroll 1
  for (int rp_ = PH(9) ? a.rep[9] : 0; rp_ > 0; --rp_) {
    TILE_IDS;
    {
      TILE8_IDS;
      ListSched<MapMN> S8{pbid >> 3, pnblk >> 3, 32, MapMN{a.XO, a.WoT, DM, xcd}};
      EpiX2 E8{a.X1B};
      pg8::gemm_phase<decltype(E8), ListSched<MapMN>, false, true>((PG8_LAS unsigned char*)plds, pg8::Gemm{DM}, S8, E8, t512, wave_s);
    }
    convert_range(a, a.cv_lo[9], a.cv_hi[9], bid, nblk, lds, tid);
  }
  SYNC_AFTER(9);
#pragma unroll 1
  for (int rp_ = PH(10) ? a.rep[10] : 0; rp_ > 0; --rp_) {
    TILE_IDS;
    const int tpb = NTOK / nblk;
    int* ex_l = (int*)(lds + 65536);
    float* we_l = (float*)lds;
    for (int c = tid; c < 4096; c += 256) { const int k = c >> 2, q = c & 3; *(f32x4*)(we_l + (q * 1024 + k) * 4) = *(const f32x4*)(a.we + k * 16 + q * 4); }
    __syncthreads();
    for (int k = 0; k < tpb / 4; ++k) {
      const int tl = wid * (tpb / 4) + k, n = bid * tpb + tl;
      int lane = tid & 63; asm volatile("" : "+v"(lane));
      const bf16_t* xr = a.H3 + (size_t)n * DM;
      float v[16]; float s = 0.f;
#pragma unroll
      for (int i = 0; i < 16; ++i) { v[i] = bf2f(xr[lane + 64 * i]); s += v[i] * v[i]; }
      s = wave_sum(s);
      const float rs = rsqrtf(s * (1.f / DM) + EPS);
      float lg[4] = {0.f, 0.f, 0.f, 0.f};
#pragma unroll
      for (int i = 0; i < 16; ++i) {
        const int k2 = lane + 64 * i; const float hk = v[i] * rs * a.g_ffn[k2]; v[i] = hk;
        const f32x4 wgv = *(const f32x4*)(a.wg + k2 * 4);
#pragma unroll
        for (int e = 0; e < 4; ++e) lg[e] += hk * wgv[e];
      }
#pragma unroll
      for (int e = 0; e < 4; ++e) lg[e] = wave_sum(lg[e]);
      float gl[4]; float gm = -INFINITY; int gi = 0;
#pragma unroll
      for (int e = 0; e < 4; ++e) { gl[e] = lg[e] + a.bg[e]; if (gl[e] > gm) { gm = gl[e]; gi = e; } }
      gi = __builtin_amdgcn_readfirstlane(gi);
      float el[4] = {0.f, 0.f, 0.f, 0.f};
#pragma unroll
      for (int i = 0; i < 16; ++i) {
        const f32x4 wv = *(const f32x4*)(we_l + (gi * 1024 + lane + 64 * i) * 4);
#pragma unroll
        for (int e = 0; e < 4; ++e) el[e] += v[i] * wv[e];
      }
#pragma unroll
      for (int e = 0; e < 4; ++e) el[e] = wave_sum(el[e]) + a.be[gi * 4 + e];
      if (lane == 0) {
        float gs = 0.f;
#pragma unroll
        for (int e = 0; e < 4; ++e) gs += __expf(gl[e] - gm);
        const float gval = 1.f / gs;
        int i0 = 0; float v0 = el[0];
#pragma unroll
        for (int e = 1; e < 4; ++e) if (el[e] > v0) { v0 = el[e]; i0 = e; }
        int i1 = -1; float v1 = -INFINITY;
#pragma unroll
        for (int e = 0; e < 4; ++e) if (e != i0 && el[e] > v1) { v1 = el[e]; i1 = e; }
        const float e1 = __expf(v1 - v0);
        ex_l[tl * 2] = gi * 4 + i0; ex_l[tl * 2 + 1] = gi * 4 + i1;
        a.RTW[n * 2] = gval / (1.f + e1); a.RTW[n * 2 + 1] = gval * e1 / (1.f + e1);
        a.RS3[n] = rs;
      }
    }
    __syncthreads();
    if (tid < 16) {
      int cnt = 0;
      for (int j = 0; j < 2 * tpb; ++j) cnt += (ex_l[j] == tid) ? 1 : 0;
      if (cnt > 0) {
        int pos = atomicAdd(&a.CNT[tid], cnt);
        for (int j = 0; j < 2 * tpb; ++j) if (ex_l[j] == tid) a.LIST[tid * NTOK + pos++] = (bid * tpb) * 2 + j;
      }
    }
    __syncthreads();
  }
  SYNC_AFTER(10);
#pragma unroll 1
  for (int rp_ = PH(11) ? a.rep[11] : 0; rp_ > 0; --rp_) {
    TILE8_IDS;
    int rtot = 0;
    for (int e = 0; e < 16; ++e) rtot += (a.CNT[e] + 255) >> 8;
    const int n1 = ((rtot - xcd + 7) >> 3) * 4;
    const int li8 = pbid >> 3, L8 = pnblk >> 3;
    unsigned* const DEP = (unsigned*)a.CNT + 1024;
    {
      MoeUpSched S8{li8, L8, n1, MapMoe{a.CNT, a.LIST, a.H3, a.W13T, (size_t)1024 * 1024, DM, xcd, 1}, DEP, wave_s == 0};
      EpiMoe1 E8{a.LIST, a.RS3, a.ACT};
      pg8::gemm_phase<EpiMoe1, MoeUpSched, true, true>((PG8_LAS unsigned char*)plds, pg8::Gemm{DM}, S8, E8, t512, wave_s);
    }
    {
      const int r = n1 % L8, fp = r ? min(n1, 2 * (L8 - r)) : 0;
      const int nfirst = (r && li8 >= r) ? max(0, min(2, n1 - 2 * (li8 - r))) : 0;
      MoeDownSched S8{li8, L8, n1, r, fp, nfirst, MapMoe{a.CNT, a.LIST, a.ACT, a.W2T, (size_t)1024 * 512, 512, xcd, 0}, DEP, wave_s == 0};
      EpiMoe2 E8{a.LIST, a.RTW, a.Y};
      { pg8::Unit u0; if (S8.next(0, u0)) S8.a_ready(u0); }
      __syncthreads();
      pg8::gemm_phase<EpiMoe2, MoeDownSched, true, true, true>((PG8_LAS unsigned char*)plds, pg8::Gemm{512}, S8, E8, t512, wave_s);
    }
  }
  if (PH(11) && PH(13)) GRID_BAR();
#pragma unroll 1
  for (int rp_ = PH(13) ? a.rep[13] : 0; rp_ > 0; --rp_) {
    TILE_IDS;
    for (int row = bid * 4 + wid; row < NTOK; row += nblk * 4) {
      f32x4* xr = (f32x4*)(a.out + (size_t)row * DM) + lane;
      const u32x2* x2r = (const u32x2*)(a.H3 + (size_t)row * DM) + lane;
      const u32x2* y0 = (const u32x2*)(a.Y + (size_t)(row * 2) * DM) + lane; const u32x2* y1 = y0 + DM / 4;
      f32x4 v[4]; float s = 0.f;
#pragma unroll
      for (int j = 0; j < 4; ++j) {
        { const u32x2 xx = __builtin_nontemporal_load(x2r + 64 * j); v[j][0] = __uint_as_float(xx.x << 16); v[j][1] = __uint_as_float(xx.x & 0xffff0000u); v[j][2] = __uint_as_float(xx.y << 16); v[j][3] = __uint_as_float(xx.y & 0xffff0000u); }
        const u32x2 p = __builtin_nontemporal_load(y0 + 64 * j), q = __builtin_nontemporal_load(y1 + 64 * j);
        v[j][0] += __uint_as_float(p.x << 16) + __uint_as_float(q.x << 16); v[j][1] += __uint_as_float(p.x & 0xffff0000u) + __uint_as_float(q.x & 0xffff0000u);
        v[j][2] += __uint_as_float(p.y << 16) + __uint_as_float(q.y << 16); v[j][3] += __uint_as_float(p.y & 0xffff0000u) + __uint_as_float(q.y & 0xffff0000u);
        s += v[j][0] * v[j][0] + v[j][1] * v[j][1] + v[j][2] * v[j][2] + v[j][3] * v[j][3];
      }
      s = wave_sum(s);
      const float rs = rsqrtf(s * (1.f / DM) + EPS);
#pragma unroll
      for (int j = 0; j < 4; ++j) __builtin_nontemporal_store(v[j] * rs * ((const f32x4*)a.g_final)[lane + 64 * j], xr + 64 * j);
    }
  }
}

extern "C" void kernel_launch(void* const* d_in, const int* in_sizes, int n_in, void* d_out, int out_size, void* d_ws, size_t ws_size, hipStream_t stream) {
  const float* x = (const float*)d_in[0];
  const float* mem = (const float*)d_in[1];
  const float* norm_mix = (const float*)d_in[2];
  const float* w_in = (const float*)d_in[3];
  const float* conv_qk = (const float*)d_in[4];
  const float* b_igate = (const float*)d_in[5];
  const float* b_fgate = (const float*)d_in[6];
  const float* mlstm_norm = (const float*)d_in[7];
  const float* cmp_pos_k = (const float*)d_in[8];
  const float* cmp_pos_v = (const float*)d_in[9];
  const float* cmp_k_w1 = (const float*)d_in[10];
  const float* cmp_k_w2 = (const float*)d_in[11];
  const float* cmp_v_w1 = (const float*)d_in[12];
  const float* cmp_v_w2 = (const float*)d_in[13];
  const float* w_br_mlstm = (const float*)d_in[14];
  const float* w_br_nsa = (const float*)d_in[15];
  const float* w_mix_out = (const float*)d_in[16];
  const float* norm_xattn = (const float*)d_in[17];
  const float* norm_mem = (const float*)d_in[18];
  const float* xa_wq = (const float*)d_in[19];
  const float* xa_wkv = (const float*)d_in[20];
  const float* xa_wo = (const float*)d_in[21];
  const float* norm_ffn = (const float*)d_in[22];
  const float* router_group_w = (const float*)d_in[23];
  const float* router_group_b = (const float*)d_in[24];
  const float* router_expert_w = (const float*)d_in[25];
  const float* router_expert_b = (const float*)d_in[26];
  const float* moe_w1 = (const float*)d_in[27];
  const float* moe_w3 = (const float*)d_in[28];
  const float* moe_w2 = (const float*)d_in[29];
  const float* norm_final = (const float*)d_in[30];
  float* out = (float*)d_out;
  char* ws = (char*)d_ws;

  int* CNT = (int*)(ws + WS_CNT); int* LIST = (int*)(ws + WS_LIST); float* RTW = (float*)(ws + WS_RTW);
  float* SM = (float*)(ws + WS_SM); float* BCUM = (float*)(ws + WS_BCUM); float* IP = (float*)(ws + WS_IP);
  float* BL = (float*)(ws + WS_BL); float* MX = (float*)(ws + WS_MX); float* MST = (float*)(ws + WS_MST); float* NST = (float*)(ws + WS_NST);
  bf16_t* KC = (bf16_t*)(ws + WS_KC); bf16_t* VC = (bf16_t*)(ws + WS_VC);
  bf16_t* QK = (bf16_t*)(ws + WS_QK); bf16_t* V = (bf16_t*)(ws + WS_V); bf16_t* O = (bf16_t*)(ws + WS_O);
  bf16_t* NQ = (bf16_t*)(ws + WS_NQ); bf16_t* KV = (bf16_t*)(ws + WS_KV); bf16_t* CST = (bf16_t*)(ws + WS_CST);
  bf16_t* AML = (bf16_t*)(ws + WS_AML); bf16_t* ANS = (bf16_t*)(ws + WS_ANS); bf16_t* MRG = (bf16_t*)(ws + WS_MRG);
  bf16_t* KVM = (bf16_t*)(ws + WS_KVM); bf16_t* MEMN = (bf16_t*)(ws + WS_MEMN);
  bf16_t* H2 = (bf16_t*)(ws + WS_H2); bf16_t* XQ = (bf16_t*)(ws + WS_XQ); bf16_t* XO = (bf16_t*)(ws + WS_XO);
  bf16_t* H3 = H2; bf16_t* ACT = XQ; bf16_t* Y = (bf16_t*)(ws + 136 * MiB);
  bf16_t* H = (bf16_t*)d_out;
  bf16_t* T2 = (bf16_t*)((char*)d_out + 32 * MiB);

  (void)hipMemsetAsync(ws, 0, 131072, stream);
  static int grid_blocks = 0;
  if (!grid_blocks) {
    int dev = 0, cus = 0, per_cu = 0;
    (void)hipGetDevice(&dev);
    (void)hipDeviceGetAttribute(&cus, hipDeviceAttributeMultiprocessorCount, dev);
    (void)hipFuncSetAttribute((const void*)k_mega, hipFuncAttributeMaxDynamicSharedMemorySize, TOTAL_LDS);
    (void)hipOccupancyMaxActiveBlocksPerMultiprocessor(&per_cu, (const void*)k_mega, 512, TOTAL_LDS);
    if (per_cu > 1) per_cu = 1;
    if (per_cu < 1) per_cu = 1;
    grid_blocks = cus * per_cu;
  }
  MegaArgs fa{};
  fa.x = x; fa.mem = mem; fa.out = out; fa.BAR = (unsigned*)(ws + 65536);
  fa.ml.conv = conv_qk; fa.ml.b_i = b_igate; fa.ml.b_f = b_fgate; fa.ml.gain = mlstm_norm;
  fa.ml.BCUM = BCUM; fa.ml.IP = IP; fa.ml.BL = BL; fa.ml.MX = MX; fa.ml.MST = MST; fa.ml.NST = NST; fa.ml.CST = CST;
  fa.XB = (bf16_t*)d_out; fa.MEMB = (bf16_t*)(ws + WS_MEMB); fa.RS1 = (float*)(ws + WS_RS1); fa.RSM = (float*)(ws + WS_RSM); fa.PS2 = (float*)(ws + WS_PS2);
  fa.QK = QK; fa.V = V; fa.O = O; fa.NQ = NQ; fa.SM = SM;
  fa.KVC = (bf16_t*)(ws + WS_KVC); fa.KS = (bf16_t*)(ws + WS_KS); fa.KW = (bf16_t*)(ws + WS_KW); fa.VST = (bf16_t*)(ws + WS_VST); fa.VWT = (bf16_t*)(ws + WS_VWT);
  fa.KC = KC; fa.VCT = VC; fa.CK1T = (bf16_t*)(ws + WS_CK1T); fa.CV1T = (bf16_t*)(ws + WS_CV1T); fa.POSW = (float*)(ws + WS_POSW);
  fa.posk = cmp_pos_k; fa.posv = cmp_pos_v; fa.ckw1 = cmp_k_w1; fa.cvw1 = cmp_v_w1; fa.ckw2 = cmp_k_w2; fa.cvw2 = cmp_v_w2;
  fa.AML = AML; fa.ANS = ANS; fa.MRG = MRG; fa.X1B = H2; fa.XQ = XQ; fa.XO = XO; fa.KVM = KVM;
  fa.WinT = (bf16_t*)(ws + WS_WIN_T); fa.WgT = (bf16_t*)(ws + WS_WG_T); fa.WmlT = (bf16_t*)(ws + WS_WML_T); fa.WnsT = (bf16_t*)(ws + WS_WNS_T);
  fa.H3 = H3; fa.ACT = ACT; fa.Y = Y; fa.W13T = (bf16_t*)(ws + 104 * MiB); fa.W2T = (bf16_t*)(ws + 240 * MiB);
  fa.CPART = (float*)(ws + 176 * MiB); fa.WQ = (int*)(ws + 256);
  fa.RS3 = (float*)(ws + WS_RSM + 8192); fa.RTW = RTW; fa.CNT = CNT; fa.LIST = LIST;
  fa.g_ffn = norm_ffn; fa.wg = router_group_w; fa.bg = router_group_b; fa.we = router_expert_w; fa.be = router_expert_b; fa.g_final = norm_final;
  fa.WoutT = (bf16_t*)(ws + WS_WOUT_T); fa.WqT = (bf16_t*)(ws + WS_WQ_T); fa.WkvT = (bf16_t*)(ws + WS_WKV_T); fa.WoT = (bf16_t*)(ws + WS_WO_T);
  {
    auto mk = [&](const float* src, bf16_t* dst, const float* gain, int ldw, int K, int c0, int ncols, int drow0) {
      TDesc d{}; d.src = src; d.dst = dst; d.gain = gain; d.ldw = ldw; d.K = K; d.c0 = c0; d.ncols = ncols; d.drow0 = drow0; d.per = (K / 64) * ((ncols + 63) / 64); d.nitems = d.per; d.mode = 0; d.rofs = 0; d.sstride = 0; d.dstride = 0; d.pad = 0; return d; };
    int n = 0;
    fa.td[n++] = mk(w_in, fa.WinT, norm_mix, DIN, DM, 0, 2048, 0);
    fa.td[n++] = mk(w_in, fa.WinT, norm_mix, DIN, DM, 2056, 512, 2048);
    fa.td[n++] = mk(w_in, fa.WinT, norm_mix, DIN, DM, 2568, 384, 2560);
    fa.td[n++] = mk(w_in, fa.WinT, norm_mix, DIN, DM, 3080, 128, 2944);
    fa.td[n++] = mk(w_in, fa.WinT, norm_mix, DIN, DM, 2952, 128, 3072);
    fa.td[n++] = mk(w_in, fa.WinT, norm_mix, DIN, DM, 3208, 128, 3200);
    fa.td[n++] = mk(w_in, fa.WinT, norm_mix, DIN, DM, 2048, 8, 3328);
    fa.td[n++] = mk(w_in, fa.WinT, norm_mix, DIN, DM, 3336, 24, 3336);
    fa.td[n++] = mk(w_in, fa.WgT, norm_mix, DIN, DM, 3360, 2048, 0);
    fa.td[n++] = mk(w_br_mlstm, fa.WmlT, nullptr, 1024, 512, 0, 1024, 0);
    fa.td[n++] = mk(w_br_nsa, fa.WnsT, nullptr, 1024, 512, 0, 1024, 0);
    fa.td[n++] = mk(w_mix_out, fa.WoutT, nullptr, 1024, 1024, 0, 1024, 0);
    fa.td[n++] = mk(xa_wq, fa.WqT, norm_xattn, 1024, 1024, 0, 1024, 0);
    fa.td[n++] = mk(xa_wkv, fa.WkvT, norm_mem, 2048, 1024, 0, 2048, 0);
    fa.td[n++] = mk(xa_wo, fa.WoT, nullptr, 1024, 1024, 0, 1024, 0);
    fa.td[n++] = mk(cmp_k_w1, fa.CK1T, nullptr, 128, 2048, 0, 128, 0);
    fa.td[n++] = mk(cmp_v_w1, fa.CV1T, nullptr, 128, 2048, 0, 128, 0);
    fa.ntdA = n;
    { TDesc d = mk(moe_w1, fa.W13T, norm_ffn, 512, 1024, 0, 512, 0); d.mode = 2; d.rofs = 0; d.nitems = 16 * d.per; d.sstride = 1024 * 512; d.dstride = 1024 * 1024; fa.td[n++] = d; }
    { TDesc d = mk(moe_w3, fa.W13T, norm_ffn, 512, 1024, 0, 512, 0); d.mode = 2; d.rofs = 16; d.nitems = 16 * d.per; d.sstride = 1024 * 512; d.dstride = 1024 * 1024; fa.td[n++] = d; }
    { TDesc d = mk(moe_w2, fa.W2T, nullptr, 1024, 512, 0, 1024, 0); d.nitems = 16 * d.per; d.sstride = 512 * 1024; d.dstride = 1024 * 512; fa.td[n++] = d; }
    fa.ntdB = n;
    int cum[25]; cum[0] = 0; for (int i = 0; i < n; ++i) cum[i + 1] = cum[i] + fa.td[i].nitems;
    for (int k = 0; k < 16; ++k) { fa.cv_lo[k] = 0; fa.cv_hi[k] = 0; }
    fa.cv_lo[0] = 0; fa.cv_hi[0] = cum[8];
    fa.cv_lo[1] = cum[8]; fa.cv_hi[1] = cum[fa.ntdA];
    { const int lo = cum[fa.ntdA], tot = cum[n] - lo; const int phs[5] = {5, 6, 7, 8, 9};
      for (int i = 0; i < 5; ++i) { fa.cv_lo[phs[i]] = lo + (int)((long long)tot * i / 5); fa.cv_hi[phs[i]] = lo + (int)((long long)tot * (i + 1) / 5); } }
  }
  int launch_i = 0;
  auto mega = [&](int lo, int hi) {
    fa.ph_lo = lo; fa.ph_hi = hi; fa.li = launch_i++; fa.pad = 0;
    for (int k = 0; k < 16; ++k) fa.rep[k] = 1;

    void* args[] = {&fa};
    (void)hipLaunchCooperativeKernel((const void*)k_mega, dim3(grid_blocks), dim3(512), args, TOTAL_LDS, stream);
  };
  mega(0, 14);
}
```
